# Optimizing an MI355X kernel written in HIP

```python
import math, functools
import jax, jax.numpy as jnp
from jax import lax
import numpy as np

D_MODEL = 2048
BATCH = 2
SEQ = 8192
DEPTH = 1
DEC_BATCH = 128
DEC_SEQ = 4
PAST_LEN = 16384
PAGE_SIZE = 128

N_BRANCH = 3
BR_W = 1024
GDN_H = 8
GDN_DK = 128
GDN_DV = 128
GDN_QK = GDN_H * GDN_DK
GDN_W = GDN_H * GDN_DV
GDN_CONV_CH = 2 * GDN_QK + GDN_W
CONV_W = 4
GDN_CHUNK = 64
SWA_H = 16
SWA_KV = 2
SWA_G = SWA_H // SWA_KV
SWA_DH = 64
SWA_QW = SWA_H * SWA_DH
SWA_KVW = SWA_KV * SWA_DH
WINDOW = 128
N_BUCKETS = 32
MAX_DISTANCE = 128
N_MEM = 256
MEM_H = 4
MEM_DH = 256
MEM_W = MEM_H * MEM_DH
NORM_EPS = 1e-6
IN_SIZES = (GDN_QK, GDN_QK, GDN_W, GDN_W, GDN_H, GDN_H,
            SWA_QW, SWA_KVW, SWA_KVW, SWA_QW,
            MEM_W, MEM_W,
            N_BRANCH * D_MODEL)
IN_COLS = sum(IN_SIZES)

kernel_name = 'gdn_swa_sink_memxattn_gated_hybrid_step'


def rmsnorm(x, w):
    xf = x.astype(jnp.float32)
    y = xf * lax.rsqrt(jnp.mean(xf * xf, axis=-1, keepdims=True) + NORM_EPS)
    return (y * w.astype(jnp.float32)).astype(x.dtype)


def l2norm(x):
    return x * lax.rsqrt(jnp.sum(x * x, axis=-1, keepdims=True) + NORM_EPS)


def t5_bucket(dist):
    n = jnp.maximum(dist, 0)
    max_exact = N_BUCKETS // 2
    nf = jnp.maximum(n, 1).astype(jnp.float32)
    large = max_exact + (jnp.log(nf / max_exact) / math.log(MAX_DISTANCE / max_exact)
                         * (N_BUCKETS - max_exact)).astype(jnp.int32)
    large = jnp.minimum(large, N_BUCKETS - 1)
    return jnp.where(n < max_exact, n, large)


def rel_bias_logits(dist, table):
    bias = table.astype(jnp.float32)[t5_bucket(dist)]
    return jnp.moveaxis(bias, -1, 0).reshape(SWA_KV, SWA_G, dist.shape[0], dist.shape[1])


def sink_softmax(logits, sink):
    m = jnp.maximum(jnp.max(logits, axis=-1, keepdims=True), sink)
    p = jnp.exp(logits - m)
    return p / (jnp.sum(p, axis=-1, keepdims=True) + jnp.exp(sink - m))


def causal_conv(x, prefix, w):
    L = x.shape[1]
    xp = jnp.concatenate([prefix.astype(x.dtype), x], axis=1)
    y = sum(xp[:, j:j + L] * w[j] for j in range(CONV_W))
    return y, xp[:, xp.shape[1] - (CONV_W - 1):]


def gated_delta_chunked(q, k, v, g, beta, s0):
    B, L, H, dk = q.shape
    dv = v.shape[-1]
    C = math.gcd(L, GDN_CHUNK)
    N = L // C

    def blocks(t):
        return jnp.moveaxis(t.reshape(B, N, C, H, -1), 3, 1)

    q, k, v = blocks(q), blocks(k), blocks(v)
    g = blocks(g[..., None])[..., 0]
    beta = blocks(beta[..., None])[..., 0]
    gc = jnp.cumsum(g, axis=-1)
    idx = jnp.arange(C)
    causal = idx[:, None] >= idx[None, :]
    decay = jnp.exp(jnp.where(causal, gc[..., :, None] - gc[..., None, :], -jnp.inf))
    k_beta = k * beta[..., None]
    a_strict = jnp.where(idx[:, None] > idx[None, :],
                         jnp.einsum('bhncd,bhnsd->bhncs', k_beta, k) * decay, 0.0)
    rhs = jnp.concatenate([v * beta[..., None], k_beta * jnp.exp(gc)[..., None]], axis=-1)
    sol = lax.linalg.triangular_solve(a_strict + jnp.eye(C, dtype=a_strict.dtype), rhs,
                                      left_side=True, lower=True, unit_diagonal=True)
    u, w = sol[..., :dv], sol[..., dv:]
    att = jnp.einsum('bhncd,bhnsd->bhncs', q, k) * decay
    q_dec = q * jnp.exp(gc)[..., None]
    k_tail = k * jnp.exp(gc[..., -1:] - gc)[..., None]
    g_tot = jnp.exp(gc[..., -1])

    def step(S, inp):
        qd, kt, uu, ww, aa, gt = inp
        v_new = uu - jnp.einsum('bhcd,bhde->bhce', ww, S)
        o = jnp.einsum('bhcd,bhde->bhce', qd, S) + jnp.einsum('bhcs,bhse->bhce', aa, v_new)
        S = S * gt[..., None, None] + jnp.einsum('bhcd,bhce->bhde', kt, v_new)
        return S, o

    xs = tuple(jnp.moveaxis(t, 2, 0) for t in (q_dec, k_tail, u, w, att, g_tot))
    s_fin, o = lax.scan(step, s0, xs)
    o = jnp.moveaxis(jnp.moveaxis(o, 0, 2), 1, 3).reshape(B, L, H, dv)
    return o, s_fin


def gdn_branch(gq, gk, gv, gz, gb, ga, conv_prefix, s0, conv_w, a_log, dt_bias, norm_w):
    B, L, _ = gq.shape
    qkv = jnp.concatenate([gq, gk, gv], axis=-1)
    conv, conv_new = causal_conv(qkv, conv_prefix, conv_w)
    conv = jax.nn.silu(conv.astype(jnp.float32))
    q = conv[..., :GDN_QK].reshape(B, L, GDN_H, GDN_DK)
    k = conv[..., GDN_QK:2 * GDN_QK].reshape(B, L, GDN_H, GDN_DK)
    v = conv[..., 2 * GDN_QK:].reshape(B, L, GDN_H, GDN_DV)
    q = l2norm(q) * (GDN_DK ** -0.5)
    k = l2norm(k)
    beta = jax.nn.sigmoid(gb.astype(jnp.float32))
    g = -jnp.exp(a_log.astype(jnp.float32)) * jax.nn.softplus(
        ga.astype(jnp.float32) + dt_bias.astype(jnp.float32))
    o, s_new = gated_delta_chunked(q, k, v, g, beta, s0.astype(jnp.float32))
    o = o * lax.rsqrt(jnp.mean(o * o, axis=-1, keepdims=True) + NORM_EPS) * norm_w.astype(jnp.float32)
    o = o * jax.nn.silu(gz.astype(jnp.float32).reshape(B, L, GDN_H, GDN_DV))
    return o.reshape(B, L, GDN_W).astype(gq.dtype), s_new.astype(s0.dtype), conv_new


def swa_prompt(q, k, v, sinks, table):
    B, L, _, _ = q.shape
    nb = L // WINDOW
    qb = q.reshape(B, nb, WINDOW, SWA_KV, SWA_G, SWA_DH)

    def with_prev(t):
        tb = t.reshape(B, nb, WINDOW, SWA_KV, SWA_DH)
        prev = jnp.pad(tb, ((0, 0), (1, 0), (0, 0), (0, 0), (0, 0)))[:, :-1]
        return jnp.concatenate([prev, tb], axis=2)

    kk, vv = with_prev(k), with_prev(v)
    qi = jnp.arange(WINDOW)[:, None] + WINDOW
    sj = jnp.arange(2 * WINDOW)[None, :]
    dist = qi - sj
    valid = (dist >= 0) & (dist < WINDOW)
    mask = valid[None] & ((jnp.arange(nb)[:, None, None] > 0) | (sj[None] >= WINDOW))
    logits = jnp.einsum('bnqkgd,bnskd->bnkgqs', qb, kk, preferred_element_type=jnp.float32)
    logits = logits * (SWA_DH ** -0.5) + rel_bias_logits(dist, table)
    logits = jnp.where(mask[None, :, None, None], logits, -jnp.inf)
    probs = sink_softmax(logits, sinks.astype(jnp.float32).reshape(SWA_KV, SWA_G, 1, 1))
    o = jnp.einsum('bnkgqs,bnskd->bnqkgd', probs.astype(v.dtype), vv)
    return o.reshape(B, L, SWA_QW), k[:, L - WINDOW:], v[:, L - WINDOW:]


def swa_sample(q, k, v, sinks, table, cache_k, cache_v):
    Bd, S, _, _ = q.shape
    Wb = cache_k.shape[1]
    kk = jnp.concatenate([cache_k.astype(k.dtype), k], axis=1)
    vv = jnp.concatenate([cache_v.astype(v.dtype), v], axis=1)
    dist = (Wb + jnp.arange(S))[:, None] - jnp.arange(Wb + S)[None, :]
    valid = (dist >= 0) & (dist < WINDOW)
    qg = q.reshape(Bd, S, SWA_KV, SWA_G, SWA_DH)
    logits = jnp.einsum('bqkgd,bskd->bkgqs', qg, kk, preferred_element_type=jnp.float32)
    logits = logits * (SWA_DH ** -0.5) + rel_bias_logits(dist, table)
    logits = jnp.where(valid, logits, -jnp.inf)
    probs = sink_softmax(logits, sinks.astype(jnp.float32).reshape(SWA_KV, SWA_G, 1, 1))
    o = jnp.einsum('bkgqs,bskd->bqkgd', probs.astype(v.dtype), vv)
    return o.reshape(Bd, S, SWA_QW), kk[:, S:], vv[:, S:]


def mem_kv(mem, norm_w, w_kv):
    B, M, _ = mem.shape
    kv = jnp.einsum('bmd,de->bme', rmsnorm(mem, norm_w), w_kv)
    return (kv[..., :MEM_W].reshape(B, M, MEM_H, MEM_DH),
            kv[..., MEM_W:].reshape(B, M, MEM_H, MEM_DH))


def mem_attend(q, mk, mv):
    B, L, _ = q.shape
    qh = q.reshape(B, L, MEM_H, MEM_DH)
    logits = jnp.einsum('blhd,bmhd->bhlm', qh, mk.astype(q.dtype),
                        preferred_element_type=jnp.float32) * (MEM_DH ** -0.5)
    probs = jax.nn.softmax(logits, axis=-1)
    o = jnp.einsum('bhlm,bmhd->blhd', probs.astype(q.dtype), mv.astype(q.dtype))
    return o.reshape(B, L, MEM_W)


def trunk_layer(x, conv_prefix, s0, swa_fn, mem_k, mem_v, norm_in, w_in, conv_w, a_log,
                dt_bias, gdn_norm, sinks, rel_table, w_branch, w_out):
    B, L, _ = x.shape
    xn = rmsnorm(x, norm_in)
    proj = jnp.einsum('bld,de->ble', xn, w_in)
    cuts = np.cumsum(IN_SIZES)[:-1].tolist()
    (gq, gk, gv, gz, gb, ga, sq, sk, sv, sz, mq, mz, mg) = jnp.split(proj, cuts, axis=-1)
    o_gdn, s_new, conv_new = gdn_branch(gq, gk, gv, gz, gb, ga, conv_prefix, s0,
                                        conv_w, a_log, dt_bias, gdn_norm)
    o_swa, k_win, v_win = swa_fn(sq.reshape(B, L, SWA_H, SWA_DH),
                                 sk.reshape(B, L, SWA_KV, SWA_DH),
                                 sv.reshape(B, L, SWA_KV, SWA_DH), sinks, rel_table)
    o_swa = o_swa * jax.nn.silu(sz)
    o_mem = mem_attend(mq, mem_k, mem_v) * jax.nn.silu(mz)
    gates = jax.nn.sigmoid(mg.astype(jnp.float32)).astype(x.dtype).reshape(B, L, N_BRANCH, D_MODEL)
    merged = sum(gates[:, :, n] * jnp.einsum('blc,cd->bld', o_n, w_branch[n])
                 for n, o_n in enumerate((o_gdn, o_swa, o_mem)))
    y = x + jnp.einsum('bld,de->ble', merged, w_out)
    return y, s_new, conv_new, k_win, v_win


def setup_inputs(seed: int = 0) -> dict:
    key = jax.random.key(seed)
    ks = jax.random.split(key, 24)
    f32 = jnp.float32

    def nrm(k, shape, scale):
        return jax.random.normal(k, shape, f32) * scale

    swa_buf = min(WINDOW, PAST_LEN)
    a_init = jax.random.uniform(ks[12], (DEPTH, GDN_H), f32, 1.0, 16.0)
    dt = jnp.exp(jax.random.uniform(ks[13], (DEPTH, GDN_H), f32, math.log(1e-3), math.log(1e-1)))
    return {
        'x_prompt': nrm(ks[0], (BATCH, SEQ, D_MODEL), 1.0),
        'x_sample': nrm(ks[1], (DEC_BATCH, DEC_SEQ, D_MODEL), 1.0),
        'state_gdn': nrm(ks[2], (DEPTH, DEC_BATCH, GDN_H, GDN_DK, GDN_DV), 0.3),
        'state_gdn_conv': nrm(ks[3], (DEPTH, DEC_BATCH, CONV_W - 1, GDN_CONV_CH), 1.0),
        'cache_swa_k': nrm(ks[4], (DEPTH, DEC_BATCH, swa_buf, SWA_KV, SWA_DH), 1.0),
        'cache_swa_v': nrm(ks[5], (DEPTH, DEC_BATCH, swa_buf, SWA_KV, SWA_DH), 1.0),
        'cache_mem_k': nrm(ks[6], (DEPTH, DEC_BATCH, N_MEM, MEM_H, MEM_DH), 1.0),
        'cache_mem_v': nrm(ks[7], (DEPTH, DEC_BATCH, N_MEM, MEM_H, MEM_DH), 1.0),
        'mem_prompt': nrm(ks[8], (BATCH, N_MEM, D_MODEL), 1.0),
        'norm_in': 1.0 + nrm(ks[9], (DEPTH, D_MODEL), 0.02),
        'w_in': nrm(ks[10], (DEPTH, D_MODEL, IN_COLS), D_MODEL ** -0.5),
        'gdn_conv_w': nrm(ks[11], (DEPTH, CONV_W, GDN_CONV_CH), CONV_W ** -0.5),
        'gdn_a_log': jnp.log(a_init),
        'gdn_dt_bias': dt + jnp.log(-jnp.expm1(-dt)),
        'gdn_norm': 1.0 + nrm(ks[14], (DEPTH, GDN_DV), 0.02),
        'swa_sinks': nrm(ks[15], (DEPTH, SWA_H), 0.5),
        'rel_bias': nrm(ks[16], (N_BUCKETS, SWA_H), 0.5),
        'norm_mem': 1.0 + nrm(ks[17], (DEPTH, D_MODEL), 0.02),
        'w_mem_kv': nrm(ks[18], (DEPTH, D_MODEL, 2 * MEM_W), D_MODEL ** -0.5),
        'w_branch': nrm(ks[19], (DEPTH, N_BRANCH, BR_W, D_MODEL), BR_W ** -0.5),
        'w_out': nrm(ks[20], (DEPTH, D_MODEL, D_MODEL), D_MODEL ** -0.5),
        'norm_f': 1.0 + nrm(ks[21], (D_MODEL,), 0.02),
    }


def reference(x_prompt, x_sample, state_gdn, state_gdn_conv, cache_swa_k, cache_swa_v,
              cache_mem_k, cache_mem_v, mem_prompt, norm_in, w_in, gdn_conv_w, gdn_a_log,
              gdn_dt_bias, gdn_norm, swa_sinks, rel_bias, norm_mem, w_mem_kv, w_branch,
              w_out, norm_f):
    hp, hs = x_prompt, x_sample
    B = x_prompt.shape[0]
    gdn_p, conv_p, swk_p, swv_p, mk_p, mv_p = [], [], [], [], [], []
    gdn_s, conv_s, swk_s, swv_s = [], [], [], []
    for l in range(DEPTH):
        weights = (norm_in[l], w_in[l], gdn_conv_w[l], gdn_a_log[l], gdn_dt_bias[l], gdn_norm[l],
                   swa_sinks[l], rel_bias, w_branch[l], w_out[l])
        mk, mv = mem_kv(mem_prompt, norm_mem[l], w_mem_kv[l])
        prefix0 = jnp.zeros((B, CONV_W - 1, GDN_CONV_CH), hp.dtype)
        s00 = jnp.zeros((B, GDN_H, GDN_DK, GDN_DV), hp.dtype)
        hp, s_new, c_new, k_new, v_new = trunk_layer(hp, prefix0, s00, swa_prompt, mk, mv, *weights)
        gdn_p.append(s_new); conv_p.append(c_new); swk_p.append(k_new); swv_p.append(v_new)
        mk_p.append(mk); mv_p.append(mv)
        swa_fn = functools.partial(swa_sample, cache_k=cache_swa_k[l], cache_v=cache_swa_v[l])
        hs, s_new, c_new, k_new, v_new = trunk_layer(hs, state_gdn_conv[l], state_gdn[l], swa_fn,
                                                     cache_mem_k[l], cache_mem_v[l], *weights)
        gdn_s.append(s_new); conv_s.append(c_new); swk_s.append(k_new); swv_s.append(v_new)
    y_prompt = rmsnorm(hp, norm_f)
    y_sample = rmsnorm(hs, norm_f)
    return (y_prompt, y_sample,
            jnp.stack(gdn_p), jnp.stack(conv_p), jnp.stack(swk_p), jnp.stack(swv_p),
            jnp.stack(mk_p), jnp.stack(mv_p),
            jnp.stack(gdn_s), jnp.stack(conv_s), jnp.stack(swk_s), jnp.stack(swv_s))
```

```cpp
#include <hip/hip_runtime.h>
#include <hip/hip_cooperative_groups.h>
#include <cstdio>
#include <cstdint>
namespace cg = cooperative_groups;

#ifndef MK_N_LAUNCHES
#define MK_N_LAUNCHES 1
#endif

#define LAS __attribute__((address_space(3)))
typedef unsigned short bf16_t;
typedef short bf16x8 __attribute__((ext_vector_type(8)));
typedef float f32x4 __attribute__((ext_vector_type(4)));
typedef unsigned u32x4 __attribute__((ext_vector_type(4)));
typedef unsigned u32x2 __attribute__((ext_vector_type(2)));

constexpr int D = 2048, SEQ = 8192, MP = 2 * SEQ, MS = 512, M = MP + MS;
constexpr int IN_COLS = 14608;
constexpr int NIN = 58 * 256;
constexpr float EPS = 1e-6f;
__host__ __device__ __forceinline__ int win_src_col(int j) {
    if (j < 4096) return j;
    if (j < 5120) return 4112 + (j - 4096);
    if (j < 6144) return 5392 + (j - 5120);
    if (j < 7168) return 6416 + (j - 6144);
    if (j < 8192) return 7440 + (j - 7168);
    if (j < 14336) return 8464 + (j - 8192);
    if (j < 14592) return 5136 + (j - 14336);
    if (j < 14608) return 4096 + (j - 14592);
    return -1;
}
constexpr size_t O_YP = 0, O_YS = O_YP + (size_t)MP * D, O_GSP = O_YS + (size_t)MS * D, O_GCP = O_GSP + 2 * 8 * 128 * 128, O_SKP = O_GCP + 2 * 3 * 3072,
                 O_SVP = O_SKP + 2 * 128 * 128, O_MKP = O_SVP + 2 * 128 * 128, O_MVP = O_MKP + 512 * 1024, O_GSS = O_MVP + 512 * 1024,
                 O_GCS = O_GSS + (size_t)128 * 8 * 128 * 128, O_SKS = O_GCS + 128 * 3 * 3072, O_SVS = O_SKS + 128 * 128 * 128, O_END = O_SVS + 128 * 128 * 128;
static_assert(O_END == 58148864, "d_out map");
constexpr size_t al(size_t x) { return (x + 255) & ~(size_t)255; }
constexpr size_t WS_CTL = 0, WS_WB = 1u << 20, WS_WO = WS_WB + al((size_t)3 * 2048 * 1024 * 2), WS_WIN = WS_WO + al((size_t)2048 * 2048 * 2),
                 WS_WMKV = WS_WIN + al((size_t)NIN * 2048 * 2), WS_QKV = WS_WMKV + al((size_t)2048 * 2048 * 2), WS_GZ = WS_QKV + al((size_t)M * 3072 * 2),
                 WS_SQ = WS_GZ + al((size_t)M * 1024 * 2), WS_SZ = WS_SQ + al((size_t)M * 1024 * 2), WS_MQ = WS_SZ + al((size_t)M * 1024 * 2), WS_MZ = WS_MQ + al((size_t)M * 1024 * 2),
                 WS_SKV = WS_MZ + al((size_t)M * 1024 * 2), WS_GATES = WS_SKV + al((size_t)M * 256 * 2), WS_MEMN = WS_GATES + al((size_t)M * 6144 * 2),
                 WS_MEMKV = WS_MEMN + al((size_t)512 * 2048 * 2), WS_GAB = WS_MEMKV + al((size_t)512 * 2048 * 2), WS_ROWSS = WS_GAB + al((size_t)M * 16 * 4),
                 WS_G = WS_ROWSS + al((size_t)M * 4), WS_BETA = WS_G + al((size_t)M * 8 * 4), WS_BTAB = WS_BETA + al((size_t)M * 8 * 4), WS_END0 = WS_BTAB + al(16 * 128 * 4);
constexpr size_t WS_OG = WS_QKV, WS_OS = WS_OG + (size_t)M * 1024 * 2, WS_OM = WS_OS + (size_t)M * 1024 * 2, WS_MERGED = WS_SQ;
constexpr size_t WS_NEGW = WS_OG, WS_SN = WS_WIN, WS_OMS = WS_MEMN;
constexpr size_t WS_UT = WS_END0, WS_ATT = WS_UT + al((size_t)2048 * 128 * 64 * 2), WS_GC = WS_ATT + al((size_t)2048 * 64 * 64 * 2), WS_DEC = WS_GC + al((size_t)MP * 8 * 4),
                 WS_GT = WS_DEC + al((size_t)2048 * 64 * 4), WS_MVT = WS_GT + al(2048 * 4), WS_VTS = WS_MVT + al((size_t)2 * 4 * 256 * 256 * 2), WS_SSQ = WS_VTS + al((size_t)2 * 2 * 64 * SEQ * 2 + 4096), WS_SSK = WS_SSQ + al((size_t)MP * 8 * 4), WS_END = WS_SSK + al((size_t)MP * 8 * 4);
constexpr size_t WS_PS = WS_UT, WS_YP = WS_UT + (size_t)3 * MS * 2048 * 2;
static_assert((size_t)3 * MS * 2048 * 2 + (size_t)4 * MS * 2048 * 4 <= (size_t)2048 * 128 * 64 * 2, "PS/YP fit in UT");
static_assert(WS_OM + (size_t)M * 1024 * 2 <= WS_GZ && WS_MERGED + (size_t)M * 2048 * 2 <= WS_MQ, "overlays");
static_assert((size_t)2048 * 64 * 128 * 2 <= (size_t)MP * 1024 * 2 && WS_SN + (size_t)2048 * 128 * 128 * 2 <= WS_QKV, "overlays 2");
static_assert(WS_END <= 670000000, "workspace budget");
constexpr size_t DO_XN = 0, DO_QN = 0, DO_KN = (size_t)M * 1024 * 2, DO_KT = 2 * (size_t)M * 1024 * 2, DO_VT = DO_KT + (size_t)2048 * 8192 * 2, DO_VNS = DO_VT + (size_t)2048 * 8192 * 2;
static_assert(DO_VNS + (size_t)512 * 1024 * 2 <= (size_t)M * D * 4, "y scratch");

constexpr int NWAVES = 8, NTHREADS = 512;
constexpr int LDS_CTL = 147456;
constexpr int LDS_BYTES = 147456 + 256;
constexpr int LDS_BT = 139264;

__device__ __forceinline__ float bf2f(unsigned v) { return __uint_as_float(v << 16); }
__device__ __forceinline__ unsigned f2bf(float f) { unsigned u = __float_as_uint(f); return (u + 0x7fffu + ((u >> 16) & 1u)) >> 16; }
__device__ __forceinline__ unsigned pk2(float lo, float hi) { return f2bf(lo) | (f2bf(hi) << 16); }
__device__ __forceinline__ float wave_sum(float v) {
#pragma unroll
    for (int o = 1; o < 64; o <<= 1) v += __shfl_xor(v, o);
    return v;
}
__device__ __forceinline__ float wave_max(float v) {
#pragma unroll
    for (int o = 1; o < 64; o <<= 1) v = fmaxf(v, __shfl_xor(v, o));
    return v;
}
__device__ __forceinline__ float sigmoidf_(float x) { return __builtin_amdgcn_rcpf(1.f + __expf(-x)); }
__device__ __forceinline__ float siluf_(float x) { return x * __builtin_amdgcn_rcpf(1.f + __expf(-x)); }
#define LDS_WAIT() asm volatile("s_waitcnt lgkmcnt(0)" ::: "memory")

namespace pg8 {
constexpr int BM = 256, BK = 64, HALF = 128, HTB = HALF * BK * 2, STAGE_BYTES = 8 * HTB, NXCD = 8, WGM = 8;
__host__ __device__ __forceinline__ int lds_byte(int r, int c) { const int st = (r >> 4) * 2 + (c >> 5), rr = r & 15, cc = c & 31, ob = rr * 64 + cc * 2; return st * 1024 + (ob ^ (((ob >> 9) & 1) << 5)); }
__host__ __device__ __forceinline__ void stage_rc(int b, int& R, int& C) { const int st = b / 1024, sb = b % 1024, swz = sb ^ (((sb >> 9) & 1) << 5); R = (st >> 1) * 16 + swz / 64; C = (st & 1) * 32 + (swz % 64) / 2; }
__host__ __device__ __forceinline__ int perm32(int rho) { const int n = rho >> 4, i = rho & 15; return 8 * (i >> 2) + 4 * n + (i & 3); }
struct Unit { int pm, pn, job; };
__device__ __forceinline__ void tile_of(int L, int nM, int nN, int& pm, int& pn) {
    const int nwg = nM * nN; int wgid = L;
    { const int q = nwg / NXCD, r = nwg % NXCD, xcd = wgid % NXCD, off = wgid / NXCD; wgid = (xcd < r ? xcd * (q + 1) : r * (q + 1) + (xcd - r) * q) + off; }
    const int nig = WGM * nN, gid = wgid / nig, fm = gid * WGM, gsz = (nM - fm) < WGM ? (nM - fm) : WGM;
    pm = fm + ((wgid % nig) % gsz); pn = (wgid % nig) / gsz;
}
__device__ __forceinline__ unsigned cvt_pk_bf16(float lo, float hi) { unsigned r; asm volatile("v_cvt_pk_bf16_f32 %0, %1, %2" : "=v"(r) : "v"(lo), "v"(hi)); return r; }

template <class Epi, class Sched, bool ALIGN_EPI = true>
__device__ __forceinline__ void gemm_phase(LAS unsigned char* lds, const int K, const Sched& S, const Epi& E) {
    const int tid = threadIdx.x, wid = __builtin_amdgcn_readfirstlane(tid >> 6), lane = tid & 63, wr = wid >> 2, wc = wid & 3, fr = lane & 15, fq = lane >> 4;
    unsigned voffA[2], voffB[2];
#pragma unroll
    for (int i = 0; i < 2; ++i) { int R, C; stage_rc(tid * 16 + i * 8192, R, C); const int Rb = ((R & ~31) + perm32(R & 31));
        voffA[i] = (unsigned)(R * K + C) * 2u; voffB[i] = (unsigned)(Rb * K + C) * 2u; }
    const size_t kstep = (size_t)(BK * 2);
    const size_t hstep = (size_t)HALF * K * 2;
    const unsigned ldsw = (unsigned)wid * 1024u;
    const int aoff = lds_byte(wr * 64 + fr, fq * 8), boff = lds_byte(wc * 32 + fr, fq * 8);
#define PG8_SA(b, h) (((b) * 2 + (h)) * HTB)
#define PG8_SB(b, h) ((4 + (b) * 2 + (h)) * HTB)
#define PG8_STAGE(bufoff, gbase, voff) do { _Pragma("unroll") for (int _i = 0; _i < 2; ++_i) \
        __builtin_amdgcn_global_load_lds((const unsigned*)((const char*)(gbase) + (voff)[_i]), (LAS unsigned*)(lds + (bufoff) + ldsw + _i * 8192), 16, 0, 0); } while (0)
#define PG8_LDA(dst, b, h) do { _Pragma("unroll") for (int m = 0; m < 4; ++m) _Pragma("unroll") for (int k = 0; k < 2; ++k) dst[m][k] = *(const LAS bf16x8*)(lds + PG8_SA(b, h) + aoff + m * 2048 + k * 1024); } while (0)
#define PG8_LDB(dst, b, h) do { _Pragma("unroll") for (int n = 0; n < 2; ++n) _Pragma("unroll") for (int k = 0; k < 2; ++k) dst[n][k] = *(const LAS bf16x8*)(lds + PG8_SB(b, h) + boff + n * 2048 + k * 1024); } while (0)
#define PG8_MMA(ai, bj, At, Bt) do { __builtin_amdgcn_s_setprio(1); _Pragma("unroll") for (int m = 0; m < 4; ++m) _Pragma("unroll") for (int n = 0; n < 2; ++n) _Pragma("unroll") for (int k = 0; k < 2; ++k) \
        acc[ai][bj][m][n] = __builtin_amdgcn_mfma_f32_16x16x32_bf16(Bt[n][k], At[m][k], acc[ai][bj][m][n], 0, 0, 0); __builtin_amdgcn_s_setprio(0); } while (0)
#define PG8_WAIT_V(n) asm volatile("s_waitcnt vmcnt(" #n ")" ::: "memory")
#define PG8_WAIT_L(n) asm volatile("s_waitcnt lgkmcnt(" #n ")" ::: "memory")
#define PG8_BAR __builtin_amdgcn_s_barrier()
#define PG8_SCHED __builtin_amdgcn_sched_barrier(0)
    Unit cur, nxt; int ui = 0;
    if (!S.next(0, cur)) return;
    f32x4 acc[2][2][4][2];
#pragma unroll
    for (int a = 0; a < 2; ++a)
#pragma unroll
        for (int b = 0; b < 2; ++b)
#pragma unroll
            for (int m = 0; m < 4; ++m)
#pragma unroll
                for (int n = 0; n < 2; ++n) acc[a][b][m][n] = (f32x4){0.f, 0.f, 0.f, 0.f};
    bf16x8 At[4][2], B0[2][2], B1[2][2];
    const char* cA; const char* cB; S.ptrs(cur, cA, cB);
    PG8_STAGE(PG8_SB(0, 0), cB, voffB); PG8_STAGE(PG8_SB(0, 1), cB + hstep, voffB); PG8_STAGE(PG8_SA(0, 0), cA, voffA); PG8_STAGE(PG8_SA(0, 1), cA + hstep, voffA);
    if (wr == 1) PG8_BAR;
    PG8_WAIT_V(2); PG8_BAR;
    PG8_STAGE(PG8_SB(1, 0), cB + kstep, voffB); PG8_STAGE(PG8_SA(1, 0), cA + kstep, voffA); PG8_STAGE(PG8_SB(1, 1), cB + hstep + kstep, voffB);
    PG8_WAIT_V(6); PG8_BAR;
    for (;;) {
        const bool has_next = S.next(ui + 1, nxt);
        const char* nA = cA; const char* nB = cB; if (has_next) S.ptrs(nxt, nA, nB);
        const int nt = S.ntiles(cur);
        for (int t = 0; t < nt; t += 2) {
            const bool last = (t == nt - 2);
            const char* a1 = cA + (size_t)(t + 1) * kstep;
            const char* a2 = last ? nA : cA + (size_t)(t + 2) * kstep; const char* b2 = last ? nB : cB + (size_t)(t + 2) * kstep;
            const char* a3 = a2 + kstep; const char* b3 = b2 + kstep;
            PG8_LDB(B0, 0, 0); PG8_LDB(B1, 0, 1); PG8_SCHED; PG8_LDA(At, 0, 0); PG8_STAGE(PG8_SA(1, 1), a1 + hstep, voffA);
            PG8_WAIT_V(8); PG8_WAIT_L(0); PG8_BAR; PG8_MMA(0, 0, At, B0); PG8_MMA(0, 1, At, B1); PG8_BAR; PG8_SCHED;
            PG8_LDA(At, 0, 1); PG8_STAGE(PG8_SB(0, 0), b2, voffB); PG8_STAGE(PG8_SB(0, 1), b2 + hstep, voffB); PG8_STAGE(PG8_SA(0, 0), a2, voffA);
            PG8_WAIT_V(8); PG8_WAIT_L(0); PG8_BAR; PG8_MMA(1, 0, At, B0); PG8_MMA(1, 1, At, B1); PG8_BAR; PG8_SCHED;
            PG8_LDB(B0, 1, 0); PG8_LDB(B1, 1, 1); PG8_SCHED; PG8_LDA(At, 1, 0); PG8_STAGE(PG8_SA(0, 1), a2 + hstep, voffA);
            PG8_WAIT_V(8); PG8_WAIT_L(0); PG8_BAR; PG8_MMA(0, 0, At, B0); PG8_MMA(0, 1, At, B1); PG8_BAR; PG8_SCHED;
            PG8_LDA(At, 1, 1); PG8_STAGE(PG8_SB(1, 0), b3, voffB); PG8_STAGE(PG8_SB(1, 1), b3 + hstep, voffB); PG8_STAGE(PG8_SA(1, 0), a3, voffA);
            PG8_WAIT_V(8); PG8_WAIT_L(0); PG8_BAR; PG8_MMA(1, 0, At, B0); PG8_MMA(1, 1, At, B1); PG8_BAR; PG8_SCHED;
        }
        if constexpr (ALIGN_EPI) { if (wr == 0) PG8_BAR; }
        E(acc, cur, wr, wc, fr, fq);
        if (!has_next) break;
#pragma unroll
        for (int a = 0; a < 2; ++a)
#pragma unroll
            for (int b = 0; b < 2; ++b)
#pragma unroll
                for (int m = 0; m < 4; ++m)
#pragma unroll
                    for (int n = 0; n < 2; ++n) acc[a][b][m][n] = (f32x4){0.f, 0.f, 0.f, 0.f};
        cur = nxt; cA = nA; cB = nB; ++ui;
        if constexpr (ALIGN_EPI) { if (wr == 1) PG8_BAR; }
    }
    PG8_WAIT_V(0);
    if constexpr (!ALIGN_EPI) { if (wr == 0) PG8_BAR; }
    PG8_BAR;
#undef PG8_SA
#undef PG8_SB
#undef PG8_STAGE
#undef PG8_LDA
#undef PG8_LDB
#undef PG8_MMA
#undef PG8_WAIT_V
#undef PG8_WAIT_L
#undef PG8_BAR
#undef PG8_SCHED
}
}

#define XB_TMO      128
#define XB_XCNT(j)  (256  + 64 * (j))
#define XB_XSUB(j)  (1280 + 64 * (j))
#define XB_XGEN(j)  (2304 + 64 * (j))
#define XB_TOP      3328
#define XB_TOPGEN   3392
#define XCD_BAR_WORDS 3456
#define XB_SPIN_CAP (1u << 20)
__device__ __forceinline__ unsigned xb_ld(unsigned* p)              { return __hip_atomic_load(p, __ATOMIC_RELAXED, __HIP_MEMORY_SCOPE_AGENT); }
__device__ __forceinline__ unsigned xb_add(unsigned* p, unsigned v) { return __hip_atomic_fetch_add(p, v, __ATOMIC_RELAXED, __HIP_MEMORY_SCOPE_AGENT); }
__device__ __forceinline__ unsigned xb_xcc_id() { return (unsigned)__builtin_amdgcn_s_getreg((3 << 11) | 20) & 0xFu; }
#define XB_SPIN(cond, bar) do { unsigned _sp = 0; while (cond) { __builtin_amdgcn_s_sleep(1); \
    if ((++_sp & 255u) == 0u) { if (xb_ld(&(bar)[XB_TMO])) break; if (_sp > XB_SPIN_CAP) { atomicAdd(&(bar)[XB_TMO], 1u); break; } } } } while (0)
struct XcdBarrier { unsigned* bar; unsigned x; volatile LAS unsigned* st; };
__device__ __forceinline__ XcdBarrier xcd_barrier_post(unsigned* bar, volatile LAS unsigned* st) {
    XcdBarrier b; b.bar = bar; b.x = xb_xcc_id(); b.st = st;
    if (threadIdx.x == 0) (void)xb_add(&bar[XB_XCNT(b.x)], 1u);
    return b;
}
__device__ __forceinline__ void xcd_barrier_complete(unsigned* bar, unsigned x, unsigned& nloc, unsigned& nx) {
    const unsigned G = gridDim.x * gridDim.y * gridDim.z;
    unsigned sum, cnt, mine, sp = 0u;
    for (;;) {
        sum = 0u; cnt = 0u; mine = 0u;
#pragma unroll
        for (unsigned j = 0; j < 16; ++j) { const unsigned c = xb_ld(&bar[XB_XCNT(j)]); sum += c; cnt += (c > 0u) ? 1u : 0u; mine = (j == x) ? c : mine; }
        if (sum == G) break;
        __builtin_amdgcn_s_sleep(1);
        if ((++sp & 255u) == 0u) { if (xb_ld(&bar[XB_TMO])) break; if (sp > XB_SPIN_CAP) { atomicAdd(&bar[XB_TMO], 1u); break; } }
    }
    nloc = mine > 0u ? mine : 1u; nx = cnt > 0u ? cnt : 1u;
}
__device__ __forceinline__ void xcd_barrier(const XcdBarrier& b) {
    asm volatile("s_waitcnt vmcnt(0)" ::: "memory");
    __syncthreads();
    if (threadIdx.x == 0) {
        unsigned* bar = b.bar;
        __builtin_amdgcn_s_waitcnt(0);
        unsigned nloc = b.st[0], nx = b.st[1];
        if (nloc == 0u) { xcd_barrier_complete(bar, b.x, nloc, nx); b.st[0] = nloc; b.st[1] = nx; }
        const unsigned old = xb_add(&bar[XB_XSUB(b.x)], 1u);
        const unsigned gen = old / nloc;
        if (old + 1u == (gen + 1u) * nloc) {
            __builtin_amdgcn_fence(__ATOMIC_RELEASE, "agent");
            asm volatile("s_waitcnt vmcnt(0)" ::: "memory");
            const unsigned og = xb_add(&bar[XB_TOP], 1u);
            const unsigned tg = og / nx;
            if (og + 1u == (tg + 1u) * nx) xb_add(&bar[XB_TOPGEN], 1u);
            else XB_SPIN(xb_ld(&bar[XB_TOPGEN]) == tg, bar);
            __builtin_amdgcn_fence(__ATOMIC_ACQUIRE, "agent");
            xb_add(&bar[XB_XGEN(b.x)], 1u);
            asm volatile("s_waitcnt vmcnt(0)" ::: "memory");
        } else {
            XB_SPIN(xb_ld(&bar[XB_XGEN(b.x)]) == gen, bar);
            __builtin_amdgcn_fence(__ATOMIC_ACQUIRE, "agent");
            asm volatile("s_waitcnt vmcnt(0)" ::: "memory");
        }
    }
    __syncthreads();
}

struct Args { const float* in[22]; float* out; unsigned char* ws; int ph_lo, ph_hi; };
enum { I_XP = 0, I_XS, I_SGDN, I_SCONV, I_CSK, I_CSV, I_CMK, I_CMV, I_MEMP, I_NORM_IN, I_WIN, I_CONVW, I_ALOG, I_DTB, I_GNORM, I_SINKS, I_RELB, I_NORM_MEM, I_WMKV, I_WBR, I_WOUT, I_NORMF };

struct Frame {
    LAS unsigned char* lds;
    int tid, lane, wave, G, bid;
    const float* const* in; float* out; unsigned char* ws;
};

template <bool WINMAP>
__device__ __forceinline__ void p0_transpose_item(const float* W, int K, int Nsrc, bf16_t* WT, LAS bf16_t* scr, int kb, int nb, int lane) {
    constexpr int TP = 130;
    const int k0 = 64 * kb, n0 = 128 * nb;
    const int dj = n0 + 4 * (lane & 31);
    const int sc = WINMAP ? win_src_col(dj) : dj;
    f32x4 v[32];
#pragma unroll
    for (int i = 0; i < 32; ++i) { const int kk = 2 * i + (lane >> 5); v[i] = sc >= 0 ? *(const f32x4*)(W + (size_t)(k0 + kk) * Nsrc + sc) : (f32x4){0.f, 0.f, 0.f, 0.f}; }
#pragma unroll
    for (int i = 0; i < 32; ++i) { const int kk = 2 * i + (lane >> 5); LAS unsigned* d = (LAS unsigned*)(scr + kk * TP + 4 * (lane & 31)); d[0] = pk2(v[i].x, v[i].y); d[1] = pk2(v[i].z, v[i].w); }
    LDS_WAIT(); asm volatile("" ::: "memory");
#pragma unroll 4
    for (int u = 0; u < 16; ++u) { const int e = lane + 64 * u, ch = e & 7, n = e >> 3; const LAS bf16_t* s = scr + (8 * ch) * TP + n;
        u32x4 o; o.x = (unsigned)s[0] | ((unsigned)s[TP] << 16); o.y = (unsigned)s[2 * TP] | ((unsigned)s[3 * TP] << 16);
        o.z = (unsigned)s[4 * TP] | ((unsigned)s[5 * TP] << 16); o.w = (unsigned)s[6 * TP] | ((unsigned)s[7 * TP] << 16);
        *(u32x4*)(WT + (size_t)(n0 + n) * K + k0 + 8 * ch) = o; }
    LDS_WAIT(); asm volatile("" ::: "memory");
}
__device__ __forceinline__ void rms_row_to_bf16(const float* xrow, const float* w, bf16_t* orow, int lane) {
    const f32x4* xr = (const f32x4*)xrow + lane; const f32x4* wr = (const f32x4*)w + lane;
    f32x4 v[8]; float s = 0.f;
#pragma unroll
    for (int j = 0; j < 8; ++j) { v[j] = xr[64 * j]; s += (v[j].x * v[j].x + v[j].y * v[j].y) + (v[j].z * v[j].z + v[j].w * v[j].w); }
    const float r = rsqrtf(wave_sum(s) * (1.f / D) + EPS);
    unsigned long long* o8 = (unsigned long long*)orow + lane;
#pragma unroll
    for (int j = 0; j < 8; ++j) { const f32x4 ww = wr[64 * j];
        o8[64 * j] = (unsigned long long)pk2(v[j].x * r * ww.x, v[j].y * r * ww.y) | ((unsigned long long)pk2(v[j].z * r * ww.z, v[j].w * r * ww.w) << 32); }
}
__device__ __forceinline__ int t5_bucket(int n) {
    if (n < 16) return n;
    int large = 16 + (int)(logf((float)n / 16.f) / 2.0794415416798357f * 16.f);
    return large < 31 ? large : 31;
}
__device__ __forceinline__ void p0_prologue(Frame& F) {
    LAS bf16_t* scr = (LAS bf16_t*)(F.lds + F.wave * 16896);
    const int gw = F.bid * NWAVES + F.wave, NGW = F.G * NWAVES;
    constexpr int I_IN = 32 * (NIN / 128), I_MKV = 32 * 16, I_BR = 16 * 16, I_OUT = 32 * 16;
    constexpr int NITEMS = I_IN + I_MKV + 3 * I_BR + I_OUT;
    bf16_t* WINT = (bf16_t*)(F.ws + WS_WIN); bf16_t* WMKVT = (bf16_t*)(F.ws + WS_WMKV); bf16_t* WBT = (bf16_t*)(F.ws + WS_WB); bf16_t* WOT = (bf16_t*)(F.ws + WS_WO);
    for (int it = gw; it < NITEMS; it += NGW) {
        int r = it;
        if (r < I_IN) { p0_transpose_item<true>(F.in[I_WIN], D, IN_COLS, WINT, scr, r / (NIN / 128), r % (NIN / 128), F.lane); continue; } r -= I_IN;
        if (r < I_MKV) { p0_transpose_item<false>(F.in[I_WMKV], D, 2048, WMKVT, scr, r / 16, r % 16, F.lane); continue; } r -= I_MKV;
        if (r < 3 * I_BR) { const int b = r / I_BR, q = r % I_BR; p0_transpose_item<false>(F.in[I_WBR] + (size_t)b * 1024 * 2048, 1024, 2048, WBT + (size_t)b * 2048 * 1024, scr, q / 16, q % 16, F.lane); continue; } r -= 3 * I_BR;
        p0_transpose_item<false>(F.in[I_WOUT], D, 2048, WOT, scr, r / 16, r % 16, F.lane);
    }
    bf16_t* XN = (bf16_t*)((unsigned char*)F.out + DO_XN); bf16_t* MEMN = (bf16_t*)(F.ws + WS_MEMN);
    for (int m = gw; m < M + 512; m += NGW) {
        if (m < MP) rms_row_to_bf16(F.in[I_XP] + (size_t)m * D, F.in[I_NORM_IN], XN + (size_t)m * D, F.lane);
        else if (m < M) rms_row_to_bf16(F.in[I_XS] + (size_t)(m - MP) * D, F.in[I_NORM_IN], XN + (size_t)m * D, F.lane);
        else rms_row_to_bf16(F.in[I_MEMP] + (size_t)(m - M) * D, F.in[I_NORM_MEM], MEMN + (size_t)(m - M) * D, F.lane);
    }
    float* BT = (float*)(F.ws + WS_BTAB);
    for (int i = F.bid * NTHREADS + F.tid; i < 16 * 128; i += F.G * NTHREADS) { const int h = i >> 7, dist = i & 127; BT[i] = F.in[I_RELB][t5_bucket(dist) * 16 + h]; }
}

struct SchedP1 {
    int G, c; const unsigned char* ws; const unsigned char* xn;
    __device__ __forceinline__ int ntiles(const pg8::Unit&) const { return D / 64; }
    static constexpr int NM = M / 256, NN = NIN / 256, NU0 = NM * NN, NU = NU0 + 16;
    __device__ __forceinline__ bool next(int i, pg8::Unit& u) const {
        const long L = (long)i * G + c; if (L >= NU) return false;
        if (L < NU0) { pg8::tile_of((int)L, NM, NN, u.pm, u.pn); u.job = 0; } else { const int q = (int)L - NU0; u.pm = q >> 3; u.pn = q & 7; u.job = 1; }
        return true;
    }
    __device__ __forceinline__ void ptrs(const pg8::Unit& u, const char*& A, const char*& B) const {
        const size_t tstep = (size_t)256 * D * 2;
        if (u.job == 0) { A = (const char*)xn + (size_t)u.pm * tstep; B = (const char*)ws + WS_WIN + (size_t)u.pn * tstep; }
        else { A = (const char*)ws + WS_MEMN + (size_t)u.pm * tstep; B = (const char*)ws + WS_WMKV + (size_t)u.pn * tstep; }
    }
};
struct EpiP1 {
    unsigned char* ws; float* out;
    __device__ __forceinline__ void operator()(const f32x4 (&acc)[2][2][4][2], const pg8::Unit& u, int wr, int wc, int fr, int fq) const {
        const int row0 = u.pm * 256 + wr * 64 + fr;
        const int cin = wc * 32 + 8 * fq;
        if (u.job == 1) {
            bf16_t* MK = (bf16_t*)(ws + WS_MEMKV);
#pragma unroll
            for (int ai = 0; ai < 2; ++ai)
#pragma unroll
                for (int m = 0; m < 4; ++m) { const int r = row0 + ai * 128 + m * 16;
#pragma unroll
                    for (int bj = 0; bj < 2; ++bj) { const int c = u.pn * 256 + bj * 128 + cin; const f32x4 v0 = acc[ai][bj][m][0], v1 = acc[ai][bj][m][1];
                        float* o = out + (c < 1024 ? O_MKP + (size_t)r * 1024 + c : O_MVP + (size_t)r * 1024 + (c - 1024));
                        *(f32x4*)o = v0; *(f32x4*)(o + 4) = v1;
                        u32x4 w; w.x = pg8::cvt_pk_bf16(v0[0], v0[1]); w.y = pg8::cvt_pk_bf16(v0[2], v0[3]); w.z = pg8::cvt_pk_bf16(v1[0], v1[1]); w.w = pg8::cvt_pk_bf16(v1[2], v1[3]);
                        *(u32x4*)(MK + (size_t)r * 2048 + c) = w;
                        if (c >= 1024) { bf16_t* MVT = (bf16_t*)(ws + WS_MVT) + ((size_t)((r >> 8) * 4 + ((c - 1024) >> 8)) * 256 + ((c - 1024) & 255)) * 256 + (r & 255);
                            MVT[0] = (bf16_t)(w.x & 0xffffu); MVT[256] = (bf16_t)(w.x >> 16); MVT[512] = (bf16_t)(w.y & 0xffffu); MVT[768] = (bf16_t)(w.y >> 16);
                            MVT[1024] = (bf16_t)(w.z & 0xffffu); MVT[1280] = (bf16_t)(w.z >> 16); MVT[1536] = (bf16_t)(w.w & 0xffffu); MVT[1792] = (bf16_t)(w.w >> 16); } } }
            return;
        }
        const int pn = u.pn;
        if (pn == 57) {
            if (wc == 0 && fq < 2) { float* GAB = (float*)(ws + WS_GAB);
#pragma unroll
                for (int ai = 0; ai < 2; ++ai)
#pragma unroll
                    for (int m = 0; m < 4; ++m) { const int r = row0 + ai * 128 + m * 16; float* o = GAB + (size_t)r * 16 + 8 * fq; *(f32x4*)o = acc[ai][0][m][0]; *(f32x4*)(o + 4) = acc[ai][0][m][1]; } }
            return;
        }
        bf16_t* base; int ld, ct, act = 0;
        if (pn < 12) { base = (bf16_t*)(ws + WS_QKV); ld = 3072; ct = pn; }
        else if (pn < 16) { base = (bf16_t*)(ws + WS_GZ); ld = 1024; ct = pn - 12; act = 1; }
        else if (pn < 20) { base = (bf16_t*)(ws + WS_SQ); ld = 1024; ct = pn - 16; }
        else if (pn < 24) { base = (bf16_t*)(ws + WS_SZ); ld = 1024; ct = pn - 20; act = 1; }
        else if (pn < 28) { base = (bf16_t*)(ws + WS_MQ); ld = 1024; ct = pn - 24; }
        else if (pn < 32) { base = (bf16_t*)(ws + WS_MZ); ld = 1024; ct = pn - 28; act = 1; }
        else if (pn < 56) { base = (bf16_t*)(ws + WS_GATES); ld = 6144; ct = pn - 32; act = 2; }
        else { base = (bf16_t*)(ws + WS_SKV); ld = 256; ct = 0; }
#pragma unroll
        for (int ai = 0; ai < 2; ++ai)
#pragma unroll
            for (int m = 0; m < 4; ++m) { bf16_t* rowp = base + (size_t)(row0 + ai * 128 + m * 16) * ld + ct * 256 + cin;
#pragma unroll
                for (int bj = 0; bj < 2; ++bj) { f32x4 v0 = acc[ai][bj][m][0], v1 = acc[ai][bj][m][1];
                    if (act == 1) {
#pragma unroll
                        for (int j = 0; j < 4; ++j) { v0[j] = siluf_(v0[j]); v1[j] = siluf_(v1[j]); } }
                    else if (act == 2) {
#pragma unroll
                        for (int j = 0; j < 4; ++j) { v0[j] = sigmoidf_(v0[j]); v1[j] = sigmoidf_(v1[j]); } }
                    u32x4 w; w.x = pg8::cvt_pk_bf16(v0[0], v0[1]); w.y = pg8::cvt_pk_bf16(v0[2], v0[3]); w.z = pg8::cvt_pk_bf16(v1[0], v1[1]); w.w = pg8::cvt_pk_bf16(v1[2], v1[3]);
                    *(u32x4*)(rowp + bj * 128) = w;
                    if (pn == 56 && bj == 1) { const int r = row0 + ai * 128 + m * 16;
                        if (r < MP) { bf16_t* vt = (bf16_t*)(ws + WS_VTS) + ((size_t)((r >> 13) * 2 + (cin >> 6)) * 64 + (cin & 63)) * SEQ + (r & (SEQ - 1));
                            vt[0] = (bf16_t)(w.x & 0xffffu); vt[SEQ] = (bf16_t)(w.x >> 16); vt[2 * SEQ] = (bf16_t)(w.y & 0xffffu); vt[3 * SEQ] = (bf16_t)(w.y >> 16);
                            vt[4 * SEQ] = (bf16_t)(w.z & 0xffffu); vt[5 * SEQ] = (bf16_t)(w.z >> 16); vt[6 * SEQ] = (bf16_t)(w.w & 0xffffu); vt[7 * SEQ] = (bf16_t)(w.w >> 16); } } } }
    }
};

__device__ __forceinline__ void gdn_gate_scalars(Frame& F, int r, int h) {
    const float* GAB = (const float*)(F.ws + WS_GAB); float* Gp = (float*)(F.ws + WS_G); float* Bp = (float*)(F.ws + WS_BETA);
    const float gb = GAB[(size_t)r * 16 + h], ga = GAB[(size_t)r * 16 + 8 + h];
    Bp[(size_t)r * 8 + h] = sigmoidf_(gb);
    const float xx = ga + F.in[I_DTB][h]; const float sp = xx > 20.f ? xx : log1pf(expf(xx));
    Gp[(size_t)r * 8 + h] = -expf(F.in[I_ALOG][h]) * sp;
}
__device__ __forceinline__ void conv_prompt_item(Frame& F, int item) {
    const int b = item >> 7, n = item & 127, row0 = b * SEQ + 64 * n, tid = F.tid;
    const bf16_t* QKV = (const bf16_t*)(F.ws + WS_QKV);
    bf16_t* QN = (bf16_t*)((unsigned char*)F.out + DO_QN); bf16_t* KN = (bf16_t*)((unsigned char*)F.out + DO_KN);
    bf16_t* KT = (bf16_t*)((unsigned char*)F.out + DO_KT); bf16_t* VT = (bf16_t*)((unsigned char*)F.out + DO_VT);
    const float* cw = F.in[I_CONVW];
    constexpr int SP = 136;
    LAS bf16_t* slab = (LAS bf16_t*)F.lds;
    { const int tok = tid >> 3, h = tid & 7; gdn_gate_scalars(F, row0 + tok, h); }
    const int t0 = tid >> 4, cg = (tid & 15) * 8;
    u32x4 cur[2][4], nxt[2][4]; f32x4 wc[4][2], wn[4][2];
#define CONV_LOAD(dst, dw, sl_) do { const int ch_ = ((sl_) >> 3) * 1024 + ((sl_) & 7) * 128 + cg; \
        _Pragma("unroll") for (int p = 0; p < 2; ++p) _Pragma("unroll") for (int j = 0; j < 4; ++j) { const int tk = t0 + 32 * p - 3 + j; \
            dst[p][j] = (64 * n + tk >= 0) ? *(const u32x4*)(QKV + (size_t)(row0 + tk) * 3072 + ch_) : (u32x4){0u, 0u, 0u, 0u}; } \
        _Pragma("unroll") for (int j = 0; j < 4; ++j) { dw[j][0] = *(const f32x4*)(cw + j * 3072 + ch_); dw[j][1] = *(const f32x4*)(cw + j * 3072 + ch_ + 4); } } while (0)
    CONV_LOAD(cur, wc, 0);
#pragma unroll 1
    for (int sl = 0; sl < 24; ++sl) {
        const int part = sl >> 3, h = sl & 7;
        if (sl < 23) CONV_LOAD(nxt, wn, sl + 1);
#pragma unroll
        for (int p = 0; p < 2; ++p) {
            const int tok = t0 + 32 * p, r = row0 + tok;
            float a[8];
#pragma unroll
            for (int e = 0; e < 8; ++e) a[e] = 0.f;
#pragma unroll
            for (int j = 0; j < 4; ++j) { const u32x4 v = cur[p][j];
                a[0] += bf2f(v.x & 0xffffu) * wc[j][0][0]; a[1] += bf2f(v.x >> 16) * wc[j][0][1]; a[2] += bf2f(v.y & 0xffffu) * wc[j][0][2]; a[3] += bf2f(v.y >> 16) * wc[j][0][3];
                a[4] += bf2f(v.z & 0xffffu) * wc[j][1][0]; a[5] += bf2f(v.z >> 16) * wc[j][1][1]; a[6] += bf2f(v.w & 0xffffu) * wc[j][1][2]; a[7] += bf2f(v.w >> 16) * wc[j][1][3]; }
#pragma unroll
            for (int e = 0; e < 8; ++e) a[e] = siluf_(a[e]);
            if (part < 2) { float ss = ((a[0] * a[0] + a[1] * a[1]) + (a[2] * a[2] + a[3] * a[3])) + ((a[4] * a[4] + a[5] * a[5]) + (a[6] * a[6] + a[7] * a[7]));
                ss += __shfl_xor(ss, 1); ss += __shfl_xor(ss, 2); ss += __shfl_xor(ss, 4); ss += __shfl_xor(ss, 8);
                if (cg == 0) ((float*)(F.ws + (part == 0 ? WS_SSQ : WS_SSK)))[(size_t)(row0 + t0 + 32 * p) * 8 + h] = ss; }
            u32x4 o4; o4.x = pk2(a[0], a[1]); o4.y = pk2(a[2], a[3]); o4.z = pk2(a[4], a[5]); o4.w = pk2(a[6], a[7]);
            const size_t o = (size_t)r * 1024 + h * 128 + cg;
            if (part == 0) *(u32x4*)(QN + o) = o4;
            else { if (part == 1) *(u32x4*)(KN + o) = o4; *(LAS u32x4*)(slab + tok * SP + cg) = o4; }
            if (n == 127 && tok >= 61) { const u32x4 raw = cur[p][3]; float* cdst = F.out + O_GCP + ((size_t)b * 3 + (tok - 61)) * 3072 + part * 1024 + h * 128 + cg;
                *(f32x4*)cdst = (f32x4){bf2f(raw.x & 0xffffu), bf2f(raw.x >> 16), bf2f(raw.y & 0xffffu), bf2f(raw.y >> 16)};
                *(f32x4*)(cdst + 4) = (f32x4){bf2f(raw.z & 0xffffu), bf2f(raw.z >> 16), bf2f(raw.w & 0xffffu), bf2f(raw.w >> 16)}; }
        }
        if (part > 0) {
            __syncthreads();
            bf16_t* dst = (part == 1 ? KT : VT) + (size_t)((b * 8 + h) * 128 + n) * 8192;
#pragma unroll
            for (int u = 0; u < 2; ++u) { const int e = tid + 512 * u, chn = e >> 3, tg = e & 7; const LAS bf16_t* s = slab + (8 * tg) * SP + chn;
                u32x4 o4; o4.x = (unsigned)s[0] | ((unsigned)s[SP] << 16); o4.y = (unsigned)s[2 * SP] | ((unsigned)s[3 * SP] << 16);
                o4.z = (unsigned)s[4 * SP] | ((unsigned)s[5 * SP] << 16); o4.w = (unsigned)s[6 * SP] | ((unsigned)s[7 * SP] << 16);
                *(u32x4*)(dst + chn * 64 + 8 * tg) = o4; }
            __syncthreads();
        }
#pragma unroll
        for (int p = 0; p < 2; ++p)
#pragma unroll
            for (int j = 0; j < 4; ++j) cur[p][j] = nxt[p][j];
#pragma unroll
        for (int j = 0; j < 4; ++j) { wc[j][0] = wn[j][0]; wc[j][1] = wn[j][1]; }
    }
#undef CONV_LOAD
}
__device__ __forceinline__ void conv_sample_items(Frame& F) {
    const int gw = F.bid * NWAVES + F.wave, NGW = F.G * NWAVES, lane = F.lane;
    const bf16_t* QKV = (const bf16_t*)(F.ws + WS_QKV);
    bf16_t* QN = (bf16_t*)((unsigned char*)F.out + DO_QN); bf16_t* KN = (bf16_t*)((unsigned char*)F.out + DO_KN); bf16_t* VNS = (bf16_t*)((unsigned char*)F.out + DO_VNS);
    const float* cw = F.in[I_CONVW];
    for (int it = gw; it < MS * 8; it += NGW) {
        const int r = MP + (it >> 3), h = it & 7, bd = (r - MP) >> 2, s = (r - MP) & 3;
        float y[3][2];
#pragma unroll
        for (int part = 0; part < 3; ++part) {
            const int ch = part * 1024 + h * 128 + 2 * lane;
            float a0 = 0.f, a1 = 0.f;
#pragma unroll
            for (int j = 0; j < 4; ++j) {
                float x0, x1; const int i = s + j;
                if (i < 3) { const float* p = F.in[I_SCONV] + ((size_t)bd * 3 + i) * 3072 + ch; x0 = p[0]; x1 = p[1]; }
                else { const unsigned v = *(const unsigned*)(QKV + (size_t)(MP + bd * 4 + i - 3) * 3072 + ch); x0 = bf2f(v & 0xffffu); x1 = bf2f(v >> 16); }
                a0 += x0 * cw[j * 3072 + ch]; a1 += x1 * cw[j * 3072 + ch + 1];
            }
            y[part][0] = siluf_(a0); y[part][1] = siluf_(a1);
        }
        const float sq = wave_sum(y[0][0] * y[0][0] + y[0][1] * y[0][1]), sk = wave_sum(y[1][0] * y[1][0] + y[1][1] * y[1][1]);
        const float rq = rsqrtf(sq + EPS) * 0.08838834764831845f, rk = rsqrtf(sk + EPS);
        const size_t o = (size_t)r * 1024 + h * 128 + 2 * lane;
        *(unsigned*)(QN + o) = pk2(y[0][0] * rq, y[0][1] * rq);
        *(unsigned*)(KN + o) = pk2(y[1][0] * rk, y[1][1] * rk);
        *(unsigned*)(VNS + (size_t)(r - MP) * 1024 + h * 128 + 2 * lane) = pk2(y[2][0], y[2][1]);
        if (lane == 0) gdn_gate_scalars(F, r, h);
        if (s >= 1) { float* cdst = F.out + O_GCS + ((size_t)bd * 3 + (s - 1)) * 3072;
#pragma unroll
            for (int part = 0; part < 3; ++part) { const int ch = part * 1024 + h * 128 + 2 * lane; const unsigned v = *(const unsigned*)(QKV + (size_t)r * 3072 + ch);
                cdst[ch] = bf2f(v & 0xffffu); cdst[ch + 1] = bf2f(v >> 16); } }
    }
}
__device__ __forceinline__ void p2_conv(Frame& F) {
    for (int it = F.bid; it < 256; it += F.G) conv_prompt_item(F, it);
    conv_sample_items(F);
}

__device__ __forceinline__ f32x4 mfma16(bf16x8 a, bf16x8 b, f32x4 c) { return __builtin_amdgcn_mfma_f32_16x16x32_bf16(a, b, c, 0, 0, 0); }
__device__ __forceinline__ u32x2 pack4(f32x4 v) { u32x2 r; r.x = pk2(v[0], v[1]); r.y = pk2(v[2], v[3]); return r; }
__device__ __forceinline__ void prep_item(Frame& F, int item) {
    const int b = item >> 7, n = item & 127, row0 = b * SEQ + 64 * n, lane = F.lane, h = F.wave, c = lane & 15, q = lane >> 4;
    const int ci = (b * 8 + h) * 128 + n;
    const bf16_t* QN = (const bf16_t*)((const unsigned char*)F.out + DO_QN); const bf16_t* KN = (const bf16_t*)((const unsigned char*)F.out + DO_KN);
    const bf16_t* KT = (const bf16_t*)((const unsigned char*)F.out + DO_KT) + (size_t)ci * 8192; const bf16_t* VT = (const bf16_t*)((const unsigned char*)F.out + DO_VT) + (size_t)ci * 8192;
    bf16_t* NEGW = (bf16_t*)(F.ws + WS_NEGW) + (size_t)ci * 8192; bf16_t* UT = (bf16_t*)(F.ws + WS_UT) + (size_t)ci * 8192; bf16_t* ATT = (bf16_t*)(F.ws + WS_ATT) + (size_t)ci * 4096;
    const float* Gp = (const float*)(F.ws + WS_G); const float* Bp = (const float*)(F.ws + WS_BETA);
    float* GC = (float*)(F.ws + WS_GC); float* DEC = (float*)(F.ws + WS_DEC); float* GT = (float*)(F.ws + WS_GT);
    LAS float* Als = (LAS float*)(F.lds + h * 18432);
    LAS float* gcs = Als + 4096; LAS float* bes = gcs + 64;
    float gc = Gp[(size_t)(row0 + lane) * 8 + h];
#pragma unroll
    for (int o = 1; o < 64; o <<= 1) { const float x = __shfl_up(gc, o); if (lane >= o) gc += x; }
    const float beta = Bp[(size_t)(row0 + lane) * 8 + h];
    const float gl = __shfl(gc, 63);
    const float sk = ((const float*)(F.ws + WS_SSK))[(size_t)(row0 + lane) * 8 + h], sq = ((const float*)(F.ws + WS_SSQ))[(size_t)(row0 + lane) * 8 + h];
    const float rk = rsqrtf(sk + EPS), rq = rsqrtf(sq + EPS) * 0.08838834764831845f;
    LAS float* rks = bes + 64; LAS float* rqs = rks + 64;
    gcs[lane] = gc; bes[lane] = beta; rks[lane] = rk; rqs[lane] = rq;
    GC[(size_t)(row0 + lane) * 8 + h] = __expf(gc) * rq; DEC[(size_t)ci * 64 + lane] = __expf(gl - gc) * rk; if (lane == 0) GT[ci] = __expf(gl);
    LDS_WAIT(); asm volatile("" ::: "memory");
    bf16x8 kf[4][4];
#pragma unroll
    for (int mt = 0; mt < 4; ++mt)
#pragma unroll
        for (int s = 0; s < 4; ++s) { const size_t o = (size_t)(row0 + 16 * mt + c) * 1024 + h * 128 + 32 * s + 8 * q; kf[mt][s] = *(const bf16x8*)(KN + o); }
#pragma unroll
    for (int mi = 0; mi < 4; ++mi) {
        const int ii = 16 * mi + c; const float gci = gcs[ii], bi = bes[ii] * rks[ii], rqi = rqs[ii];
        const bf16_t* qrow_p = QN + (size_t)(row0 + ii) * 1024 + h * 128 + 8 * q;
#pragma unroll
        for (int nj = 0; nj < 4; ++nj) {
            u32x2 av; av.x = 0u; av.y = 0u;
            if (nj <= mi) {
                f32x4 dk = {0.f, 0.f, 0.f, 0.f}, dq = {0.f, 0.f, 0.f, 0.f};
#pragma unroll
                for (int s = 0; s < 4; ++s) { dk = mfma16(kf[nj][s], kf[mi][s], dk); dq = mfma16(kf[nj][s], *(const bf16x8*)(qrow_p + 32 * s), dq); }
                const f32x4 gj = *(const LAS f32x4*)(gcs + 16 * nj + 4 * q), rkj = *(const LAS f32x4*)(rks + 16 * nj + 4 * q);
                f32x4 a, at;
#pragma unroll
                for (int r = 0; r < 4; ++r) { const int jj = 16 * nj + 4 * q + r; const float e = __expf(gci - gj[r]);
                    a[r] = (ii > jj) ? bi * rkj[r] * dk[r] * e : 0.f; at[r] = (ii >= jj) ? rqi * rkj[r] * dq[r] * e : 0.f; }
                *(LAS f32x4*)(Als + ii * 64 + 16 * nj + 4 * q) = a;
                av = pack4(at);
            }
            *(u32x2*)(ATT + ii * 64 + 16 * nj + 4 * q) = av;
        }
    }
    LDS_WAIT();
    float t[64];
#pragma unroll
    for (int i = 0; i < 64; ++i) {
        float acc = (lane == i) ? 1.f : 0.f;
#pragma unroll
        for (int m4 = 0; m4 < i; m4 += 4) { const f32x4 a = *(const LAS f32x4*)(Als + i * 64 + m4);
            acc -= a[0] * t[m4]; if (m4 + 1 < i) acc -= a[1] * t[m4 + 1]; if (m4 + 2 < i) acc -= a[2] * t[m4 + 2]; if (m4 + 3 < i) acc -= a[3] * t[m4 + 3]; }
        t[i] = acc;
    }
    LAS bf16_t* T1 = (LAS bf16_t*)Als; LAS bf16_t* T2 = T1 + 64 * 72;
    const float s1 = beta, s2 = -beta * __expf(gc) * rk;
    LDS_WAIT();
#pragma unroll
    for (int i = 0; i < 64; ++i) { T1[i * 72 + lane] = (bf16_t)f2bf(t[i] * s1); T2[i * 72 + lane] = (bf16_t)f2bf(t[i] * s2); }
    LDS_WAIT();
    bf16x8 t1f[4][2], t2f[4][2];
#pragma unroll
    for (int it = 0; it < 4; ++it)
#pragma unroll
        for (int s = 0; s < 2; ++s) { t1f[it][s] = *(const LAS bf16x8*)(T1 + (16 * it + c) * 72 + 32 * s + 8 * q); t2f[it][s] = *(const LAS bf16x8*)(T2 + (16 * it + c) * 72 + 32 * s + 8 * q); }
#pragma unroll 2
    for (int dt = 0; dt < 8; ++dt) {
        bf16x8 vb[2], ka[2];
#pragma unroll
        for (int s = 0; s < 2; ++s) { vb[s] = *(const bf16x8*)(VT + (16 * dt + c) * 64 + 32 * s + 8 * q); ka[s] = *(const bf16x8*)(KT + (16 * dt + c) * 64 + 32 * s + 8 * q); }
#pragma unroll
        for (int it = 0; it < 4; ++it) {
            f32x4 du = {0.f, 0.f, 0.f, 0.f}, dw = {0.f, 0.f, 0.f, 0.f};
            du = mfma16(t1f[it][0], vb[0], du); dw = mfma16(ka[0], t2f[it][0], dw);
            if (it >= 2) { du = mfma16(t1f[it][1], vb[1], du); dw = mfma16(ka[1], t2f[it][1], dw); }
            *(u32x2*)(UT + (16 * dt + c) * 64 + 16 * it + 4 * q) = pack4(du);
            *(u32x2*)(NEGW + (16 * it + c) * 128 + 16 * dt + 4 * q) = pack4(dw);
        }
    }
    LDS_WAIT();
}
__device__ __forceinline__ void p2_prep(Frame& F) { for (int it = F.bid; it < 256; it += F.G) { prep_item(F, it); __syncthreads(); } }

__device__ __forceinline__ void scan_item(Frame& F, int bh, int sl) {
    const int lane = F.lane, w = F.wave, c = lane & 15, q = lane >> 4, dvs = 16 * sl;
    const bf16_t* KT = (const bf16_t*)((const unsigned char*)F.out + DO_KT); const bf16_t* NEGW = (const bf16_t*)(F.ws + WS_NEGW);
    bf16_t* UT = (bf16_t*)(F.ws + WS_UT); bf16_t* SN = (bf16_t*)(F.ws + WS_SN);
    const float* DEC = (const float*)(F.ws + WS_DEC); const float* GT = (const float*)(F.ws + WS_GT);
    LAS bf16_t* SS = (LAS bf16_t*)F.lds;
    LAS bf16_t* VS = SS + 16 * 136;
    LAS bf16_t* VU = VS + 16 * 72;
    f32x4 Sacc = {0.f, 0.f, 0.f, 0.f};
    for (int e = F.tid; e < 16 * 136 / 2; e += NTHREADS) ((LAS unsigned*)SS)[e] = 0u;
    struct Ops { bf16x8 wf[4], kf[2]; u32x2 u2; f32x4 dec4; float gt; };
#define SCAN_LOAD(o, n_) do { const size_t ci__ = (size_t)bh * 128 + ((n_) < 128 ? (n_) : 127); \
        _Pragma("unroll") for (int s = 0; s < 2; ++s) o.kf[s] = *(const bf16x8*)(KT + ci__ * 8192 + (16 * w + c) * 64 + 32 * s + 8 * q); \
        o.gt = GT[ci__]; \
        if (w < 4) { _Pragma("unroll") for (int s = 0; s < 4; ++s) o.wf[s] = *(const bf16x8*)(NEGW + ci__ * 8192 + (16 * w + c) * 128 + 32 * s + 8 * q); \
            o.u2 = *(const u32x2*)(UT + ci__ * 8192 + (dvs + c) * 64 + 16 * w + 4 * q); o.dec4 = *(const f32x4*)(DEC + ci__ * 64 + 16 * w + 4 * q); } } while (0)
#define SCAN_STEP(o, n_) do { const size_t ci = (size_t)bh * 128 + (n_); \
        if (w < 4) { \
            f32x4 v = {bf2f(o.u2.x & 0xffffu), bf2f(o.u2.x >> 16), bf2f(o.u2.y & 0xffffu), bf2f(o.u2.y >> 16)}; \
            _Pragma("unroll") for (int s = 0; s < 4; ++s) { const bf16x8 sf = *(const LAS bf16x8*)(SS + c * 136 + 32 * s + 8 * q); v = mfma16(o.wf[s], sf, v); } \
            *(LAS u32x2*)(VU + c * 72 + 16 * w + 4 * q) = pack4(v); \
            const f32x4 vd = v * o.dec4; \
            *(LAS u32x2*)(VS + c * 72 + 16 * w + 4 * q) = pack4(vd); \
        } else if (w == 4) {   \
            _Pragma("unroll") for (int u = 0; u < 4; ++u) { const int p = lane + 64 * u, r = p >> 4, cc = p & 15; \
                *(u32x4*)(SN + ci * 16384 + (dvs + r) * 128 + cc * 8) = *(const LAS u32x4*)(SS + r * 136 + cc * 8); } \
        } \
        asm volatile("s_waitcnt lgkmcnt(0)" ::: "memory"); __builtin_amdgcn_s_barrier(); asm volatile("" ::: "memory"); \
        Sacc = Sacc * o.gt; \
        _Pragma("unroll") for (int s = 0; s < 2; ++s) { const bf16x8 vf = *(const LAS bf16x8*)(VS + c * 72 + 32 * s + 8 * q); Sacc = mfma16(o.kf[s], vf, Sacc); } \
        if (w == 5) {   \
            _Pragma("unroll") for (int u = 0; u < 2; ++u) { const int p = lane + 64 * u, r = p >> 3, cc = p & 7; \
                *(u32x4*)(UT + ci * 8192 + (dvs + r) * 64 + cc * 8) = *(const LAS u32x4*)(VU + r * 72 + cc * 8); } } \
        { const u32x2 sp = pack4(Sacc); *(LAS u32x2*)(SS + c * 136 + 16 * w + 4 * q) = sp; } \
        asm volatile("s_waitcnt lgkmcnt(0)" ::: "memory"); __builtin_amdgcn_s_barrier(); asm volatile("" ::: "memory"); } while (0)
    Ops o0, o1, o2, o3;
    SCAN_LOAD(o0, 0); SCAN_LOAD(o1, 1); SCAN_LOAD(o2, 2);
    asm volatile("s_waitcnt lgkmcnt(0)" ::: "memory"); __builtin_amdgcn_s_barrier(); asm volatile("" ::: "memory");
#pragma unroll 1
    for (int n0 = 0; n0 < 128; n0 += 4) {
        SCAN_LOAD(o3, n0 + 3); SCAN_STEP(o0, n0);
        SCAN_LOAD(o0, n0 + 4); SCAN_STEP(o1, n0 + 1);
        SCAN_LOAD(o1, n0 + 5); SCAN_STEP(o2, n0 + 2);
        SCAN_LOAD(o2, n0 + 6); SCAN_STEP(o3, n0 + 3);
    }
#undef SCAN_LOAD
#undef SCAN_STEP
    float* so = F.out + O_GSP + (size_t)bh * 16384;
#pragma unroll
    for (int r = 0; r < 4; ++r) so[(size_t)(16 * w + 4 * q + r) * 128 + dvs + c] = Sacc[r];
}

__device__ __forceinline__ void gdn_out_item(Frame& F, int item) {
    const int b = item >> 7, n = item & 127, row0 = b * SEQ + 64 * n, lane = F.lane, h = F.wave, c = lane & 15, q = lane >> 4;
    const size_t ci = (size_t)(b * 8 + h) * 128 + n;
    const bf16_t* QN = (const bf16_t*)((const unsigned char*)F.out + DO_QN);
    const bf16_t* SN = (const bf16_t*)(F.ws + WS_SN) + ci * 16384; const bf16_t* VNT = (const bf16_t*)(F.ws + WS_UT) + ci * 8192; const bf16_t* ATT = (const bf16_t*)(F.ws + WS_ATT) + ci * 4096;
    const float* GC = (const float*)(F.ws + WS_GC); const bf16_t* GZ = (const bf16_t*)(F.ws + WS_GZ); bf16_t* OG = (bf16_t*)(F.ws + WS_OG); const float* gn = F.in[I_GNORM];
    LAS bf16_t* ol = (LAS bf16_t*)(F.lds + h * 18432);
    bf16x8 qf[4][4], af[4][2]; float egc[4], ss[4];
#pragma unroll
    for (int it = 0; it < 4; ++it) { const int i = 16 * it + c; const size_t r = (size_t)row0 + i;
#pragma unroll
        for (int s = 0; s < 4; ++s) qf[it][s] = *(const bf16x8*)(QN + r * 1024 + h * 128 + 32 * s + 8 * q);
#pragma unroll
        for (int s = 0; s < 2; ++s) af[it][s] = *(const bf16x8*)(ATT + i * 64 + 32 * s + 8 * q);
        egc[it] = GC[r * 8 + h]; ss[it] = 0.f; }
#pragma unroll 1
    for (int dt = 0; dt < 8; ++dt) {
        bf16x8 sf[4], vf[2];
#pragma unroll
        for (int s = 0; s < 4; ++s) sf[s] = *(const bf16x8*)(SN + (16 * dt + c) * 128 + 32 * s + 8 * q);
#pragma unroll
        for (int s = 0; s < 2; ++s) vf[s] = *(const bf16x8*)(VNT + (16 * dt + c) * 64 + 32 * s + 8 * q);
#pragma unroll
        for (int it = 0; it < 4; ++it) {
            f32x4 a = {0.f, 0.f, 0.f, 0.f};
#pragma unroll
            for (int s = 0; s < 4; ++s) a = mfma16(sf[s], qf[it][s], a);
            a = a * egc[it];
#pragma unroll
            for (int s = 0; s < 2; ++s) a = mfma16(vf[s], af[it][s], a);
            ss[it] += (a[0] * a[0] + a[1] * a[1]) + (a[2] * a[2] + a[3] * a[3]);
            *(LAS u32x2*)(ol + (16 * it + c) * 136 + 16 * dt + 4 * q) = pack4(a);
        }
    }
    LAS float* rsl = (LAS float*)(ol + 64 * 136);
#pragma unroll
    for (int it = 0; it < 4; ++it) { float s = ss[it]; s += __shfl_xor(s, 16); s += __shfl_xor(s, 32); if (q == 0) rsl[16 * it + c] = rsqrtf(s * (1.f / 128.f) + EPS); }
    LDS_WAIT();
#pragma unroll 4
    for (int u = 0; u < 16; ++u) { const int p = lane + 64 * u, tk = p >> 4, ch = p & 15;
        const size_t o = ((size_t)row0 + tk) * 1024 + h * 128 + ch * 8; const u32x4 z = *(const u32x4*)(GZ + o);
        const f32x4 g0 = *(const f32x4*)(gn + ch * 8), g1 = *(const f32x4*)(gn + ch * 8 + 4);
        const u32x4 pv = *(const LAS u32x4*)(ol + tk * 136 + ch * 8); const float r = rsl[tk]; u32x4 w;
        w.x = pk2(bf2f(pv.x & 0xffffu) * r * g0[0] * bf2f(z.x & 0xffffu), bf2f(pv.x >> 16) * r * g0[1] * bf2f(z.x >> 16));
        w.y = pk2(bf2f(pv.y & 0xffffu) * r * g0[2] * bf2f(z.y & 0xffffu), bf2f(pv.y >> 16) * r * g0[3] * bf2f(z.y >> 16));
        w.z = pk2(bf2f(pv.z & 0xffffu) * r * g1[0] * bf2f(z.z & 0xffffu), bf2f(pv.z >> 16) * r * g1[1] * bf2f(z.z >> 16));
        w.w = pk2(bf2f(pv.w & 0xffffu) * r * g1[2] * bf2f(z.w & 0xffffu), bf2f(pv.w >> 16) * r * g1[3] * bf2f(z.w >> 16));
        *(u32x4*)(OG + o) = w; }
    LDS_WAIT();
}

__device__ __forceinline__ void gdn_seq_item(Frame& F, int row0, int L, int h, const float* S0, float* Sout, bf16_t* OG) {
    const bf16_t* QN = (const bf16_t*)((unsigned char*)F.out + DO_QN); const bf16_t* KN = (const bf16_t*)((unsigned char*)F.out + DO_KN); const bf16_t* VNS = (const bf16_t*)((unsigned char*)F.out + DO_VNS);
    const float* Gp = (const float*)(F.ws + WS_G); const float* Bp = (const float*)(F.ws + WS_BETA);
    const int tid = F.tid, dvc = tid & 127, dkq = tid >> 7;
    constexpr int TB = 32;
    LAS float* sq = (LAS float*)F.lds;
    LAS float* sk = sq + TB * 128;
    LAS float* sv = sk + TB * 128;
    LAS float* sg = sv + TB * 128;
    LAS float* red = sg + 2 * TB;
    LAS float* redqk = red + 2 * 2 * 4 * 128;
    float S[32];
#pragma unroll
    for (int i = 0; i < 32; ++i) S[i] = S0 ? S0[(size_t)(32 * dkq + i) * 128 + dvc] : 0.f;
    int buf = 0;
    for (int t0 = 0; t0 < L; t0 += TB) {
        const int nb = (L - t0) < TB ? (L - t0) : TB;
        __syncthreads();
        for (int e = tid; e < nb * 128; e += NTHREADS) { const int tt = e >> 7, c = e & 127; const size_t o = (size_t)(row0 + t0 + tt) * 1024 + h * 128 + c;
            sq[e] = bf2f(QN[o]); sk[e] = bf2f(KN[o]); sv[e] = bf2f(VNS[o - (size_t)MP * 1024]); }
        if (tid < nb) { sg[tid] = expf(Gp[(size_t)(row0 + t0 + tid) * 8 + h]); sg[TB + tid] = Bp[(size_t)(row0 + t0 + tid) * 8 + h]; }
        __syncthreads();
        for (int tt = 0; tt < nb; ++tt) {
            const LAS float* kq = sk + tt * 128 + 32 * dkq; const LAS float* qq = sq + tt * 128 + 32 * dkq;
            float pk = 0.f, pq = 0.f, pqk = 0.f;
#pragma unroll
            for (int i = 0; i < 32; ++i) { const float kk = kq[i], qv = qq[i]; pk += kk * S[i]; pq += qv * S[i]; pqk += qv * kk; }
            LAS float* rb = red + buf * 1024;
            rb[dkq * 128 + dvc] = pk; rb[512 + dkq * 128 + dvc] = pq; if (dvc == 0) redqk[buf * 4 + dkq] = pqk;
            __syncthreads();
            const float kS = (rb[dvc] + rb[128 + dvc]) + (rb[256 + dvc] + rb[384 + dvc]);
            const float qS = (rb[512 + dvc] + rb[640 + dvc]) + (rb[768 + dvc] + rb[896 + dvc]);
            const float qk = (redqk[buf * 4] + redqk[buf * 4 + 1]) + (redqk[buf * 4 + 2] + redqk[buf * 4 + 3]);
            const float e = sg[tt], beta = sg[TB + tt];
            const float vnew = beta * (sv[tt * 128 + dvc] - e * kS);
            const float o = e * qS + qk * vnew;
#pragma unroll
            for (int i = 0; i < 32; ++i) S[i] = e * S[i] + kq[i] * vnew;
            if (dkq == 0) OG[(size_t)(row0 + t0 + tt) * 1024 + h * 128 + dvc] = (bf16_t)f2bf(o);
            buf ^= 1;
        }
    }
#pragma unroll
    for (int i = 0; i < 32; ++i) Sout[(size_t)(32 * dkq + i) * 128 + dvc] = S[i];
    __syncthreads();
}
__device__ __forceinline__ void p2_gdn_sample(Frame& F, int wk, int nwk, int lo, int hi) {
    bf16_t* OG = (bf16_t*)(F.ws + WS_OG);
    for (int q = lo + wk; q < hi; q += nwk) { const int bd = q >> 3, h = q & 7; gdn_seq_item(F, MP + bd * 4, 4, h, F.in[I_SGDN] + (size_t)q * 16384, F.out + O_GSS + (size_t)q * 16384, OG); }
}
__device__ __forceinline__ void p2_gdn_norm_sample(Frame& F) {
    const int gw = F.bid * NWAVES + F.wave, NGW = F.G * NWAVES, lane = F.lane;
    bf16_t* OG = (bf16_t*)(F.ws + WS_OG); const bf16_t* GZ = (const bf16_t*)(F.ws + WS_GZ); const float* gn = F.in[I_GNORM];
    for (int it = gw; it < MS * 8; it += NGW) {
        const size_t o = (size_t)(MP + (it >> 3)) * 1024 + (it & 7) * 128 + 2 * lane;
        const unsigned v = *(const unsigned*)(OG + o), z = *(const unsigned*)(GZ + o);
        const float a = bf2f(v & 0xffffu), b = bf2f(v >> 16);
        const float r = rsqrtf(wave_sum(a * a + b * b) * (1.f / 128.f) + EPS);
        *(unsigned*)(OG + o) = pk2(a * r * gn[2 * lane] * bf2f(z & 0xffffu), b * r * gn[2 * lane + 1] * bf2f(z >> 16));
    }
}

__device__ __forceinline__ void swa_wave_item(Frame& F, bool sample, int bidx, int t, int kv) {
    const int lane = F.lane;
    LAS float* qs = (LAS float*)(F.lds + F.wave * 8192);
    LAS float* ps = qs + 512;
    const bf16_t* SQ = (const bf16_t*)(F.ws + WS_SQ); const bf16_t* SKV = (const bf16_t*)(F.ws + WS_SKV); const bf16_t* SZ = (const bf16_t*)(F.ws + WS_SZ);
    const float* BT = (const float*)(F.ws + WS_BTAB);
    const int row = sample ? MP + bidx * 4 + t : bidx * SEQ + t;
    const int qpos = sample ? 128 + t : t;
    for (int e = lane; e < 512; e += 64) qs[e] = bf2f(SQ[(size_t)row * 1024 + kv * 512 + e]);
    LDS_WAIT();
#pragma unroll 1
    for (int u = 0; u < 2; ++u) {
        const int j = lane + 64 * u; const int kp = qpos - j;
        float kr[64];
        const bool valid = kp >= 0;
        if (valid) {
            if (sample && kp < 128) { const float* p = F.in[I_CSK] + (((size_t)bidx * 128 + kp) * 2 + kv) * 64;
#pragma unroll
                for (int d = 0; d < 64; d += 4) { const f32x4 v = *(const f32x4*)(p + d); kr[d] = v.x; kr[d + 1] = v.y; kr[d + 2] = v.z; kr[d + 3] = v.w; } }
            else { const int krow = sample ? MP + bidx * 4 + (kp - 128) : bidx * SEQ + kp; const bf16_t* p = SKV + (size_t)krow * 256 + kv * 64;
#pragma unroll
                for (int d = 0; d < 64; d += 8) { const u32x4 v = *(const u32x4*)(p + d);
                    kr[d] = bf2f(v.x & 0xffffu); kr[d + 1] = bf2f(v.x >> 16); kr[d + 2] = bf2f(v.y & 0xffffu); kr[d + 3] = bf2f(v.y >> 16);
                    kr[d + 4] = bf2f(v.z & 0xffffu); kr[d + 5] = bf2f(v.z >> 16); kr[d + 6] = bf2f(v.w & 0xffffu); kr[d + 7] = bf2f(v.w >> 16); } }
        } else {
#pragma unroll
            for (int d = 0; d < 64; ++d) kr[d] = 0.f;
        }
#pragma unroll 1
        for (int g = 0; g < 8; ++g) { float a = 0.f;
#pragma unroll
            for (int d = 0; d < 64; d += 4) { const f32x4 qv = *(const LAS f32x4*)(qs + g * 64 + d); a += kr[d] * qv.x + kr[d + 1] * qv.y + kr[d + 2] * qv.z + kr[d + 3] * qv.w; }
            ps[g * 128 + j] = valid ? a * 0.125f + BT[(kv * 8 + g) * 128 + j] : -INFINITY; }
    }
    LDS_WAIT();
    float inv[8];
#pragma unroll
    for (int g = 0; g < 8; ++g) {
        const float sink = F.in[I_SINKS][kv * 8 + g];
        const float l0 = ps[g * 128 + lane], l1 = ps[g * 128 + 64 + lane];
        const float mx = fmaxf(wave_max(fmaxf(l0, l1)), sink);
        const float p0 = __expf(l0 - mx), p1 = __expf(l1 - mx);
        const float den = wave_sum(p0 + p1) + __expf(sink - mx);
        inv[g] = 1.f / den;
        ps[g * 128 + lane] = p0; ps[g * 128 + 64 + lane] = p1;
    }
    LDS_WAIT();
    float o[8];
#pragma unroll
    for (int g = 0; g < 8; ++g) o[g] = 0.f;
#pragma unroll 1
    for (int j0 = 0; j0 < 128; j0 += 8) {
        float vv[8];
#pragma unroll
        for (int u = 0; u < 8; ++u) { int kp = qpos - (j0 + u); kp = kp < 0 ? 0 : kp;
            if (sample && kp < 128) vv[u] = F.in[I_CSV][(((size_t)bidx * 128 + kp) * 2 + kv) * 64 + lane];
            else { const int krow = sample ? MP + bidx * 4 + (kp - 128) : bidx * SEQ + kp; vv[u] = bf2f(SKV[(size_t)krow * 256 + 128 + kv * 64 + lane]); } }
#pragma unroll
        for (int u = 0; u < 8; ++u)
#pragma unroll
            for (int g = 0; g < 8; ++g) o[g] += ps[g * 128 + j0 + u] * vv[u];
    }
    bf16_t* OS = (bf16_t*)(F.ws + WS_OS);
#pragma unroll
    for (int g = 0; g < 8; ++g) { const size_t oo = (size_t)row * 1024 + (kv * 8 + g) * 64 + lane; OS[oo] = (bf16_t)f2bf(o[g] * inv[g] * bf2f(SZ[oo])); }
    LDS_WAIT();
}
__device__ __forceinline__ bf16x8 cat8(u32x2 a, u32x2 b) { u32x4 t; t.x = a.x; t.y = a.y; t.z = b.x; t.w = b.y; return __builtin_bit_cast(bf16x8, t); }
__device__ __forceinline__ void mem_mfma_item(Frame& F, int b, int h, int qt) {
    const int lane = F.lane, c = lane & 15, q = lane >> 4;
    const bf16_t* Kp = (const bf16_t*)(F.ws + WS_MEMKV) + (size_t)(b * 256) * 2048 + h * 256;
    const bf16_t* VTp = (const bf16_t*)(F.ws + WS_MVT) + (size_t)((b * 4 + h) * 256) * 256;
    const bf16_t* MQ = (const bf16_t*)(F.ws + WS_MQ); const bf16_t* MZ = (const bf16_t*)(F.ws + WS_MZ); bf16_t* OM = (bf16_t*)(F.ws + WS_OM);
    const size_t qrow = (size_t)b * SEQ + 16 * qt + c;
    bf16x8 qf[8];
#pragma unroll
    for (int s = 0; s < 8; ++s) qf[s] = *(const bf16x8*)(MQ + qrow * 1024 + h * 256 + 32 * s + 8 * q);
    f32x4 sacc[16];
#pragma unroll
    for (int mt = 0; mt < 16; ++mt) { f32x4 a = {0.f, 0.f, 0.f, 0.f};
#pragma unroll
        for (int s = 0; s < 8; ++s) a = mfma16(*(const bf16x8*)(Kp + (size_t)(16 * mt + c) * 2048 + 32 * s + 8 * q), qf[s], a);
        sacc[mt] = a; }
    float mx = -INFINITY;
#pragma unroll
    for (int mt = 0; mt < 16; ++mt) mx = fmaxf(mx, fmaxf(fmaxf(sacc[mt][0], sacc[mt][1]), fmaxf(sacc[mt][2], sacc[mt][3])));
    mx = fmaxf(mx, __shfl_xor(mx, 16)); mx = fmaxf(mx, __shfl_xor(mx, 32));
    float sum = 0.f; const float sc = 0.0625f * 1.4426950408889634f;
#pragma unroll
    for (int mt = 0; mt < 16; ++mt)
#pragma unroll
        for (int r = 0; r < 4; ++r) { const float p = exp2f((sacc[mt][r] - mx) * sc); sacc[mt][r] = p; sum += p; }
    sum += __shfl_xor(sum, 16); sum += __shfl_xor(sum, 32);
    const float inv = 1.f / sum;
    bf16x8 pf[8];
#pragma unroll
    for (int ks = 0; ks < 8; ++ks) pf[ks] = cat8(pack4(sacc[2 * ks]), pack4(sacc[2 * ks + 1]));
#pragma unroll 4
    for (int dt = 0; dt < 16; ++dt) { f32x4 o = {0.f, 0.f, 0.f, 0.f};
#pragma unroll
        for (int ks = 0; ks < 8; ++ks) { const bf16_t* vp = VTp + (size_t)(16 * dt + c) * 256 + 32 * ks + 4 * q;
            o = mfma16(cat8(*(const u32x2*)vp, *(const u32x2*)(vp + 16)), pf[ks], o); }
        const size_t oo = qrow * 1024 + h * 256 + 16 * dt + 4 * q; const u32x2 z = *(const u32x2*)(MZ + oo);
        o[0] *= inv * bf2f(z.x & 0xffffu); o[1] *= inv * bf2f(z.x >> 16); o[2] *= inv * bf2f(z.y & 0xffffu); o[3] *= inv * bf2f(z.y >> 16);
        *(u32x2*)(OM + oo) = pack4(o); }
}
__device__ __forceinline__ void swa_mfma_item(Frame& F, int b, int h, int a) {
    const int lane = F.lane, c = lane & 15, q = lane >> 4, kv = h >> 3;
    const bf16_t* SQ = (const bf16_t*)(F.ws + WS_SQ); const bf16_t* SKV = (const bf16_t*)(F.ws + WS_SKV); const bf16_t* SZ = (const bf16_t*)(F.ws + WS_SZ); bf16_t* OS = (bf16_t*)(F.ws + WS_OS);
    const bf16_t* VTp = (const bf16_t*)(F.ws + WS_VTS) + (size_t)((b * 2 + kv) * 64) * SEQ;
    const LAS float* BTl = (const LAS float*)(F.lds + LDS_BT) + h * 128;
    const size_t qrow = (size_t)b * SEQ + 16 * a + c;
    bf16x8 qf[2];
#pragma unroll
    for (int s = 0; s < 2; ++s) qf[s] = *(const bf16x8*)(SQ + qrow * 1024 + h * 64 + 32 * s + 8 * q);
    f32x4 p[10];
    const float sink = F.in[I_SINKS][h];
    float mx = sink;
#pragma unroll
    for (int u = 0; u < 9; ++u) {
        const int kbase = 16 * (a - 8 + u);
        f32x4 d = {0.f, 0.f, 0.f, 0.f};
        if (kbase >= 0) {
#pragma unroll
            for (int s = 0; s < 2; ++s) d = mfma16(*(const bf16x8*)(SKV + ((size_t)b * SEQ + kbase + c) * 256 + kv * 64 + 32 * s + 8 * q), qf[s], d);
        }
#pragma unroll
        for (int r = 0; r < 4; ++r) { const int dist = (16 * a + c) - (kbase + 4 * q + r); const bool valid = kbase >= 0 && dist >= 0 && dist < 128;
            const float l = valid ? d[r] * 0.125f + BTl[dist & 127] : -INFINITY; d[r] = l; mx = fmaxf(mx, l); }
        p[u] = d;
    }
    mx = fmaxf(mx, __shfl_xor(mx, 16)); mx = fmaxf(mx, __shfl_xor(mx, 32));
    float sum = 0.f;
#pragma unroll
    for (int u = 0; u < 9; ++u)
#pragma unroll
        for (int r = 0; r < 4; ++r) { const float e = __expf(p[u][r] - mx); p[u][r] = e; sum += e; }
    p[9] = (f32x4){0.f, 0.f, 0.f, 0.f};
    sum += __shfl_xor(sum, 16); sum += __shfl_xor(sum, 32);
    const float inv = 1.f / (sum + __expf(sink - mx));
    bf16x8 pf[5];
#pragma unroll
    for (int ks = 0; ks < 5; ++ks) pf[ks] = cat8(pack4(p[2 * ks]), pack4(p[2 * ks + 1]));
#pragma unroll
    for (int dt = 0; dt < 4; ++dt) { f32x4 o = {0.f, 0.f, 0.f, 0.f};
#pragma unroll
        for (int ks = 0; ks < 5; ++ks) { int m0 = 16 * (a - 8 + 2 * ks) + 4 * q, m1 = m0 + 16;
            m0 = m0 < 0 ? 0 : m0; m1 = m1 < 0 ? 0 : (m1 > SEQ - 4 ? SEQ - 4 : m1);
            const bf16_t* vp = VTp + (size_t)(16 * dt + c) * SEQ;
            o = mfma16(cat8(*(const u32x2*)(vp + m0), *(const u32x2*)(vp + m1)), pf[ks], o); }
        const size_t oo = qrow * 1024 + h * 64 + 16 * dt + 4 * q; const u32x2 z = *(const u32x2*)(SZ + oo);
        o[0] *= inv * bf2f(z.x & 0xffffu); o[1] *= inv * bf2f(z.x >> 16); o[2] *= inv * bf2f(z.y & 0xffffu); o[3] *= inv * bf2f(z.y >> 16);
        *(u32x2*)(OS + oo) = pack4(o); }
}
__device__ __forceinline__ void swa_wg_item(Frame& F, int b, int kv, int qb) {
    int lane_ = F.lane, tid_ = F.tid; asm volatile("" : "+v"(lane_), "+v"(tid_));
    const int lane = lane_, c = lane & 15, q = lane >> 4, tid = tid_, h = kv * 8 + F.wave;
    const bf16_t* SQ = (const bf16_t*)(F.ws + WS_SQ); const bf16_t* SKV = (const bf16_t*)(F.ws + WS_SKV); const bf16_t* SZ = (const bf16_t*)(F.ws + WS_SZ); bf16_t* OS = (bf16_t*)(F.ws + WS_OS);
    const bf16_t* VTg = (const bf16_t*)(F.ws + WS_VTS) + (size_t)((b * 2 + kv) * 64) * SEQ;
    LAS unsigned char* Kl = F.lds; LAS unsigned char* Vl = F.lds + 32768;
    const LAS float* BTl = (const LAS float*)(F.lds + LDS_BT) + h * 128;
    const int kstart = 128 * (qb - 1);
    __syncthreads();
    {   u32x4 kr[4], vr[4];
#pragma unroll
        for (int u = 0; u < 4; ++u) { const int p = tid + 512 * u, key = p >> 3, ch = p & 7;
            kr[u] = (kstart + key >= 0) ? *(const u32x4*)(SKV + ((size_t)b * SEQ + kstart + key) * 256 + kv * 64 + ch * 8) : (u32x4){0u, 0u, 0u, 0u};
            const int d = p >> 5, c16 = p & 31;
            vr[u] = (kstart + c16 * 8 >= 0) ? *(const u32x4*)(VTg + (size_t)d * SEQ + kstart + c16 * 8) : (u32x4){0u, 0u, 0u, 0u}; }
#pragma unroll
        for (int u = 0; u < 4; ++u) { const int p = tid + 512 * u, key = p >> 3, ch = p & 7;
            *(LAS u32x4*)(Kl + key * 128 + ((ch ^ ((key >> 1) & 7)) << 4)) = kr[u];
            const int d = p >> 5, c16 = p & 31;
            *(LAS u32x4*)(Vl + d * 512 + (((2 * c16) ^ (2 * (d & 15))) << 3)) = vr[u]; } }
    __syncthreads();
    const float sink = F.in[I_SINKS][h];
    bf16x8 qfa[8][2];
#pragma unroll
    for (int ap = 0; ap < 8; ++ap)
#pragma unroll
        for (int s = 0; s < 2; ++s) qfa[ap][s] = *(const bf16x8*)(SQ + ((size_t)b * SEQ + 128 * qb + 16 * ap + c) * 1024 + h * 64 + 32 * s + 8 * q);
#pragma unroll
    for (int ap = 0; ap < 8; ++ap) {
        const size_t qrow = (size_t)b * SEQ + 128 * qb + 16 * ap + c;
        bf16x8 qf[2]; qf[0] = qfa[ap][0]; qf[1] = qfa[ap][1];
        u32x2 zz[4];
#pragma unroll
        for (int dt = 0; dt < 4; ++dt) zz[dt] = *(const u32x2*)(SZ + qrow * 1024 + h * 64 + 16 * dt + 4 * q);
        f32x4 p[10]; float mx = sink;
#pragma unroll
        for (int u = 0; u < 9; ++u) {
            const int wt = ap + u, row = 16 * wt + c;
            f32x4 d = {0.f, 0.f, 0.f, 0.f};
#pragma unroll
            for (int s = 0; s < 2; ++s) d = mfma16(*(const LAS bf16x8*)(Kl + row * 128 + (((4 * s + q) ^ ((row >> 1) & 7)) << 4)), qf[s], d);
            const bool tile_ok = (qb > 0) || (wt >= 8);
#pragma unroll
            for (int r = 0; r < 4; ++r) { const int dist = 128 - 16 * u + c - 4 * q - r; const bool valid = tile_ok && dist >= 0 && dist < 128;
                const float l = valid ? d[r] * 0.125f + BTl[dist & 127] : -INFINITY; d[r] = l; mx = fmaxf(mx, l); }
            p[u] = d;
        }
        mx = fmaxf(mx, __shfl_xor(mx, 16)); mx = fmaxf(mx, __shfl_xor(mx, 32));
        float sum = 0.f;
#pragma unroll
        for (int u = 0; u < 9; ++u)
#pragma unroll
            for (int r = 0; r < 4; ++r) { const float e = __expf(p[u][r] - mx); p[u][r] = e; sum += e; }
        p[9] = (f32x4){0.f, 0.f, 0.f, 0.f};
        sum += __shfl_xor(sum, 16); sum += __shfl_xor(sum, 32);
        const float inv = 1.f / (sum + __expf(sink - mx));
        bf16x8 pf[5];
#pragma unroll
        for (int ks = 0; ks < 5; ++ks) pf[ks] = cat8(pack4(p[2 * ks]), pack4(p[2 * ks + 1]));
#pragma unroll
        for (int dt = 0; dt < 4; ++dt) { f32x4 o = {0.f, 0.f, 0.f, 0.f}; const int dd = 16 * dt + c; const LAS unsigned char* vrow = Vl + dd * 512; const int sw = 2 * (dd & 15);
#pragma unroll
            for (int ks = 0; ks < 5; ++ks) { const int wt0 = ap + 2 * ks; int wt1 = wt0 + 1; wt1 = wt1 > 15 ? 15 : wt1;
                const u32x2 v0 = *(const LAS u32x2*)(vrow + (((4 * wt0 + q) ^ sw) << 3)), v1 = *(const LAS u32x2*)(vrow + (((4 * wt1 + q) ^ sw) << 3));
                o = mfma16(cat8(v0, v1), pf[ks], o); }
            const size_t oo = qrow * 1024 + h * 64 + 16 * dt + 4 * q; const u32x2 z = zz[dt];
            o[0] *= inv * bf2f(z.x & 0xffffu); o[1] *= inv * bf2f(z.x >> 16); o[2] *= inv * bf2f(z.y & 0xffffu); o[3] *= inv * bf2f(z.y >> 16);
            *(u32x2*)(OS + oo) = pack4(o); }
        asm volatile("" ::: "memory");
    }
}
__device__ __forceinline__ void mem_wg_item(Frame& F, int b, int h, int qblk) {
    int lane_ = F.lane, tid_ = F.tid; asm volatile("" : "+v"(lane_), "+v"(tid_));
    const int lane = lane_, c = lane & 15, q = lane >> 4, tid = tid_, w = F.wave;
    const bf16_t* Kg = (const bf16_t*)(F.ws + WS_MEMKV) + (size_t)(b * 256) * 2048 + h * 256;
    const bf16_t* VTg = (const bf16_t*)(F.ws + WS_MVT) + (size_t)((b * 4 + h) * 256) * 256;
    const bf16_t* MQ = (const bf16_t*)(F.ws + WS_MQ); const bf16_t* MZ = (const bf16_t*)(F.ws + WS_MZ); bf16_t* OM = (bf16_t*)(F.ws + WS_OM);
    LAS unsigned char* L = F.lds;
    __syncthreads();
#pragma unroll
    for (int hf = 0; hf < 2; ++hf) { u32x4 kr[8];
#pragma unroll
        for (int u = 0; u < 8; ++u) { const int p = tid + 512 * (u + 8 * hf), key = p >> 5, ch = p & 31; kr[u] = *(const u32x4*)(Kg + (size_t)key * 2048 + ch * 8); }
#pragma unroll
        for (int u = 0; u < 8; ++u) { const int p = tid + 512 * (u + 8 * hf), key = p >> 5, ch = p & 31; *(LAS u32x4*)(L + key * 512 + ((ch ^ (key & 15)) << 4)) = kr[u]; } }
    __syncthreads();
    size_t qrow[2];
#pragma unroll
    for (int t = 0; t < 2; ++t) qrow[t] = (size_t)b * SEQ + 256 * qblk + 32 * w + 16 * t + c;
    f32x4 sacc[2][16];
#pragma unroll
    for (int mt = 0; mt < 16; ++mt) { sacc[0][mt] = (f32x4){0.f, 0.f, 0.f, 0.f}; sacc[1][mt] = (f32x4){0.f, 0.f, 0.f, 0.f}; }
    bf16x8 qn0 = *(const bf16x8*)(MQ + qrow[0] * 1024 + h * 256 + 8 * q), qn1 = *(const bf16x8*)(MQ + qrow[1] * 1024 + h * 256 + 8 * q);
#pragma unroll 1
    for (int s = 0; s < 8; ++s) {
        const bf16x8 q0 = qn0, q1 = qn1; const int sn = s < 7 ? s + 1 : 7;
        qn0 = *(const bf16x8*)(MQ + qrow[0] * 1024 + h * 256 + 32 * sn + 8 * q); qn1 = *(const bf16x8*)(MQ + qrow[1] * 1024 + h * 256 + 32 * sn + 8 * q);
#pragma unroll
        for (int mt = 0; mt < 16; ++mt) { const int row = 16 * mt + c;
            const bf16x8 kf = *(const LAS bf16x8*)(L + row * 512 + (((4 * s + q) ^ (row & 15)) << 4));
            sacc[0][mt] = mfma16(kf, q0, sacc[0][mt]); sacc[1][mt] = mfma16(kf, q1, sacc[1][mt]); }
        asm volatile("" ::: "memory");
    }
    float inv[2]; bf16x8 pf[2][8];
    const float sc = 0.0625f * 1.4426950408889634f;
#pragma unroll
    for (int t = 0; t < 2; ++t) { float mx = -INFINITY;
#pragma unroll
        for (int mt = 0; mt < 16; ++mt) mx = fmaxf(mx, fmaxf(fmaxf(sacc[t][mt][0], sacc[t][mt][1]), fmaxf(sacc[t][mt][2], sacc[t][mt][3])));
        mx = fmaxf(mx, __shfl_xor(mx, 16)); mx = fmaxf(mx, __shfl_xor(mx, 32));
        float sum = 0.f;
#pragma unroll
        for (int mt = 0; mt < 16; ++mt)
#pragma unroll
            for (int r = 0; r < 4; ++r) { const float e = exp2f((sacc[t][mt][r] - mx) * sc); sacc[t][mt][r] = e; sum += e; }
        sum += __shfl_xor(sum, 16); sum += __shfl_xor(sum, 32); inv[t] = 1.f / sum;
#pragma unroll
        for (int ks = 0; ks < 8; ++ks) pf[t][ks] = cat8(pack4(sacc[t][2 * ks]), pack4(sacc[t][2 * ks + 1])); }
    __syncthreads();
#pragma unroll
    for (int hf = 0; hf < 2; ++hf) { u32x4 vr[8];
#pragma unroll
        for (int u = 0; u < 8; ++u) { const int p = tid + 512 * (u + 8 * hf), d = p >> 5, c16 = p & 31; vr[u] = *(const u32x4*)(VTg + (size_t)d * 256 + c16 * 8); }
#pragma unroll
        for (int u = 0; u < 8; ++u) { const int p = tid + 512 * (u + 8 * hf), d = p >> 5, c16 = p & 31; *(LAS u32x4*)(L + d * 512 + (((2 * c16) ^ (2 * (d & 15))) << 3)) = vr[u]; } }
    __syncthreads();
    u32x2 zn0 = *(const u32x2*)(MZ + qrow[0] * 1024 + h * 256 + 4 * q), zn1 = *(const u32x2*)(MZ + qrow[1] * 1024 + h * 256 + 4 * q);
#pragma unroll 1
    for (int dt = 0; dt < 16; ++dt) { f32x4 o0 = {0.f, 0.f, 0.f, 0.f}, o1 = {0.f, 0.f, 0.f, 0.f}; const int dd = 16 * dt + c;
        const u32x2 zc0 = zn0, zc1 = zn1; const int dn = dt < 15 ? dt + 1 : 15;
        zn0 = *(const u32x2*)(MZ + qrow[0] * 1024 + h * 256 + 16 * dn + 4 * q); zn1 = *(const u32x2*)(MZ + qrow[1] * 1024 + h * 256 + 16 * dn + 4 * q); const LAS unsigned char* vrow = L + dd * 512; const int sw = 2 * (dd & 15);
#pragma unroll
        for (int ks = 0; ks < 8; ++ks) { const bf16x8 vf = cat8(*(const LAS u32x2*)(vrow + (((8 * ks + q) ^ sw) << 3)), *(const LAS u32x2*)(vrow + (((8 * ks + 4 + q) ^ sw) << 3)));
            o0 = mfma16(vf, pf[0][ks], o0); o1 = mfma16(vf, pf[1][ks], o1); }
#pragma unroll
        for (int t = 0; t < 2; ++t) { f32x4 o = t ? o1 : o0; const size_t oo = qrow[t] * 1024 + h * 256 + 16 * dt + 4 * q; const u32x2 z = t ? zc1 : zc0;
            o[0] *= inv[t] * bf2f(z.x & 0xffffu); o[1] *= inv[t] * bf2f(z.x >> 16); o[2] *= inv[t] * bf2f(z.y & 0xffffu); o[3] *= inv[t] * bf2f(z.y >> 16);
            *(u32x2*)(OM + oo) = pack4(o); }
        asm volatile("" ::: "memory"); }
}
__device__ __forceinline__ void p2_attn_prompt(Frame& F, int wk, int nwk) {
    const int gw = wk * NWAVES + F.wave, NGW = nwk * NWAVES, lane = F.lane;
    { LAS float* BTl = (LAS float*)(F.lds + LDS_BT); const float* BT = (const float*)(F.ws + WS_BTAB); for (int i = F.tid; i < 2048; i += NTHREADS) BTl[i] = BT[i]; }
    __syncthreads();
    for (int it = wk; it < 256; it += nwk) { const int qblk = it & 31, bh = it >> 5; mem_wg_item(F, bh >> 2, bh & 3, qblk); }
    for (int it = wk; it < 256; it += nwk) { const int qb = it & 63, bk = it >> 6; swa_wg_item(F, bk >> 1, bk & 1, qb); }
    __syncthreads();
    const bf16_t* SKV = (const bf16_t*)(F.ws + WS_SKV);
    for (int it = gw; it < 256; it += NGW) { const int b = it >> 7, j = it & 127; const bf16_t* pp = SKV + (size_t)(b * SEQ + SEQ - 128 + j) * 256;
        for (int cc = lane; cc < 128; cc += 64) { F.out[O_SKP + ((size_t)b * 128 + j) * 128 + cc] = bf2f(pp[cc]); F.out[O_SVP + ((size_t)b * 128 + j) * 128 + cc] = bf2f(pp[128 + cc]); } }
}
__device__ __forceinline__ void p2_swa_sample(Frame& F, int wk, int nwk) {
    const int gw = wk * NWAVES + F.wave, NGW = nwk * NWAVES, lane = F.lane;
    const bf16_t* SKV = (const bf16_t*)(F.ws + WS_SKV);
    for (int it = gw; it < MS * 2; it += NGW) { const int r = it >> 1, kv = it & 1; swa_wave_item(F, true, r >> 2, r & 3, kv); }
    { const u32x4* s4 = (const u32x4*)(F.ws + WS_OMS); u32x4* d4 = (u32x4*)(F.ws + WS_OM + (size_t)MP * 1024 * 2); for (int i = gw * 64 + lane; i < MS * 1024 / 8; i += NGW * 64) d4[i] = s4[i]; }
    { const int gt = gw * 64 + lane, NT = NGW * 64;
        for (int i = gt; i < 128 * 124 * 32; i += NT) { const int bd = i / (124 * 32), e = i - bd * (124 * 32);
            ((f32x4*)(F.out + O_SKS + (size_t)bd * 16384))[e] = ((const f32x4*)(F.in[I_CSK] + (size_t)bd * 16384 + 512))[e];
            ((f32x4*)(F.out + O_SVS + (size_t)bd * 16384))[e] = ((const f32x4*)(F.in[I_CSV] + (size_t)bd * 16384 + 512))[e]; }
        for (int i = gt; i < 128 * 4 * 128; i += NT) { const int bd = i >> 9, jj = (i >> 7) & 3, cc = i & 127; const bf16_t* pp = SKV + (size_t)(MP + bd * 4 + jj) * 256;
            F.out[O_SKS + ((size_t)bd * 128 + 124 + jj) * 128 + cc] = bf2f(pp[cc]); F.out[O_SVS + ((size_t)bd * 128 + 124 + jj) * 128 + cc] = bf2f(pp[128 + cc]); } }
}
__device__ __forceinline__ void mem_sample_item(Frame& F, int bd, int hp) {
    const int lane = F.lane, w = F.wave, tid = F.tid, hl = lane >> 5, h = 2 * hp + hl, d0 = (lane & 31) * 8;
    const bf16_t* MQ = (const bf16_t*)(F.ws + WS_MQ); const bf16_t* MZ = (const bf16_t*)(F.ws + WS_MZ); bf16_t* OM = (bf16_t*)(F.ws + WS_OM);
    LAS float* lg = (LAS float*)F.lds;
    LAS float* isum = lg + 2048;
    LAS float* po = isum + 8;
    float qr[4][8];
#pragma unroll
    for (int s = 0; s < 4; ++s) { const u32x4 v = *(const u32x4*)(MQ + (size_t)(MP + bd * 4 + s) * 1024 + h * 256 + d0);
        qr[s][0] = bf2f(v.x & 0xffffu); qr[s][1] = bf2f(v.x >> 16); qr[s][2] = bf2f(v.y & 0xffffu); qr[s][3] = bf2f(v.y >> 16);
        qr[s][4] = bf2f(v.z & 0xffffu); qr[s][5] = bf2f(v.z >> 16); qr[s][6] = bf2f(v.w & 0xffffu); qr[s][7] = bf2f(v.w >> 16); }
    const float* Kc = F.in[I_CMK] + ((size_t)bd * 256 * 4 + h) * 256 + d0; const float* Vc = F.in[I_CMV] + ((size_t)bd * 256 * 4 + h) * 256 + d0;
#pragma unroll 4
    for (int i = 0; i < 32; ++i) { const int m = w + 8 * i; const f32x4 k0 = *(const f32x4*)(Kc + (size_t)m * 1024), k1 = *(const f32x4*)(Kc + (size_t)m * 1024 + 4);
        float l[4];
#pragma unroll
        for (int s = 0; s < 4; ++s) { float a = k0.x * qr[s][0] + k0.y * qr[s][1] + k0.z * qr[s][2] + k0.w * qr[s][3] + k1.x * qr[s][4] + k1.y * qr[s][5] + k1.z * qr[s][6] + k1.w * qr[s][7];
#pragma unroll
            for (int o = 1; o < 32; o <<= 1) a += __shfl_xor(a, o);
            l[s] = a * 0.0625f; }
        if ((lane & 31) == 0) {
#pragma unroll
            for (int s = 0; s < 4; ++s) lg[(hl * 4 + s) * 256 + m] = l[s]; } }
    __syncthreads();
    { const int pr = w; float l4[4];
#pragma unroll
        for (int u = 0; u < 4; ++u) l4[u] = lg[pr * 256 + lane + 64 * u];
        const float mx = wave_max(fmaxf(fmaxf(l4[0], l4[1]), fmaxf(l4[2], l4[3]))); float s = 0.f;
#pragma unroll
        for (int u = 0; u < 4; ++u) { l4[u] = __expf(l4[u] - mx); s += l4[u]; lg[pr * 256 + lane + 64 * u] = l4[u]; }
        s = wave_sum(s); if (lane == 0) isum[pr] = 1.f / s; }
    __syncthreads();
    float o[4][8];
#pragma unroll
    for (int s = 0; s < 4; ++s)
#pragma unroll
        for (int j = 0; j < 8; ++j) o[s][j] = 0.f;
#pragma unroll 4
    for (int i = 0; i < 32; ++i) { const int m = w + 8 * i; const f32x4 v0 = *(const f32x4*)(Vc + (size_t)m * 1024), v1 = *(const f32x4*)(Vc + (size_t)m * 1024 + 4);
#pragma unroll
        for (int s = 0; s < 4; ++s) { const float p = lg[(hl * 4 + s) * 256 + m];
            o[s][0] += p * v0.x; o[s][1] += p * v0.y; o[s][2] += p * v0.z; o[s][3] += p * v0.w; o[s][4] += p * v1.x; o[s][5] += p * v1.y; o[s][6] += p * v1.z; o[s][7] += p * v1.w; } }
#pragma unroll
    for (int s = 0; s < 4; ++s) { LAS float* pp = po + ((w * 4 + s) * 512 + hl * 256 + d0);
        *(LAS f32x4*)pp = (f32x4){o[s][0], o[s][1], o[s][2], o[s][3]}; *(LAS f32x4*)(pp + 4) = (f32x4){o[s][4], o[s][5], o[s][6], o[s][7]}; }
    __syncthreads();
#pragma unroll
    for (int u = 0; u < 4; ++u) { const int e = tid + 512 * u, s = e >> 9, cc = e & 511; float a = 0.f;
#pragma unroll
        for (int ww = 0; ww < 8; ++ww) a += po[(ww * 4 + s) * 512 + cc];
        const int hh = 2 * hp + (cc >> 8); const size_t oo = (size_t)(MP + bd * 4 + s) * 1024 + hh * 256 + (cc & 255);
        ((bf16_t*)(F.ws + WS_OMS))[oo - (size_t)MP * 1024] = (bf16_t)f2bf(a * isum[(cc >> 8) * 4 + s] * bf2f(MZ[oo])); }
    __syncthreads();
}

struct SchedP3 {
    int G, c; const unsigned char* ws;
    __device__ __forceinline__ int ntiles(const pg8::Unit&) const { return 1024 / 64; }
    __device__ __forceinline__ bool next(int i, pg8::Unit& u) const {
        if (i < 6) { const int round = i / 3, b = i - round * 3; pg8::tile_of(round * G + c, 64, 8, u.pm, u.pn); u.job = b; return true; }
        if (i == 6 && c < 48) { u.pm = 64 + c / 24; const int rem = c % 24; u.pn = rem / 3; u.job = rem % 3; return true; }
        return false;
    }
    __device__ __forceinline__ void ptrs(const pg8::Unit& u, const char*& A, const char*& B) const {
        A = (const char*)ws + WS_OG + (size_t)u.job * M * 1024 * 2 + (size_t)u.pm * 256 * 1024 * 2;
        B = (const char*)ws + WS_WB + (size_t)u.job * 2048 * 1024 * 2 + (size_t)u.pn * 256 * 1024 * 2;
    }
};
struct EpiP3 {
    unsigned char* ws;
    __device__ __forceinline__ void operator()(const f32x4 (&acc)[2][2][4][2], const pg8::Unit& u, int wr, int wc, int fr, int fq) const {
        const int row0 = u.pm * 256 + wr * 64 + fr, col0 = u.pn * 256 + wc * 32 + 8 * fq, b = u.job;
        const bf16_t* GT = (const bf16_t*)(ws + WS_GATES); bf16_t* MG = (bf16_t*)(ws + WS_MERGED);
        const bool rmw = (b > 0) && (u.pm < 64);
#pragma unroll
        for (int ai = 0; ai < 2; ++ai) {
            u32x4 g[4][2], p[4][2];
#pragma unroll
            for (int m = 0; m < 4; ++m)
#pragma unroll
                for (int bj = 0; bj < 2; ++bj) { const int r = row0 + ai * 128 + m * 16, c = col0 + bj * 128;
                    g[m][bj] = *(const u32x4*)(GT + (size_t)r * 6144 + b * 2048 + c);
                    p[m][bj] = rmw ? *(const u32x4*)(MG + (size_t)r * 2048 + c) : (u32x4){0u, 0u, 0u, 0u}; }
#pragma unroll
            for (int m = 0; m < 4; ++m)
#pragma unroll
                for (int bj = 0; bj < 2; ++bj) { const int r = row0 + ai * 128 + m * 16, c = col0 + bj * 128;
                    const u32x4 gg = g[m][bj], pp = p[m][bj];
                    f32x4 v0 = acc[ai][bj][m][0], v1 = acc[ai][bj][m][1];
                    v0[0] = v0[0] * bf2f(gg.x & 0xffffu) + bf2f(pp.x & 0xffffu); v0[1] = v0[1] * bf2f(gg.x >> 16) + bf2f(pp.x >> 16); v0[2] = v0[2] * bf2f(gg.y & 0xffffu) + bf2f(pp.y & 0xffffu); v0[3] = v0[3] * bf2f(gg.y >> 16) + bf2f(pp.y >> 16);
                    v1[0] = v1[0] * bf2f(gg.z & 0xffffu) + bf2f(pp.z & 0xffffu); v1[1] = v1[1] * bf2f(gg.z >> 16) + bf2f(pp.z >> 16); v1[2] = v1[2] * bf2f(gg.w & 0xffffu) + bf2f(pp.w & 0xffffu); v1[3] = v1[3] * bf2f(gg.w >> 16) + bf2f(pp.w >> 16);
                    u32x4 w; w.x = pg8::cvt_pk_bf16(v0[0], v0[1]); w.y = pg8::cvt_pk_bf16(v0[2], v0[3]); w.z = pg8::cvt_pk_bf16(v1[0], v1[1]); w.w = pg8::cvt_pk_bf16(v1[2], v1[3]);
                    u32x4* mp = u.pm < 64 ? (u32x4*)(MG + (size_t)r * 2048 + c) : (u32x4*)((bf16_t*)(ws + WS_PS) + ((size_t)b * MS + (r - MP)) * 2048 + c);
                    *mp = w; }
        }
    }
};

struct SchedP4 {
    int G, c; const unsigned char* ws;
    __device__ __forceinline__ int ntiles(const pg8::Unit& u) const { return u.job == 0 ? D / 64 : 512 / 64; }
    __device__ __forceinline__ bool next(int i, pg8::Unit& u) const {
        if (i < 2) { pg8::tile_of(i * G + c, 64, 8, u.pm, u.pn); u.job = 0; return true; }
        if (i == 2 && c < 64) { u.pm = 64 + c / 32; const int rem = c % 32; u.pn = rem / 4; u.job = 1 + (rem & 3); return true; }
        return false;
    }
    __device__ __forceinline__ void ptrs(const pg8::Unit& u, const char*& A, const char*& B) const {
        const size_t ko = u.job == 0 ? 0 : (size_t)(u.job - 1) * 512 * 2;
        A = (const char*)ws + WS_MERGED + (size_t)u.pm * 256 * 2048 * 2 + ko; B = (const char*)ws + WS_WO + (size_t)u.pn * 256 * 2048 * 2 + ko;
    }
};
struct EpiP4 {
    unsigned char* ws; float* out; const float* xp; const float* xs;
    __device__ __forceinline__ void operator()(const f32x4 (&acc)[2][2][4][2], const pg8::Unit& u, int wr, int wc, int fr, int fq) const {
        const int row0 = u.pm * 256 + wr * 64 + fr, col0 = u.pn * 256 + wc * 32 + 8 * fq;
        if (u.job != 0) {
#pragma unroll
            for (int ai = 0; ai < 2; ++ai)
#pragma unroll
                for (int m = 0; m < 4; ++m) { const int r = row0 + ai * 128 + m * 16; float* yp = (float*)(ws + WS_YP) + ((size_t)(u.job - 1) * MS + (r - MP)) * D;
#pragma unroll
                    for (int bj = 0; bj < 2; ++bj) { const int c = col0 + bj * 128; *(f32x4*)(yp + c) = acc[ai][bj][m][0]; *(f32x4*)(yp + c + 4) = acc[ai][bj][m][1]; } }
            return;
        }
#pragma unroll
        for (int ai = 0; ai < 2; ++ai)
#pragma unroll
            for (int mh = 0; mh < 2; ++mh) {
                f32x4 xv[2][2][2];
#pragma unroll
                for (int mm = 0; mm < 2; ++mm)
#pragma unroll
                    for (int bj = 0; bj < 2; ++bj) { const float* xr = xp + (size_t)(row0 + ai * 128 + (2 * mh + mm) * 16) * D + col0 + bj * 128; xv[mm][bj][0] = *(const f32x4*)xr; xv[mm][bj][1] = *(const f32x4*)(xr + 4); }
#pragma unroll
                for (int mm = 0; mm < 2; ++mm)
#pragma unroll
                    for (int bj = 0; bj < 2; ++bj) { float* yr = out + (size_t)(row0 + ai * 128 + (2 * mh + mm) * 16) * D + col0 + bj * 128;
                        *(f32x4*)yr = acc[ai][bj][2 * mh + mm][0] + xv[mm][bj][0]; *(f32x4*)(yr + 4) = acc[ai][bj][2 * mh + mm][1] + xv[mm][bj][1]; }
            }
    }
};
__device__ __forceinline__ void p3_combine_sample(Frame& F) {
    const u32x4* ps = (const u32x4*)(F.ws + WS_PS); u32x4* mg = (u32x4*)(F.ws + WS_MERGED + (size_t)MP * 2048 * 2);
    constexpr int NV = MS * 2048 / 8;
    for (int i = F.bid * NTHREADS + F.tid; i < NV; i += F.G * NTHREADS) { const u32x4 a = ps[i], b = ps[NV + i], c = ps[2 * NV + i]; u32x4 o;
        o.x = pk2(bf2f(a.x & 0xffffu) + bf2f(b.x & 0xffffu) + bf2f(c.x & 0xffffu), bf2f(a.x >> 16) + bf2f(b.x >> 16) + bf2f(c.x >> 16));
        o.y = pk2(bf2f(a.y & 0xffffu) + bf2f(b.y & 0xffffu) + bf2f(c.y & 0xffffu), bf2f(a.y >> 16) + bf2f(b.y >> 16) + bf2f(c.y >> 16));
        o.z = pk2(bf2f(a.z & 0xffffu) + bf2f(b.z & 0xffffu) + bf2f(c.z & 0xffffu), bf2f(a.z >> 16) + bf2f(b.z >> 16) + bf2f(c.z >> 16));
        o.w = pk2(bf2f(a.w & 0xffffu) + bf2f(b.w & 0xffffu) + bf2f(c.w & 0xffffu), bf2f(a.w >> 16) + bf2f(b.w >> 16) + bf2f(c.w >> 16));
        mg[i] = o; }
}
__device__ __forceinline__ void p5_final_norm(Frame& F) {
    const int gw = F.bid * NWAVES + F.wave, NGW = F.G * NWAVES, lane = F.lane;
    const f32x4* wn = (const f32x4*)F.in[I_NORMF] + lane;
    for (int r = gw; r < M; r += NGW) {
        f32x4* y = (f32x4*)(F.out + (size_t)r * D) + lane;
        f32x4 v[8]; float s = 0.f;
        if (r >= MP) { const f32x4* xs4 = (const f32x4*)(F.in[I_XS] + (size_t)(r - MP) * D) + lane; const f32x4* yp4 = (const f32x4*)((const float*)(F.ws + WS_YP) + (size_t)(r - MP) * D) + lane;
#pragma unroll
            for (int j = 0; j < 8; ++j) { f32x4 a = xs4[64 * j];
#pragma unroll
                for (int kq = 0; kq < 4; ++kq) a = a + yp4[(size_t)kq * MS * D / 4 + 64 * j];
                v[j] = a; s += (a.x * a.x + a.y * a.y) + (a.z * a.z + a.w * a.w); } }
        else
#pragma unroll
        for (int j = 0; j < 8; ++j) { v[j] = y[64 * j]; s += (v[j].x * v[j].x + v[j].y * v[j].y) + (v[j].z * v[j].z + v[j].w * v[j].w); }
        const float sc = rsqrtf(wave_sum(s) * (1.f / D) + EPS);
#pragma unroll
        for (int j = 0; j < 8; ++j) { const f32x4 w = wn[64 * j]; f32x4 o = v[j]; o.x *= sc * w.x; o.y *= sc * w.y; o.z *= sc * w.z; o.w *= sc * w.w; y[64 * j] = o; }
    }
}

constexpr int N_PHASES = 10;
__global__ void __launch_bounds__(NTHREADS, 2) hybrid_fwd(Args args) {
    extern __shared__ __attribute__((aligned(16))) unsigned char lds_raw[];
    cg::grid_group grid = cg::this_grid();
    Frame F;
    F.lds = (LAS unsigned char*)lds_raw; F.tid = threadIdx.x; F.lane = F.tid & 63; F.wave = __builtin_amdgcn_readfirstlane(F.tid >> 6);
    F.G = gridDim.x; F.bid = blockIdx.x; F.in = args.in; F.out = args.out; F.ws = args.ws;
    const int lo = args.ph_lo, hi = args.ph_hi;
    if (lo < 0) grid.sync();
    if (F.tid < 64) ((LAS unsigned*)(F.lds + LDS_CTL))[F.tid] = 0u;
    __syncthreads();
    const XcdBarrier bar = xcd_barrier_post((unsigned*)(F.ws + WS_CTL), (volatile LAS unsigned*)(F.lds + LDS_CTL));
#define IN(k) (lo <= (k) && (k) < hi)
#define SEAM(k) do { if (IN(k) && IN((k) + 1)) xcd_barrier(bar); } while (0)
    if (IN(0)) p0_prologue(F);
    SEAM(0);
    if (IN(1)) { SchedP1 S{F.G, F.bid, F.ws, (const unsigned char*)F.out + DO_XN}; EpiP1 E{F.ws, F.out}; pg8::gemm_phase<EpiP1, SchedP1>(F.lds, D, S, E); }
    SEAM(1);
    if (IN(2)) { p2_conv(F); __syncthreads(); for (int it = F.bid; it < 256; it += F.G) mem_sample_item(F, it >> 1, it & 1); }
    SEAM(2);
    if (IN(3)) p2_prep(F);
    SEAM(3);
    if (IN(4)) {
        constexpr int GSPLIT = 640;
        if (F.bid < 128) { scan_item(F, F.bid & 15, F.bid >> 4); __syncthreads(); p2_gdn_sample(F, F.bid, 128, 0, GSPLIT); }
        else { const int wk = F.bid - 128, nwk = F.G - 128; p2_attn_prompt(F, wk, nwk); __syncthreads(); p2_swa_sample(F, wk, nwk); __syncthreads(); p2_gdn_sample(F, wk, nwk, GSPLIT, 1024); }
    }
    SEAM(4);
    if (IN(5)) { for (int it = F.bid; it < 256; it += F.G) gdn_out_item(F, it); p2_gdn_norm_sample(F); }
    SEAM(5);
    if (IN(6)) { SchedP3 S{F.G, F.bid, F.ws}; EpiP3 E{F.ws}; pg8::gemm_phase<EpiP3, SchedP3>(F.lds, 1024, S, E); }
    SEAM(6);
    if (IN(7)) p3_combine_sample(F);
    SEAM(7);
    if (IN(8)) { SchedP4 S{F.G, F.bid, F.ws}; EpiP4 E{F.ws, F.out, F.in[I_XP], F.in[I_XS]}; pg8::gemm_phase<EpiP4, SchedP4>(F.lds, D, S, E); }
    SEAM(8);
    if (IN(9)) p5_final_norm(F);
#undef IN
#undef SEAM
}

extern "C" void kernel_launch(void* const* d_in, const int* in_sizes, int n_in, void* d_out, int out_size, void* d_ws, size_t ws_size, hipStream_t stream) {
    static int grid = 0;
    if (grid == 0) {
        if (n_in != 22 || out_size != (int)O_END || ws_size < WS_END) { fprintf(stderr, "kernel_launch: unexpected shapes (n_in %d out %d ws %zu need %zu)\n", n_in, out_size, ws_size, (size_t)WS_END); grid = -1; return; }
        int dev = 0, cus = 0, per_cu = 0;
        hipGetDevice(&dev); hipDeviceGetAttribute(&cus, hipDeviceAttributeMultiprocessorCount, dev);
        hipFuncSetAttribute((const void*)hybrid_fwd, hipFuncAttributeMaxDynamicSharedMemorySize, LDS_BYTES);
        hipOccupancyMaxActiveBlocksPerMultiprocessor(&per_cu, (const void*)hybrid_fwd, NTHREADS, LDS_BYTES);
        if (per_cu < 1) { fprintf(stderr, "kernel_launch: occupancy query says %d blocks per CU\n", per_cu); grid = -1; return; }
        grid = cus;
    }
    if (grid < 0) return;
    Args a{};
    for (int i = 0; i < 22; ++i) a.in[i] = (const float*)d_in[i];
    a.out = (float*)d_out; a.ws = (unsigned char*)d_ws;
    if (hipMemsetAsync((char*)d_ws + WS_CTL, 0, XCD_BAR_WORDS * 4, stream) != hipSuccess) { fprintf(stderr, "kernel_launch: hipMemsetAsync failed\n"); return; }
#if MK_N_LAUNCHES == 1
    a.ph_lo = 0; a.ph_hi = N_PHASES;
    void* kargs[] = {&a};
    hipError_t e = hipLaunchCooperativeKernel((const void*)hybrid_fwd, dim3(grid), dim3(NTHREADS), kargs, LDS_BYTES, stream);
    if (e != hipSuccess) fprintf(stderr, "cooperative launch failed: %s (grid %d)\n", hipGetErrorString(e), grid);
#endif
}
```

```cpp
#include <hip/hip_runtime.h>
#include <hip/hip_cooperative_groups.h>
#include <cstdio>
#include <cstdint>
namespace cg = cooperative_groups;

#ifndef MK_N_LAUNCHES
#define MK_N_LAUNCHES 1
#endif

#define LAS __attribute__((address_space(3)))
typedef unsigned short bf16_t;
typedef short bf16x8 __attribute__((ext_vector_type(8)));
typedef float f32x4 __attribute__((ext_vector_type(4)));
typedef unsigned u32x4 __attribute__((ext_vector_type(4)));
typedef unsigned u32x2 __attribute__((ext_vector_type(2)));

constexpr int D = 2048, SEQ = 8192, MP = 2 * SEQ, MS = 512, M = MP + MS;
constexpr int IN_COLS = 14608;
constexpr int NIN = 58 * 256;
constexpr float EPS = 1e-6f;
__host__ __device__ __forceinline__ int win_src_col(int j) {
    if (j < 4096) return j;
    if (j < 5120) return 4112 + (j - 4096);
    if (j < 6144) return 5392 + (j - 5120);
    if (j < 7168) return 6416 + (j - 6144);
    if (j < 8192) return 7440 + (j - 7168);
    if (j < 14336) return 8464 + (j - 8192);
    if (j < 14592) return 5136 + (j - 14336);
    if (j < 14608) return 4096 + (j - 14592);
    return -1;
}
constexpr size_t O_YP = 0, O_YS = O_YP + (size_t)MP * D, O_GSP = O_YS + (size_t)MS * D, O_GCP = O_GSP + 2 * 8 * 128 * 128, O_SKP = O_GCP + 2 * 3 * 3072,
                 O_SVP = O_SKP + 2 * 128 * 128, O_MKP = O_SVP + 2 * 128 * 128, O_MVP = O_MKP + 512 * 1024, O_GSS = O_MVP + 512 * 1024,
                 O_GCS = O_GSS + (size_t)128 * 8 * 128 * 128, O_SKS = O_GCS + 128 * 3 * 3072, O_SVS = O_SKS + 128 * 128 * 128, O_END = O_SVS + 128 * 128 * 128;
static_assert(O_END == 58148864, "d_out map");
constexpr size_t al(size_t x) { return (x + 255) & ~(size_t)255; }
constexpr size_t WS_CTL = 0, WS_WB = 1u << 20, WS_WO = WS_WB + al((size_t)3 * 2048 * 1024 * 2), WS_WIN = WS_WO + al((size_t)2048 * 2048 * 2),
                 WS_WMKV = WS_WIN + al((size_t)NIN * 2048 * 2), WS_QKV = WS_WMKV + al((size_t)2048 * 2048 * 2), WS_GZ = WS_QKV + al((size_t)M * 3072 * 2),
                 WS_SQ = WS_GZ + al((size_t)M * 1024 * 2), WS_SZ = WS_SQ + al((size_t)M * 1024 * 2), WS_MQ = WS_SZ + al((size_t)M * 1024 * 2), WS_MZ = WS_MQ + al((size_t)M * 1024 * 2),
                 WS_SKV = WS_MZ + al((size_t)M * 1024 * 2), WS_GATES = WS_SKV + al((size_t)M * 256 * 2), WS_MEMN = WS_GATES + al((size_t)M * 6144 * 2),
                 WS_MEMKV = WS_MEMN + al((size_t)512 * 2048 * 2), WS_GAB = WS_MEMKV + al((size_t)512 * 2048 * 2), WS_ROWSS = WS_GAB + al((size_t)M * 16 * 4),
                 WS_G = WS_ROWSS + al((size_t)M * 4), WS_BETA = WS_G + al((size_t)M * 8 * 4), WS_BTAB = WS_BETA + al((size_t)M * 8 * 4), WS_END0 = WS_BTAB + al(16 * 128 * 4);
constexpr size_t WS_OG = WS_QKV, WS_OS = WS_OG + (size_t)M * 1024 * 2, WS_OM = WS_OS + (size_t)M * 1024 * 2, WS_MERGED = WS_SQ;
constexpr size_t WS_NEGW = WS_OG, WS_SN = WS_WIN, WS_OMS = WS_MEMN;
constexpr size_t WS_UT = WS_END0, WS_ATT = WS_UT + al((size_t)2048 * 128 * 64 * 2), WS_GC = WS_ATT + al((size_t)2048 * 64 * 64 * 2), WS_DEC = WS_GC + al((size_t)MP * 8 * 4),
                 WS_GT = WS_DEC + al((size_t)2048 * 64 * 4), WS_MVT = WS_GT + al(2048 * 4), WS_VTS = WS_MVT + al((size_t)2 * 4 * 256 * 256 * 2), WS_SSQ = WS_VTS + al((size_t)2 * 2 * 64 * SEQ * 2 + 4096), WS_SSK = WS_SSQ + al((size_t)MP * 8 * 4), WS_END = WS_SSK + al((size_t)MP * 8 * 4);
constexpr size_t WS_PS = WS_UT, WS_YP = WS_UT + (size_t)3 * MS * 2048 * 2;
static_assert((size_t)3 * MS * 2048 * 2 + (size_t)4 * MS * 2048 * 4 <= (size_t)2048 * 128 * 64 * 2, "PS/YP fit in UT");
static_assert(WS_OM + (size_t)M * 1024 * 2 <= WS_GZ && WS_MERGED + (size_t)M * 2048 * 2 <= WS_MQ, "overlays");
static_assert((size_t)2048 * 64 * 128 * 2 <= (size_t)MP * 1024 * 2 && WS_SN + (size_t)2048 * 128 * 128 * 2 <= WS_QKV, "overlays 2");
static_assert(WS_END <= 670000000, "workspace budget");
constexpr size_t DO_XN = 0, DO_QN = 0, DO_KN = (size_t)M * 1024 * 2, DO_KT = 2 * (size_t)M * 1024 * 2, DO_VT = DO_KT + (size_t)2048 * 8192 * 2, DO_VNS = DO_VT + (size_t)2048 * 8192 * 2;
static_assert(DO_VNS + (size_t)512 * 1024 * 2 <= (size_t)M * D * 4, "y scratch");

constexpr int NWAVES = 8, NTHREADS = 512;
constexpr int LDS_CTL = 147456;
constexpr int LDS_BYTES = 147456 + 256;
constexpr int LDS_BT = 139264;

__device__ __forceinline__ float bf2f(unsigned v) { return __uint_as_float(v << 16); }
__device__ __forceinline__ unsigned f2bf(float f) { unsigned u = __float_as_uint(f); return (u + 0x7fffu + ((u >> 16) & 1u)) >> 16; }
__device__ __forceinline__ unsigned pk2(float lo, float hi) { return f2bf(lo) | (f2bf(hi) << 16); }
__device__ __forceinline__ float wave_sum(float v) {
#pragma unroll
    for (int o = 1; o < 64; o <<= 1) v += __shfl_xor(v, o);
    return v;
}
__device__ __forceinline__ float wave_max(float v) {
#pragma unroll
    for (int o = 1; o < 64; o <<= 1) v = fmaxf(v, __shfl_xor(v, o));
    return v;
}
__device__ __forceinline__ float sigmoidf_(float x) { return __builtin_amdgcn_rcpf(1.f + __expf(-x)); }
__device__ __forceinline__ float siluf_(float x) { return x * __builtin_amdgcn_rcpf(1.f + __expf(-x)); }
#define LDS_WAIT() asm volatile("s_waitcnt lgkmcnt(0)" ::: "memory")

namespace pg8 {
constexpr int BM = 256, BK = 64, HALF = 128, HTB = HALF * BK * 2, STAGE_BYTES = 8 * HTB, NXCD = 8, WGM = 8;
__host__ __device__ __forceinline__ int lds_byte(int r, int c) { const int st = (r >> 4) * 2 + (c >> 5), rr = r & 15, cc = c & 31, ob = rr * 64 + cc * 2; return st * 1024 + (ob ^ (((ob >> 9) & 1) << 5)); }
__host__ __device__ __forceinline__ void stage_rc(int b, int& R, int& C) { const int st = b / 1024, sb = b % 1024, swz = sb ^ (((sb >> 9) & 1) << 5); R = (st >> 1) * 16 + swz / 64; C = (st & 1) * 32 + (swz % 64) / 2; }
__host__ __device__ __forceinline__ int perm32(int rho) { const int n = rho >> 4, i = rho & 15; return 8 * (i >> 2) + 4 * n + (i & 3); }
struct Unit { int pm, pn, job; };
__device__ __forceinline__ void tile_of(int L, int nM, int nN, int& pm, int& pn) {
    const int nwg = nM * nN; int wgid = L;
    { const int q = nwg / NXCD, r = nwg % NXCD, xcd = wgid % NXCD, off = wgid / NXCD; wgid = (xcd < r ? xcd * (q + 1) : r * (q + 1) + (xcd - r) * q) + off; }
    const int nig = WGM * nN, gid = wgid / nig, fm = gid * WGM, gsz = (nM - fm) < WGM ? (nM - fm) : WGM;
    pm = fm + ((wgid % nig) % gsz); pn = (wgid % nig) / gsz;
}
__device__ __forceinline__ unsigned cvt_pk_bf16(float lo, float hi) { unsigned r; asm volatile("v_cvt_pk_bf16_f32 %0, %1, %2" : "=v"(r) : "v"(lo), "v"(hi)); return r; }

template <class Epi, class Sched, bool ALIGN_EPI = true>
__device__ __forceinline__ void gemm_phase(LAS unsigned char* lds, const int K, const Sched& S, const Epi& E) {
    const int tid = threadIdx.x, wid = __builtin_amdgcn_readfirstlane(tid >> 6), lane = tid & 63, wr = wid >> 2, wc = wid & 3, fr = lane & 15, fq = lane >> 4;
    unsigned voffA[2], voffB[2];
#pragma unroll
    for (int i = 0; i < 2; ++i) { int R, C; stage_rc(tid * 16 + i * 8192, R, C); const int Rb = ((R & ~31) + perm32(R & 31));
        voffA[i] = (unsigned)(R * K + C) * 2u; voffB[i] = (unsigned)(Rb * K + C) * 2u; }
    const size_t kstep = (size_t)(BK * 2);
    const size_t hstep = (size_t)HALF * K * 2;
    const unsigned ldsw = (unsigned)wid * 1024u;
    const int aoff = lds_byte(wr * 64 + fr, fq * 8), boff = lds_byte(wc * 32 + fr, fq * 8);
#define PG8_SA(b, h) (((b) * 2 + (h)) * HTB)
#define PG8_SB(b, h) ((4 + (b) * 2 + (h)) * HTB)
#define PG8_STAGE(bufoff, gbase, voff) do { _Pragma("unroll") for (int _i = 0; _i < 2; ++_i) \
        __builtin_amdgcn_global_load_lds((const unsigned*)((const char*)(gbase) + (voff)[_i]), (LAS unsigned*)(lds + (bufoff) + ldsw + _i * 8192), 16, 0, 0); } while (0)
#define PG8_LDA(dst, b, h) do { _Pragma("unroll") for (int m = 0; m < 4; ++m) _Pragma("unroll") for (int k = 0; k < 2; ++k) dst[m][k] = *(const LAS bf16x8*)(lds + PG8_SA(b, h) + aoff + m * 2048 + k * 1024); } while (0)
#define PG8_LDB(dst, b, h) do { _Pragma("unroll") for (int n = 0; n < 2; ++n) _Pragma("unroll") for (int k = 0; k < 2; ++k) dst[n][k] = *(const LAS bf16x8*)(lds + PG8_SB(b, h) + boff + n * 2048 + k * 1024); } while (0)
#define PG8_MMA(ai, bj, At, Bt) do { __builtin_amdgcn_s_setprio(1); _Pragma("unroll") for (int m = 0; m < 4; ++m) _Pragma("unroll") for (int n = 0; n < 2; ++n) _Pragma("unroll") for (int k = 0; k < 2; ++k) \
        acc[ai][bj][m][n] = __builtin_amdgcn_mfma_f32_16x16x32_bf16(Bt[n][k], At[m][k], acc[ai][bj][m][n], 0, 0, 0); __builtin_amdgcn_s_setprio(0); } while (0)
#define PG8_WAIT_V(n) asm volatile("s_waitcnt vmcnt(" #n ")" ::: "memory")
#define PG8_WAIT_L(n) asm volatile("s_waitcnt lgkmcnt(" #n ")" ::: "memory")
#define PG8_BAR __builtin_amdgcn_s_barrier()
#define PG8_SCHED __builtin_amdgcn_sched_barrier(0)
    Unit cur, nxt; int ui = 0;
    if (!S.next(0, cur)) return;
    f32x4 acc[2][2][4][2];
#pragma unroll
    for (int a = 0; a < 2; ++a)
#pragma unroll
        for (int b = 0; b < 2; ++b)
#pragma unroll
            for (int m = 0; m < 4; ++m)
#pragma unroll
                for (int n = 0; n < 2; ++n) acc[a][b][m][n] = (f32x4){0.f, 0.f, 0.f, 0.f};
    bf16x8 At[4][2], B0[2][2], B1[2][2];
    const char* cA; const char* cB; S.ptrs(cur, cA, cB);
    PG8_STAGE(PG8_SB(0, 0), cB, voffB); PG8_STAGE(PG8_SB(0, 1), cB + hstep, voffB); PG8_STAGE(PG8_SA(0, 0), cA, voffA); PG8_STAGE(PG8_SA(0, 1), cA + hstep, voffA);
    if (wr == 1) PG8_BAR;
    PG8_WAIT_V(2); PG8_BAR;
    PG8_STAGE(PG8_SB(1, 0), cB + kstep, voffB); PG8_STAGE(PG8_SA(1, 0), cA + kstep, voffA); PG8_STAGE(PG8_SB(1, 1), cB + hstep + kstep, voffB);
    PG8_WAIT_V(6); PG8_BAR;
    for (;;) {
        const bool has_next = S.next(ui + 1, nxt);
        const char* nA = cA; const char* nB = cB; if (has_next) S.ptrs(nxt, nA, nB);
        const int nt = S.ntiles(cur);
        for (int t = 0; t < nt; t += 2) {
            const bool last = (t == nt - 2);
            const char* a1 = cA + (size_t)(t + 1) * kstep;
            const char* a2 = last ? nA : cA + (size_t)(t + 2) * kstep; const char* b2 = last ? nB : cB + (size_t)(t + 2) * kstep;
            const char* a3 = a2 + kstep; const char* b3 = b2 + kstep;
            PG8_LDB(B0, 0, 0); PG8_LDB(B1, 0, 1); PG8_SCHED; PG8_LDA(At, 0, 0); PG8_STAGE(PG8_SA(1, 1), a1 + hstep, voffA);
            PG8_WAIT_V(8); PG8_WAIT_L(0); PG8_BAR; PG8_MMA(0, 0, At, B0); PG8_MMA(0, 1, At, B1); PG8_BAR; PG8_SCHED;
            PG8_LDA(At, 0, 1); PG8_STAGE(PG8_SB(0, 0), b2, voffB); PG8_STAGE(PG8_SB(0, 1), b2 + hstep, voffB); PG8_STAGE(PG8_SA(0, 0), a2, voffA);
            PG8_WAIT_V(8); PG8_WAIT_L(0); PG8_BAR; PG8_MMA(1, 0, At, B0); PG8_MMA(1, 1, At, B1); PG8_BAR; PG8_SCHED;
            PG8_LDB(B0, 1, 0); PG8_LDB(B1, 1, 1); PG8_SCHED; PG8_LDA(At, 1, 0); PG8_STAGE(PG8_SA(0, 1), a2 + hstep, voffA);
            PG8_WAIT_V(8); PG8_WAIT_L(0); PG8_BAR; PG8_MMA(0, 0, At, B0); PG8_MMA(0, 1, At, B1); PG8_BAR; PG8_SCHED;
            PG8_LDA(At, 1, 1); PG8_STAGE(PG8_SB(1, 0), b3, voffB); PG8_STAGE(PG8_SB(1, 1), b3 + hstep, voffB); PG8_STAGE(PG8_SA(1, 0), a3, voffA);
            PG8_WAIT_V(8); PG8_WAIT_L(0); PG8_BAR; PG8_MMA(1, 0, At, B0); PG8_MMA(1, 1, At, B1); PG8_BAR; PG8_SCHED;
        }
        if constexpr (ALIGN_EPI) { if (wr == 0) PG8_BAR; }
        E(acc, cur, wr, wc, fr, fq);
        if (!has_next) break;
#pragma unroll
        for (int a = 0; a < 2; ++a)
#pragma unroll
            for (int b = 0; b < 2; ++b)
#pragma unroll
                for (int m = 0; m < 4; ++m)
#pragma unroll
                    for (int n = 0; n < 2; ++n) acc[a][b][m][n] = (f32x4){0.f, 0.f, 0.f, 0.f};
        cur = nxt; cA = nA; cB = nB; ++ui;
        if constexpr (ALIGN_EPI) { if (wr == 1) PG8_BAR; }
    }
    PG8_WAIT_V(0);
    if constexpr (!ALIGN_EPI) { if (wr == 0) PG8_BAR; }
    PG8_BAR;
#undef PG8_SA
#undef PG8_SB
#undef PG8_STAGE
#undef PG8_LDA
#undef PG8_LDB
#undef PG8_MMA
#undef PG8_WAIT_V
#undef PG8_WAIT_L
#undef PG8_BAR
#undef PG8_SCHED
}
}

#define XB_TMO      128
#define XB_XCNT(j)  (256  + 64 * (j))
#define XB_XSUB(j)  (1280 + 64 * (j))
#define XB_XGEN(j)  (2304 + 64 * (j))
#define XB_TOP      3328
#define XB_TOPGEN   3392
#define XCD_BAR_WORDS 3456
#define XB_SPIN_CAP (1u << 20)
__device__ __forceinline__ unsigned xb_ld(unsigned* p)              { return __hip_atomic_load(p, __ATOMIC_RELAXED, __HIP_MEMORY_SCOPE_AGENT); }
__device__ __forceinline__ unsigned xb_add(unsigned* p, unsigned v) { return __hip_atomic_fetch_add(p, v, __ATOMIC_RELAXED, __HIP_MEMORY_SCOPE_AGENT); }
__device__ __forceinline__ unsigned xb_xcc_id() { return (unsigned)__builtin_amdgcn_s_getreg((3 << 11) | 20) & 0xFu; }
#define XB_SPIN(cond, bar) do { unsigned _sp = 0; while (cond) { __builtin_amdgcn_s_sleep(1); \
    if ((++_sp & 255u) == 0u) { if (xb_ld(&(bar)[XB_TMO])) break; if (_sp > XB_SPIN_CAP) { atomicAdd(&(bar)[XB_TMO], 1u); break; } } } } while (0)
struct XcdBarrier { unsigned* bar; unsigned x; volatile LAS unsigned* st; };
__device__ __forceinline__ XcdBarrier xcd_barrier_post(unsigned* bar, volatile LAS unsigned* st) {
    XcdBarrier b; b.bar = bar; b.x = xb_xcc_id(); b.st = st;
    if (threadIdx.x == 0) (void)xb_add(&bar[XB_XCNT(b.x)], 1u);
    return b;
}
__device__ __forceinline__ void xcd_barrier_complete(unsigned* bar, unsigned x, unsigned& nloc, unsigned& nx) {
    const unsigned G = gridDim.x * gridDim.y * gridDim.z;
    unsigned sum, cnt, mine, sp = 0u;
    for (;;) {
        sum = 0u; cnt = 0u; mine = 0u;
#pragma unroll
        for (unsigned j = 0; j < 16; ++j) { const unsigned c = xb_ld(&bar[XB_XCNT(j)]); sum += c; cnt += (c > 0u) ? 1u : 0u; mine = (j == x) ? c : mine; }
        if (sum == G) break;
        __builtin_amdgcn_s_sleep(1);
        if ((++sp & 255u) == 0u) { if (xb_ld(&bar[XB_TMO])) break; if (sp > XB_SPIN_CAP) { atomicAdd(&bar[XB_TMO], 1u); break; } }
    }
    nloc = mine > 0u ? mine : 1u; nx = cnt > 0u ? cnt : 1u;
}
__device__ __forceinline__ void xcd_barrier(const XcdBarrier& b) {
    asm volatile("s_waitcnt vmcnt(0)" ::: "memory");
    __syncthreads();
    if (threadIdx.x == 0) {
        unsigned* bar = b.bar;
        __builtin_amdgcn_s_waitcnt(0);
        unsigned nloc = b.st[0], nx = b.st[1];
        if (nloc == 0u) { xcd_barrier_complete(bar, b.x, nloc, nx); b.st[0] = nloc; b.st[1] = nx; }
        const unsigned old = xb_add(&bar[XB_XSUB(b.x)], 1u);
        const unsigned gen = old / nloc;
        if (old + 1u == (gen + 1u) * nloc) {
            __builtin_amdgcn_fence(__ATOMIC_RELEASE, "agent");
            asm volatile("s_waitcnt vmcnt(0)" ::: "memory");
            const unsigned og = xb_add(&bar[XB_TOP], 1u);
            const unsigned tg = og / nx;
            if (og + 1u == (tg + 1u) * nx) xb_add(&bar[XB_TOPGEN], 1u);
            else XB_SPIN(xb_ld(&bar[XB_TOPGEN]) == tg, bar);
            __builtin_amdgcn_fence(__ATOMIC_ACQUIRE, "agent");
            xb_add(&bar[XB_XGEN(b.x)], 1u);
            asm volatile("s_waitcnt vmcnt(0)" ::: "memory");
        } else {
            XB_SPIN(xb_ld(&bar[XB_XGEN(b.x)]) == gen, bar);
            __builtin_amdgcn_fence(__ATOMIC_ACQUIRE, "agent");
            asm volatile("s_waitcnt vmcnt(0)" ::: "memory");
        }
    }
    __syncthreads();
}

struct Args { const float* in[22]; float* out; unsigned char* ws; int ph_lo, ph_hi; };
enum { I_XP = 0, I_XS, I_SGDN, I_SCONV, I_CSK, I_CSV, I_CMK, I_CMV, I_MEMP, I_NORM_IN, I_WIN, I_CONVW, I_ALOG, I_DTB, I_GNORM, I_SINKS, I_RELB, I_NORM_MEM, I_WMKV, I_WBR, I_WOUT, I_NORMF };

struct Frame {
    LAS unsigned char* lds;
    int tid, lane, wave, G, bid;
    const float* const* in; float* out; unsigned char* ws;
};

template <bool WINMAP>
__device__ __forceinline__ void p0_transpose_item(const float* W, int K, int Nsrc, bf16_t* WT, LAS bf16_t* scr, int kb, int nb, int lane) {
    constexpr int TP = 130;
    const int k0 = 64 * kb, n0 = 128 * nb;
    const int dj = n0 + 4 * (lane & 31);
    const int sc = WINMAP ? win_src_col(dj) : dj;
    f32x4 v[32];
#pragma unroll
    for (int i = 0; i < 32; ++i) { const int kk = 2 * i + (lane >> 5); v[i] = sc >= 0 ? *(const f32x4*)(W + (size_t)(k0 + kk) * Nsrc + sc) : (f32x4){0.f, 0.f, 0.f, 0.f}; }
#pragma unroll
    for (int i = 0; i < 32; ++i) { const int kk = 2 * i + (lane >> 5); LAS unsigned* d = (LAS unsigned*)(scr + kk * TP + 4 * (lane & 31)); d[0] = pk2(v[i].x, v[i].y); d[1] = pk2(v[i].z, v[i].w); }
    LDS_WAIT(); asm volatile("" ::: "memory");
#pragma unroll 4
    for (int u = 0; u < 16; ++u) { const int e = lane + 64 * u, ch = e & 7, n = e >> 3; const LAS bf16_t* s = scr + (8 * ch) * TP + n;
        u32x4 o; o.x = (unsigned)s[0] | ((unsigned)s[TP] << 16); o.y = (unsigned)s[2 * TP] | ((unsigned)s[3 * TP] << 16);
        o.z = (unsigned)s[4 * TP] | ((unsigned)s[5 * TP] << 16); o.w = (unsigned)s[6 * TP] | ((unsigned)s[7 * TP] << 16);
        *(u32x4*)(WT + (size_t)(n0 + n) * K + k0 + 8 * ch) = o; }
    LDS_WAIT(); asm volatile("" ::: "memory");
}
__device__ __forceinline__ void rms_row_to_bf16(const float* xrow, const float* w, bf16_t* orow, int lane) {
    const f32x4* xr = (const f32x4*)xrow + lane; const f32x4* wr = (const f32x4*)w + lane;
    f32x4 v[8]; float s = 0.f;
#pragma unroll
    for (int j = 0; j < 8; ++j) { v[j] = xr[64 * j]; s += (v[j].x * v[j].x + v[j].y * v[j].y) + (v[j].z * v[j].z + v[j].w * v[j].w); }
    const float r = rsqrtf(wave_sum(s) * (1.f / D) + EPS);
    unsigned long long* o8 = (unsigned long long*)orow + lane;
#pragma unroll
    for (int j = 0; j < 8; ++j) { const f32x4 ww = wr[64 * j];
        o8[64 * j] = (unsigned long long)pk2(v[j].x * r * ww.x, v[j].y * r * ww.y) | ((unsigned long long)pk2(v[j].z * r * ww.z, v[j].w * r * ww.w) << 32); }
}
__device__ __forceinline__ int t5_bucket(int n) {
    if (n < 16) return n;
    int large = 16 + (int)(logf((float)n / 16.f) / 2.0794415416798357f * 16.f);
    return large < 31 ? large : 31;
}
__device__ __forceinline__ void p0_prologue(Frame& F) {
    LAS bf16_t* scr = (LAS bf16_t*)(F.lds + F.wave * 16896);
    const int gw = F.bid * NWAVES + F.wave, NGW = F.G * NWAVES;
    constexpr int I_IN = 32 * (NIN / 128), I_MKV = 32 * 16, I_BR = 16 * 16, I_OUT = 32 * 16;
    constexpr int NITEMS = I_IN + I_MKV + 3 * I_BR + I_OUT;
    bf16_t* WINT = (bf16_t*)(F.ws + WS_WIN); bf16_t* WMKVT = (bf16_t*)(F.ws + WS_WMKV); bf16_t* WBT = (bf16_t*)(F.ws + WS_WB); bf16_t* WOT = (bf16_t*)(F.ws + WS_WO);
    for (int it = gw; it < NITEMS; it += NGW) {
        int r = it;
        if (r < I_IN) { p0_transpose_item<true>(F.in[I_WIN], D, IN_COLS, WINT, scr, r / (NIN / 128), r % (NIN / 128), F.lane); continue; } r -= I_IN;
        if (r < I_MKV) { p0_transpose_item<false>(F.in[I_WMKV], D, 2048, WMKVT, scr, r / 16, r % 16, F.lane); continue; } r -= I_MKV;
        if (r < 3 * I_BR) { const int b = r / I_BR, q = r % I_BR; p0_transpose_item<false>(F.in[I_WBR] + (size_t)b * 1024 * 2048, 1024, 2048, WBT + (size_t)b * 2048 * 1024, scr, q / 16, q % 16, F.lane); continue; } r -= 3 * I_BR;
        p0_transpose_item<false>(F.in[I_WOUT], D, 2048, WOT, scr, r / 16, r % 16, F.lane);
    }
    bf16_t* XN = (bf16_t*)((unsigned char*)F.out + DO_XN); bf16_t* MEMN = (bf16_t*)(F.ws + WS_MEMN);
    for (int m = gw; m < M + 512; m += NGW) {
        if (m < MP) rms_row_to_bf16(F.in[I_XP] + (size_t)m * D, F.in[I_NORM_IN], XN + (size_t)m * D, F.lane);
        else if (m < M) rms_row_to_bf16(F.in[I_XS] + (size_t)(m - MP) * D, F.in[I_NORM_IN], XN + (size_t)m * D, F.lane);
        else rms_row_to_bf16(F.in[I_MEMP] + (size_t)(m - M) * D, F.in[I_NORM_MEM], MEMN + (size_t)(m - M) * D, F.lane);
    }
    float* BT = (float*)(F.ws + WS_BTAB);
    for (int i = F.bid * NTHREADS + F.tid; i < 16 * 128; i += F.G * NTHREADS) { const int h = i >> 7, dist = i & 127; BT[i] = F.in[I_RELB][t5_bucket(dist) * 16 + h]; }
}

struct SchedP1 {
    int G, c; const unsigned char* ws; const unsigned char* xn;
    __device__ __forceinline__ int ntiles(const pg8::Unit&) const { return D / 64; }
    static constexpr int NM = M / 256, NN = NIN / 256, NU0 = NM * NN, NU = NU0 + 16;
    __device__ __forceinline__ bool next(int i, pg8::Unit& u) const {
        const long L = (long)i * G + c; if (L >= NU) return false;
        if (L < NU0) { pg8::tile_of((int)L, NM, NN, u.pm, u.pn); u.job = 0; } else { const int q = (int)L - NU0; u.pm = q >> 3; u.pn = q & 7; u.job = 1; }
        return true;
    }
    __device__ __forceinline__ void ptrs(const pg8::Unit& u, const char*& A, const char*& B) const {
        const size_t tstep = (size_t)256 * D * 2;
        if (u.job == 0) { A = (const char*)xn + (size_t)u.pm * tstep; B = (const char*)ws + WS_WIN + (size_t)u.pn * tstep; }
        else { A = (const char*)ws + WS_MEMN + (size_t)u.pm * tstep; B = (const char*)ws + WS_WMKV + (size_t)u.pn * tstep; }
    }
};
struct EpiP1 {
    unsigned char* ws; float* out;
    __device__ __forceinline__ void operator()(const f32x4 (&acc)[2][2][4][2], const pg8::Unit& u, int wr, int wc, int fr, int fq) const {
        const int row0 = u.pm * 256 + wr * 64 + fr;
        const int cin = wc * 32 + 8 * fq;
        if (u.job == 1) {
            bf16_t* MK = (bf16_t*)(ws + WS_MEMKV);
#pragma unroll
            for (int ai = 0; ai < 2; ++ai)
#pragma unroll
                for (int m = 0; m < 4; ++m) { const int r = row0 + ai * 128 + m * 16;
#pragma unroll
                    for (int bj = 0; bj < 2; ++bj) { const int c = u.pn * 256 + bj * 128 + cin; const f32x4 v0 = acc[ai][bj][m][0], v1 = acc[ai][bj][m][1];
                        float* o = out + (c < 1024 ? O_MKP + (size_t)r * 1024 + c : O_MVP + (size_t)r * 1024 + (c - 1024));
                        *(f32x4*)o = v0; *(f32x4*)(o + 4) = v1;
                        u32x4 w; w.x = pg8::cvt_pk_bf16(v0[0], v0[1]); w.y = pg8::cvt_pk_bf16(v0[2], v0[3]); w.z = pg8::cvt_pk_bf16(v1[0], v1[1]); w.w = pg8::cvt_pk_bf16(v1[2], v1[3]);
                        *(u32x4*)(MK + (size_t)r * 2048 + c) = w;
                        if (c >= 1024) { bf16_t* MVT = (bf16_t*)(ws + WS_MVT) + ((size_t)((r >> 8) * 4 + ((c - 1024) >> 8)) * 256 + ((c - 1024) & 255)) * 256 + (r & 255);
                            MVT[0] = (bf16_t)(w.x & 0xffffu); MVT[256] = (bf16_t)(w.x >> 16); MVT[512] = (bf16_t)(w.y & 0xffffu); MVT[768] = (bf16_t)(w.y >> 16);
                            MVT[1024] = (bf16_t)(w.z & 0xffffu); MVT[1280] = (bf16_t)(w.z >> 16); MVT[1536] = (bf16_t)(w.w & 0xffffu); MVT[1792] = (bf16_t)(w.w >> 16); } } }
            return;
        }
        const int pn = u.pn;
        if (pn == 57) {
            if (wc == 0 && fq < 2) { float* GAB = (float*)(ws + WS_GAB);
#pragma unroll
                for (int ai = 0; ai < 2; ++ai)
#pragma unroll
                    for (int m = 0; m < 4; ++m) { const int r = row0 + ai * 128 + m * 16; float* o = GAB + (size_t)r * 16 + 8 * fq; *(f32x4*)o = acc[ai][0][m][0]; *(f32x4*)(o + 4) = acc[ai][0][m][1]; } }
            return;
        }
        bf16_t* base; int ld, ct, act = 0;
        if (pn < 12) { base = (bf16_t*)(ws + WS_QKV); ld = 3072; ct = pn; }
        else if (pn < 16) { base = (bf16_t*)(ws + WS_GZ); ld = 1024; ct = pn - 12; act = 1; }
        else if (pn < 20) { base = (bf16_t*)(ws + WS_SQ); ld = 1024; ct = pn - 16; }
        else if (pn < 24) { base = (bf16_t*)(ws + WS_SZ); ld = 1024; ct = pn - 20; act = 1; }
        else if (pn < 28) { base = (bf16_t*)(ws + WS_MQ); ld = 1024; ct = pn - 24; }
        else if (pn < 32) { base = (bf16_t*)(ws + WS_MZ); ld = 1024; ct = pn - 28; act = 1; }
        else if (pn < 56) { base = (bf16_t*)(ws + WS_GATES); ld = 6144; ct = pn - 32; act = 2; }
        else { base = (bf16_t*)(ws + WS_SKV); ld = 256; ct = 0; }
#pragma unroll
        for (int ai = 0; ai < 2; ++ai)
#pragma unroll
            for (int m = 0; m < 4; ++m) { bf16_t* rowp = base + (size_t)(row0 + ai * 128 + m * 16) * ld + ct * 256 + cin;
#pragma unroll
                for (int bj = 0; bj < 2; ++bj) { f32x4 v0 = acc[ai][bj][m][0], v1 = acc[ai][bj][m][1];
                    if (act == 1) {
#pragma unroll
                        for (int j = 0; j < 4; ++j) { v0[j] = siluf_(v0[j]); v1[j] = siluf_(v1[j]); } }
                    else if (act == 2) {
#pragma unroll
                        for (int j = 0; j < 4; ++j) { v0[j] = sigmoidf_(v0[j]); v1[j] = sigmoidf_(v1[j]); } }
                    u32x4 w; w.x = pg8::cvt_pk_bf16(v0[0], v0[1]); w.y = pg8::cvt_pk_bf16(v0[2], v0[3]); w.z = pg8::cvt_pk_bf16(v1[0], v1[1]); w.w = pg8::cvt_pk_bf16(v1[2], v1[3]);
                    *(u32x4*)(rowp + bj * 128) = w;
                    if (pn == 56 && bj == 1) { const int r = row0 + ai * 128 + m * 16;
                        if (r < MP) { bf16_t* vt = (bf16_t*)(ws + WS_VTS) + ((size_t)((r >> 13) * 2 + (cin >> 6)) * 64 + (cin & 63)) * SEQ + (r & (SEQ - 1));
                            vt[0] = (bf16_t)(w.x & 0xffffu); vt[SEQ] = (bf16_t)(w.x >> 16); vt[2 * SEQ] = (bf16_t)(w.y & 0xffffu); vt[3 * SEQ] = (bf16_t)(w.y >> 16);
                            vt[4 * SEQ] = (bf16_t)(w.z & 0xffffu); vt[5 * SEQ] = (bf16_t)(w.z >> 16); vt[6 * SEQ] = (bf16_t)(w.w & 0xffffu); vt[7 * SEQ] = (bf16_t)(w.w >> 16); } } } }
    }
};

__device__ __forceinline__ void gdn_gate_scalars(Frame& F, int r, int h) {
    const float* GAB = (const float*)(F.ws + WS_GAB); float* Gp = (float*)(F.ws + WS_G); float* Bp = (float*)(F.ws + WS_BETA);
    const float gb = GAB[(size_t)r * 16 + h], ga = GAB[(size_t)r * 16 + 8 + h];
    Bp[(size_t)r * 8 + h] = sigmoidf_(gb);
    const float xx = ga + F.in[I_DTB][h]; const float sp = xx > 20.f ? xx : log1pf(expf(xx));
    Gp[(size_t)r * 8 + h] = -expf(F.in[I_ALOG][h]) * sp;
}
__device__ __forceinline__ void conv_prompt_item(Frame& F, int item) {
    const int b = item >> 7, n = item & 127, row0 = b * SEQ + 64 * n, tid = F.tid;
    const bf16_t* QKV = (const bf16_t*)(F.ws + WS_QKV);
    bf16_t* QN = (bf16_t*)((unsigned char*)F.out + DO_QN); bf16_t* KN = (bf16_t*)((unsigned char*)F.out + DO_KN);
    bf16_t* KT = (bf16_t*)((unsigned char*)F.out + DO_KT); bf16_t* VT = (bf16_t*)((unsigned char*)F.out + DO_VT);
    const float* cw = F.in[I_CONVW];
    constexpr int SP = 136;
    LAS bf16_t* slab = (LAS bf16_t*)F.lds;
    { const int tok = tid >> 3, h = tid & 7; gdn_gate_scalars(F, row0 + tok, h); }
    const int t0 = tid >> 4, cg = (tid & 15) * 8;
    u32x4 cur[2][4], nxt[2][4]; f32x4 wc[4][2], wn[4][2];
#define CONV_LOAD(dst, dw, sl_) do { const int ch_ = ((sl_) >> 3) * 1024 + ((sl_) & 7) * 128 + cg; \
        _Pragma("unroll") for (int p = 0; p < 2; ++p) _Pragma("unroll") for (int j = 0; j < 4; ++j) { const int tk = t0 + 32 * p - 3 + j; \
            dst[p][j] = (64 * n + tk >= 0) ? *(const u32x4*)(QKV + (size_t)(row0 + tk) * 3072 + ch_) : (u32x4){0u, 0u, 0u, 0u}; } \
        _Pragma("unroll") for (int j = 0; j < 4; ++j) { dw[j][0] = *(const f32x4*)(cw + j * 3072 + ch_); dw[j][1] = *(const f32x4*)(cw + j * 3072 + ch_ + 4); } } while (0)
    CONV_LOAD(cur, wc, 0);
#pragma unroll 1
    for (int sl = 0; sl < 24; ++sl) {
        const int part = sl >> 3, h = sl & 7;
        if (sl < 23) CONV_LOAD(nxt, wn, sl + 1);
#pragma unroll
        for (int p = 0; p < 2; ++p) {
            const int tok = t0 + 32 * p, r = row0 + tok;
            float a[8];
#pragma unroll
            for (int e = 0; e < 8; ++e) a[e] = 0.f;
#pragma unroll
            for (int j = 0; j < 4; ++j) { const u32x4 v = cur[p][j];
                a[0] += bf2f(v.x & 0xffffu) * wc[j][0][0]; a[1] += bf2f(v.x >> 16) * wc[j][0][1]; a[2] += bf2f(v.y & 0xffffu) * wc[j][0][2]; a[3] += bf2f(v.y >> 16) * wc[j][0][3];
                a[4] += bf2f(v.z & 0xffffu) * wc[j][1][0]; a[5] += bf2f(v.z >> 16) * wc[j][1][1]; a[6] += bf2f(v.w & 0xffffu) * wc[j][1][2]; a[7] += bf2f(v.w >> 16) * wc[j][1][3]; }
#pragma unroll
            for (int e = 0; e < 8; ++e) a[e] = siluf_(a[e]);
            if (part < 2) { float ss = ((a[0] * a[0] + a[1] * a[1]) + (a[2] * a[2] + a[3] * a[3])) + ((a[4] * a[4] + a[5] * a[5]) + (a[6] * a[6] + a[7] * a[7]));
                ss += __shfl_xor(ss, 1); ss += __shfl_xor(ss, 2); ss += __shfl_xor(ss, 4); ss += __shfl_xor(ss, 8);
                if (cg == 0) ((float*)(F.ws + (part == 0 ? WS_SSQ : WS_SSK)))[(size_t)(row0 + t0 + 32 * p) * 8 + h] = ss; }
            u32x4 o4; o4.x = pk2(a[0], a[1]); o4.y = pk2(a[2], a[3]); o4.z = pk2(a[4], a[5]); o4.w = pk2(a[6], a[7]);
            const size_t o = (size_t)r * 1024 + h * 128 + cg;
            if (part == 0) *(u32x4*)(QN + o) = o4;
            else { if (part == 1) *(u32x4*)(KN + o) = o4; *(LAS u32x4*)(slab + tok * SP + cg) = o4; }
            if (n == 127 && tok >= 61) { const u32x4 raw = cur[p][3]; float* cdst = F.out + O_GCP + ((size_t)b * 3 + (tok - 61)) * 3072 + part * 1024 + h * 128 + cg;
                *(f32x4*)cdst = (f32x4){bf2f(raw.x & 0xffffu), bf2f(raw.x >> 16), bf2f(raw.y & 0xffffu), bf2f(raw.y >> 16)};
                *(f32x4*)(cdst + 4) = (f32x4){bf2f(raw.z & 0xffffu), bf2f(raw.z >> 16), bf2f(raw.w & 0xffffu), bf2f(raw.w >> 16)}; }
        }
        if (part > 0) {
            __syncthreads();
            bf16_t* dst = (part == 1 ? KT : VT) + (size_t)((b * 8 + h) * 128 + n) * 8192;
#pragma unroll
            for (int u = 0; u < 2; ++u) { const int e = tid + 512 * u, chn = e >> 3, tg = e & 7; const LAS bf16_t* s = slab + (8 * tg) * SP + chn;
                u32x4 o4; o4.x = (unsigned)s[0] | ((unsigned)s[SP] << 16); o4.y = (unsigned)s[2 * SP] | ((unsigned)s[3 * SP] << 16);
                o4.z = (unsigned)s[4 * SP] | ((unsigned)s[5 * SP] << 16); o4.w = (unsigned)s[6 * SP] | ((unsigned)s[7 * SP] << 16);
                *(u32x4*)(dst + chn * 64 + 8 * tg) = o4; }
            __syncthreads();
        }
#pragma unroll
        for (int p = 0; p < 2; ++p)
#pragma unroll
            for (int j = 0; j < 4; ++j) cur[p][j] = nxt[p][j];
#pragma unroll
        for (int j = 0; j < 4; ++j) { wc[j][0] = wn[j][0]; wc[j][1] = wn[j][1]; }
    }
#undef CONV_LOAD
}
__device__ __forceinline__ void conv_sample_items(Frame& F) {
    const int gw = F.bid * NWAVES + F.wave, NGW = F.G * NWAVES, lane = F.lane;
    const bf16_t* QKV = (const bf16_t*)(F.ws + WS_QKV);
    bf16_t* QN = (bf16_t*)((unsigned char*)F.out + DO_QN); bf16_t* KN = (bf16_t*)((unsigned char*)F.out + DO_KN); bf16_t* VNS = (bf16_t*)((unsigned char*)F.out + DO_VNS);
    const float* cw = F.in[I_CONVW];
    for (int it = gw; it < MS * 8; it += NGW) {
        const int r = MP + (it >> 3), h = it & 7, bd = (r - MP) >> 2, s = (r - MP) & 3;
        float y[3][2];
#pragma unroll
        for (int part = 0; part < 3; ++part) {
            const int ch = part * 1024 + h * 128 + 2 * lane;
            float a0 = 0.f, a1 = 0.f;
#pragma unroll
            for (int j = 0; j < 4; ++j) {
                float x0, x1; const int i = s + j;
                if (i < 3) { const float* p = F.in[I_SCONV] + ((size_t)bd * 3 + i) * 3072 + ch; x0 = p[0]; x1 = p[1]; }
                else { const unsigned v = *(const unsigned*)(QKV + (size_t)(MP + bd * 4 + i - 3) * 3072 + ch); x0 = bf2f(v & 0xffffu); x1 = bf2f(v >> 16); }
                a0 += x0 * cw[j * 3072 + ch]; a1 += x1 * cw[j * 3072 + ch + 1];
            }
            y[part][0] = siluf_(a0); y[part][1] = siluf_(a1);
        }
        const float sq = wave_sum(y[0][0] * y[0][0] + y[0][1] * y[0][1]), sk = wave_sum(y[1][0] * y[1][0] + y[1][1] * y[1][1]);
        const float rq = rsqrtf(sq + EPS) * 0.08838834764831845f, rk = rsqrtf(sk + EPS);
        const size_t o = (size_t)r * 1024 + h * 128 + 2 * lane;
        *(unsigned*)(QN + o) = pk2(y[0][0] * rq, y[0][1] * rq);
        *(unsigned*)(KN + o) = pk2(y[1][0] * rk, y[1][1] * rk);
        *(unsigned*)(VNS + (size_t)(r - MP) * 1024 + h * 128 + 2 * lane) = pk2(y[2][0], y[2][1]);
        if (lane == 0) gdn_gate_scalars(F, r, h);
        if (s >= 1) { float* cdst = F.out + O_GCS + ((size_t)bd * 3 + (s - 1)) * 3072;
#pragma unroll
            for (int part = 0; part < 3; ++part) { const int ch = part * 1024 + h * 128 + 2 * lane; const unsigned v = *(const unsigned*)(QKV + (size_t)r * 3072 + ch);
                cdst[ch] = bf2f(v & 0xffffu); cdst[ch + 1] = bf2f(v >> 16); } }
    }
}
__device__ __forceinline__ void p2_conv(Frame& F) {
    for (int it = F.bid; it < 256; it += F.G) conv_prompt_item(F, it);
    conv_sample_items(F);
}

__device__ __forceinline__ f32x4 mfma16(bf16x8 a, bf16x8 b, f32x4 c) { return __builtin_amdgcn_mfma_f32_16x16x32_bf16(a, b, c, 0, 0, 0); }
__device__ __forceinline__ u32x2 pack4(f32x4 v) { u32x2 r; r.x = pk2(v[0], v[1]); r.y = pk2(v[2], v[3]); return r; }
__device__ __forceinline__ void prep_item(Frame& F, int item) {
    const int b = item >> 7, n = item & 127, row0 = b * SEQ + 64 * n, lane = F.lane, h = F.wave, c = lane & 15, q = lane >> 4;
    const int ci = (b * 8 + h) * 128 + n;
    const bf16_t* QN = (const bf16_t*)((const unsigned char*)F.out + DO_QN); const bf16_t* KN = (const bf16_t*)((const unsigned char*)F.out + DO_KN);
    const bf16_t* KT = (const bf16_t*)((const unsigned char*)F.out + DO_KT) + (size_t)ci * 8192; const bf16_t* VT = (const bf16_t*)((const unsigned char*)F.out + DO_VT) + (size_t)ci * 8192;
    bf16_t* NEGW = (bf16_t*)(F.ws + WS_NEGW) + (size_t)ci * 8192; bf16_t* UT = (bf16_t*)(F.ws + WS_UT) + (size_t)ci * 8192; bf16_t* ATT = (bf16_t*)(F.ws + WS_ATT) + (size_t)ci * 4096;
    const float* Gp = (const float*)(F.ws + WS_G); const float* Bp = (const float*)(F.ws + WS_BETA);
    float* GC = (float*)(F.ws + WS_GC); float* DEC = (float*)(F.ws + WS_DEC); float* GT = (float*)(F.ws + WS_GT);
    LAS float* Als = (LAS float*)(F.lds + h * 18432);
    LAS float* gcs = Als + 4096; LAS float* bes = gcs + 64;
    float gc = Gp[(size_t)(row0 + lane) * 8 + h];
#pragma unroll
    for (int o = 1; o < 64; o <<= 1) { const float x = __shfl_up(gc, o); if (lane >= o) gc += x; }
    const float beta = Bp[(size_t)(row0 + lane) * 8 + h];
    const float gl = __shfl(gc, 63);
    const float sk = ((const float*)(F.ws + WS_SSK))[(size_t)(row0 + lane) * 8 + h], sq = ((const float*)(F.ws + WS_SSQ))[(size_t)(row0 + lane) * 8 + h];
    const float rk = rsqrtf(sk + EPS), rq = rsqrtf(sq + EPS) * 0.08838834764831845f;
    LAS float* rks = bes + 64; LAS float* rqs = rks + 64;
    gcs[lane] = gc; bes[lane] = beta; rks[lane] = rk; rqs[lane] = rq;
    GC[(size_t)(row0 + lane) * 8 + h] = __expf(gc) * rq; DEC[(size_t)ci * 64 + lane] = __expf(gl - gc) * rk; if (lane == 0) GT[ci] = __expf(gl);
    LDS_WAIT(); asm volatile("" ::: "memory");
    bf16x8 kf[4][4];
#pragma unroll
    for (int mt = 0; mt < 4; ++mt)
#pragma unroll
        for (int s = 0; s < 4; ++s) { const size_t o = (size_t)(row0 + 16 * mt + c) * 1024 + h * 128 + 32 * s + 8 * q; kf[mt][s] = *(const bf16x8*)(KN + o); }
#pragma unroll
    for (int mi = 0; mi < 4; ++mi) {
        const int ii = 16 * mi + c; const float gci = gcs[ii], bi = bes[ii] * rks[ii], rqi = rqs[ii];
        const bf16_t* qrow_p = QN + (size_t)(row0 + ii) * 1024 + h * 128 + 8 * q;
#pragma unroll
        for (int nj = 0; nj < 4; ++nj) {
            u32x2 av; av.x = 0u; av.y = 0u;
            if (nj <= mi) {
                f32x4 dk = {0.f, 0.f, 0.f, 0.f}, dq = {0.f, 0.f, 0.f, 0.f};
#pragma unroll
                for (int s = 0; s < 4; ++s) { dk = mfma16(kf[nj][s], kf[mi][s], dk); dq = mfma16(kf[nj][s], *(const bf16x8*)(qrow_p + 32 * s), dq); }
                const f32x4 gj = *(const LAS f32x4*)(gcs + 16 * nj + 4 * q), rkj = *(const LAS f32x4*)(rks + 16 * nj + 4 * q);
                f32x4 a, at;
#pragma unroll
                for (int r = 0; r < 4; ++r) { const int jj = 16 * nj + 4 * q + r; const float e = __expf(gci - gj[r]);
                    a[r] = (ii > jj) ? bi * rkj[r] * dk[r] * e : 0.f; at[r] = (ii >= jj) ? rqi * rkj[r] * dq[r] * e : 0.f; }
                *(LAS f32x4*)(Als + ii * 64 + 16 * nj + 4 * q) = a;
                av = pack4(at);
            }
            *(u32x2*)(ATT + ii * 64 + 16 * nj + 4 * q) = av;
        }
    }
    LDS_WAIT();
    float t[64];
#pragma unroll
    for (int i = 0; i < 64; ++i) {
        float acc = (lane == i) ? 1.f : 0.f;
#pragma unroll
        for (int m4 = 0; m4 < i; m4 += 4) { const f32x4 a = *(const LAS f32x4*)(Als + i * 64 + m4);
            acc -= a[0] * t[m4]; if (m4 + 1 < i) acc -= a[1] * t[m4 + 1]; if (m4 + 2 < i) acc -= a[2] * t[m4 + 2]; if (m4 + 3 < i) acc -= a[3] * t[m4 + 3]; }
        t[i] = acc;
    }
    LAS bf16_t* T1 = (LAS bf16_t*)Als; LAS bf16_t* T2 = T1 + 64 * 72;
    const float s1 = beta, s2 = -beta * __expf(gc) * rk;
    LDS_WAIT();
#pragma unroll
    for (int i = 0; i < 64; ++i) { T1[i * 72 + lane] = (bf16_t)f2bf(t[i] * s1); T2[i * 72 + lane] = (bf16_t)f2bf(t[i] * s2); }
    LDS_WAIT();
    bf16x8 t1f[4][2], t2f[4][2];
#pragma unroll
    for (int it = 0; it < 4; ++it)
#pragma unroll
        for (int s = 0; s < 2; ++s) { t1f[it][s] = *(const LAS bf16x8*)(T1 + (16 * it + c) * 72 + 32 * s + 8 * q); t2f[it][s] = *(const LAS bf16x8*)(T2 + (16 * it + c) * 72 + 32 * s + 8 * q); }
#pragma unroll 2
    for (int dt = 0; dt < 8; ++dt) {
        bf16x8 vb[2], ka[2];
#pragma unroll
        for (int s = 0; s < 2; ++s) { vb[s] = *(const bf16x8*)(VT + (16 * dt + c) * 64 + 32 * s + 8 * q); ka[s] = *(const bf16x8*)(KT + (16 * dt + c) * 64 + 32 * s + 8 * q); }
#pragma unroll
        for (int it = 0; it < 4; ++it) {
            f32x4 du = {0.f, 0.f, 0.f, 0.f}, dw = {0.f, 0.f, 0.f, 0.f};
            du = mfma16(t1f[it][0], vb[0], du); dw = mfma16(ka[0], t2f[it][0], dw);
            if (it >= 2) { du = mfma16(t1f[it][1], vb[1], du); dw = mfma16(ka[1], t2f[it][1], dw); }
            *(u32x2*)(UT + (16 * dt + c) * 64 + 16 * it + 4 * q) = pack4(du);
            *(u32x2*)(NEGW + (16 * it + c) * 128 + 16 * dt + 4 * q) = pack4(dw);
        }
    }
    LDS_WAIT();
}
__device__ __forceinline__ void p2_prep(Frame& F) { for (int it = F.bid; it < 256; it += F.G) { prep_item(F, it); __syncthreads(); } }

__device__ __forceinline__ void scan_item(Frame& F, int bh, int sl) {
    const int lane = F.lane, w = F.wave, c = lane & 15, q = lane >> 4, dvs = 16 * sl;
    const bf16_t* KT = (const bf16_t*)((const unsigned char*)F.out + DO_KT); const bf16_t* NEGW = (const bf16_t*)(F.ws + WS_NEGW);
    bf16_t* UT = (bf16_t*)(F.ws + WS_UT); bf16_t* SN = (bf16_t*)(F.ws + WS_SN);
    const float* DEC = (const float*)(F.ws + WS_DEC); const float* GT = (const float*)(F.ws + WS_GT);
    LAS bf16_t* SS = (LAS bf16_t*)F.lds;
    LAS bf16_t* VS = SS + 16 * 136;
    LAS bf16_t* VU = VS + 16 * 72;
    f32x4 Sacc = {0.f, 0.f, 0.f, 0.f};
    for (int e = F.tid; e < 16 * 136 / 2; e += NTHREADS) ((LAS unsigned*)SS)[e] = 0u;
    struct Ops { bf16x8 wf[4], kf[2]; u32x2 u2; f32x4 dec4; float gt; };
#define SCAN_LOAD(o, n_) do { const size_t ci__ = (size_t)bh * 128 + ((n_) < 128 ? (n_) : 127); \
        _Pragma("unroll") for (int s = 0; s < 2; ++s) o.kf[s] = *(const bf16x8*)(KT + ci__ * 8192 + (16 * w + c) * 64 + 32 * s + 8 * q); \
        o.gt = GT[ci__]; \
        if (w < 4) { _Pragma("unroll") for (int s = 0; s < 4; ++s) o.wf[s] = *(const bf16x8*)(NEGW + ci__ * 8192 + (16 * w + c) * 128 + 32 * s + 8 * q); \
            o.u2 = *(const u32x2*)(UT + ci__ * 8192 + (dvs + c) * 64 + 16 * w + 4 * q); o.dec4 = *(const f32x4*)(DEC + ci__ * 64 + 16 * w + 4 * q); } } while (0)
#define SCAN_STEP(o, n_) do { const size_t ci = (size_t)bh * 128 + (n_); \
        if (w < 4) { \
            f32x4 v = {bf2f(o.u2.x & 0xffffu), bf2f(o.u2.x >> 16), bf2f(o.u2.y & 0xffffu), bf2f(o.u2.y >> 16)}; \
            _Pragma("unroll") for (int s = 0; s < 4; ++s) { const bf16x8 sf = *(const LAS bf16x8*)(SS + c * 136 + 32 * s + 8 * q); v = mfma16(o.wf[s], sf, v); } \
            *(LAS u32x2*)(VU + c * 72 + 16 * w + 4 * q) = pack4(v); \
            const f32x4 vd = v * o.dec4; \
            *(LAS u32x2*)(VS + c * 72 + 16 * w + 4 * q) = pack4(vd); \
        } else if (w == 4) {   \
            _Pragma("unroll") for (int u = 0; u < 4; ++u) { const int p = lane + 64 * u, r = p >> 4, cc = p & 15; \
                *(u32x4*)(SN + ci * 16384 + (dvs + r) * 128 + cc * 8) = *(const LAS u32x4*)(SS + r * 136 + cc * 8); } \
        } \
        asm volatile("s_waitcnt lgkmcnt(0)" ::: "memory"); __builtin_amdgcn_s_barrier(); asm volatile("" ::: "memory"); \
        Sacc = Sacc * o.gt; \
        _Pragma("unroll") for (int s = 0; s < 2; ++s) { const bf16x8 vf = *(const LAS bf16x8*)(VS + c * 72 + 32 * s + 8 * q); Sacc = mfma16(o.kf[s], vf, Sacc); } \
        if (w == 5) {   \
            _Pragma("unroll") for (int u = 0; u < 2; ++u) { const int p = lane + 64 * u, r = p >> 3, cc = p & 7; \
                *(u32x4*)(UT + ci * 8192 + (dvs + r) * 64 + cc * 8) = *(const LAS u32x4*)(VU + r * 72 + cc * 8); } } \
        { const u32x2 sp = pack4(Sacc); *(LAS u32x2*)(SS + c * 136 + 16 * w + 4 * q) = sp; } \
        asm volatile("s_waitcnt lgkmcnt(0)" ::: "memory"); __builtin_amdgcn_s_barrier(); asm volatile("" ::: "memory"); } while (0)
    Ops o0, o1, o2, o3;
    SCAN_LOAD(o0, 0); SCAN_LOAD(o1, 1); SCAN_LOAD(o2, 2);
    asm volatile("s_waitcnt lgkmcnt(0)" ::: "memory"); __builtin_amdgcn_s_barrier(); asm volatile("" ::: "memory");
#pragma unroll 1
    for (int n0 = 0; n0 < 128; n0 += 4) {
        SCAN_LOAD(o3, n0 + 3); SCAN_STEP(o0, n0);
        SCAN_LOAD(o0, n0 + 4); SCAN_STEP(o1, n0 + 1);
        SCAN_LOAD(o1, n0 + 5); SCAN_STEP(o2, n0 + 2);
        SCAN_LOAD(o2, n0 + 6); SCAN_STEP(o3, n0 + 3);
    }
#undef SCAN_LOAD
#undef SCAN_STEP
    float* so = F.out + O_GSP + (size_t)bh * 16384;
#pragma unroll
    for (int r = 0; r < 4; ++r) so[(size_t)(16 * w + 4 * q + r) * 128 + dvs + c] = Sacc[r];
}

__device__ __forceinline__ void gdn_out_item(Frame& F, int item) {
    const int b = item >> 7, n = item & 127, row0 = b * SEQ + 64 * n, lane = F.lane, h = F.wave, c = lane & 15, q = lane >> 4;
    const size_t ci = (size_t)(b * 8 + h) * 128 + n;
    const bf16_t* QN = (const bf16_t*)((const unsigned char*)F.out + DO_QN);
    const bf16_t* SN = (const bf16_t*)(F.ws + WS_SN) + ci * 16384; const bf16_t* VNT = (const bf16_t*)(F.ws + WS_UT) + ci * 8192; const bf16_t* ATT = (const bf16_t*)(F.ws + WS_ATT) + ci * 4096;
    const float* GC = (const float*)(F.ws + WS_GC); const bf16_t* GZ = (const bf16_t*)(F.ws + WS_GZ); bf16_t* OG = (bf16_t*)(F.ws + WS_OG); const float* gn = F.in[I_GNORM];
    LAS bf16_t* ol = (LAS bf16_t*)(F.lds + h * 18432);
    bf16x8 qf[4][4], af[4][2]; float egc[4], ss[4];
#pragma unroll
    for (int it = 0; it < 4; ++it) { const int i = 16 * it + c; const size_t r = (size_t)row0 + i;
#pragma unroll
        for (int s = 0; s < 4; ++s) qf[it][s] = *(const bf16x8*)(QN + r * 1024 + h * 128 + 32 * s + 8 * q);
#pragma unroll
        for (int s = 0; s < 2; ++s) af[it][s] = *(const bf16x8*)(ATT + i * 64 + 32 * s + 8 * q);
        egc[it] = GC[r * 8 + h]; ss[it] = 0.f; }
#pragma unroll 1
    for (int dt = 0; dt < 8; ++dt) {
        bf16x8 sf[4], vf[2];
#pragma unroll
        for (int s = 0; s < 4; ++s) sf[s] = *(const bf16x8*)(SN + (16 * dt + c) * 128 + 32 * s + 8 * q);
#pragma unroll
        for (int s = 0; s < 2; ++s) vf[s] = *(const bf16x8*)(VNT + (16 * dt + c) * 64 + 32 * s + 8 * q);
#pragma unroll
        for (int it = 0; it < 4; ++it) {
            f32x4 a = {0.f, 0.f, 0.f, 0.f};
#pragma unroll
            for (int s = 0; s < 4; ++s) a = mfma16(sf[s], qf[it][s], a);
            a = a * egc[it];
#pragma unroll
            for (int s = 0; s < 2; ++s) a = mfma16(vf[s], af[it][s], a);
            ss[it] += (a[0] * a[0] + a[1] * a[1]) + (a[2] * a[2] + a[3] * a[3]);
            *(LAS u32x2*)(ol + (16 * it + c) * 136 + 16 * dt + 4 * q) = pack4(a);
        }
    }
    float rs[4];
#pragma unroll
    for (int it = 0; it < 4; ++it) { float s = ss[it]; s += __shfl_xor(s, 16); s += __shfl_xor(s, 32); rs[it] = rsqrtf(s * (1.f / 128.f) + EPS); }
    LDS_WAIT();
#pragma unroll
    for (int it = 0; it < 4; ++it)
#pragma unroll
        for (int dt = 0; dt < 8; ++dt) { const size_t o = ((size_t)row0 + 16 * it + c) * 1024 + h * 128 + 16 * dt + 4 * q; const u32x2 z = *(const u32x2*)(GZ + o); const f32x4 g4 = *(const f32x4*)(gn + 16 * dt + 4 * q);
            const u32x2 pv = *(const LAS u32x2*)(ol + (16 * it + c) * 136 + 16 * dt + 4 * q); f32x4 v;
            v[0] = bf2f(pv.x & 0xffffu) * rs[it] * g4[0] * bf2f(z.x & 0xffffu); v[1] = bf2f(pv.x >> 16) * rs[it] * g4[1] * bf2f(z.x >> 16);
            v[2] = bf2f(pv.y & 0xffffu) * rs[it] * g4[2] * bf2f(z.y & 0xffffu); v[3] = bf2f(pv.y >> 16) * rs[it] * g4[3] * bf2f(z.y >> 16);
            *(u32x2*)(OG + o) = pack4(v); }
    LDS_WAIT();
}

__device__ __forceinline__ void gdn_seq_item(Frame& F, int row0, int L, int h, const float* S0, float* Sout, bf16_t* OG) {
    const bf16_t* QN = (const bf16_t*)((unsigned char*)F.out + DO_QN); const bf16_t* KN = (const bf16_t*)((unsigned char*)F.out + DO_KN); const bf16_t* VNS = (const bf16_t*)((unsigned char*)F.out + DO_VNS);
    const float* Gp = (const float*)(F.ws + WS_G); const float* Bp = (const float*)(F.ws + WS_BETA);
    const int tid = F.tid, dvc = tid & 127, dkq = tid >> 7;
    constexpr int TB = 32;
    LAS float* sq = (LAS float*)F.lds;
    LAS float* sk = sq + TB * 128;
    LAS float* sv = sk + TB * 128;
    LAS float* sg = sv + TB * 128;
    LAS float* red = sg + 2 * TB;
    LAS float* redqk = red + 2 * 2 * 4 * 128;
    float S[32];
#pragma unroll
    for (int i = 0; i < 32; ++i) S[i] = S0 ? S0[(size_t)(32 * dkq + i) * 128 + dvc] : 0.f;
    int buf = 0;
    for (int t0 = 0; t0 < L; t0 += TB) {
        const int nb = (L - t0) < TB ? (L - t0) : TB;
        __syncthreads();
        for (int e = tid; e < nb * 128; e += NTHREADS) { const int tt = e >> 7, c = e & 127; const size_t o = (size_t)(row0 + t0 + tt) * 1024 + h * 128 + c;
            sq[e] = bf2f(QN[o]); sk[e] = bf2f(KN[o]); sv[e] = bf2f(VNS[o - (size_t)MP * 1024]); }
        if (tid < nb) { sg[tid] = expf(Gp[(size_t)(row0 + t0 + tid) * 8 + h]); sg[TB + tid] = Bp[(size_t)(row0 + t0 + tid) * 8 + h]; }
        __syncthreads();
        for (int tt = 0; tt < nb; ++tt) {
            const LAS float* kq = sk + tt * 128 + 32 * dkq; const LAS float* qq = sq + tt * 128 + 32 * dkq;
            float pk = 0.f, pq = 0.f, pqk = 0.f;
#pragma unroll
            for (int i = 0; i < 32; ++i) { const float kk = kq[i], qv = qq[i]; pk += kk * S[i]; pq += qv * S[i]; pqk += qv * kk; }
            LAS float* rb = red + buf * 1024;
            rb[dkq * 128 + dvc] = pk; rb[512 + dkq * 128 + dvc] = pq; if (dvc == 0) redqk[buf * 4 + dkq] = pqk;
            __syncthreads();
            const float kS = (rb[dvc] + rb[128 + dvc]) + (rb[256 + dvc] + rb[384 + dvc]);
            const float qS = (rb[512 + dvc] + rb[640 + dvc]) + (rb[768 + dvc] + rb[896 + dvc]);
            const float qk = (redqk[buf * 4] + redqk[buf * 4 + 1]) + (redqk[buf * 4 + 2] + redqk[buf * 4 + 3]);
            const float e = sg[tt], beta = sg[TB + tt];
            const float vnew = beta * (sv[tt * 128 + dvc] - e * kS);
            const float o = e * qS + qk * vnew;
#pragma unroll
            for (int i = 0; i < 32; ++i) S[i] = e * S[i] + kq[i] * vnew;
            if (dkq == 0) OG[(size_t)(row0 + t0 + tt) * 1024 + h * 128 + dvc] = (bf16_t)f2bf(o);
            buf ^= 1;
        }
    }
#pragma unroll
    for (int i = 0; i < 32; ++i) Sout[(size_t)(32 * dkq + i) * 128 + dvc] = S[i];
    __syncthreads();
}
__device__ __forceinline__ void p2_gdn_sample(Frame& F, int wk, int nwk, int lo, int hi) {
    bf16_t* OG = (bf16_t*)(F.ws + WS_OG);
    for (int q = lo + wk; q < hi; q += nwk) { const int bd = q >> 3, h = q & 7; gdn_seq_item(F, MP + bd * 4, 4, h, F.in[I_SGDN] + (size_t)q * 16384, F.out + O_GSS + (size_t)q * 16384, OG); }
}
__device__ __forceinline__ void p2_gdn_norm_sample(Frame& F) {
    const int gw = F.bid * NWAVES + F.wave, NGW = F.G * NWAVES, lane = F.lane;
    bf16_t* OG = (bf16_t*)(F.ws + WS_OG); const bf16_t* GZ = (const bf16_t*)(F.ws + WS_GZ); const float* gn = F.in[I_GNORM];
    for (int it = gw; it < MS * 8; it += NGW) {
        const size_t o = (size_t)(MP + (it >> 3)) * 1024 + (it & 7) * 128 + 2 * lane;
        const unsigned v = *(const unsigned*)(OG + o), z = *(const unsigned*)(GZ + o);
        const float a = bf2f(v & 0xffffu), b = bf2f(v >> 16);
        const float r = rsqrtf(wave_sum(a * a + b * b) * (1.f / 128.f) + EPS);
        *(unsigned*)(OG + o) = pk2(a * r * gn[2 * lane] * bf2f(z & 0xffffu), b * r * gn[2 * lane + 1] * bf2f(z >> 16));
    }
}

__device__ __forceinline__ void swa_wave_item(Frame& F, bool sample, int bidx, int t, int kv) {
    const int lane = F.lane;
    LAS float* qs = (LAS float*)(F.lds + F.wave * 8192);
    LAS float* ps = qs + 512;
    const bf16_t* SQ = (const bf16_t*)(F.ws + WS_SQ); const bf16_t* SKV = (const bf16_t*)(F.ws + WS_SKV); const bf16_t* SZ = (const bf16_t*)(F.ws + WS_SZ);
    const float* BT = (const float*)(F.ws + WS_BTAB);
    const int row = sample ? MP + bidx * 4 + t : bidx * SEQ + t;
    const int qpos = sample ? 128 + t : t;
    for (int e = lane; e < 512; e += 64) qs[e] = bf2f(SQ[(size_t)row * 1024 + kv * 512 + e]);
    LDS_WAIT();
#pragma unroll 1
    for (int u = 0; u < 2; ++u) {
        const int j = lane + 64 * u; const int kp = qpos - j;
        float kr[64];
        const bool valid = kp >= 0;
        if (valid) {
            if (sample && kp < 128) { const float* p = F.in[I_CSK] + (((size_t)bidx * 128 + kp) * 2 + kv) * 64;
#pragma unroll
                for (int d = 0; d < 64; d += 4) { const f32x4 v = *(const f32x4*)(p + d); kr[d] = v.x; kr[d + 1] = v.y; kr[d + 2] = v.z; kr[d + 3] = v.w; } }
            else { const int krow = sample ? MP + bidx * 4 + (kp - 128) : bidx * SEQ + kp; const bf16_t* p = SKV + (size_t)krow * 256 + kv * 64;
#pragma unroll
                for (int d = 0; d < 64; d += 8) { const u32x4 v = *(const u32x4*)(p + d);
                    kr[d] = bf2f(v.x & 0xffffu); kr[d + 1] = bf2f(v.x >> 16); kr[d + 2] = bf2f(v.y & 0xffffu); kr[d + 3] = bf2f(v.y >> 16);
                    kr[d + 4] = bf2f(v.z & 0xffffu); kr[d + 5] = bf2f(v.z >> 16); kr[d + 6] = bf2f(v.w & 0xffffu); kr[d + 7] = bf2f(v.w >> 16); } }
        } else {
#pragma unroll
            for (int d = 0; d < 64; ++d) kr[d] = 0.f;
        }
#pragma unroll 1
        for (int g = 0; g < 8; ++g) { float a = 0.f;
#pragma unroll
            for (int d = 0; d < 64; d += 4) { const f32x4 qv = *(const LAS f32x4*)(qs + g * 64 + d); a += kr[d] * qv.x + kr[d + 1] * qv.y + kr[d + 2] * qv.z + kr[d + 3] * qv.w; }
            ps[g * 128 + j] = valid ? a * 0.125f + BT[(kv * 8 + g) * 128 + j] : -INFINITY; }
    }
    LDS_WAIT();
    float inv[8];
#pragma unroll
    for (int g = 0; g < 8; ++g) {
        const float sink = F.in[I_SINKS][kv * 8 + g];
        const float l0 = ps[g * 128 + lane], l1 = ps[g * 128 + 64 + lane];
        const float mx = fmaxf(wave_max(fmaxf(l0, l1)), sink);
        const float p0 = __expf(l0 - mx), p1 = __expf(l1 - mx);
        const float den = wave_sum(p0 + p1) + __expf(sink - mx);
        inv[g] = 1.f / den;
        ps[g * 128 + lane] = p0; ps[g * 128 + 64 + lane] = p1;
    }
    LDS_WAIT();
    float o[8];
#pragma unroll
    for (int g = 0; g < 8; ++g) o[g] = 0.f;
#pragma unroll 1
    for (int j0 = 0; j0 < 128; j0 += 8) {
        float vv[8];
#pragma unroll
        for (int u = 0; u < 8; ++u) { int kp = qpos - (j0 + u); kp = kp < 0 ? 0 : kp;
            if (sample && kp < 128) vv[u] = F.in[I_CSV][(((size_t)bidx * 128 + kp) * 2 + kv) * 64 + lane];
            else { const int krow = sample ? MP + bidx * 4 + (kp - 128) : bidx * SEQ + kp; vv[u] = bf2f(SKV[(size_t)krow * 256 + 128 + kv * 64 + lane]); } }
#pragma unroll
        for (int u = 0; u < 8; ++u)
#pragma unroll
            for (int g = 0; g < 8; ++g) o[g] += ps[g * 128 + j0 + u] * vv[u];
    }
    bf16_t* OS = (bf16_t*)(F.ws + WS_OS);
#pragma unroll
    for (int g = 0; g < 8; ++g) { const size_t oo = (size_t)row * 1024 + (kv * 8 + g) * 64 + lane; OS[oo] = (bf16_t)f2bf(o[g] * inv[g] * bf2f(SZ[oo])); }
    LDS_WAIT();
}
__device__ __forceinline__ bf16x8 cat8(u32x2 a, u32x2 b) { u32x4 t; t.x = a.x; t.y = a.y; t.z = b.x; t.w = b.y; return __builtin_bit_cast(bf16x8, t); }
__device__ __forceinline__ void mem_mfma_item(Frame& F, int b, int h, int qt) {
    const int lane = F.lane, c = lane & 15, q = lane >> 4;
    const bf16_t* Kp = (const bf16_t*)(F.ws + WS_MEMKV) + (size_t)(b * 256) * 2048 + h * 256;
    const bf16_t* VTp = (const bf16_t*)(F.ws + WS_MVT) + (size_t)((b * 4 + h) * 256) * 256;
    const bf16_t* MQ = (const bf16_t*)(F.ws + WS_MQ); const bf16_t* MZ = (const bf16_t*)(F.ws + WS_MZ); bf16_t* OM = (bf16_t*)(F.ws + WS_OM);
    const size_t qrow = (size_t)b * SEQ + 16 * qt + c;
    bf16x8 qf[8];
#pragma unroll
    for (int s = 0; s < 8; ++s) qf[s] = *(const bf16x8*)(MQ + qrow * 1024 + h * 256 + 32 * s + 8 * q);
    f32x4 sacc[16];
#pragma unroll
    for (int mt = 0; mt < 16; ++mt) { f32x4 a = {0.f, 0.f, 0.f, 0.f};
#pragma unroll
        for (int s = 0; s < 8; ++s) a = mfma16(*(const bf16x8*)(Kp + (size_t)(16 * mt + c) * 2048 + 32 * s + 8 * q), qf[s], a);
        sacc[mt] = a; }
    float mx = -INFINITY;
#pragma unroll
    for (int mt = 0; mt < 16; ++mt) mx = fmaxf(mx, fmaxf(fmaxf(sacc[mt][0], sacc[mt][1]), fmaxf(sacc[mt][2], sacc[mt][3])));
    mx = fmaxf(mx, __shfl_xor(mx, 16)); mx = fmaxf(mx, __shfl_xor(mx, 32));
    float sum = 0.f; const float sc = 0.0625f * 1.4426950408889634f;
#pragma unroll
    for (int mt = 0; mt < 16; ++mt)
#pragma unroll
        for (int r = 0; r < 4; ++r) { const float p = exp2f((sacc[mt][r] - mx) * sc); sacc[mt][r] = p; sum += p; }
    sum += __shfl_xor(sum, 16); sum += __shfl_xor(sum, 32);
    const float inv = 1.f / sum;
    bf16x8 pf[8];
#pragma unroll
    for (int ks = 0; ks < 8; ++ks) pf[ks] = cat8(pack4(sacc[2 * ks]), pack4(sacc[2 * ks + 1]));
#pragma unroll 4
    for (int dt = 0; dt < 16; ++dt) { f32x4 o = {0.f, 0.f, 0.f, 0.f};
#pragma unroll
        for (int ks = 0; ks < 8; ++ks) { const bf16_t* vp = VTp + (size_t)(16 * dt + c) * 256 + 32 * ks + 4 * q;
            o = mfma16(cat8(*(const u32x2*)vp, *(const u32x2*)(vp + 16)), pf[ks], o); }
        const size_t oo = qrow * 1024 + h * 256 + 16 * dt + 4 * q; const u32x2 z = *(const u32x2*)(MZ + oo);
        o[0] *= inv * bf2f(z.x & 0xffffu); o[1] *= inv * bf2f(z.x >> 16); o[2] *= inv * bf2f(z.y & 0xffffu); o[3] *= inv * bf2f(z.y >> 16);
        *(u32x2*)(OM + oo) = pack4(o); }
}
__device__ __forceinline__ void swa_mfma_item(Frame& F, int b, int h, int a) {
    const int lane = F.lane, c = lane & 15, q = lane >> 4, kv = h >> 3;
    const bf16_t* SQ = (const bf16_t*)(F.ws + WS_SQ); const bf16_t* SKV = (const bf16_t*)(F.ws + WS_SKV); const bf16_t* SZ = (const bf16_t*)(F.ws + WS_SZ); bf16_t* OS = (bf16_t*)(F.ws + WS_OS);
    const bf16_t* VTp = (const bf16_t*)(F.ws + WS_VTS) + (size_t)((b * 2 + kv) * 64) * SEQ;
    const LAS float* BTl = (const LAS float*)(F.lds + LDS_BT) + h * 128;
    const size_t qrow = (size_t)b * SEQ + 16 * a + c;
    bf16x8 qf[2];
#pragma unroll
    for (int s = 0; s < 2; ++s) qf[s] = *(const bf16x8*)(SQ + qrow * 1024 + h * 64 + 32 * s + 8 * q);
    f32x4 p[10];
    const float sink = F.in[I_SINKS][h];
    float mx = sink;
#pragma unroll
    for (int u = 0; u < 9; ++u) {
        const int kbase = 16 * (a - 8 + u);
        f32x4 d = {0.f, 0.f, 0.f, 0.f};
        if (kbase >= 0) {
#pragma unroll
            for (int s = 0; s < 2; ++s) d = mfma16(*(const bf16x8*)(SKV + ((size_t)b * SEQ + kbase + c) * 256 + kv * 64 + 32 * s + 8 * q), qf[s], d);
        }
#pragma unroll
        for (int r = 0; r < 4; ++r) { const int dist = (16 * a + c) - (kbase + 4 * q + r); const bool valid = kbase >= 0 && dist >= 0 && dist < 128;
            const float l = valid ? d[r] * 0.125f + BTl[dist & 127] : -INFINITY; d[r] = l; mx = fmaxf(mx, l); }
        p[u] = d;
    }
    mx = fmaxf(mx, __shfl_xor(mx, 16)); mx = fmaxf(mx, __shfl_xor(mx, 32));
    float sum = 0.f;
#pragma unroll
    for (int u = 0; u < 9; ++u)
#pragma unroll
        for (int r = 0; r < 4; ++r) { const float e = __expf(p[u][r] - mx); p[u][r] = e; sum += e; }
    p[9] = (f32x4){0.f, 0.f, 0.f, 0.f};
    sum += __shfl_xor(sum, 16); sum += __shfl_xor(sum, 32);
    const float inv = 1.f / (sum + __expf(sink - mx));
    bf16x8 pf[5];
#pragma unroll
    for (int ks = 0; ks < 5; ++ks) pf[ks] = cat8(pack4(p[2 * ks]), pack4(p[2 * ks + 1]));
#pragma unroll
    for (int dt = 0; dt < 4; ++dt) { f32x4 o = {0.f, 0.f, 0.f, 0.f};
#pragma unroll
        for (int ks = 0; ks < 5; ++ks) { int m0 = 16 * (a - 8 + 2 * ks) + 4 * q, m1 = m0 + 16;
            m0 = m0 < 0 ? 0 : m0; m1 = m1 < 0 ? 0 : (m1 > SEQ - 4 ? SEQ - 4 : m1);
            const bf16_t* vp = VTp + (size_t)(16 * dt + c) * SEQ;
            o = mfma16(cat8(*(const u32x2*)(vp + m0), *(const u32x2*)(vp + m1)), pf[ks], o); }
        const size_t oo = qrow * 1024 + h * 64 + 16 * dt + 4 * q; const u32x2 z = *(const u32x2*)(SZ + oo);
        o[0] *= inv * bf2f(z.x & 0xffffu); o[1] *= inv * bf2f(z.x >> 16); o[2] *= inv * bf2f(z.y & 0xffffu); o[3] *= inv * bf2f(z.y >> 16);
        *(u32x2*)(OS + oo) = pack4(o); }
}
__device__ __forceinline__ void swa_wg_item(Frame& F, int b, int kv, int qb) {
    int lane_ = F.lane, tid_ = F.tid; asm volatile("" : "+v"(lane_), "+v"(tid_));
    const int lane = lane_, c = lane & 15, q = lane >> 4, tid = tid_, h = kv * 8 + F.wave;
    const bf16_t* SQ = (const bf16_t*)(F.ws + WS_SQ); const bf16_t* SKV = (const bf16_t*)(F.ws + WS_SKV); const bf16_t* SZ = (const bf16_t*)(F.ws + WS_SZ); bf16_t* OS = (bf16_t*)(F.ws + WS_OS);
    const bf16_t* VTg = (const bf16_t*)(F.ws + WS_VTS) + (size_t)((b * 2 + kv) * 64) * SEQ;
    LAS unsigned char* Kl = F.lds; LAS unsigned char* Vl = F.lds + 32768;
    const LAS float* BTl = (const LAS float*)(F.lds + LDS_BT) + h * 128;
    const int kstart = 128 * (qb - 1);
    __syncthreads();
    {   u32x4 kr[4], vr[4];
#pragma unroll
        for (int u = 0; u < 4; ++u) { const int p = tid + 512 * u, key = p >> 3, ch = p & 7;
            kr[u] = (kstart + key >= 0) ? *(const u32x4*)(SKV + ((size_t)b * SEQ + kstart + key) * 256 + kv * 64 + ch * 8) : (u32x4){0u, 0u, 0u, 0u};
            const int d = p >> 5, c16 = p & 31;
            vr[u] = (kstart + c16 * 8 >= 0) ? *(const u32x4*)(VTg + (size_t)d * SEQ + kstart + c16 * 8) : (u32x4){0u, 0u, 0u, 0u}; }
#pragma unroll
        for (int u = 0; u < 4; ++u) { const int p = tid + 512 * u, key = p >> 3, ch = p & 7;
            *(LAS u32x4*)(Kl + key * 128 + ((ch ^ ((key >> 1) & 7)) << 4)) = kr[u];
            const int d = p >> 5, c16 = p & 31;
            *(LAS u32x4*)(Vl + d * 512 + (((2 * c16) ^ (2 * (d & 15))) << 3)) = vr[u]; } }
    __syncthreads();
    const float L2E = 1.4426950408889634f;
    const float sink = F.in[I_SINKS][h] * L2E;
    float bias[9][4];
#pragma unroll
    for (int u = 0; u < 9; ++u)
#pragma unroll
        for (int r = 0; r < 4; ++r) { const int dist = 128 - 16 * u + c - 4 * q - r; bias[u][r] = (dist >= 0 && dist < 128) ? BTl[dist & 127] * L2E : -INFINITY; }
    bf16x8 qfa[8][2];
#pragma unroll
    for (int ap = 0; ap < 8; ++ap)
#pragma unroll
        for (int s = 0; s < 2; ++s) qfa[ap][s] = *(const bf16x8*)(SQ + ((size_t)b * SEQ + 128 * qb + 16 * ap + c) * 1024 + h * 64 + 32 * s + 8 * q);
#pragma unroll
    for (int ap = 0; ap < 8; ++ap) {
        const size_t qrow = (size_t)b * SEQ + 128 * qb + 16 * ap + c;
        bf16x8 qf[2]; qf[0] = qfa[ap][0]; qf[1] = qfa[ap][1];
        u32x2 zz[4];
#pragma unroll
        for (int dt = 0; dt < 4; ++dt) zz[dt] = *(const u32x2*)(SZ + qrow * 1024 + h * 64 + 16 * dt + 4 * q);
        f32x4 p[10]; float mx = sink;
#pragma unroll
        for (int u = 0; u < 9; ++u) {
            const int wt = ap + u, row = 16 * wt + c;
            f32x4 d = {0.f, 0.f, 0.f, 0.f};
#pragma unroll
            for (int s = 0; s < 2; ++s) d = mfma16(*(const LAS bf16x8*)(Kl + row * 128 + (((4 * s + q) ^ ((row >> 1) & 7)) << 4)), qf[s], d);
            const float tmask = ((qb > 0) || (wt >= 8)) ? 0.f : -INFINITY;
#pragma unroll
            for (int r = 0; r < 4; ++r) { const float l = d[r] * (0.125f * L2E) + (bias[u][r] + tmask); d[r] = l; mx = fmaxf(mx, l); }
            p[u] = d;
        }
        mx = fmaxf(mx, __shfl_xor(mx, 16)); mx = fmaxf(mx, __shfl_xor(mx, 32));
        float sum = 0.f;
#pragma unroll
        for (int u = 0; u < 9; ++u)
#pragma unroll
            for (int r = 0; r < 4; ++r) { const float e = exp2f(p[u][r] - mx); p[u][r] = e; sum += e; }
        p[9] = (f32x4){0.f, 0.f, 0.f, 0.f};
        sum += __shfl_xor(sum, 16); sum += __shfl_xor(sum, 32);
        const float inv = 1.f / (sum + exp2f(sink - mx));
        bf16x8 pf[5];
#pragma unroll
        for (int ks = 0; ks < 5; ++ks) pf[ks] = cat8(pack4(p[2 * ks]), pack4(p[2 * ks + 1]));
#pragma unroll
        for (int dt = 0; dt < 4; ++dt) { f32x4 o = {0.f, 0.f, 0.f, 0.f}; const int dd = 16 * dt + c; const LAS unsigned char* vrow = Vl + dd * 512; const int sw = 2 * (dd & 15);
#pragma unroll
            for (int ks = 0; ks < 5; ++ks) { const int wt0 = ap + 2 * ks; int wt1 = wt0 + 1; wt1 = wt1 > 15 ? 15 : wt1;
                const u32x2 v0 = *(const LAS u32x2*)(vrow + (((4 * wt0 + q) ^ sw) << 3)), v1 = *(const LAS u32x2*)(vrow + (((4 * wt1 + q) ^ sw) << 3));
                o = mfma16(cat8(v0, v1), pf[ks], o); }
            const size_t oo = qrow * 1024 + h * 64 + 16 * dt + 4 * q; const u32x2 z = zz[dt];
            o[0] *= inv * bf2f(z.x & 0xffffu); o[1] *= inv * bf2f(z.x >> 16); o[2] *= inv * bf2f(z.y & 0xffffu); o[3] *= inv * bf2f(z.y >> 16);
            *(u32x2*)(OS + oo) = pack4(o); }
        asm volatile("" ::: "memory");
    }
}
__device__ __forceinline__ void mem_wg_item(Frame& F, int b, int h, int qblk) {
    int lane_ = F.lane, tid_ = F.tid; asm volatile("" : "+v"(lane_), "+v"(tid_));
    const int lane = lane_, c = lane & 15, q = lane >> 4, tid = tid_, w = F.wave;
    const bf16_t* Kg = (const bf16_t*)(F.ws + WS_MEMKV) + (size_t)(b * 256) * 2048 + h * 256;
    const bf16_t* VTg = (const bf16_t*)(F.ws + WS_MVT) + (size_t)((b * 4 + h) * 256) * 256;
    const bf16_t* MQ = (const bf16_t*)(F.ws + WS_MQ); const bf16_t* MZ = (const bf16_t*)(F.ws + WS_MZ); bf16_t* OM = (bf16_t*)(F.ws + WS_OM);
    LAS unsigned char* L = F.lds;
    __syncthreads();
#pragma unroll
    for (int hf = 0; hf < 2; ++hf) { u32x4 kr[8];
#pragma unroll
        for (int u = 0; u < 8; ++u) { const int p = tid + 512 * (u + 8 * hf), key = p >> 5, ch = p & 31; kr[u] = *(const u32x4*)(Kg + (size_t)key * 2048 + ch * 8); }
#pragma unroll
        for (int u = 0; u < 8; ++u) { const int p = tid + 512 * (u + 8 * hf), key = p >> 5, ch = p & 31; *(LAS u32x4*)(L + key * 512 + ((ch ^ (key & 15)) << 4)) = kr[u]; } }
    __syncthreads();
    size_t qrow[2];
#pragma unroll
    for (int t = 0; t < 2; ++t) qrow[t] = (size_t)b * SEQ + 256 * qblk + 32 * w + 16 * t + c;
    f32x4 sacc[2][16];
#pragma unroll
    for (int mt = 0; mt < 16; ++mt) { sacc[0][mt] = (f32x4){0.f, 0.f, 0.f, 0.f}; sacc[1][mt] = (f32x4){0.f, 0.f, 0.f, 0.f}; }
    bf16x8 qn0 = *(const bf16x8*)(MQ + qrow[0] * 1024 + h * 256 + 8 * q), qn1 = *(const bf16x8*)(MQ + qrow[1] * 1024 + h * 256 + 8 * q);
#pragma unroll 1
    for (int s = 0; s < 8; ++s) {
        const bf16x8 q0 = qn0, q1 = qn1; const int sn = s < 7 ? s + 1 : 7;
        qn0 = *(const bf16x8*)(MQ + qrow[0] * 1024 + h * 256 + 32 * sn + 8 * q); qn1 = *(const bf16x8*)(MQ + qrow[1] * 1024 + h * 256 + 32 * sn + 8 * q);
#pragma unroll
        for (int mt = 0; mt < 16; ++mt) { const int row = 16 * mt + c;
            const bf16x8 kf = *(const LAS bf16x8*)(L + row * 512 + (((4 * s + q) ^ (row & 15)) << 4));
            sacc[0][mt] = mfma16(kf, q0, sacc[0][mt]); sacc[1][mt] = mfma16(kf, q1, sacc[1][mt]); }
        asm volatile("" ::: "memory");
    }
    float inv[2]; bf16x8 pf[2][8];
    const float sc = 0.0625f * 1.4426950408889634f;
#pragma unroll
    for (int t = 0; t < 2; ++t) { float mx = -INFINITY;
#pragma unroll
        for (int mt = 0; mt < 16; ++mt) mx = fmaxf(mx, fmaxf(fmaxf(sacc[t][mt][0], sacc[t][mt][1]), fmaxf(sacc[t][mt][2], sacc[t][mt][3])));
        mx = fmaxf(mx, __shfl_xor(mx, 16)); mx = fmaxf(mx, __shfl_xor(mx, 32));
        float sum = 0.f;
#pragma unroll
        for (int mt = 0; mt < 16; ++mt)
#pragma unroll
            for (int r = 0; r < 4; ++r) { const float e = exp2f((sacc[t][mt][r] - mx) * sc); sacc[t][mt][r] = e; sum += e; }
        sum += __shfl_xor(sum, 16); sum += __shfl_xor(sum, 32); inv[t] = 1.f / sum;
#pragma unroll
        for (int ks = 0; ks < 8; ++ks) pf[t][ks] = cat8(pack4(sacc[t][2 * ks]), pack4(sacc[t][2 * ks + 1])); }
    __syncthreads();
#pragma unroll
    for (int hf = 0; hf < 2; ++hf) { u32x4 vr[8];
#pragma unroll
        for (int u = 0; u < 8; ++u) { const int p = tid + 512 * (u + 8 * hf), d = p >> 5, c16 = p & 31; vr[u] = *(const u32x4*)(VTg + (size_t)d * 256 + c16 * 8); }
#pragma unroll
        for (int u = 0; u < 8; ++u) { const int p = tid + 512 * (u + 8 * hf), d = p >> 5, c16 = p & 31; *(LAS u32x4*)(L + d * 512 + (((2 * c16) ^ (2 * (d & 15))) << 3)) = vr[u]; } }
    __syncthreads();
    u32x2 zn0 = *(const u32x2*)(MZ + qrow[0] * 1024 + h * 256 + 4 * q), zn1 = *(const u32x2*)(MZ + qrow[1] * 1024 + h * 256 + 4 * q);
#pragma unroll 1
    for (int dt = 0; dt < 16; ++dt) { f32x4 o0 = {0.f, 0.f, 0.f, 0.f}, o1 = {0.f, 0.f, 0.f, 0.f}; const int dd = 16 * dt + c;
        const u32x2 zc0 = zn0, zc1 = zn1; const int dn = dt < 15 ? dt + 1 : 15;
        zn0 = *(const u32x2*)(MZ + qrow[0] * 1024 + h * 256 + 16 * dn + 4 * q); zn1 = *(const u32x2*)(MZ + qrow[1] * 1024 + h * 256 + 16 * dn + 4 * q); const LAS unsigned char* vrow = L + dd * 512; const int sw = 2 * (dd & 15);
#pragma unroll
        for (int ks = 0; ks < 8; ++ks) { const bf16x8 vf = cat8(*(const LAS u32x2*)(vrow + (((8 * ks + q) ^ sw) << 3)), *(const LAS u32x2*)(vrow + (((8 * ks + 4 + q) ^ sw) << 3)));
            o0 = mfma16(vf, pf[0][ks], o0); o1 = mfma16(vf, pf[1][ks], o1); }
#pragma unroll
        for (int t = 0; t < 2; ++t) { f32x4 o = t ? o1 : o0; const size_t oo = qrow[t] * 1024 + h * 256 + 16 * dt + 4 * q; const u32x2 z = t ? zc1 : zc0;
            o[0] *= inv[t] * bf2f(z.x & 0xffffu); o[1] *= inv[t] * bf2f(z.x >> 16); o[2] *= inv[t] * bf2f(z.y & 0xffffu); o[3] *= inv[t] * bf2f(z.y >> 16);
            *(u32x2*)(OM + oo) = pack4(o); }
        asm volatile("" ::: "memory"); }
}
__device__ __forceinline__ void p2_attn_prompt(Frame& F, int wk, int nwk) {
    const int gw = wk * NWAVES + F.wave, NGW = nwk * NWAVES, lane = F.lane;
    { LAS float* BTl = (LAS float*)(F.lds + LDS_BT); const float* BT = (const float*)(F.ws + WS_BTAB); for (int i = F.tid; i < 2048; i += NTHREADS) BTl[i] = BT[i]; }
    __syncthreads();
    for (int it = wk; it < 256; it += nwk) { const int qblk = it & 31, bh = it >> 5; mem_wg_item(F, bh >> 2, bh & 3, qblk); }
    for (int it = wk; it < 256; it += nwk) { const int qb = it & 63, bk = it >> 6; swa_wg_item(F, bk >> 1, bk & 1, qb); }
    __syncthreads();
    const bf16_t* SKV = (const bf16_t*)(F.ws + WS_SKV);
    for (int it = gw; it < 256; it += NGW) { const int b = it >> 7, j = it & 127; const bf16_t* pp = SKV + (size_t)(b * SEQ + SEQ - 128 + j) * 256;
        for (int cc = lane; cc < 128; cc += 64) { F.out[O_SKP + ((size_t)b * 128 + j) * 128 + cc] = bf2f(pp[cc]); F.out[O_SVP + ((size_t)b * 128 + j) * 128 + cc] = bf2f(pp[128 + cc]); } }
}
__device__ __forceinline__ void p2_swa_sample(Frame& F, int wk, int nwk) {
    const int gw = wk * NWAVES + F.wave, NGW = nwk * NWAVES, lane = F.lane;
    const bf16_t* SKV = (const bf16_t*)(F.ws + WS_SKV);
    for (int it = gw; it < MS * 2; it += NGW) { const int r = it >> 1, kv = it & 1; swa_wave_item(F, true, r >> 2, r & 3, kv); }
    { const u32x4* s4 = (const u32x4*)(F.ws + WS_OMS); u32x4* d4 = (u32x4*)(F.ws + WS_OM + (size_t)MP * 1024 * 2); for (int i = gw * 64 + lane; i < MS * 1024 / 8; i += NGW * 64) d4[i] = s4[i]; }
    { const int gt = gw * 64 + lane, NT = NGW * 64;
        for (int i = gt; i < 128 * 124 * 32; i += NT) { const int bd = i / (124 * 32), e = i - bd * (124 * 32);
            ((f32x4*)(F.out + O_SKS + (size_t)bd * 16384))[e] = ((const f32x4*)(F.in[I_CSK] + (size_t)bd * 16384 + 512))[e];
            ((f32x4*)(F.out + O_SVS + (size_t)bd * 16384))[e] = ((const f32x4*)(F.in[I_CSV] + (size_t)bd * 16384 + 512))[e]; }
        for (int i = gt; i < 128 * 4 * 128; i += NT) { const int bd = i >> 9, jj = (i >> 7) & 3, cc = i & 127; const bf16_t* pp = SKV + (size_t)(MP + bd * 4 + jj) * 256;
            F.out[O_SKS + ((size_t)bd * 128 + 124 + jj) * 128 + cc] = bf2f(pp[cc]); F.out[O_SVS + ((size_t)bd * 128 + 124 + jj) * 128 + cc] = bf2f(pp[128 + cc]); } }
}
__device__ __forceinline__ void mem_sample_item(Frame& F, int bd, int hp) {
    const int lane = F.lane, w = F.wave, tid = F.tid, hl = lane >> 5, h = 2 * hp + hl, d0 = (lane & 31) * 8;
    const bf16_t* MQ = (const bf16_t*)(F.ws + WS_MQ); const bf16_t* MZ = (const bf16_t*)(F.ws + WS_MZ); bf16_t* OM = (bf16_t*)(F.ws + WS_OM);
    LAS float* lg = (LAS float*)F.lds;
    LAS float* isum = lg + 2048;
    LAS float* po = isum + 8;
    float qr[4][8];
#pragma unroll
    for (int s = 0; s < 4; ++s) { const u32x4 v = *(const u32x4*)(MQ + (size_t)(MP + bd * 4 + s) * 1024 + h * 256 + d0);
        qr[s][0] = bf2f(v.x & 0xffffu); qr[s][1] = bf2f(v.x >> 16); qr[s][2] = bf2f(v.y & 0xffffu); qr[s][3] = bf2f(v.y >> 16);
        qr[s][4] = bf2f(v.z & 0xffffu); qr[s][5] = bf2f(v.z >> 16); qr[s][6] = bf2f(v.w & 0xffffu); qr[s][7] = bf2f(v.w >> 16); }
    const float* Kc = F.in[I_CMK] + ((size_t)bd * 256 * 4 + h) * 256 + d0; const float* Vc = F.in[I_CMV] + ((size_t)bd * 256 * 4 + h) * 256 + d0;
#pragma unroll 4
    for (int i = 0; i < 32; ++i) { const int m = w + 8 * i; const f32x4 k0 = *(const f32x4*)(Kc + (size_t)m * 1024), k1 = *(const f32x4*)(Kc + (size_t)m * 1024 + 4);
        float l[4];
#pragma unroll
        for (int s = 0; s < 4; ++s) { float a = k0.x * qr[s][0] + k0.y * qr[s][1] + k0.z * qr[s][2] + k0.w * qr[s][3] + k1.x * qr[s][4] + k1.y * qr[s][5] + k1.z * qr[s][6] + k1.w * qr[s][7];
#pragma unroll
            for (int o = 1; o < 32; o <<= 1) a += __shfl_xor(a, o);
            l[s] = a * 0.0625f; }
        if ((lane & 31) == 0) {
#pragma unroll
            for (int s = 0; s < 4; ++s) lg[(hl * 4 + s) * 256 + m] = l[s]; } }
    __syncthreads();
    { const int pr = w; float l4[4];
#pragma unroll
        for (int u = 0; u < 4; ++u) l4[u] = lg[pr * 256 + lane + 64 * u];
        const float mx = wave_max(fmaxf(fmaxf(l4[0], l4[1]), fmaxf(l4[2], l4[3]))); float s = 0.f;
#pragma unroll
        for (int u = 0; u < 4; ++u) { l4[u] = __expf(l4[u] - mx); s += l4[u]; lg[pr * 256 + lane + 64 * u] = l4[u]; }
        s = wave_sum(s); if (lane == 0) isum[pr] = 1.f / s; }
    __syncthreads();
    float o[4][8];
#pragma unroll
    for (int s = 0; s < 4; ++s)
#pragma unroll
        for (int j = 0; j < 8; ++j) o[s][j] = 0.f;
#pragma unroll 4
    for (int i = 0; i < 32; ++i) { const int m = w + 8 * i; const f32x4 v0 = *(const f32x4*)(Vc + (size_t)m * 1024), v1 = *(const f32x4*)(Vc + (size_t)m * 1024 + 4);
#pragma unroll
        for (int s = 0; s < 4; ++s) { const float p = lg[(hl * 4 + s) * 256 + m];
            o[s][0] += p * v0.x; o[s][1] += p * v0.y; o[s][2] += p * v0.z; o[s][3] += p * v0.w; o[s][4] += p * v1.x; o[s][5] += p * v1.y; o[s][6] += p * v1.z; o[s][7] += p * v1.w; } }
#pragma unroll
    for (int s = 0; s < 4; ++s) { LAS float* pp = po + ((w * 4 + s) * 512 + hl * 256 + d0);
        *(LAS f32x4*)pp = (f32x4){o[s][0], o[s][1], o[s][2], o[s][3]}; *(LAS f32x4*)(pp + 4) = (f32x4){o[s][4], o[s][5], o[s][6], o[s][7]}; }
    __syncthreads();
#pragma unroll
    for (int u = 0; u < 4; ++u) { const int e = tid + 512 * u, s = e >> 9, cc = e & 511; float a = 0.f;
#pragma unroll
        for (int ww = 0; ww < 8; ++ww) a += po[(ww * 4 + s) * 512 + cc];
        const int hh = 2 * hp + (cc >> 8); const size_t oo = (size_t)(MP + bd * 4 + s) * 1024 + hh * 256 + (cc & 255);
        ((bf16_t*)(F.ws + WS_OMS))[oo - (size_t)MP * 1024] = (bf16_t)f2bf(a * isum[(cc >> 8) * 4 + s] * bf2f(MZ[oo])); }
    __syncthreads();
}

struct SchedP3 {
    int G, c; const unsigned char* ws;
    __device__ __forceinline__ int ntiles(const pg8::Unit&) const { return 1024 / 64; }
    __device__ __forceinline__ bool next(int i, pg8::Unit& u) const {
        if (i < 6) { const int round = i / 3, b = i - round * 3; pg8::tile_of(round * G + c, 64, 8, u.pm, u.pn); u.job = b; return true; }
        if (i == 6 && c < 48) { u.pm = 64 + c / 24; const int rem = c % 24; u.pn = rem / 3; u.job = rem % 3; return true; }
        return false;
    }
    __device__ __forceinline__ void ptrs(const pg8::Unit& u, const char*& A, const char*& B) const {
        A = (const char*)ws + WS_OG + (size_t)u.job * M * 1024 * 2 + (size_t)u.pm * 256 * 1024 * 2;
        B = (const char*)ws + WS_WB + (size_t)u.job * 2048 * 1024 * 2 + (size_t)u.pn * 256 * 1024 * 2;
    }
};
struct EpiP3 {
    unsigned char* ws;
    __device__ __forceinline__ void operator()(const f32x4 (&acc)[2][2][4][2], const pg8::Unit& u, int wr, int wc, int fr, int fq) const {
        const int row0 = u.pm * 256 + wr * 64 + fr, col0 = u.pn * 256 + wc * 32 + 8 * fq, b = u.job;
        const bf16_t* GT = (const bf16_t*)(ws + WS_GATES); bf16_t* MG = (bf16_t*)(ws + WS_MERGED);
        const bool rmw = (b > 0) && (u.pm < 64);
#pragma unroll
        for (int ai = 0; ai < 2; ++ai) {
            u32x4 g[4][2], p[4][2];
#pragma unroll
            for (int m = 0; m < 4; ++m)
#pragma unroll
                for (int bj = 0; bj < 2; ++bj) { const int r = row0 + ai * 128 + m * 16, c = col0 + bj * 128;
                    g[m][bj] = *(const u32x4*)(GT + (size_t)r * 6144 + b * 2048 + c);
                    p[m][bj] = rmw ? *(const u32x4*)(MG + (size_t)r * 2048 + c) : (u32x4){0u, 0u, 0u, 0u}; }
#pragma unroll
            for (int m = 0; m < 4; ++m)
#pragma unroll
                for (int bj = 0; bj < 2; ++bj) { const int r = row0 + ai * 128 + m * 16, c = col0 + bj * 128;
                    const u32x4 gg = g[m][bj], pp = p[m][bj];
                    f32x4 v0 = acc[ai][bj][m][0], v1 = acc[ai][bj][m][1];
                    v0[0] = v0[0] * bf2f(gg.x & 0xffffu) + bf2f(pp.x & 0xffffu); v0[1] = v0[1] * bf2f(gg.x >> 16) + bf2f(pp.x >> 16); v0[2] = v0[2] * bf2f(gg.y & 0xffffu) + bf2f(pp.y & 0xffffu); v0[3] = v0[3] * bf2f(gg.y >> 16) + bf2f(pp.y >> 16);
                    v1[0] = v1[0] * bf2f(gg.z & 0xffffu) + bf2f(pp.z & 0xffffu); v1[1] = v1[1] * bf2f(gg.z >> 16) + bf2f(pp.z >> 16); v1[2] = v1[2] * bf2f(gg.w & 0xffffu) + bf2f(pp.w & 0xffffu); v1[3] = v1[3] * bf2f(gg.w >> 16) + bf2f(pp.w >> 16);
                    u32x4 w; w.x = pg8::cvt_pk_bf16(v0[0], v0[1]); w.y = pg8::cvt_pk_bf16(v0[2], v0[3]); w.z = pg8::cvt_pk_bf16(v1[0], v1[1]); w.w = pg8::cvt_pk_bf16(v1[2], v1[3]);
                    u32x4* mp = u.pm < 64 ? (u32x4*)(MG + (size_t)r * 2048 + c) : (u32x4*)((bf16_t*)(ws + WS_PS) + ((size_t)b * MS + (r - MP)) * 2048 + c);
                    *mp = w; }
        }
    }
};

struct SchedP4 {
    int G, c; const unsigned char* ws;
    __device__ __forceinline__ int ntiles(const pg8::Unit& u) const { return u.job == 0 ? D / 64 : 512 / 64; }
    __device__ __forceinline__ bool next(int i, pg8::Unit& u) const {
        if (i < 2) { pg8::tile_of(i * G + c, 64, 8, u.pm, u.pn); u.job = 0; return true; }
        if (i == 2 && c < 64) { u.pm = 64 + c / 32; const int rem = c % 32; u.pn = rem / 4; u.job = 1 + (rem & 3); return true; }
        return false;
    }
    __device__ __forceinline__ void ptrs(const pg8::Unit& u, const char*& A, const char*& B) const {
        const size_t ko = u.job == 0 ? 0 : (size_t)(u.job - 1) * 512 * 2;
        A = (const char*)ws + WS_MERGED + (size_t)u.pm * 256 * 2048 * 2 + ko; B = (const char*)ws + WS_WO + (size_t)u.pn * 256 * 2048 * 2 + ko;
    }
};
struct EpiP4 {
    unsigned char* ws; float* out; const float* xp; const float* xs;
    __device__ __forceinline__ void operator()(const f32x4 (&acc)[2][2][4][2], const pg8::Unit& u, int wr, int wc, int fr, int fq) const {
        const int row0 = u.pm * 256 + wr * 64 + fr, col0 = u.pn * 256 + wc * 32 + 8 * fq;
        if (u.job != 0) {
#pragma unroll
            for (int ai = 0; ai < 2; ++ai)
#pragma unroll
                for (int m = 0; m < 4; ++m) { const int r = row0 + ai * 128 + m * 16; float* yp = (float*)(ws + WS_YP) + ((size_t)(u.job - 1) * MS + (r - MP)) * D;
#pragma unroll
                    for (int bj = 0; bj < 2; ++bj) { const int c = col0 + bj * 128; *(f32x4*)(yp + c) = acc[ai][bj][m][0]; *(f32x4*)(yp + c + 4) = acc[ai][bj][m][1]; } }
            return;
        }
#pragma unroll
        for (int ai = 0; ai < 2; ++ai)
#pragma unroll
            for (int mh = 0; mh < 2; ++mh) {
                f32x4 xv[2][2][2];
#pragma unroll
                for (int mm = 0; mm < 2; ++mm)
#pragma unroll
                    for (int bj = 0; bj < 2; ++bj) { const float* xr = xp + (size_t)(row0 + ai * 128 + (2 * mh + mm) * 16) * D + col0 + bj * 128; xv[mm][bj][0] = *(const f32x4*)xr; xv[mm][bj][1] = *(const f32x4*)(xr + 4); }
#pragma unroll
                for (int mm = 0; mm < 2; ++mm)
#pragma unroll
                    for (int bj = 0; bj < 2; ++bj) { float* yr = out + (size_t)(row0 + ai * 128 + (2 * mh + mm) * 16) * D + col0 + bj * 128;
                        *(f32x4*)yr = acc[ai][bj][2 * mh + mm][0] + xv[mm][bj][0]; *(f32x4*)(yr + 4) = acc[ai][bj][2 * mh + mm][1] + xv[mm][bj][1]; }
            }
    }
};
__device__ __forceinline__ void p3_combine_sample(Frame& F) {
    const u32x4* ps = (const u32x4*)(F.ws + WS_PS); u32x4* mg = (u32x4*)(F.ws + WS_MERGED + (size_t)MP * 2048 * 2);
    constexpr int NV = MS * 2048 / 8;
    for (int i = F.bid * NTHREADS + F.tid; i < NV; i += F.G * NTHREADS) { const u32x4 a = ps[i], b = ps[NV + i], c = ps[2 * NV + i]; u32x4 o;
        o.x = pk2(bf2f(a.x & 0xffffu) + bf2f(b.x & 0xffffu) + bf2f(c.x & 0xffffu), bf2f(a.x >> 16) + bf2f(b.x >> 16) + bf2f(c.x >> 16));
        o.y = pk2(bf2f(a.y & 0xffffu) + bf2f(b.y & 0xffffu) + bf2f(c.y & 0xffffu), bf2f(a.y >> 16) + bf2f(b.y >> 16) + bf2f(c.y >> 16));
        o.z = pk2(bf2f(a.z & 0xffffu) + bf2f(b.z & 0xffffu) + bf2f(c.z & 0xffffu), bf2f(a.z >> 16) + bf2f(b.z >> 16) + bf2f(c.z >> 16));
        o.w = pk2(bf2f(a.w & 0xffffu) + bf2f(b.w & 0xffffu) + bf2f(c.w & 0xffffu), bf2f(a.w >> 16) + bf2f(b.w >> 16) + bf2f(c.w >> 16));
        mg[i] = o; }
}
__device__ __forceinline__ void p5_final_norm(Frame& F) {
    const int gw = F.bid * NWAVES + F.wave, NGW = F.G * NWAVES, lane = F.lane;
    const f32x4* wn = (const f32x4*)F.in[I_NORMF] + lane;
    for (int r = gw; r < M; r += NGW) {
        f32x4* y = (f32x4*)(F.out + (size_t)r * D) + lane;
        f32x4 v[8]; float s = 0.f;
        if (r >= MP) { const f32x4* xs4 = (const f32x4*)(F.in[I_XS] + (size_t)(r - MP) * D) + lane; const f32x4* yp4 = (const f32x4*)((const float*)(F.ws + WS_YP) + (size_t)(r - MP) * D) + lane;
#pragma unroll
            for (int j = 0; j < 8; ++j) { f32x4 a = xs4[64 * j];
#pragma unroll
                for (int kq = 0; kq < 4; ++kq) a = a + yp4[(size_t)kq * MS * D / 4 + 64 * j];
                v[j] = a; s += (a.x * a.x + a.y * a.y) + (a.z * a.z + a.w * a.w); } }
        else
#pragma unroll
        for (int j = 0; j < 8; ++j) { v[j] = y[64 * j]; s += (v[j].x * v[j].x + v[j].y * v[j].y) + (v[j].z * v[j].z + v[j].w * v[j].w); }
        const float sc = rsqrtf(wave_sum(s) * (1.f / D) + EPS);
#pragma unroll
        for (int j = 0; j < 8; ++j) { const f32x4 w = wn[64 * j]; f32x4 o = v[j]; o.x *= sc * w.x; o.y *= sc * w.y; o.z *= sc * w.z; o.w *= sc * w.w; y[64 * j] = o; }
    }
}

constexpr int N_PHASES = 10;
__global__ void __launch_bounds__(NTHREADS, 2) hybrid_fwd(Args args) {
    extern __shared__ __attribute__((aligned(16))) unsigned char lds_raw[];
    cg::grid_group grid = cg::this_grid();
    Frame F;
    F.lds = (LAS unsigned char*)lds_raw; F.tid = threadIdx.x; F.lane = F.tid & 63; F.wave = __builtin_amdgcn_readfirstlane(F.tid >> 6);
    F.G = gridDim.x; F.bid = blockIdx.x; F.in = args.in; F.out = args.out; F.ws = args.ws;
    const int lo = args.ph_lo, hi = args.ph_hi;
    if (lo < 0) grid.sync();
    if (F.tid < 64) ((LAS unsigned*)(F.lds + LDS_CTL))[F.tid] = 0u;
    __syncthreads();
    const XcdBarrier bar = xcd_barrier_post((unsigned*)(F.ws + WS_CTL), (volatile LAS unsigned*)(F.lds + LDS_CTL));
#define IN(k) (lo <= (k) && (k) < hi)
#define SEAM(k) do { if (IN(k) && IN((k) + 1)) xcd_barrier(bar); } while (0)
    if (IN(0)) p0_prologue(F);
    SEAM(0);
    if (IN(1)) { SchedP1 S{F.G, F.bid, F.ws, (const unsigned char*)F.out + DO_XN}; EpiP1 E{F.ws, F.out}; pg8::gemm_phase<EpiP1, SchedP1>(F.lds, D, S, E); }
    SEAM(1);
    if (IN(2)) { p2_conv(F); __syncthreads(); for (int it = F.bid; it < 256; it += F.G) mem_sample_item(F, it >> 1, it & 1); }
    SEAM(2);
    if (IN(3)) p2_prep(F);
    SEAM(3);
    if (IN(4)) {
        constexpr int GSPLIT = 512;
        if (F.bid < 128) { scan_item(F, F.bid & 15, F.bid >> 4); __syncthreads(); p2_gdn_sample(F, F.bid, 128, 0, GSPLIT); }
        else { const int wk = F.bid - 128, nwk = F.G - 128; p2_attn_prompt(F, wk, nwk); __syncthreads(); p2_swa_sample(F, wk, nwk); __syncthreads(); p2_gdn_sample(F, wk, nwk, GSPLIT, 1024); }
    }
    SEAM(4);
    if (IN(5)) { for (int it = F.bid; it < 256; it += F.G) gdn_out_item(F, it); p2_gdn_norm_sample(F); }
    SEAM(5);
    if (IN(6)) { SchedP3 S{F.G, F.bid, F.ws}; EpiP3 E{F.ws}; pg8::gemm_phase<EpiP3, SchedP3>(F.lds, 1024, S, E); }
    SEAM(6);
    if (IN(7)) p3_combine_sample(F);
    SEAM(7);
    if (IN(8)) { SchedP4 S{F.G, F.bid, F.ws}; EpiP4 E{F.ws, F.out, F.in[I_XP], F.in[I_XS]}; pg8::gemm_phase<EpiP4, SchedP4>(F.lds, D, S, E); }
    SEAM(8);
    if (IN(9)) p5_final_norm(F);
#undef IN
#undef SEAM
}

extern "C" void kernel_launch(void* const* d_in, const int* in_sizes, int n_in, void* d_out, int out_size, void* d_ws, size_t ws_size, hipStream_t stream) {
    static int grid = 0;
    if (grid == 0) {
        if (n_in != 22 || out_size != (int)O_END || ws_size < WS_END) { fprintf(stderr, "kernel_launch: unexpected shapes (n_in %d out %d ws %zu need %zu)\n", n_in, out_size, ws_size, (size_t)WS_END); grid = -1; return; }
        int dev = 0, cus = 0, per_cu = 0;
        hipGetDevice(&dev); hipDeviceGetAttribute(&cus, hipDeviceAttributeMultiprocessorCount, dev);
        hipFuncSetAttribute((const void*)hybrid_fwd, hipFuncAttributeMaxDynamicSharedMemorySize, LDS_BYTES);
        hipOccupancyMaxActiveBlocksPerMultiprocessor(&per_cu, (const void*)hybrid_fwd, NTHREADS, LDS_BYTES);
        if (per_cu < 1) { fprintf(stderr, "kernel_launch: occupancy query says %d blocks per CU\n", per_cu); grid = -1; return; }
        grid = cus;
    }
    if (grid < 0) return;
    Args a{};
    for (int i = 0; i < 22; ++i) a.in[i] = (const float*)d_in[i];
    a.out = (float*)d_out; a.ws = (unsigned char*)d_ws;
    if (hipMemsetAsync((char*)d_ws + WS_CTL, 0, XCD_BAR_WORDS * 4, stream) != hipSuccess) { fprintf(stderr, "kernel_launch: hipMemsetAsync failed\n"); return; }
#if MK_N_LAUNCHES == 1
    a.ph_lo = 0; a.ph_hi = N_PHASES;
    void* kargs[] = {&a};
    hipError_t e = hipLaunchCooperativeKernel((const void*)hybrid_fwd, dim3(grid), dim3(NTHREADS), kargs, LDS_BYTES, stream);
    if (e != hipSuccess) fprintf(stderr, "cooperative launch failed: %s (grid %d)\n", hipGetErrorString(e), grid);
#endif
}
```

```cpp
#include <hip/hip_runtime.h>
#include <hip/hip_cooperative_groups.h>
#include <cstdio>
#include <cstdint>
namespace cg = cooperative_groups;

#ifndef MK_N_LAUNCHES
#define MK_N_LAUNCHES 1
#endif

#define LAS __attribute__((address_space(3)))
typedef unsigned short bf16_t;
typedef short bf16x8 __attribute__((ext_vector_type(8)));
typedef float f32x4 __attribute__((ext_vector_type(4)));
typedef unsigned u32x4 __attribute__((ext_vector_type(4)));
typedef unsigned u32x2 __attribute__((ext_vector_type(2)));

constexpr int D = 2048, SEQ = 8192, MP = 2 * SEQ, MS = 512, M = MP + MS;
constexpr int IN_COLS = 14608;
constexpr int NIN = 58 * 256;
constexpr float EPS = 1e-6f;
__host__ __device__ __forceinline__ int win_src_col(int j) {
    if (j < 4096) return j;
    if (j < 5120) return 4112 + (j - 4096);
    if (j < 6144) return 5392 + (j - 5120);
    if (j < 7168) return 6416 + (j - 6144);
    if (j < 8192) return 7440 + (j - 7168);
    if (j < 14336) return 8464 + (j - 8192);
    if (j < 14592) return 5136 + (j - 14336);
    if (j < 14608) return 4096 + (j - 14592);
    return -1;
}
constexpr size_t O_YP = 0, O_YS = O_YP + (size_t)MP * D, O_GSP = O_YS + (size_t)MS * D, O_GCP = O_GSP + 2 * 8 * 128 * 128, O_SKP = O_GCP + 2 * 3 * 3072,
                 O_SVP = O_SKP + 2 * 128 * 128, O_MKP = O_SVP + 2 * 128 * 128, O_MVP = O_MKP + 512 * 1024, O_GSS = O_MVP + 512 * 1024,
                 O_GCS = O_GSS + (size_t)128 * 8 * 128 * 128, O_SKS = O_GCS + 128 * 3 * 3072, O_SVS = O_SKS + 128 * 128 * 128, O_END = O_SVS + 128 * 128 * 128;
static_assert(O_END == 58148864, "d_out map");
constexpr size_t al(size_t x) { return (x + 255) & ~(size_t)255; }
constexpr size_t WS_CTL = 0, WS_WB = 1u << 20, WS_WO = WS_WB + al((size_t)3 * 2048 * 1024 * 2), WS_WIN = WS_WO + al((size_t)2048 * 2048 * 2),
                 WS_WMKV = WS_WIN + al((size_t)NIN * 2048 * 2), WS_QKV = WS_WMKV + al((size_t)2048 * 2048 * 2), WS_GZ = WS_QKV + al((size_t)M * 3072 * 2),
                 WS_SQ = WS_GZ + al((size_t)M * 1024 * 2), WS_SZ = WS_SQ + al((size_t)M * 1024 * 2), WS_MQ = WS_SZ + al((size_t)M * 1024 * 2), WS_MZ = WS_MQ + al((size_t)M * 1024 * 2),
                 WS_SKV = WS_MZ + al((size_t)M * 1024 * 2), WS_GATES = WS_SKV + al((size_t)M * 256 * 2), WS_MEMN = WS_GATES + al((size_t)M * 6144 * 2),
                 WS_MEMKV = WS_MEMN + al((size_t)512 * 2048 * 2), WS_GAB = WS_MEMKV + al((size_t)512 * 2048 * 2), WS_ROWSS = WS_GAB + al((size_t)M * 16 * 4),
                 WS_G = WS_ROWSS + al((size_t)M * 4), WS_BETA = WS_G + al((size_t)M * 8 * 4), WS_BTAB = WS_BETA + al((size_t)M * 8 * 4), WS_END0 = WS_BTAB + al(16 * 128 * 4);
constexpr size_t WS_OG = WS_QKV, WS_OS = WS_OG + (size_t)M * 1024 * 2, WS_OM = WS_OS + (size_t)M * 1024 * 2, WS_MERGED = WS_SQ;
constexpr size_t WS_NEGW = WS_OG, WS_SN = WS_WIN, WS_OMS = WS_MEMN;
constexpr size_t WS_UT = WS_END0, WS_ATT = WS_UT + al((size_t)2048 * 128 * 64 * 2), WS_GC = WS_ATT + al((size_t)2048 * 64 * 64 * 2), WS_DEC = WS_GC + al((size_t)MP * 8 * 4),
                 WS_GT = WS_DEC + al((size_t)2048 * 64 * 4), WS_MVT = WS_GT + al(2048 * 4), WS_VTS = WS_MVT + al((size_t)2 * 4 * 256 * 256 * 2), WS_SSQ = WS_VTS + al((size_t)2 * 2 * 64 * SEQ * 2 + 4096), WS_SSK = WS_SSQ + al((size_t)MP * 8 * 4), WS_END = WS_SSK + al((size_t)MP * 8 * 4);
constexpr size_t WS_PS = WS_UT, WS_YP = WS_UT + (size_t)3 * MS * 2048 * 2;
static_assert((size_t)3 * MS * 2048 * 2 + (size_t)4 * MS * 2048 * 4 <= (size_t)2048 * 128 * 64 * 2, "PS/YP fit in UT");
static_assert(WS_OM + (size_t)M * 1024 * 2 <= WS_GZ && WS_MERGED + (size_t)M * 2048 * 2 <= WS_MQ, "overlays");
static_assert((size_t)2048 * 64 * 128 * 2 <= (size_t)MP * 1024 * 2 && WS_SN + (size_t)2048 * 128 * 128 * 2 <= WS_QKV, "overlays 2");
static_assert(WS_END <= 670000000, "workspace budget");
constexpr size_t DO_XN = 0, DO_QN = 0, DO_KN = (size_t)M * 1024 * 2, DO_KT = 2 * (size_t)M * 1024 * 2, DO_VT = DO_KT + (size_t)2048 * 8192 * 2, DO_VNS = DO_VT + (size_t)2048 * 8192 * 2;
static_assert(DO_VNS + (size_t)512 * 1024 * 2 <= (size_t)M * D * 4, "y scratch");

constexpr int NWAVES = 8, NTHREADS = 512;
constexpr int LDS_CTL = 147456;
constexpr int LDS_BYTES = 147456 + 256;
constexpr int LDS_BT = 139264;

__device__ __forceinline__ float bf2f(unsigned v) { return __uint_as_float(v << 16); }
__device__ __forceinline__ unsigned f2bf(float f) { unsigned u = __float_as_uint(f); return (u + 0x7fffu + ((u >> 16) & 1u)) >> 16; }
__device__ __forceinline__ unsigned pk2(float lo, float hi) { return f2bf(lo) | (f2bf(hi) << 16); }
__device__ __forceinline__ float wave_sum(float v) {
#pragma unroll
    for (int o = 1; o < 64; o <<= 1) v += __shfl_xor(v, o);
    return v;
}
__device__ __forceinline__ float wave_max(float v) {
#pragma unroll
    for (int o = 1; o < 64; o <<= 1) v = fmaxf(v, __shfl_xor(v, o));
    return v;
}
__device__ __forceinline__ float sigmoidf_(float x) { return __builtin_amdgcn_rcpf(1.f + __expf(-x)); }
__device__ __forceinline__ float siluf_(float x) { return x * __builtin_amdgcn_rcpf(1.f + __expf(-x)); }
#define LDS_WAIT() asm volatile("s_waitcnt lgkmcnt(0)" ::: "memory")

namespace pg8 {
constexpr int BM = 256, BK = 64, HALF = 128, HTB = HALF * BK * 2, STAGE_BYTES = 8 * HTB, NXCD = 8, WGM = 8;
__host__ __device__ __forceinline__ int lds_byte(int r, int c) { const int st = (r >> 4) * 2 + (c >> 5), rr = r & 15, cc = c & 31, ob = rr * 64 + cc * 2; return st * 1024 + (ob ^ (((ob >> 9) & 1) << 5)); }
__host__ __device__ __forceinline__ void stage_rc(int b, int& R, int& C) { const int st = b / 1024, sb = b % 1024, swz = sb ^ (((sb >> 9) & 1) << 5); R = (st >> 1) * 16 + swz / 64; C = (st & 1) * 32 + (swz % 64) / 2; }
__host__ __device__ __forceinline__ int perm32(int rho) { const int n = rho >> 4, i = rho & 15; return 8 * (i >> 2) + 4 * n + (i & 3); }
struct Unit { int pm, pn, job; };
__device__ __forceinline__ void tile_of(int L, int nM, int nN, int& pm, int& pn) {
    const int nwg = nM * nN; int wgid = L;
    { const int q = nwg / NXCD, r = nwg % NXCD, xcd = wgid % NXCD, off = wgid / NXCD; wgid = (xcd < r ? xcd * (q + 1) : r * (q + 1) + (xcd - r) * q) + off; }
    const int nig = WGM * nN, gid = wgid / nig, fm = gid * WGM, gsz = (nM - fm) < WGM ? (nM - fm) : WGM;
    pm = fm + ((wgid % nig) % gsz); pn = (wgid % nig) / gsz;
}
__device__ __forceinline__ unsigned cvt_pk_bf16(float lo, float hi) { unsigned r; asm volatile("v_cvt_pk_bf16_f32 %0, %1, %2" : "=v"(r) : "v"(lo), "v"(hi)); return r; }

template <class Epi, class Sched, bool ALIGN_EPI = true>
__device__ __forceinline__ void gemm_phase(LAS unsigned char* lds, const int K, const Sched& S, const Epi& E) {
    const int tid = threadIdx.x, wid = __builtin_amdgcn_readfirstlane(tid >> 6), lane = tid & 63, wr = wid >> 2, wc = wid & 3, fr = lane & 15, fq = lane >> 4;
    unsigned voffA[2], voffB[2];
#pragma unroll
    for (int i = 0; i < 2; ++i) { int R, C; stage_rc(tid * 16 + i * 8192, R, C); const int Rb = ((R & ~31) + perm32(R & 31));
        voffA[i] = (unsigned)(R * K + C) * 2u; voffB[i] = (unsigned)(Rb * K + C) * 2u; }
    const size_t kstep = (size_t)(BK * 2);
    const size_t hstep = (size_t)HALF * K * 2;
    const unsigned ldsw = (unsigned)wid * 1024u;
    const int aoff = lds_byte(wr * 64 + fr, fq * 8), boff = lds_byte(wc * 32 + fr, fq * 8);
#define PG8_SA(b, h) (((b) * 2 + (h)) * HTB)
#define PG8_SB(b, h) ((4 + (b) * 2 + (h)) * HTB)
#define PG8_STAGE(bufoff, gbase, voff) do { _Pragma("unroll") for (int _i = 0; _i < 2; ++_i) \
        __builtin_amdgcn_global_load_lds((const unsigned*)((const char*)(gbase) + (voff)[_i]), (LAS unsigned*)(lds + (bufoff) + ldsw + _i * 8192), 16, 0, 0); } while (0)
#define PG8_LDA(dst, b, h) do { _Pragma("unroll") for (int m = 0; m < 4; ++m) _Pragma("unroll") for (int k = 0; k < 2; ++k) dst[m][k] = *(const LAS bf16x8*)(lds + PG8_SA(b, h) + aoff + m * 2048 + k * 1024); } while (0)
#define PG8_LDB(dst, b, h) do { _Pragma("unroll") for (int n = 0; n < 2; ++n) _Pragma("unroll") for (int k = 0; k < 2; ++k) dst[n][k] = *(const LAS bf16x8*)(lds + PG8_SB(b, h) + boff + n * 2048 + k * 1024); } while (0)
#define PG8_MMA(ai, bj, At, Bt) do { __builtin_amdgcn_s_setprio(1); _Pragma("unroll") for (int m = 0; m < 4; ++m) _Pragma("unroll") for (int n = 0; n < 2; ++n) _Pragma("unroll") for (int k = 0; k < 2; ++k) \
        acc[ai][bj][m][n] = __builtin_amdgcn_mfma_f32_16x16x32_bf16(Bt[n][k], At[m][k], acc[ai][bj][m][n], 0, 0, 0); __builtin_amdgcn_s_setprio(0); } while (0)
#define PG8_WAIT_V(n) asm volatile("s_waitcnt vmcnt(" #n ")" ::: "memory")
#define PG8_WAIT_L(n) asm volatile("s_waitcnt lgkmcnt(" #n ")" ::: "memory")
#define PG8_BAR __builtin_amdgcn_s_barrier()
#define PG8_SCHED __builtin_amdgcn_sched_barrier(0)
    Unit cur, nxt; int ui = 0;
    if (!S.next(0, cur)) return;
    f32x4 acc[2][2][4][2];
#pragma unroll
    for (int a = 0; a < 2; ++a)
#pragma unroll
        for (int b = 0; b < 2; ++b)
#pragma unroll
            for (int m = 0; m < 4; ++m)
#pragma unroll
                for (int n = 0; n < 2; ++n) acc[a][b][m][n] = (f32x4){0.f, 0.f, 0.f, 0.f};
    bf16x8 At[4][2], B0[2][2], B1[2][2];
    const char* cA; const char* cB; S.ptrs(cur, cA, cB);
    PG8_STAGE(PG8_SB(0, 0), cB, voffB); PG8_STAGE(PG8_SB(0, 1), cB + hstep, voffB); PG8_STAGE(PG8_SA(0, 0), cA, voffA); PG8_STAGE(PG8_SA(0, 1), cA + hstep, voffA);
    if (wr == 1) PG8_BAR;
    PG8_WAIT_V(2); PG8_BAR;
    PG8_STAGE(PG8_SB(1, 0), cB + kstep, voffB); PG8_STAGE(PG8_SA(1, 0), cA + kstep, voffA); PG8_STAGE(PG8_SB(1, 1), cB + hstep + kstep, voffB);
    PG8_WAIT_V(6); PG8_BAR;
    for (;;) {
        const bool has_next = S.next(ui + 1, nxt);
        const char* nA = cA; const char* nB = cB; if (has_next) S.ptrs(nxt, nA, nB);
        const int nt = S.ntiles(cur);
        for (int t = 0; t < nt; t += 2) {
            const bool last = (t == nt - 2);
            const char* a1 = cA + (size_t)(t + 1) * kstep;
            const char* a2 = last ? nA : cA + (size_t)(t + 2) * kstep; const char* b2 = last ? nB : cB + (size_t)(t + 2) * kstep;
            const char* a3 = a2 + kstep; const char* b3 = b2 + kstep;
            PG8_LDB(B0, 0, 0); PG8_LDB(B1, 0, 1); PG8_SCHED; PG8_LDA(At, 0, 0); PG8_STAGE(PG8_SA(1, 1), a1 + hstep, voffA);
            PG8_WAIT_V(8); PG8_WAIT_L(0); PG8_BAR; PG8_MMA(0, 0, At, B0); PG8_MMA(0, 1, At, B1); PG8_BAR; PG8_SCHED;
            PG8_LDA(At, 0, 1); PG8_STAGE(PG8_SB(0, 0), b2, voffB); PG8_STAGE(PG8_SB(0, 1), b2 + hstep, voffB); PG8_STAGE(PG8_SA(0, 0), a2, voffA);
            PG8_WAIT_V(8); PG8_WAIT_L(0); PG8_BAR; PG8_MMA(1, 0, At, B0); PG8_MMA(1, 1, At, B1); PG8_BAR; PG8_SCHED;
            PG8_LDB(B0, 1, 0); PG8_LDB(B1, 1, 1); PG8_SCHED; PG8_LDA(At, 1, 0); PG8_STAGE(PG8_SA(0, 1), a2 + hstep, voffA);
            PG8_WAIT_V(8); PG8_WAIT_L(0); PG8_BAR; PG8_MMA(0, 0, At, B0); PG8_MMA(0, 1, At, B1); PG8_BAR; PG8_SCHED;
            PG8_LDA(At, 1, 1); PG8_STAGE(PG8_SB(1, 0), b3, voffB); PG8_STAGE(PG8_SB(1, 1), b3 + hstep, voffB); PG8_STAGE(PG8_SA(1, 0), a3, voffA);
            PG8_WAIT_V(8); PG8_WAIT_L(0); PG8_BAR; PG8_MMA(1, 0, At, B0); PG8_MMA(1, 1, At, B1); PG8_BAR; PG8_SCHED;
        }
        if constexpr (ALIGN_EPI) { if (wr == 0) PG8_BAR; }
        E(acc, cur, wr, wc, fr, fq);
        if (!has_next) break;
#pragma unroll
        for (int a = 0; a < 2; ++a)
#pragma unroll
            for (int b = 0; b < 2; ++b)
#pragma unroll
                for (int m = 0; m < 4; ++m)
#pragma unroll
                    for (int n = 0; n < 2; ++n) acc[a][b][m][n] = (f32x4){0.f, 0.f, 0.f, 0.f};
        cur = nxt; cA = nA; cB = nB; ++ui;
        if constexpr (ALIGN_EPI) { if (wr == 1) PG8_BAR; }
    }
    PG8_WAIT_V(0);
    if constexpr (!ALIGN_EPI) { if (wr == 0) PG8_BAR; }
    PG8_BAR;
#undef PG8_SA
#undef PG8_SB
#undef PG8_STAGE
#undef PG8_LDA
#undef PG8_LDB
#undef PG8_MMA
#undef PG8_WAIT_V
#undef PG8_WAIT_L
#undef PG8_BAR
#undef PG8_SCHED
}
}

#define XB_TMO      128
#define XB_XCNT(j)  (256  + 64 * (j))
#define XB_XSUB(j)  (1280 + 64 * (j))
#define XB_XGEN(j)  (2304 + 64 * (j))
#define XB_TOP      3328
#define XB_TOPGEN   3392
#define XCD_BAR_WORDS 3456
#define XB_SPIN_CAP (1u << 20)
__device__ __forceinline__ unsigned xb_ld(unsigned* p)              { return __hip_atomic_load(p, __ATOMIC_RELAXED, __HIP_MEMORY_SCOPE_AGENT); }
__device__ __forceinline__ unsigned xb_add(unsigned* p, unsigned v) { return __hip_atomic_fetch_add(p, v, __ATOMIC_RELAXED, __HIP_MEMORY_SCOPE_AGENT); }
__device__ __forceinline__ unsigned xb_xcc_id() { return (unsigned)__builtin_amdgcn_s_getreg((3 << 11) | 20) & 0xFu; }
#define XB_SPIN(cond, bar) do { unsigned _sp = 0; while (cond) { __builtin_amdgcn_s_sleep(1); \
    if ((++_sp & 255u) == 0u) { if (xb_ld(&(bar)[XB_TMO])) break; if (_sp > XB_SPIN_CAP) { atomicAdd(&(bar)[XB_TMO], 1u); break; } } } } while (0)
struct XcdBarrier { unsigned* bar; unsigned x; volatile LAS unsigned* st; };
__device__ __forceinline__ XcdBarrier xcd_barrier_post(unsigned* bar, volatile LAS unsigned* st) {
    XcdBarrier b; b.bar = bar; b.x = xb_xcc_id(); b.st = st;
    if (threadIdx.x == 0) (void)xb_add(&bar[XB_XCNT(b.x)], 1u);
    return b;
}
__device__ __forceinline__ void xcd_barrier_complete(unsigned* bar, unsigned x, unsigned& nloc, unsigned& nx) {
    const unsigned G = gridDim.x * gridDim.y * gridDim.z;
    unsigned sum, cnt, mine, sp = 0u;
    for (;;) {
        sum = 0u; cnt = 0u; mine = 0u;
#pragma unroll
        for (unsigned j = 0; j < 16; ++j) { const unsigned c = xb_ld(&bar[XB_XCNT(j)]); sum += c; cnt += (c > 0u) ? 1u : 0u; mine = (j == x) ? c : mine; }
        if (sum == G) break;
        __builtin_amdgcn_s_sleep(1);
        if ((++sp & 255u) == 0u) { if (xb_ld(&bar[XB_TMO])) break; if (sp > XB_SPIN_CAP) { atomicAdd(&bar[XB_TMO], 1u); break; } }
    }
    nloc = mine > 0u ? mine : 1u; nx = cnt > 0u ? cnt : 1u;
}
__device__ __forceinline__ void xcd_barrier(const XcdBarrier& b) {
    asm volatile("s_waitcnt vmcnt(0)" ::: "memory");
    __syncthreads();
    if (threadIdx.x == 0) {
        unsigned* bar = b.bar;
        __builtin_amdgcn_s_waitcnt(0);
        unsigned nloc = b.st[0], nx = b.st[1];
        if (nloc == 0u) { xcd_barrier_complete(bar, b.x, nloc, nx); b.st[0] = nloc; b.st[1] = nx; }
        const unsigned old = xb_add(&bar[XB_XSUB(b.x)], 1u);
        const unsigned gen = old / nloc;
        if (old + 1u == (gen + 1u) * nloc) {
            __builtin_amdgcn_fence(__ATOMIC_RELEASE, "agent");
            asm volatile("s_waitcnt vmcnt(0)" ::: "memory");
            const unsigned og = xb_add(&bar[XB_TOP], 1u);
            const unsigned tg = og / nx;
            if (og + 1u == (tg + 1u) * nx) xb_add(&bar[XB_TOPGEN], 1u);
            else XB_SPIN(xb_ld(&bar[XB_TOPGEN]) == tg, bar);
            __builtin_amdgcn_fence(__ATOMIC_ACQUIRE, "agent");
            xb_add(&bar[XB_XGEN(b.x)], 1u);
            asm volatile("s_waitcnt vmcnt(0)" ::: "memory");
        } else {
            XB_SPIN(xb_ld(&bar[XB_XGEN(b.x)]) == gen, bar);
            __builtin_amdgcn_fence(__ATOMIC_ACQUIRE, "agent");
            asm volatile("s_waitcnt vmcnt(0)" ::: "memory");
        }
    }
    __syncthreads();
}

struct Args { const float* in[22]; float* out; unsigned char* ws; int ph_lo, ph_hi; };
enum { I_XP = 0, I_XS, I_SGDN, I_SCONV, I_CSK, I_CSV, I_CMK, I_CMV, I_MEMP, I_NORM_IN, I_WIN, I_CONVW, I_ALOG, I_DTB, I_GNORM, I_SINKS, I_RELB, I_NORM_MEM, I_WMKV, I_WBR, I_WOUT, I_NORMF };

struct Frame {
    LAS unsigned char* lds;
    int tid, lane, wave, G, bid;
    const float* const* in; float* out; unsigned char* ws;
};

template <bool WINMAP>
__device__ __forceinline__ void p0_transpose_item(const float* W, int K, int Nsrc, bf16_t* WT, LAS bf16_t* scr, int kb, int nb, int lane) {
    constexpr int TP = 130;
    const int k0 = 64 * kb, n0 = 128 * nb;
    const int dj = n0 + 4 * (lane & 31);
    const int sc = WINMAP ? win_src_col(dj) : dj;
    f32x4 v[32];
#pragma unroll
    for (int i = 0; i < 32; ++i) { const int kk = 2 * i + (lane >> 5); v[i] = sc >= 0 ? *(const f32x4*)(W + (size_t)(k0 + kk) * Nsrc + sc) : (f32x4){0.f, 0.f, 0.f, 0.f}; }
#pragma unroll
    for (int i = 0; i < 32; ++i) { const int kk = 2 * i + (lane >> 5); LAS unsigned* d = (LAS unsigned*)(scr + kk * TP + 4 * (lane & 31)); d[0] = pk2(v[i].x, v[i].y); d[1] = pk2(v[i].z, v[i].w); }
    LDS_WAIT(); asm volatile("" ::: "memory");
#pragma unroll 4
    for (int u = 0; u < 16; ++u) { const int e = lane + 64 * u, ch = e & 7, n = e >> 3; const LAS bf16_t* s = scr + (8 * ch) * TP + n;
        u32x4 o; o.x = (unsigned)s[0] | ((unsigned)s[TP] << 16); o.y = (unsigned)s[2 * TP] | ((unsigned)s[3 * TP] << 16);
        o.z = (unsigned)s[4 * TP] | ((unsigned)s[5 * TP] << 16); o.w = (unsigned)s[6 * TP] | ((unsigned)s[7 * TP] << 16);
        *(u32x4*)(WT + (size_t)(n0 + n) * K + k0 + 8 * ch) = o; }
    LDS_WAIT(); asm volatile("" ::: "memory");
}
__device__ __forceinline__ void rms_row_to_bf16(const float* xrow, const float* w, bf16_t* orow, int lane) {
    const f32x4* xr = (const f32x4*)xrow + lane; const f32x4* wr = (const f32x4*)w + lane;
    f32x4 v[8]; float s = 0.f;
#pragma unroll
    for (int j = 0; j < 8; ++j) { v[j] = xr[64 * j]; s += (v[j].x * v[j].x + v[j].y * v[j].y) + (v[j].z * v[j].z + v[j].w * v[j].w); }
    const float r = rsqrtf(wave_sum(s) * (1.f / D) + EPS);
    unsigned long long* o8 = (unsigned long long*)orow + lane;
#pragma unroll
    for (int j = 0; j < 8; ++j) { const f32x4 ww = wr[64 * j];
        o8[64 * j] = (unsigned long long)pk2(v[j].x * r * ww.x, v[j].y * r * ww.y) | ((unsigned long long)pk2(v[j].z * r * ww.z, v[j].w * r * ww.w) << 32); }
}
__device__ __forceinline__ int t5_bucket(int n) {
    if (n < 16) return n;
    int large = 16 + (int)(logf((float)n / 16.f) / 2.0794415416798357f * 16.f);
    return large < 31 ? large : 31;
}
__device__ __forceinline__ void p0_prologue(Frame& F) {
    LAS bf16_t* scr = (LAS bf16_t*)(F.lds + F.wave * 16896);
    const int gw = F.bid * NWAVES + F.wave, NGW = F.G * NWAVES;
    constexpr int I_IN = 32 * (NIN / 128), I_MKV = 32 * 16, I_BR = 16 * 16, I_OUT = 32 * 16;
    constexpr int NITEMS = I_IN + I_MKV + 3 * I_BR + I_OUT;
    bf16_t* WINT = (bf16_t*)(F.ws + WS_WIN); bf16_t* WMKVT = (bf16_t*)(F.ws + WS_WMKV); bf16_t* WBT = (bf16_t*)(F.ws + WS_WB); bf16_t* WOT = (bf16_t*)(F.ws + WS_WO);
    for (int it = gw; it < NITEMS; it += NGW) {
        int r = it;
        if (r < I_IN) { p0_transpose_item<true>(F.in[I_WIN], D, IN_COLS, WINT, scr, r / (NIN / 128), r % (NIN / 128), F.lane); continue; } r -= I_IN;
        if (r < I_MKV) { p0_transpose_item<false>(F.in[I_WMKV], D, 2048, WMKVT, scr, r / 16, r % 16, F.lane); continue; } r -= I_MKV;
        if (r < 3 * I_BR) { const int b = r / I_BR, q = r % I_BR; p0_transpose_item<false>(F.in[I_WBR] + (size_t)b * 1024 * 2048, 1024, 2048, WBT + (size_t)b * 2048 * 1024, scr, q / 16, q % 16, F.lane); continue; } r -= 3 * I_BR;
        p0_transpose_item<false>(F.in[I_WOUT], D, 2048, WOT, scr, r / 16, r % 16, F.lane);
    }
    bf16_t* XN = (bf16_t*)((unsigned char*)F.out + DO_XN); bf16_t* MEMN = (bf16_t*)(F.ws + WS_MEMN);
    for (int m = gw; m < M + 512; m += NGW) {
        if (m < MP) rms_row_to_bf16(F.in[I_XP] + (size_t)m * D, F.in[I_NORM_IN], XN + (size_t)m * D, F.lane);
        else if (m < M) rms_row_to_bf16(F.in[I_XS] + (size_t)(m - MP) * D, F.in[I_NORM_IN], XN + (size_t)m * D, F.lane);
        else rms_row_to_bf16(F.in[I_MEMP] + (size_t)(m - M) * D, F.in[I_NORM_MEM], MEMN + (size_t)(m - M) * D, F.lane);
    }
    float* BT = (float*)(F.ws + WS_BTAB);
    for (int i = F.bid * NTHREADS + F.tid; i < 16 * 128; i += F.G * NTHREADS) { const int h = i >> 7, dist = i & 127; BT[i] = F.in[I_RELB][t5_bucket(dist) * 16 + h]; }
}

struct SchedP1 {
    int G, c; const unsigned char* ws; const unsigned char* xn;
    __device__ __forceinline__ int ntiles(const pg8::Unit&) const { return D / 64; }
    static constexpr int NM = M / 256, NN = NIN / 256, NU0 = NM * NN, NU = NU0 + 16;
    __device__ __forceinline__ bool next(int i, pg8::Unit& u) const {
        const long L = (long)i * G + c; if (L >= NU) return false;
        if (L < NU0) { pg8::tile_of((int)L, NM, NN, u.pm, u.pn); u.job = 0; } else { const int q = (int)L - NU0; u.pm = q >> 3; u.pn = q & 7; u.job = 1; }
        return true;
    }
    __device__ __forceinline__ void ptrs(const pg8::Unit& u, const char*& A, const char*& B) const {
        const size_t tstep = (size_t)256 * D * 2;
        if (u.job == 0) { A = (const char*)xn + (size_t)u.pm * tstep; B = (const char*)ws + WS_WIN + (size_t)u.pn * tstep; }
        else { A = (const char*)ws + WS_MEMN + (size_t)u.pm * tstep; B = (const char*)ws + WS_WMKV + (size_t)u.pn * tstep; }
    }
};
struct EpiP1 {
    unsigned char* ws; float* out;
    __device__ __forceinline__ void operator()(const f32x4 (&acc)[2][2][4][2], const pg8::Unit& u, int wr, int wc, int fr, int fq) const {
        const int row0 = u.pm * 256 + wr * 64 + fr;
        const int cin = wc * 32 + 8 * fq;
        if (u.job == 1) {
            bf16_t* MK = (bf16_t*)(ws + WS_MEMKV);
#pragma unroll
            for (int ai = 0; ai < 2; ++ai)
#pragma unroll
                for (int m = 0; m < 4; ++m) { const int r = row0 + ai * 128 + m * 16;
#pragma unroll
                    for (int bj = 0; bj < 2; ++bj) { const int c = u.pn * 256 + bj * 128 + cin; const f32x4 v0 = acc[ai][bj][m][0], v1 = acc[ai][bj][m][1];
                        float* o = out + (c < 1024 ? O_MKP + (size_t)r * 1024 + c : O_MVP + (size_t)r * 1024 + (c - 1024));
                        *(f32x4*)o = v0; *(f32x4*)(o + 4) = v1;
                        u32x4 w; w.x = pg8::cvt_pk_bf16(v0[0], v0[1]); w.y = pg8::cvt_pk_bf16(v0[2], v0[3]); w.z = pg8::cvt_pk_bf16(v1[0], v1[1]); w.w = pg8::cvt_pk_bf16(v1[2], v1[3]);
                        *(u32x4*)(MK + (size_t)r * 2048 + c) = w;
                        if (c >= 1024) { bf16_t* MVT = (bf16_t*)(ws + WS_MVT) + ((size_t)((r >> 8) * 4 + ((c - 1024) >> 8)) * 256 + ((c - 1024) & 255)) * 256 + (r & 255);
                            MVT[0] = (bf16_t)(w.x & 0xffffu); MVT[256] = (bf16_t)(w.x >> 16); MVT[512] = (bf16_t)(w.y & 0xffffu); MVT[768] = (bf16_t)(w.y >> 16);
                            MVT[1024] = (bf16_t)(w.z & 0xffffu); MVT[1280] = (bf16_t)(w.z >> 16); MVT[1536] = (bf16_t)(w.w & 0xffffu); MVT[1792] = (bf16_t)(w.w >> 16); } } }
            return;
        }
        const int pn = u.pn;
        if (pn == 57) {
            if (wc == 0 && fq < 2) { float* GAB = (float*)(ws + WS_GAB);
#pragma unroll
                for (int ai = 0; ai < 2; ++ai)
#pragma unroll
                    for (int m = 0; m < 4; ++m) { const int r = row0 + ai * 128 + m * 16; float* o = GAB + (size_t)r * 16 + 8 * fq; *(f32x4*)o = acc[ai][0][m][0]; *(f32x4*)(o + 4) = acc[ai][0][m][1]; } }
            return;
        }
        bf16_t* base; int ld, ct, act = 0;
        if (pn < 12) { base = (bf16_t*)(ws + WS_QKV); ld = 3072; ct = pn; }
        else if (pn < 16) { base = (bf16_t*)(ws + WS_GZ); ld = 1024; ct = pn - 12; act = 1; }
        else if (pn < 20) { base = (bf16_t*)(ws + WS_SQ); ld = 1024; ct = pn - 16; }
        else if (pn < 24) { base = (bf16_t*)(ws + WS_SZ); ld = 1024; ct = pn - 20; act = 1; }
        else if (pn < 28) { base = (bf16_t*)(ws + WS_MQ); ld = 1024; ct = pn - 24; }
        else if (pn < 32) { base = (bf16_t*)(ws + WS_MZ); ld = 1024; ct = pn - 28; act = 1; }
        else if (pn < 56) { base = (bf16_t*)(ws + WS_GATES); ld = 6144; ct = pn - 32; act = 2; }
        else { base = (bf16_t*)(ws + WS_SKV); ld = 256; ct = 0; }
#pragma unroll
        for (int ai = 0; ai < 2; ++ai)
#pragma unroll
            for (int m = 0; m < 4; ++m) { bf16_t* rowp = base + (size_t)(row0 + ai * 128 + m * 16) * ld + ct * 256 + cin;
#pragma unroll
                for (int bj = 0; bj < 2; ++bj) { f32x4 v0 = acc[ai][bj][m][0], v1 = acc[ai][bj][m][1];
                    if (act == 1) {
#pragma unroll
                        for (int j = 0; j < 4; ++j) { v0[j] = siluf_(v0[j]); v1[j] = siluf_(v1[j]); } }
                    else if (act == 2) {
#pragma unroll
                        for (int j = 0; j < 4; ++j) { v0[j] = sigmoidf_(v0[j]); v1[j] = sigmoidf_(v1[j]); } }
                    u32x4 w; w.x = pg8::cvt_pk_bf16(v0[0], v0[1]); w.y = pg8::cvt_pk_bf16(v0[2], v0[3]); w.z = pg8::cvt_pk_bf16(v1[0], v1[1]); w.w = pg8::cvt_pk_bf16(v1[2], v1[3]);
                    *(u32x4*)(rowp + bj * 128) = w;
                    if (pn == 56 && bj == 1) { const int r = row0 + ai * 128 + m * 16;
                        if (r < MP) { bf16_t* vt = (bf16_t*)(ws + WS_VTS) + ((size_t)((r >> 13) * 2 + (cin >> 6)) * 64 + (cin & 63)) * SEQ + (r & (SEQ - 1));
                            vt[0] = (bf16_t)(w.x & 0xffffu); vt[SEQ] = (bf16_t)(w.x >> 16); vt[2 * SEQ] = (bf16_t)(w.y & 0xffffu); vt[3 * SEQ] = (bf16_t)(w.y >> 16);
                            vt[4 * SEQ] = (bf16_t)(w.z & 0xffffu); vt[5 * SEQ] = (bf16_t)(w.z >> 16); vt[6 * SEQ] = (bf16_t)(w.w & 0xffffu); vt[7 * SEQ] = (bf16_t)(w.w >> 16); } } } }
    }
};

__device__ __forceinline__ void gdn_gate_scalars(Frame& F, int r, int h) {
    const float* GAB = (const float*)(F.ws + WS_GAB); float* Gp = (float*)(F.ws + WS_G); float* Bp = (float*)(F.ws + WS_BETA);
    const float gb = GAB[(size_t)r * 16 + h], ga = GAB[(size_t)r * 16 + 8 + h];
    Bp[(size_t)r * 8 + h] = sigmoidf_(gb);
    const float xx = ga + F.in[I_DTB][h]; const float sp = xx > 20.f ? xx : log1pf(expf(xx));
    Gp[(size_t)r * 8 + h] = -expf(F.in[I_ALOG][h]) * sp;
}
__device__ __forceinline__ void conv_prompt_item(Frame& F, int item) {
    const int b = item >> 7, n = item & 127, row0 = b * SEQ + 64 * n, tid = F.tid;
    const bf16_t* QKV = (const bf16_t*)(F.ws + WS_QKV);
    bf16_t* QN = (bf16_t*)((unsigned char*)F.out + DO_QN); bf16_t* KN = (bf16_t*)((unsigned char*)F.out + DO_KN);
    bf16_t* KT = (bf16_t*)((unsigned char*)F.out + DO_KT); bf16_t* VT = (bf16_t*)((unsigned char*)F.out + DO_VT);
    const float* cw = F.in[I_CONVW];
    constexpr int SP = 136;
    LAS bf16_t* slab = (LAS bf16_t*)F.lds;
    { const int tok = tid >> 3, h = tid & 7; gdn_gate_scalars(F, row0 + tok, h); }
    const int t0 = tid >> 4, cg = (tid & 15) * 8;
    LAS float* cwl = (LAS float*)(F.lds + 32768);
    for (int i = tid; i < 4 * 3072 / 4; i += NTHREADS) ((LAS f32x4*)cwl)[i] = ((const f32x4*)cw)[i];
    __syncthreads();
    struct Slab { u32x4 x[2][4]; };
#define CONV_LOAD(S_, sl_) do { const int ch_ = ((sl_) >> 3) * 1024 + ((sl_) & 7) * 128 + cg; \
        _Pragma("unroll") for (int p = 0; p < 2; ++p) _Pragma("unroll") for (int j = 0; j < 4; ++j) { const int tk = t0 + 32 * p - 3 + j; \
            S_.x[p][j] = (64 * n + tk >= 0) ? *(const u32x4*)(QKV + (size_t)(row0 + tk) * 3072 + ch_) : (u32x4){0u, 0u, 0u, 0u}; } \
        } while (0)
#define CONV_SLAB(S_, sl_) do { const int part = (sl_) >> 3, h = (sl_) & 7; f32x4 wq[4][2]; \
        _Pragma("unroll") for (int j = 0; j < 4; ++j) { wq[j][0] = *(const LAS f32x4*)(cwl + j * 3072 + part * 1024 + h * 128 + cg); wq[j][1] = *(const LAS f32x4*)(cwl + j * 3072 + part * 1024 + h * 128 + cg + 4); } \
        _Pragma("unroll") for (int p = 0; p < 2; ++p) { \
            const int tok = t0 + 32 * p, r = row0 + tok; \
            float a[8]; \
            _Pragma("unroll") for (int e = 0; e < 8; ++e) a[e] = 0.f; \
            _Pragma("unroll") for (int j = 0; j < 4; ++j) { const u32x4 v = S_.x[p][j]; \
                a[0] += bf2f(v.x & 0xffffu) * wq[j][0][0]; a[1] += bf2f(v.x >> 16) * wq[j][0][1]; a[2] += bf2f(v.y & 0xffffu) * wq[j][0][2]; a[3] += bf2f(v.y >> 16) * wq[j][0][3]; \
                a[4] += bf2f(v.z & 0xffffu) * wq[j][1][0]; a[5] += bf2f(v.z >> 16) * wq[j][1][1]; a[6] += bf2f(v.w & 0xffffu) * wq[j][1][2]; a[7] += bf2f(v.w >> 16) * wq[j][1][3]; } \
            _Pragma("unroll") for (int e = 0; e < 8; ++e) a[e] = siluf_(a[e]); \
            if (part < 2) { float ss = ((a[0] * a[0] + a[1] * a[1]) + (a[2] * a[2] + a[3] * a[3])) + ((a[4] * a[4] + a[5] * a[5]) + (a[6] * a[6] + a[7] * a[7])); \
                ss += __shfl_xor(ss, 1); ss += __shfl_xor(ss, 2); ss += __shfl_xor(ss, 4); ss += __shfl_xor(ss, 8); \
                if (cg == 0) ((float*)(F.ws + (part == 0 ? WS_SSQ : WS_SSK)))[(size_t)(row0 + t0 + 32 * p) * 8 + h] = ss; } \
            u32x4 o4; o4.x = pk2(a[0], a[1]); o4.y = pk2(a[2], a[3]); o4.z = pk2(a[4], a[5]); o4.w = pk2(a[6], a[7]); \
            const size_t o = (size_t)r * 1024 + h * 128 + cg; \
            if (part == 0) *(u32x4*)(QN + o) = o4; \
            else { if (part == 1) *(u32x4*)(KN + o) = o4; *(LAS u32x4*)(slab + tok * SP + cg) = o4; } \
            if (n == 127 && tok >= 61) { const u32x4 raw = S_.x[p][3]; float* cdst = F.out + O_GCP + ((size_t)b * 3 + (tok - 61)) * 3072 + part * 1024 + h * 128 + cg; \
                *(f32x4*)cdst = (f32x4){bf2f(raw.x & 0xffffu), bf2f(raw.x >> 16), bf2f(raw.y & 0xffffu), bf2f(raw.y >> 16)}; \
                *(f32x4*)(cdst + 4) = (f32x4){bf2f(raw.z & 0xffffu), bf2f(raw.z >> 16), bf2f(raw.w & 0xffffu), bf2f(raw.w >> 16)}; } \
        } \
        if (part > 0) { \
            __syncthreads(); \
            bf16_t* dst = (part == 1 ? KT : VT) + (size_t)((b * 8 + h) * 128 + n) * 8192; \
            _Pragma("unroll") for (int u = 0; u < 2; ++u) { const int e = tid + 512 * u, chn = e >> 3, tg = e & 7; const LAS bf16_t* s = slab + (8 * tg) * SP + chn; \
                u32x4 o4; o4.x = (unsigned)s[0] | ((unsigned)s[SP] << 16); o4.y = (unsigned)s[2 * SP] | ((unsigned)s[3 * SP] << 16); \
                o4.z = (unsigned)s[4 * SP] | ((unsigned)s[5 * SP] << 16); o4.w = (unsigned)s[6 * SP] | ((unsigned)s[7 * SP] << 16); \
                *(u32x4*)(dst + chn * 64 + 8 * tg) = o4; } \
            __syncthreads(); \
        } } while (0)
    Slab s0, s1, s2;
    CONV_LOAD(s0, 0); CONV_LOAD(s1, 1);
#pragma unroll 1
    for (int sl = 0; sl < 24; sl += 3) {
        CONV_LOAD(s2, sl + 2); CONV_SLAB(s0, sl);
        if (sl + 3 < 24) CONV_LOAD(s0, sl + 3); CONV_SLAB(s1, sl + 1);
        if (sl + 4 < 24) CONV_LOAD(s1, sl + 4); CONV_SLAB(s2, sl + 2);
    }
#undef CONV_LOAD
#undef CONV_SLAB
}
__device__ __forceinline__ void conv_sample_items(Frame& F) {
    const int gw = F.bid * NWAVES + F.wave, NGW = F.G * NWAVES, lane = F.lane;
    const bf16_t* QKV = (const bf16_t*)(F.ws + WS_QKV);
    bf16_t* QN = (bf16_t*)((unsigned char*)F.out + DO_QN); bf16_t* KN = (bf16_t*)((unsigned char*)F.out + DO_KN); bf16_t* VNS = (bf16_t*)((unsigned char*)F.out + DO_VNS);
    const float* cw = F.in[I_CONVW];
    for (int it = gw; it < 128 * 8; it += NGW) {
        const int bd = it >> 3, h = it & 7;
        float xr[3][7][2], wv[3][4][2];
#pragma unroll
        for (int part = 0; part < 3; ++part) { const int ch = part * 1024 + h * 128 + 2 * lane;
#pragma unroll
            for (int i = 0; i < 3; ++i) { const float2 p2 = *(const float2*)(F.in[I_SCONV] + ((size_t)bd * 3 + i) * 3072 + ch); xr[part][i][0] = p2.x; xr[part][i][1] = p2.y; }
#pragma unroll
            for (int i = 0; i < 4; ++i) { const unsigned v = *(const unsigned*)(QKV + (size_t)(MP + bd * 4 + i) * 3072 + ch); xr[part][3 + i][0] = bf2f(v & 0xffffu); xr[part][3 + i][1] = bf2f(v >> 16); }
#pragma unroll
            for (int j = 0; j < 4; ++j) { const float2 w2 = *(const float2*)(cw + j * 3072 + ch); wv[part][j][0] = w2.x; wv[part][j][1] = w2.y; } }
#pragma unroll
        for (int s = 0; s < 4; ++s) {
            const int r = MP + bd * 4 + s;
            float y[3][2];
#pragma unroll
            for (int part = 0; part < 3; ++part) { float a0 = 0.f, a1 = 0.f;
#pragma unroll
                for (int j = 0; j < 4; ++j) { a0 += xr[part][s + j][0] * wv[part][j][0]; a1 += xr[part][s + j][1] * wv[part][j][1]; }
                y[part][0] = siluf_(a0); y[part][1] = siluf_(a1); }
            const float sq = wave_sum(y[0][0] * y[0][0] + y[0][1] * y[0][1]), sk = wave_sum(y[1][0] * y[1][0] + y[1][1] * y[1][1]);
            const float rq = rsqrtf(sq + EPS) * 0.08838834764831845f, rk = rsqrtf(sk + EPS);
            const size_t o = (size_t)r * 1024 + h * 128 + 2 * lane;
            *(unsigned*)(QN + o) = pk2(y[0][0] * rq, y[0][1] * rq);
            *(unsigned*)(KN + o) = pk2(y[1][0] * rk, y[1][1] * rk);
            *(unsigned*)(VNS + (size_t)(r - MP) * 1024 + h * 128 + 2 * lane) = pk2(y[2][0], y[2][1]);
            if (lane == 0) gdn_gate_scalars(F, r, h);
            if (s >= 1) { float* cdst = F.out + O_GCS + ((size_t)bd * 3 + (s - 1)) * 3072;
#pragma unroll
                for (int part = 0; part < 3; ++part) { const int ch = part * 1024 + h * 128 + 2 * lane; *(float2*)(cdst + ch) = make_float2(xr[part][3 + s][0], xr[part][3 + s][1]); } }
        }
    }
}
__device__ __forceinline__ void p2_conv(Frame& F) {
    for (int it = F.bid; it < 256; it += F.G) conv_prompt_item(F, it);
    conv_sample_items(F);
}

__device__ __forceinline__ f32x4 mfma16(bf16x8 a, bf16x8 b, f32x4 c) { return __builtin_amdgcn_mfma_f32_16x16x32_bf16(a, b, c, 0, 0, 0); }
__device__ __forceinline__ u32x2 pack4(f32x4 v) { u32x2 r; r.x = pk2(v[0], v[1]); r.y = pk2(v[2], v[3]); return r; }
__device__ __forceinline__ void prep_item(Frame& F, int item) {
    const int b = item >> 7, n = item & 127, row0 = b * SEQ + 64 * n, lane = F.lane, h = F.wave, c = lane & 15, q = lane >> 4;
    const int ci = (b * 8 + h) * 128 + n;
    const bf16_t* QN = (const bf16_t*)((const unsigned char*)F.out + DO_QN); const bf16_t* KN = (const bf16_t*)((const unsigned char*)F.out + DO_KN);
    const bf16_t* KT = (const bf16_t*)((const unsigned char*)F.out + DO_KT) + (size_t)ci * 8192; const bf16_t* VT = (const bf16_t*)((const unsigned char*)F.out + DO_VT) + (size_t)ci * 8192;
    bf16_t* NEGW = (bf16_t*)(F.ws + WS_NEGW) + (size_t)ci * 8192; bf16_t* UT = (bf16_t*)(F.ws + WS_UT) + (size_t)ci * 8192; bf16_t* ATT = (bf16_t*)(F.ws + WS_ATT) + (size_t)ci * 4096;
    const float* Gp = (const float*)(F.ws + WS_G); const float* Bp = (const float*)(F.ws + WS_BETA);
    float* GC = (float*)(F.ws + WS_GC); float* DEC = (float*)(F.ws + WS_DEC); float* GT = (float*)(F.ws + WS_GT);
    LAS float* Als = (LAS float*)(F.lds + h * 18432);
    LAS float* gcs = Als + 4096; LAS float* bes = gcs + 64;
    float gc = Gp[(size_t)(row0 + lane) * 8 + h];
#pragma unroll
    for (int o = 1; o < 64; o <<= 1) { const float x = __shfl_up(gc, o); if (lane >= o) gc += x; }
    const float beta = Bp[(size_t)(row0 + lane) * 8 + h];
    const float gl = __shfl(gc, 63);
    const float sk = ((const float*)(F.ws + WS_SSK))[(size_t)(row0 + lane) * 8 + h], sq = ((const float*)(F.ws + WS_SSQ))[(size_t)(row0 + lane) * 8 + h];
    const float rk = rsqrtf(sk + EPS), rq = rsqrtf(sq + EPS) * 0.08838834764831845f;
    LAS float* rks = bes + 64; LAS float* rqs = rks + 64;
    gcs[lane] = gc; bes[lane] = beta; rks[lane] = rk; rqs[lane] = rq;
    GC[(size_t)(row0 + lane) * 8 + h] = __expf(gc) * rq; DEC[(size_t)ci * 64 + lane] = __expf(gl - gc) * rk; if (lane == 0) GT[ci] = __expf(gl);
    LDS_WAIT(); asm volatile("" ::: "memory");
    bf16x8 kf[4][4];
#pragma unroll
    for (int mt = 0; mt < 4; ++mt)
#pragma unroll
        for (int s = 0; s < 4; ++s) { const size_t o = (size_t)(row0 + 16 * mt + c) * 1024 + h * 128 + 32 * s + 8 * q; kf[mt][s] = *(const bf16x8*)(KN + o); }
#pragma unroll
    for (int mi = 0; mi < 4; ++mi) {
        const int ii = 16 * mi + c; const float gci = gcs[ii], bi = bes[ii] * rks[ii], rqi = rqs[ii];
        const bf16_t* qrow_p = QN + (size_t)(row0 + ii) * 1024 + h * 128 + 8 * q;
#pragma unroll
        for (int nj = 0; nj < 4; ++nj) {
            u32x2 av; av.x = 0u; av.y = 0u;
            if (nj <= mi) {
                f32x4 dk = {0.f, 0.f, 0.f, 0.f}, dq = {0.f, 0.f, 0.f, 0.f};
#pragma unroll
                for (int s = 0; s < 4; ++s) { dk = mfma16(kf[nj][s], kf[mi][s], dk); dq = mfma16(kf[nj][s], *(const bf16x8*)(qrow_p + 32 * s), dq); }
                const f32x4 gj = *(const LAS f32x4*)(gcs + 16 * nj + 4 * q), rkj = *(const LAS f32x4*)(rks + 16 * nj + 4 * q);
                f32x4 a, at;
#pragma unroll
                for (int r = 0; r < 4; ++r) { const int jj = 16 * nj + 4 * q + r; const float e = __expf(gci - gj[r]);
                    a[r] = (ii > jj) ? bi * rkj[r] * dk[r] * e : 0.f; at[r] = (ii >= jj) ? rqi * rkj[r] * dq[r] * e : 0.f; }
                *(LAS f32x4*)(Als + ii * 64 + 16 * nj + 4 * q) = a;
                av = pack4(at);
            }
            *(u32x2*)(ATT + ii * 64 + 16 * nj + 4 * q) = av;
        }
    }
    LDS_WAIT();
    float t[64];
#pragma unroll
    for (int i = 0; i < 64; ++i) {
        float acc = (lane == i) ? 1.f : 0.f;
#pragma unroll
        for (int m4 = 0; m4 < i; m4 += 4) { const f32x4 a = *(const LAS f32x4*)(Als + i * 64 + m4);
            acc -= a[0] * t[m4]; if (m4 + 1 < i) acc -= a[1] * t[m4 + 1]; if (m4 + 2 < i) acc -= a[2] * t[m4 + 2]; if (m4 + 3 < i) acc -= a[3] * t[m4 + 3]; }
        t[i] = acc;
    }
    LAS bf16_t* T1 = (LAS bf16_t*)Als; LAS bf16_t* T2 = T1 + 64 * 72;
    const float s1 = beta, s2 = -beta * __expf(gc) * rk;
    LDS_WAIT();
#pragma unroll
    for (int i = 0; i < 64; ++i) { T1[i * 72 + lane] = (bf16_t)f2bf(t[i] * s1); T2[i * 72 + lane] = (bf16_t)f2bf(t[i] * s2); }
    LDS_WAIT();
    bf16x8 t1f[4][2], t2f[4][2];
#pragma unroll
    for (int it = 0; it < 4; ++it)
#pragma unroll
        for (int s = 0; s < 2; ++s) { t1f[it][s] = *(const LAS bf16x8*)(T1 + (16 * it + c) * 72 + 32 * s + 8 * q); t2f[it][s] = *(const LAS bf16x8*)(T2 + (16 * it + c) * 72 + 32 * s + 8 * q); }
#pragma unroll 2
    for (int dt = 0; dt < 8; ++dt) {
        bf16x8 vb[2], ka[2];
#pragma unroll
        for (int s = 0; s < 2; ++s) { vb[s] = *(const bf16x8*)(VT + (16 * dt + c) * 64 + 32 * s + 8 * q); ka[s] = *(const bf16x8*)(KT + (16 * dt + c) * 64 + 32 * s + 8 * q); }
#pragma unroll
        for (int it = 0; it < 4; ++it) {
            f32x4 du = {0.f, 0.f, 0.f, 0.f}, dw = {0.f, 0.f, 0.f, 0.f};
            du = mfma16(t1f[it][0], vb[0], du); dw = mfma16(ka[0], t2f[it][0], dw);
            if (it >= 2) { du = mfma16(t1f[it][1], vb[1], du); dw = mfma16(ka[1], t2f[it][1], dw); }
            *(u32x2*)(UT + (16 * dt + c) * 64 + 16 * it + 4 * q) = pack4(du);
            *(u32x2*)(NEGW + (16 * it + c) * 128 + 16 * dt + 4 * q) = pack4(dw);
        }
    }
    LDS_WAIT();
}
__device__ __forceinline__ void p2_prep(Frame& F) { for (int it = F.bid; it < 256; it += F.G) { prep_item(F, it); __syncthreads(); } }

__device__ __forceinline__ void scan_item(Frame& F, int bh, int sl) {
    const int lane = F.lane, w = F.wave, c = lane & 15, q = lane >> 4, dvs = 16 * sl;
    const bf16_t* KT = (const bf16_t*)((const unsigned char*)F.out + DO_KT); const bf16_t* NEGW = (const bf16_t*)(F.ws + WS_NEGW);
    bf16_t* UT = (bf16_t*)(F.ws + WS_UT); bf16_t* SN = (bf16_t*)(F.ws + WS_SN);
    const float* DEC = (const float*)(F.ws + WS_DEC); const float* GT = (const float*)(F.ws + WS_GT);
    LAS bf16_t* SS = (LAS bf16_t*)F.lds;
    LAS bf16_t* VS = SS + 16 * 136;
    LAS bf16_t* VU = VS + 16 * 72;
    f32x4 Sacc = {0.f, 0.f, 0.f, 0.f};
    for (int e = F.tid; e < 16 * 136 / 2; e += NTHREADS) ((LAS unsigned*)SS)[e] = 0u;
    struct Ops { bf16x8 wf[4], kf[2]; u32x2 u2; f32x4 dec4; float gt; };
#define SCAN_LOAD(o, n_) do { const size_t ci__ = (size_t)bh * 128 + ((n_) < 128 ? (n_) : 127); \
        _Pragma("unroll") for (int s = 0; s < 2; ++s) o.kf[s] = *(const bf16x8*)(KT + ci__ * 8192 + (16 * w + c) * 64 + 32 * s + 8 * q); \
        o.gt = GT[ci__]; \
        if (w < 4) { _Pragma("unroll") for (int s = 0; s < 4; ++s) o.wf[s] = *(const bf16x8*)(NEGW + ci__ * 8192 + (16 * w + c) * 128 + 32 * s + 8 * q); \
            o.u2 = *(const u32x2*)(UT + ci__ * 8192 + (dvs + c) * 64 + 16 * w + 4 * q); o.dec4 = *(const f32x4*)(DEC + ci__ * 64 + 16 * w + 4 * q); } } while (0)
#define SCAN_STEP(o, n_) do { const size_t ci = (size_t)bh * 128 + (n_); \
        if (w < 4) { \
            f32x4 v = {bf2f(o.u2.x & 0xffffu), bf2f(o.u2.x >> 16), bf2f(o.u2.y & 0xffffu), bf2f(o.u2.y >> 16)}; \
            _Pragma("unroll") for (int s = 0; s < 4; ++s) { const bf16x8 sf = *(const LAS bf16x8*)(SS + c * 136 + 32 * s + 8 * q); v = mfma16(o.wf[s], sf, v); } \
            *(LAS u32x2*)(VU + c * 72 + 16 * w + 4 * q) = pack4(v); \
            const f32x4 vd = v * o.dec4; \
            *(LAS u32x2*)(VS + c * 72 + 16 * w + 4 * q) = pack4(vd); \
        } else if (w == 4) {   \
            _Pragma("unroll") for (int u = 0; u < 4; ++u) { const int p = lane + 64 * u, r = p >> 4, cc = p & 15; \
                *(u32x4*)(SN + ci * 16384 + (dvs + r) * 128 + cc * 8) = *(const LAS u32x4*)(SS + r * 136 + cc * 8); } \
        } \
        asm volatile("s_waitcnt lgkmcnt(0)" ::: "memory"); __builtin_amdgcn_s_barrier(); asm volatile("" ::: "memory"); \
        Sacc = Sacc * o.gt; \
        _Pragma("unroll") for (int s = 0; s < 2; ++s) { const bf16x8 vf = *(const LAS bf16x8*)(VS + c * 72 + 32 * s + 8 * q); Sacc = mfma16(o.kf[s], vf, Sacc); } \
        if (w == 5) {   \
            _Pragma("unroll") for (int u = 0; u < 2; ++u) { const int p = lane + 64 * u, r = p >> 3, cc = p & 7; \
                *(u32x4*)(UT + ci * 8192 + (dvs + r) * 64 + cc * 8) = *(const LAS u32x4*)(VU + r * 72 + cc * 8); } } \
        { const u32x2 sp = pack4(Sacc); *(LAS u32x2*)(SS + c * 136 + 16 * w + 4 * q) = sp; } \
        asm volatile("s_waitcnt lgkmcnt(0)" ::: "memory"); __builtin_amdgcn_s_barrier(); asm volatile("" ::: "memory"); } while (0)
    Ops o0, o1, o2, o3;
    SCAN_LOAD(o0, 0); SCAN_LOAD(o1, 1); SCAN_LOAD(o2, 2);
    asm volatile("s_waitcnt lgkmcnt(0)" ::: "memory"); __builtin_amdgcn_s_barrier(); asm volatile("" ::: "memory");
#pragma unroll 1
    for (int n0 = 0; n0 < 128; n0 += 4) {
        SCAN_LOAD(o3, n0 + 3); SCAN_STEP(o0, n0);
        SCAN_LOAD(o0, n0 + 4); SCAN_STEP(o1, n0 + 1);
        SCAN_LOAD(o1, n0 + 5); SCAN_STEP(o2, n0 + 2);
        SCAN_LOAD(o2, n0 + 6); SCAN_STEP(o3, n0 + 3);
    }
#undef SCAN_LOAD
#undef SCAN_STEP
    float* so = F.out + O_GSP + (size_t)bh * 16384;
#pragma unroll
    for (int r = 0; r < 4; ++r) so[(size_t)(16 * w + 4 * q + r) * 128 + dvs + c] = Sacc[r];
}

__device__ __forceinline__ void gdn_out_item(Frame& F, int item) {
    const int b = item >> 7, n = item & 127, row0 = b * SEQ + 64 * n, lane = F.lane, h = F.wave, c = lane & 15, q = lane >> 4;
    const size_t ci = (size_t)(b * 8 + h) * 128 + n;
    const bf16_t* QN = (const bf16_t*)((const unsigned char*)F.out + DO_QN);
    const bf16_t* SN = (const bf16_t*)(F.ws + WS_SN) + ci * 16384; const bf16_t* VNT = (const bf16_t*)(F.ws + WS_UT) + ci * 8192; const bf16_t* ATT = (const bf16_t*)(F.ws + WS_ATT) + ci * 4096;
    const float* GC = (const float*)(F.ws + WS_GC); const bf16_t* GZ = (const bf16_t*)(F.ws + WS_GZ); bf16_t* OG = (bf16_t*)(F.ws + WS_OG); const float* gn = F.in[I_GNORM];
    LAS bf16_t* ol = (LAS bf16_t*)(F.lds + h * 18432);
    bf16x8 qf[4][4], af[4][2]; float egc[4], ss[4];
#pragma unroll
    for (int it = 0; it < 4; ++it) { const int i = 16 * it + c; const size_t r = (size_t)row0 + i;
#pragma unroll
        for (int s = 0; s < 4; ++s) qf[it][s] = *(const bf16x8*)(QN + r * 1024 + h * 128 + 32 * s + 8 * q);
#pragma unroll
        for (int s = 0; s < 2; ++s) af[it][s] = *(const bf16x8*)(ATT + i * 64 + 32 * s + 8 * q);
        egc[it] = GC[r * 8 + h]; ss[it] = 0.f; }
#pragma unroll 1
    for (int dt = 0; dt < 8; ++dt) {
        bf16x8 sf[4], vf[2];
#pragma unroll
        for (int s = 0; s < 4; ++s) sf[s] = *(const bf16x8*)(SN + (16 * dt + c) * 128 + 32 * s + 8 * q);
#pragma unroll
        for (int s = 0; s < 2; ++s) vf[s] = *(const bf16x8*)(VNT + (16 * dt + c) * 64 + 32 * s + 8 * q);
#pragma unroll
        for (int it = 0; it < 4; ++it) {
            f32x4 a = {0.f, 0.f, 0.f, 0.f};
#pragma unroll
            for (int s = 0; s < 4; ++s) a = mfma16(sf[s], qf[it][s], a);
            a = a * egc[it];
#pragma unroll
            for (int s = 0; s < 2; ++s) a = mfma16(vf[s], af[it][s], a);
            ss[it] += (a[0] * a[0] + a[1] * a[1]) + (a[2] * a[2] + a[3] * a[3]);
            *(LAS u32x2*)(ol + (16 * it + c) * 136 + 16 * dt + 4 * q) = pack4(a);
        }
    }
    float rs[4];
#pragma unroll
    for (int it = 0; it < 4; ++it) { float s = ss[it]; s += __shfl_xor(s, 16); s += __shfl_xor(s, 32); rs[it] = rsqrtf(s * (1.f / 128.f) + EPS); }
    LDS_WAIT();
#pragma unroll
    for (int it = 0; it < 4; ++it)
#pragma unroll
        for (int dt = 0; dt < 8; ++dt) { const size_t o = ((size_t)row0 + 16 * it + c) * 1024 + h * 128 + 16 * dt + 4 * q; const u32x2 z = *(const u32x2*)(GZ + o); const f32x4 g4 = *(const f32x4*)(gn + 16 * dt + 4 * q);
            const u32x2 pv = *(const LAS u32x2*)(ol + (16 * it + c) * 136 + 16 * dt + 4 * q); f32x4 v;
            v[0] = bf2f(pv.x & 0xffffu) * rs[it] * g4[0] * bf2f(z.x & 0xffffu); v[1] = bf2f(pv.x >> 16) * rs[it] * g4[1] * bf2f(z.x >> 16);
            v[2] = bf2f(pv.y & 0xffffu) * rs[it] * g4[2] * bf2f(z.y & 0xffffu); v[3] = bf2f(pv.y >> 16) * rs[it] * g4[3] * bf2f(z.y >> 16);
            *(u32x2*)(OG + o) = pack4(v); }
    LDS_WAIT();
}

__device__ __forceinline__ void gdn_seq_item(Frame& F, int row0, int L, int h, const float* S0, float* Sout, bf16_t* OG) {
    const bf16_t* QN = (const bf16_t*)((unsigned char*)F.out + DO_QN); const bf16_t* KN = (const bf16_t*)((unsigned char*)F.out + DO_KN); const bf16_t* VNS = (const bf16_t*)((unsigned char*)F.out + DO_VNS);
    const float* Gp = (const float*)(F.ws + WS_G); const float* Bp = (const float*)(F.ws + WS_BETA);
    const int tid = F.tid, dvc = tid & 127, dkq = tid >> 7;
    constexpr int TB = 32;
    LAS float* sq = (LAS float*)F.lds;
    LAS float* sk = sq + TB * 128;
    LAS float* sv = sk + TB * 128;
    LAS float* sg = sv + TB * 128;
    LAS float* red = sg + 2 * TB;
    LAS float* redqk = red + 2 * 2 * 4 * 128;
    float S[32];
#pragma unroll
    for (int i = 0; i < 32; ++i) S[i] = S0 ? S0[(size_t)(32 * dkq + i) * 128 + dvc] : 0.f;
    int buf = 0;
    for (int t0 = 0; t0 < L; t0 += TB) {
        const int nb = (L - t0) < TB ? (L - t0) : TB;
        __syncthreads();
        for (int e = tid; e < nb * 128; e += NTHREADS) { const int tt = e >> 7, c = e & 127; const size_t o = (size_t)(row0 + t0 + tt) * 1024 + h * 128 + c;
            sq[e] = bf2f(QN[o]); sk[e] = bf2f(KN[o]); sv[e] = bf2f(VNS[o - (size_t)MP * 1024]); }
        if (tid < nb) { sg[tid] = expf(Gp[(size_t)(row0 + t0 + tid) * 8 + h]); sg[TB + tid] = Bp[(size_t)(row0 + t0 + tid) * 8 + h]; }
        __syncthreads();
        for (int tt = 0; tt < nb; ++tt) {
            const LAS float* kq = sk + tt * 128 + 32 * dkq; const LAS float* qq = sq + tt * 128 + 32 * dkq;
            float pk = 0.f, pq = 0.f, pqk = 0.f;
#pragma unroll
            for (int i = 0; i < 32; ++i) { const float kk = kq[i], qv = qq[i]; pk += kk * S[i]; pq += qv * S[i]; pqk += qv * kk; }
            LAS float* rb = red + buf * 1024;
            rb[dkq * 128 + dvc] = pk; rb[512 + dkq * 128 + dvc] = pq; if (dvc == 0) redqk[buf * 4 + dkq] = pqk;
            __syncthreads();
            const float kS = (rb[dvc] + rb[128 + dvc]) + (rb[256 + dvc] + rb[384 + dvc]);
            const float qS = (rb[512 + dvc] + rb[640 + dvc]) + (rb[768 + dvc] + rb[896 + dvc]);
            const float qk = (redqk[buf * 4] + redqk[buf * 4 + 1]) + (redqk[buf * 4 + 2] + redqk[buf * 4 + 3]);
            const float e = sg[tt], beta = sg[TB + tt];
            const float vnew = beta * (sv[tt * 128 + dvc] - e * kS);
            const float o = e * qS + qk * vnew;
#pragma unroll
            for (int i = 0; i < 32; ++i) S[i] = e * S[i] + kq[i] * vnew;
            if (dkq == 0) OG[(size_t)(row0 + t0 + tt) * 1024 + h * 128 + dvc] = (bf16_t)f2bf(o);
            buf ^= 1;
        }
    }
#pragma unroll
    for (int i = 0; i < 32; ++i) Sout[(size_t)(32 * dkq + i) * 128 + dvc] = S[i];
    __syncthreads();
}
__device__ __forceinline__ void p2_gdn_sample(Frame& F, int wk, int nwk, int lo, int hi) {
    bf16_t* OG = (bf16_t*)(F.ws + WS_OG);
    for (int q = lo + wk; q < hi; q += nwk) { const int bd = q >> 3, h = q & 7; gdn_seq_item(F, MP + bd * 4, 4, h, F.in[I_SGDN] + (size_t)q * 16384, F.out + O_GSS + (size_t)q * 16384, OG); }
}
__device__ __forceinline__ void p2_gdn_norm_sample(Frame& F) {
    const int gw = F.bid * NWAVES + F.wave, NGW = F.G * NWAVES, lane = F.lane;
    bf16_t* OG = (bf16_t*)(F.ws + WS_OG); const bf16_t* GZ = (const bf16_t*)(F.ws + WS_GZ); const float* gn = F.in[I_GNORM];
    for (int it = gw; it < MS * 8; it += NGW) {
        const size_t o = (size_t)(MP + (it >> 3)) * 1024 + (it & 7) * 128 + 2 * lane;
        const unsigned v = *(const unsigned*)(OG + o), z = *(const unsigned*)(GZ + o);
        const float a = bf2f(v & 0xffffu), b = bf2f(v >> 16);
        const float r = rsqrtf(wave_sum(a * a + b * b) * (1.f / 128.f) + EPS);
        *(unsigned*)(OG + o) = pk2(a * r * gn[2 * lane] * bf2f(z & 0xffffu), b * r * gn[2 * lane + 1] * bf2f(z >> 16));
    }
}

__device__ __forceinline__ void swa_wave_item(Frame& F, bool sample, int bidx, int t, int kv) {
    const int lane = F.lane;
    LAS float* qs = (LAS float*)(F.lds + F.wave * 8192);
    LAS float* ps = qs + 512;
    const bf16_t* SQ = (const bf16_t*)(F.ws + WS_SQ); const bf16_t* SKV = (const bf16_t*)(F.ws + WS_SKV); const bf16_t* SZ = (const bf16_t*)(F.ws + WS_SZ);
    const float* BT = (const float*)(F.ws + WS_BTAB);
    const int row = sample ? MP + bidx * 4 + t : bidx * SEQ + t;
    const int qpos = sample ? 128 + t : t;
    for (int e = lane; e < 512; e += 64) qs[e] = bf2f(SQ[(size_t)row * 1024 + kv * 512 + e]);
    LDS_WAIT();
#pragma unroll 1
    for (int u = 0; u < 2; ++u) {
        const int j = lane + 64 * u; const int kp = qpos - j;
        float kr[64];
        const bool valid = kp >= 0;
        if (valid) {
            if (sample && kp < 128) { const float* p = F.in[I_CSK] + (((size_t)bidx * 128 + kp) * 2 + kv) * 64;
#pragma unroll
                for (int d = 0; d < 64; d += 4) { const f32x4 v = *(const f32x4*)(p + d); kr[d] = v.x; kr[d + 1] = v.y; kr[d + 2] = v.z; kr[d + 3] = v.w; } }
            else { const int krow = sample ? MP + bidx * 4 + (kp - 128) : bidx * SEQ + kp; const bf16_t* p = SKV + (size_t)krow * 256 + kv * 64;
#pragma unroll
                for (int d = 0; d < 64; d += 8) { const u32x4 v = *(const u32x4*)(p + d);
                    kr[d] = bf2f(v.x & 0xffffu); kr[d + 1] = bf2f(v.x >> 16); kr[d + 2] = bf2f(v.y & 0xffffu); kr[d + 3] = bf2f(v.y >> 16);
                    kr[d + 4] = bf2f(v.z & 0xffffu); kr[d + 5] = bf2f(v.z >> 16); kr[d + 6] = bf2f(v.w & 0xffffu); kr[d + 7] = bf2f(v.w >> 16); } }
        } else {
#pragma unroll
            for (int d = 0; d < 64; ++d) kr[d] = 0.f;
        }
#pragma unroll 1
        for (int g = 0; g < 8; ++g) { float a = 0.f;
#pragma unroll
            for (int d = 0; d < 64; d += 4) { const f32x4 qv = *(const LAS f32x4*)(qs + g * 64 + d); a += kr[d] * qv.x + kr[d + 1] * qv.y + kr[d + 2] * qv.z + kr[d + 3] * qv.w; }
            ps[g * 128 + j] = valid ? a * 0.125f + BT[(kv * 8 + g) * 128 + j] : -INFINITY; }
    }
    LDS_WAIT();
    float inv[8];
#pragma unroll
    for (int g = 0; g < 8; ++g) {
        const float sink = F.in[I_SINKS][kv * 8 + g];
        const float l0 = ps[g * 128 + lane], l1 = ps[g * 128 + 64 + lane];
        const float mx = fmaxf(wave_max(fmaxf(l0, l1)), sink);
        const float p0 = __expf(l0 - mx), p1 = __expf(l1 - mx);
        const float den = wave_sum(p0 + p1) + __expf(sink - mx);
        inv[g] = 1.f / den;
        ps[g * 128 + lane] = p0; ps[g * 128 + 64 + lane] = p1;
    }
    LDS_WAIT();
    float o[8];
#pragma unroll
    for (int g = 0; g < 8; ++g) o[g] = 0.f;
#pragma unroll 1
    for (int j0 = 0; j0 < 128; j0 += 8) {
        float vv[8];
#pragma unroll
        for (int u = 0; u < 8; ++u) { int kp = qpos - (j0 + u); kp = kp < 0 ? 0 : kp;
            if (sample && kp < 128) vv[u] = F.in[I_CSV][(((size_t)bidx * 128 + kp) * 2 + kv) * 64 + lane];
            else { const int krow = sample ? MP + bidx * 4 + (kp - 128) : bidx * SEQ + kp; vv[u] = bf2f(SKV[(size_t)krow * 256 + 128 + kv * 64 + lane]); } }
#pragma unroll
        for (int u = 0; u < 8; ++u)
#pragma unroll
            for (int g = 0; g < 8; ++g) o[g] += ps[g * 128 + j0 + u] * vv[u];
    }
    bf16_t* OS = (bf16_t*)(F.ws + WS_OS);
#pragma unroll
    for (int g = 0; g < 8; ++g) { const size_t oo = (size_t)row * 1024 + (kv * 8 + g) * 64 + lane; OS[oo] = (bf16_t)f2bf(o[g] * inv[g] * bf2f(SZ[oo])); }
    LDS_WAIT();
}
__device__ __forceinline__ bf16x8 cat8(u32x2 a, u32x2 b) { u32x4 t; t.x = a.x; t.y = a.y; t.z = b.x; t.w = b.y; return __builtin_bit_cast(bf16x8, t); }
__device__ __forceinline__ void mem_mfma_item(Frame& F, int b, int h, int qt) {
    const int lane = F.lane, c = lane & 15, q = lane >> 4;
    const bf16_t* Kp = (const bf16_t*)(F.ws + WS_MEMKV) + (size_t)(b * 256) * 2048 + h * 256;
    const bf16_t* VTp = (const bf16_t*)(F.ws + WS_MVT) + (size_t)((b * 4 + h) * 256) * 256;
    const bf16_t* MQ = (const bf16_t*)(F.ws + WS_MQ); const bf16_t* MZ = (const bf16_t*)(F.ws + WS_MZ); bf16_t* OM = (bf16_t*)(F.ws + WS_OM);
    const size_t qrow = (size_t)b * SEQ + 16 * qt + c;
    bf16x8 qf[8];
#pragma unroll
    for (int s = 0; s < 8; ++s) qf[s] = *(const bf16x8*)(MQ + qrow * 1024 + h * 256 + 32 * s + 8 * q);
    f32x4 sacc[16];
#pragma unroll
    for (int mt = 0; mt < 16; ++mt) { f32x4 a = {0.f, 0.f, 0.f, 0.f};
#pragma unroll
        for (int s = 0; s < 8; ++s) a = mfma16(*(const bf16x8*)(Kp + (size_t)(16 * mt + c) * 2048 + 32 * s + 8 * q), qf[s], a);
        sacc[mt] = a; }
    float mx = -INFINITY;
#pragma unroll
    for (int mt = 0; mt < 16; ++mt) mx = fmaxf(mx, fmaxf(fmaxf(sacc[mt][0], sacc[mt][1]), fmaxf(sacc[mt][2], sacc[mt][3])));
    mx = fmaxf(mx, __shfl_xor(mx, 16)); mx = fmaxf(mx, __shfl_xor(mx, 32));
    float sum = 0.f; const float sc = 0.0625f * 1.4426950408889634f;
#pragma unroll
    for (int mt = 0; mt < 16; ++mt)
#pragma unroll
        for (int r = 0; r < 4; ++r) { const float p = exp2f((sacc[mt][r] - mx) * sc); sacc[mt][r] = p; sum += p; }
    sum += __shfl_xor(sum, 16); sum += __shfl_xor(sum, 32);
    const float inv = 1.f / sum;
    bf16x8 pf[8];
#pragma unroll
    for (int ks = 0; ks < 8; ++ks) pf[ks] = cat8(pack4(sacc[2 * ks]), pack4(sacc[2 * ks + 1]));
#pragma unroll 4
    for (int dt = 0; dt < 16; ++dt) { f32x4 o = {0.f, 0.f, 0.f, 0.f};
#pragma unroll
        for (int ks = 0; ks < 8; ++ks) { const bf16_t* vp = VTp + (size_t)(16 * dt + c) * 256 + 32 * ks + 4 * q;
            o = mfma16(cat8(*(const u32x2*)vp, *(const u32x2*)(vp + 16)), pf[ks], o); }
        const size_t oo = qrow * 1024 + h * 256 + 16 * dt + 4 * q; const u32x2 z = *(const u32x2*)(MZ + oo);
        o[0] *= inv * bf2f(z.x & 0xffffu); o[1] *= inv * bf2f(z.x >> 16); o[2] *= inv * bf2f(z.y & 0xffffu); o[3] *= inv * bf2f(z.y >> 16);
        *(u32x2*)(OM + oo) = pack4(o); }
}
__device__ __forceinline__ void swa_mfma_item(Frame& F, int b, int h, int a) {
    const int lane = F.lane, c = lane & 15, q = lane >> 4, kv = h >> 3;
    const bf16_t* SQ = (const bf16_t*)(F.ws + WS_SQ); const bf16_t* SKV = (const bf16_t*)(F.ws + WS_SKV); const bf16_t* SZ = (const bf16_t*)(F.ws + WS_SZ); bf16_t* OS = (bf16_t*)(F.ws + WS_OS);
    const bf16_t* VTp = (const bf16_t*)(F.ws + WS_VTS) + (size_t)((b * 2 + kv) * 64) * SEQ;
    const LAS float* BTl = (const LAS float*)(F.lds + LDS_BT) + h * 128;
    const size_t qrow = (size_t)b * SEQ + 16 * a + c;
    bf16x8 qf[2];
#pragma unroll
    for (int s = 0; s < 2; ++s) qf[s] = *(const bf16x8*)(SQ + qrow * 1024 + h * 64 + 32 * s + 8 * q);
    f32x4 p[10];
    const float sink = F.in[I_SINKS][h];
    float mx = sink;
#pragma unroll
    for (int u = 0; u < 9; ++u) {
        const int kbase = 16 * (a - 8 + u);
        f32x4 d = {0.f, 0.f, 0.f, 0.f};
        if (kbase >= 0) {
#pragma unroll
            for (int s = 0; s < 2; ++s) d = mfma16(*(const bf16x8*)(SKV + ((size_t)b * SEQ + kbase + c) * 256 + kv * 64 + 32 * s + 8 * q), qf[s], d);
        }
#pragma unroll
        for (int r = 0; r < 4; ++r) { const int dist = (16 * a + c) - (kbase + 4 * q + r); const bool valid = kbase >= 0 && dist >= 0 && dist < 128;
            const float l = valid ? d[r] * 0.125f + BTl[dist & 127] : -INFINITY; d[r] = l; mx = fmaxf(mx, l); }
        p[u] = d;
    }
    mx = fmaxf(mx, __shfl_xor(mx, 16)); mx = fmaxf(mx, __shfl_xor(mx, 32));
    float sum = 0.f;
#pragma unroll
    for (int u = 0; u < 9; ++u)
#pragma unroll
        for (int r = 0; r < 4; ++r) { const float e = __expf(p[u][r] - mx); p[u][r] = e; sum += e; }
    p[9] = (f32x4){0.f, 0.f, 0.f, 0.f};
    sum += __shfl_xor(sum, 16); sum += __shfl_xor(sum, 32);
    const float inv = 1.f / (sum + __expf(sink - mx));
    bf16x8 pf[5];
#pragma unroll
    for (int ks = 0; ks < 5; ++ks) pf[ks] = cat8(pack4(p[2 * ks]), pack4(p[2 * ks + 1]));
#pragma unroll
    for (int dt = 0; dt < 4; ++dt) { f32x4 o = {0.f, 0.f, 0.f, 0.f};
#pragma unroll
        for (int ks = 0; ks < 5; ++ks) { int m0 = 16 * (a - 8 + 2 * ks) + 4 * q, m1 = m0 + 16;
            m0 = m0 < 0 ? 0 : m0; m1 = m1 < 0 ? 0 : (m1 > SEQ - 4 ? SEQ - 4 : m1);
            const bf16_t* vp = VTp + (size_t)(16 * dt + c) * SEQ;
            o = mfma16(cat8(*(const u32x2*)(vp + m0), *(const u32x2*)(vp + m1)), pf[ks], o); }
        const size_t oo = qrow * 1024 + h * 64 + 16 * dt + 4 * q; const u32x2 z = *(const u32x2*)(SZ + oo);
        o[0] *= inv * bf2f(z.x & 0xffffu); o[1] *= inv * bf2f(z.x >> 16); o[2] *= inv * bf2f(z.y & 0xffffu); o[3] *= inv * bf2f(z.y >> 16);
        *(u32x2*)(OS + oo) = pack4(o); }
}
__device__ __forceinline__ void swa_wg_item(Frame& F, int b, int kv, int qb) {
    int lane_ = F.lane, tid_ = F.tid; asm volatile("" : "+v"(lane_), "+v"(tid_));
    const int lane = lane_, c = lane & 15, q = lane >> 4, tid = tid_, h = kv * 8 + F.wave;
    const bf16_t* SQ = (const bf16_t*)(F.ws + WS_SQ); const bf16_t* SKV = (const bf16_t*)(F.ws + WS_SKV); const bf16_t* SZ = (const bf16_t*)(F.ws + WS_SZ); bf16_t* OS = (bf16_t*)(F.ws + WS_OS);
    const bf16_t* VTg = (const bf16_t*)(F.ws + WS_VTS) + (size_t)((b * 2 + kv) * 64) * SEQ;
    LAS unsigned char* Kl = F.lds; LAS unsigned char* Vl = F.lds + 32768;
    const LAS float* BTl = (const LAS float*)(F.lds + LDS_BT) + h * 128;
    const int kstart = 128 * (qb - 1);
    __syncthreads();
    {   u32x4 kr[4], vr[4];
#pragma unroll
        for (int u = 0; u < 4; ++u) { const int p = tid + 512 * u, key = p >> 3, ch = p & 7;
            kr[u] = (kstart + key >= 0) ? *(const u32x4*)(SKV + ((size_t)b * SEQ + kstart + key) * 256 + kv * 64 + ch * 8) : (u32x4){0u, 0u, 0u, 0u};
            const int d = p >> 5, c16 = p & 31;
            vr[u] = (kstart + c16 * 8 >= 0) ? *(const u32x4*)(VTg + (size_t)d * SEQ + kstart + c16 * 8) : (u32x4){0u, 0u, 0u, 0u}; }
#pragma unroll
        for (int u = 0; u < 4; ++u) { const int p = tid + 512 * u, key = p >> 3, ch = p & 7;
            *(LAS u32x4*)(Kl + key * 128 + ((ch ^ ((key >> 1) & 7)) << 4)) = kr[u];
            const int d = p >> 5, c16 = p & 31;
            *(LAS u32x4*)(Vl + d * 512 + (((2 * c16) ^ (2 * (d & 15))) << 3)) = vr[u]; } }
    __syncthreads();
    const float L2E = 1.4426950408889634f;
    const float sink = F.in[I_SINKS][h] * L2E;
    float bias[9][4];
#pragma unroll
    for (int u = 0; u < 9; ++u)
#pragma unroll
        for (int r = 0; r < 4; ++r) { const int dist = 128 - 16 * u + c - 4 * q - r; bias[u][r] = (dist >= 0 && dist < 128) ? BTl[dist & 127] * L2E : -INFINITY; }
    bf16x8 qfa[8][2];
#pragma unroll
    for (int ap = 0; ap < 8; ++ap)
#pragma unroll
        for (int s = 0; s < 2; ++s) qfa[ap][s] = *(const bf16x8*)(SQ + ((size_t)b * SEQ + 128 * qb + 16 * ap + c) * 1024 + h * 64 + 32 * s + 8 * q);
#pragma unroll
    for (int ap = 0; ap < 8; ++ap) {
        const size_t qrow = (size_t)b * SEQ + 128 * qb + 16 * ap + c;
        bf16x8 qf[2]; qf[0] = qfa[ap][0]; qf[1] = qfa[ap][1];
        u32x2 zz[4];
#pragma unroll
        for (int dt = 0; dt < 4; ++dt) zz[dt] = *(const u32x2*)(SZ + qrow * 1024 + h * 64 + 16 * dt + 4 * q);
        f32x4 p[10]; float mx = sink;
#pragma unroll
        for (int u = 0; u < 9; ++u) {
            const int wt = ap + u, row = 16 * wt + c;
            f32x4 d = {0.f, 0.f, 0.f, 0.f};
#pragma unroll
            for (int s = 0; s < 2; ++s) d = mfma16(*(const LAS bf16x8*)(Kl + row * 128 + (((4 * s + q) ^ ((row >> 1) & 7)) << 4)), qf[s], d);
            const float tmask = ((qb > 0) || (wt >= 8)) ? 0.f : -INFINITY;
#pragma unroll
            for (int r = 0; r < 4; ++r) { const float l = d[r] * (0.125f * L2E) + (bias[u][r] + tmask); d[r] = l; mx = fmaxf(mx, l); }
            p[u] = d;
        }
        mx = fmaxf(mx, __shfl_xor(mx, 16)); mx = fmaxf(mx, __shfl_xor(mx, 32));
        float sum = 0.f;
#pragma unroll
        for (int u = 0; u < 9; ++u)
#pragma unroll
            for (int r = 0; r < 4; ++r) { const float e = exp2f(p[u][r] - mx); p[u][r] = e; sum += e; }
        p[9] = (f32x4){0.f, 0.f, 0.f, 0.f};
        sum += __shfl_xor(sum, 16); sum += __shfl_xor(sum, 32);
        const float inv = 1.f / (sum + exp2f(sink - mx));
        bf16x8 pf[5];
#pragma unroll
        for (int ks = 0; ks < 5; ++ks) pf[ks] = cat8(pack4(p[2 * ks]), pack4(p[2 * ks + 1]));
#pragma unroll
        for (int dt = 0; dt < 4; ++dt) { f32x4 o = {0.f, 0.f, 0.f, 0.f}; const int dd = 16 * dt + c; const LAS unsigned char* vrow = Vl + dd * 512; const int sw = 2 * (dd & 15);
#pragma unroll
            for (int ks = 0; ks < 5; ++ks) { const int wt0 = ap + 2 * ks; int wt1 = wt0 + 1; wt1 = wt1 > 15 ? 15 : wt1;
                const u32x2 v0 = *(const LAS u32x2*)(vrow + (((4 * wt0 + q) ^ sw) << 3)), v1 = *(const LAS u32x2*)(vrow + (((4 * wt1 + q) ^ sw) << 3));
                o = mfma16(cat8(v0, v1), pf[ks], o); }
            const size_t oo = qrow * 1024 + h * 64 + 16 * dt + 4 * q; const u32x2 z = zz[dt];
            o[0] *= inv * bf2f(z.x & 0xffffu); o[1] *= inv * bf2f(z.x >> 16); o[2] *= inv * bf2f(z.y & 0xffffu); o[3] *= inv * bf2f(z.y >> 16);
            *(u32x2*)(OS + oo) = pack4(o); }
        asm volatile("" ::: "memory");
    }
}
__device__ __forceinline__ void mem_wg_item(Frame& F, int b, int h, int qblk) {
    int lane_ = F.lane, tid_ = F.tid; asm volatile("" : "+v"(lane_), "+v"(tid_));
    const int lane = lane_, c = lane & 15, q = lane >> 4, tid = tid_, w = F.wave;
    const bf16_t* Kg = (const bf16_t*)(F.ws + WS_MEMKV) + (size_t)(b * 256) * 2048 + h * 256;
    const bf16_t* VTg = (const bf16_t*)(F.ws + WS_MVT) + (size_t)((b * 4 + h) * 256) * 256;
    const bf16_t* MQ = (const bf16_t*)(F.ws + WS_MQ); const bf16_t* MZ = (const bf16_t*)(F.ws + WS_MZ); bf16_t* OM = (bf16_t*)(F.ws + WS_OM);
    LAS unsigned char* L = F.lds;
    __syncthreads();
#pragma unroll
    for (int hf = 0; hf < 2; ++hf) { u32x4 kr[8];
#pragma unroll
        for (int u = 0; u < 8; ++u) { const int p = tid + 512 * (u + 8 * hf), key = p >> 5, ch = p & 31; kr[u] = *(const u32x4*)(Kg + (size_t)key * 2048 + ch * 8); }
#pragma unroll
        for (int u = 0; u < 8; ++u) { const int p = tid + 512 * (u + 8 * hf), key = p >> 5, ch = p & 31; *(LAS u32x4*)(L + key * 512 + ((ch ^ (key & 15)) << 4)) = kr[u]; } }
    __syncthreads();
    size_t qrow[2];
#pragma unroll
    for (int t = 0; t < 2; ++t) qrow[t] = (size_t)b * SEQ + 256 * qblk + 32 * w + 16 * t + c;
    f32x4 sacc[2][16];
#pragma unroll
    for (int mt = 0; mt < 16; ++mt) { sacc[0][mt] = (f32x4){0.f, 0.f, 0.f, 0.f}; sacc[1][mt] = (f32x4){0.f, 0.f, 0.f, 0.f}; }
    bf16x8 qn0 = *(const bf16x8*)(MQ + qrow[0] * 1024 + h * 256 + 8 * q), qn1 = *(const bf16x8*)(MQ + qrow[1] * 1024 + h * 256 + 8 * q);
#pragma unroll 1
    for (int s = 0; s < 8; ++s) {
        const bf16x8 q0 = qn0, q1 = qn1; const int sn = s < 7 ? s + 1 : 7;
        qn0 = *(const bf16x8*)(MQ + qrow[0] * 1024 + h * 256 + 32 * sn + 8 * q); qn1 = *(const bf16x8*)(MQ + qrow[1] * 1024 + h * 256 + 32 * sn + 8 * q);
#pragma unroll
        for (int mt = 0; mt < 16; ++mt) { const int row = 16 * mt + c;
            const bf16x8 kf = *(const LAS bf16x8*)(L + row * 512 + (((4 * s + q) ^ (row & 15)) << 4));
            sacc[0][mt] = mfma16(kf, q0, sacc[0][mt]); sacc[1][mt] = mfma16(kf, q1, sacc[1][mt]); }
        asm volatile("" ::: "memory");
    }
    float inv[2]; bf16x8 pf[2][8];
    const float sc = 0.0625f * 1.4426950408889634f;
#pragma unroll
    for (int t = 0; t < 2; ++t) { float mx = -INFINITY;
#pragma unroll
        for (int mt = 0; mt < 16; ++mt) mx = fmaxf(mx, fmaxf(fmaxf(sacc[t][mt][0], sacc[t][mt][1]), fmaxf(sacc[t][mt][2], sacc[t][mt][3])));
        mx = fmaxf(mx, __shfl_xor(mx, 16)); mx = fmaxf(mx, __shfl_xor(mx, 32));
        float sum = 0.f;
#pragma unroll
        for (int mt = 0; mt < 16; ++mt)
#pragma unroll
            for (int r = 0; r < 4; ++r) { const float e = exp2f((sacc[t][mt][r] - mx) * sc); sacc[t][mt][r] = e; sum += e; }
        sum += __shfl_xor(sum, 16); sum += __shfl_xor(sum, 32); inv[t] = 1.f / sum;
#pragma unroll
        for (int ks = 0; ks < 8; ++ks) pf[t][ks] = cat8(pack4(sacc[t][2 * ks]), pack4(sacc[t][2 * ks + 1])); }
    __syncthreads();
#pragma unroll
    for (int hf = 0; hf < 2; ++hf) { u32x4 vr[8];
#pragma unroll
        for (int u = 0; u < 8; ++u) { const int p = tid + 512 * (u + 8 * hf), d = p >> 5, c16 = p & 31; vr[u] = *(const u32x4*)(VTg + (size_t)d * 256 + c16 * 8); }
#pragma unroll
        for (int u = 0; u < 8; ++u) { const int p = tid + 512 * (u + 8 * hf), d = p >> 5, c16 = p & 31; *(LAS u32x4*)(L + d * 512 + (((2 * c16) ^ (2 * (d & 15))) << 3)) = vr[u]; } }
    __syncthreads();
    u32x2 zn0 = *(const u32x2*)(MZ + qrow[0] * 1024 + h * 256 + 4 * q), zn1 = *(const u32x2*)(MZ + qrow[1] * 1024 + h * 256 + 4 * q);
#pragma unroll 1
    for (int dt = 0; dt < 16; ++dt) { f32x4 o0 = {0.f, 0.f, 0.f, 0.f}, o1 = {0.f, 0.f, 0.f, 0.f}; const int dd = 16 * dt + c;
        const u32x2 zc0 = zn0, zc1 = zn1; const int dn = dt < 15 ? dt + 1 : 15;
        zn0 = *(const u32x2*)(MZ + qrow[0] * 1024 + h * 256 + 16 * dn + 4 * q); zn1 = *(const u32x2*)(MZ + qrow[1] * 1024 + h * 256 + 16 * dn + 4 * q); const LAS unsigned char* vrow = L + dd * 512; const int sw = 2 * (dd & 15);
#pragma unroll
        for (int ks = 0; ks < 8; ++ks) { const bf16x8 vf = cat8(*(const LAS u32x2*)(vrow + (((8 * ks + q) ^ sw) << 3)), *(const LAS u32x2*)(vrow + (((8 * ks + 4 + q) ^ sw) << 3)));
            o0 = mfma16(vf, pf[0][ks], o0); o1 = mfma16(vf, pf[1][ks], o1); }
#pragma unroll
        for (int t = 0; t < 2; ++t) { f32x4 o = t ? o1 : o0; const size_t oo = qrow[t] * 1024 + h * 256 + 16 * dt + 4 * q; const u32x2 z = t ? zc1 : zc0;
            o[0] *= inv[t] * bf2f(z.x & 0xffffu); o[1] *= inv[t] * bf2f(z.x >> 16); o[2] *= inv[t] * bf2f(z.y & 0xffffu); o[3] *= inv[t] * bf2f(z.y >> 16);
            *(u32x2*)(OM + oo) = pack4(o); }
        asm volatile("" ::: "memory"); }
}
__device__ __forceinline__ void p2_attn_prompt(Frame& F, int wk, int nwk) {
    const int gw = wk * NWAVES + F.wave, NGW = nwk * NWAVES, lane = F.lane;
    { LAS float* BTl = (LAS float*)(F.lds + LDS_BT); const float* BT = (const float*)(F.ws + WS_BTAB); for (int i = F.tid; i < 2048; i += NTHREADS) BTl[i] = BT[i]; }
    __syncthreads();
    for (int it = wk; it < 256; it += nwk) { const int qblk = it & 31, bh = it >> 5; mem_wg_item(F, bh >> 2, bh & 3, qblk); }
    for (int it = wk; it < 256; it += nwk) { const int qb = it & 63, bk = it >> 6; swa_wg_item(F, bk >> 1, bk & 1, qb); }
    __syncthreads();
    const bf16_t* SKV = (const bf16_t*)(F.ws + WS_SKV);
    for (int it = gw; it < 256; it += NGW) { const int b = it >> 7, j = it & 127; const bf16_t* pp = SKV + (size_t)(b * SEQ + SEQ - 128 + j) * 256;
        for (int cc = lane; cc < 128; cc += 64) { F.out[O_SKP + ((size_t)b * 128 + j) * 128 + cc] = bf2f(pp[cc]); F.out[O_SVP + ((size_t)b * 128 + j) * 128 + cc] = bf2f(pp[128 + cc]); } }
}
__device__ __forceinline__ void p2_swa_sample(Frame& F, int wk, int nwk) {
    const int gw = wk * NWAVES + F.wave, NGW = nwk * NWAVES, lane = F.lane;
    const bf16_t* SKV = (const bf16_t*)(F.ws + WS_SKV);
    for (int it = gw; it < MS * 2; it += NGW) { const int r = it >> 1, kv = it & 1; swa_wave_item(F, true, r >> 2, r & 3, kv); }
    { const u32x4* s4 = (const u32x4*)(F.ws + WS_OMS); u32x4* d4 = (u32x4*)(F.ws + WS_OM + (size_t)MP * 1024 * 2); for (int i = gw * 64 + lane; i < MS * 1024 / 8; i += NGW * 64) d4[i] = s4[i]; }
    { const int gt = gw * 64 + lane, NT = NGW * 64;
        for (int i = gt; i < 128 * 124 * 32; i += NT) { const int bd = i / (124 * 32), e = i - bd * (124 * 32);
            ((f32x4*)(F.out + O_SKS + (size_t)bd * 16384))[e] = ((const f32x4*)(F.in[I_CSK] + (size_t)bd * 16384 + 512))[e];
            ((f32x4*)(F.out + O_SVS + (size_t)bd * 16384))[e] = ((const f32x4*)(F.in[I_CSV] + (size_t)bd * 16384 + 512))[e]; }
        for (int i = gt; i < 128 * 4 * 128; i += NT) { const int bd = i >> 9, jj = (i >> 7) & 3, cc = i & 127; const bf16_t* pp = SKV + (size_t)(MP + bd * 4 + jj) * 256;
            F.out[O_SKS + ((size_t)bd * 128 + 124 + jj) * 128 + cc] = bf2f(pp[cc]); F.out[O_SVS + ((size_t)bd * 128 + 124 + jj) * 128 + cc] = bf2f(pp[128 + cc]); } }
}
__device__ __forceinline__ void mem_sample_item(Frame& F, int bd, int hp) {
    const int lane = F.lane, w = F.wave, tid = F.tid, hl = lane >> 5, h = 2 * hp + hl, d0 = (lane & 31) * 8;
    const bf16_t* MQ = (const bf16_t*)(F.ws + WS_MQ); const bf16_t* MZ = (const bf16_t*)(F.ws + WS_MZ); bf16_t* OM = (bf16_t*)(F.ws + WS_OM);
    LAS float* lg = (LAS float*)F.lds;
    LAS float* isum = lg + 2048;
    LAS float* po = isum + 8;
    float qr[4][8];
#pragma unroll
    for (int s = 0; s < 4; ++s) { const u32x4 v = *(const u32x4*)(MQ + (size_t)(MP + bd * 4 + s) * 1024 + h * 256 + d0);
        qr[s][0] = bf2f(v.x & 0xffffu); qr[s][1] = bf2f(v.x >> 16); qr[s][2] = bf2f(v.y & 0xffffu); qr[s][3] = bf2f(v.y >> 16);
        qr[s][4] = bf2f(v.z & 0xffffu); qr[s][5] = bf2f(v.z >> 16); qr[s][6] = bf2f(v.w & 0xffffu); qr[s][7] = bf2f(v.w >> 16); }
    const float* Kc = F.in[I_CMK] + ((size_t)bd * 256 * 4 + h) * 256 + d0; const float* Vc = F.in[I_CMV] + ((size_t)bd * 256 * 4 + h) * 256 + d0;
#pragma unroll 4
    for (int i = 0; i < 32; ++i) { const int m = w + 8 * i; const f32x4 k0 = *(const f32x4*)(Kc + (size_t)m * 1024), k1 = *(const f32x4*)(Kc + (size_t)m * 1024 + 4);
        float l[4];
#pragma unroll
        for (int s = 0; s < 4; ++s) { float a = k0.x * qr[s][0] + k0.y * qr[s][1] + k0.z * qr[s][2] + k0.w * qr[s][3] + k1.x * qr[s][4] + k1.y * qr[s][5] + k1.z * qr[s][6] + k1.w * qr[s][7];
#pragma unroll
            for (int o = 1; o < 32; o <<= 1) a += __shfl_xor(a, o);
            l[s] = a * 0.0625f; }
        if ((lane & 31) == 0) {
#pragma unroll
            for (int s = 0; s < 4; ++s) lg[(hl * 4 + s) * 256 + m] = l[s]; } }
    __syncthreads();
    { const int pr = w; float l4[4];
#pragma unroll
        for (int u = 0; u < 4; ++u) l4[u] = lg[pr * 256 + lane + 64 * u];
        const float mx = wave_max(fmaxf(fmaxf(l4[0], l4[1]), fmaxf(l4[2], l4[3]))); float s = 0.f;
#pragma unroll
        for (int u = 0; u < 4; ++u) { l4[u] = __expf(l4[u] - mx); s += l4[u]; lg[pr * 256 + lane + 64 * u] = l4[u]; }
        s = wave_sum(s); if (lane == 0) isum[pr] = 1.f / s; }
    __syncthreads();
    float o[4][8];
#pragma unroll
    for (int s = 0; s < 4; ++s)
#pragma unroll
        for (int j = 0; j < 8; ++j) o[s][j] = 0.f;
#pragma unroll 4
    for (int i = 0; i < 32; ++i) { const int m = w + 8 * i; const f32x4 v0 = *(const f32x4*)(Vc + (size_t)m * 1024), v1 = *(const f32x4*)(Vc + (size_t)m * 1024 + 4);
#pragma unroll
        for (int s = 0; s < 4; ++s) { const float p = lg[(hl * 4 + s) * 256 + m];
            o[s][0] += p * v0.x; o[s][1] += p * v0.y; o[s][2] += p * v0.z; o[s][3] += p * v0.w; o[s][4] += p * v1.x; o[s][5] += p * v1.y; o[s][6] += p * v1.z; o[s][7] += p * v1.w; } }
#pragma unroll
    for (int s = 0; s < 4; ++s) { LAS float* pp = po + ((w * 4 + s) * 512 + hl * 256 + d0);
        *(LAS f32x4*)pp = (f32x4){o[s][0], o[s][1], o[s][2], o[s][3]}; *(LAS f32x4*)(pp + 4) = (f32x4){o[s][4], o[s][5], o[s][6], o[s][7]}; }
    __syncthreads();
#pragma unroll
    for (int u = 0; u < 4; ++u) { const int e = tid + 512 * u, s = e >> 9, cc = e & 511; float a = 0.f;
#pragma unroll
        for (int ww = 0; ww < 8; ++ww) a += po[(ww * 4 + s) * 512 + cc];
        const int hh = 2 * hp + (cc >> 8); const size_t oo = (size_t)(MP + bd * 4 + s) * 1024 + hh * 256 + (cc & 255);
        ((bf16_t*)(F.ws + WS_OMS))[oo - (size_t)MP * 1024] = (bf16_t)f2bf(a * isum[(cc >> 8) * 4 + s] * bf2f(MZ[oo])); }
    __syncthreads();
}

struct SchedP3 {
    int G, c; const unsigned char* ws;
    __device__ __forceinline__ int ntiles(const pg8::Unit&) const { return 1024 / 64; }
    __device__ __forceinline__ bool next(int i, pg8::Unit& u) const {
        if (i < 6) { const int round = i / 3, b = i - round * 3; pg8::tile_of(round * G + c, 64, 8, u.pm, u.pn); u.job = b; return true; }
        if (i == 6 && c < 48) { u.pm = 64 + c / 24; const int rem = c % 24; u.pn = rem / 3; u.job = rem % 3; return true; }
        return false;
    }
    __device__ __forceinline__ void ptrs(const pg8::Unit& u, const char*& A, const char*& B) const {
        A = (const char*)ws + WS_OG + (size_t)u.job * M * 1024 * 2 + (size_t)u.pm * 256 * 1024 * 2;
        B = (const char*)ws + WS_WB + (size_t)u.job * 2048 * 1024 * 2 + (size_t)u.pn * 256 * 1024 * 2;
    }
};
struct EpiP3 {
    unsigned char* ws;
    __device__ __forceinline__ void operator()(const f32x4 (&acc)[2][2][4][2], const pg8::Unit& u, int wr, int wc, int fr, int fq) const {
        const int row0 = u.pm * 256 + wr * 64 + fr, col0 = u.pn * 256 + wc * 32 + 8 * fq, b = u.job;
        const bf16_t* GT = (const bf16_t*)(ws + WS_GATES); bf16_t* MG = (bf16_t*)(ws + WS_MERGED);
        const bool rmw = (b > 0) && (u.pm < 64);
#pragma unroll
        for (int ai = 0; ai < 2; ++ai) {
            u32x4 g[4][2], p[4][2];
#pragma unroll
            for (int m = 0; m < 4; ++m)
#pragma unroll
                for (int bj = 0; bj < 2; ++bj) { const int r = row0 + ai * 128 + m * 16, c = col0 + bj * 128;
                    g[m][bj] = *(const u32x4*)(GT + (size_t)r * 6144 + b * 2048 + c);
                    p[m][bj] = rmw ? *(const u32x4*)(MG + (size_t)r * 2048 + c) : (u32x4){0u, 0u, 0u, 0u}; }
#pragma unroll
            for (int m = 0; m < 4; ++m)
#pragma unroll
                for (int bj = 0; bj < 2; ++bj) { const int r = row0 + ai * 128 + m * 16, c = col0 + bj * 128;
                    const u32x4 gg = g[m][bj], pp = p[m][bj];
                    f32x4 v0 = acc[ai][bj][m][0], v1 = acc[ai][bj][m][1];
                    v0[0] = v0[0] * bf2f(gg.x & 0xffffu) + bf2f(pp.x & 0xffffu); v0[1] = v0[1] * bf2f(gg.x >> 16) + bf2f(pp.x >> 16); v0[2] = v0[2] * bf2f(gg.y & 0xffffu) + bf2f(pp.y & 0xffffu); v0[3] = v0[3] * bf2f(gg.y >> 16) + bf2f(pp.y >> 16);
                    v1[0] = v1[0] * bf2f(gg.z & 0xffffu) + bf2f(pp.z & 0xffffu); v1[1] = v1[1] * bf2f(gg.z >> 16) + bf2f(pp.z >> 16); v1[2] = v1[2] * bf2f(gg.w & 0xffffu) + bf2f(pp.w & 0xffffu); v1[3] = v1[3] * bf2f(gg.w >> 16) + bf2f(pp.w >> 16);
                    u32x4 w; w.x = pg8::cvt_pk_bf16(v0[0], v0[1]); w.y = pg8::cvt_pk_bf16(v0[2], v0[3]); w.z = pg8::cvt_pk_bf16(v1[0], v1[1]); w.w = pg8::cvt_pk_bf16(v1[2], v1[3]);
                    u32x4* mp = u.pm < 64 ? (u32x4*)(MG + (size_t)r * 2048 + c) : (u32x4*)((bf16_t*)(ws + WS_PS) + ((size_t)b * MS + (r - MP)) * 2048 + c);
                    *mp = w; }
        }
    }
};

struct SchedP4 {
    int G, c; const unsigned char* ws;
    __device__ __forceinline__ int ntiles(const pg8::Unit& u) const { return u.job == 0 ? D / 64 : 512 / 64; }
    __device__ __forceinline__ bool next(int i, pg8::Unit& u) const {
        if (i < 2) { pg8::tile_of(i * G + c, 64, 8, u.pm, u.pn); u.job = 0; return true; }
        if (i == 2 && c < 64) { u.pm = 64 + c / 32; const int rem = c % 32; u.pn = rem / 4; u.job = 1 + (rem & 3); return true; }
        return false;
    }
    __device__ __forceinline__ void ptrs(const pg8::Unit& u, const char*& A, const char*& B) const {
        const size_t ko = u.job == 0 ? 0 : (size_t)(u.job - 1) * 512 * 2;
        A = (const char*)ws + WS_MERGED + (size_t)u.pm * 256 * 2048 * 2 + ko; B = (const char*)ws + WS_WO + (size_t)u.pn * 256 * 2048 * 2 + ko;
    }
};
struct EpiP4 {
    unsigned char* ws; float* out; const float* xp; const float* xs;
    __device__ __forceinline__ void operator()(const f32x4 (&acc)[2][2][4][2], const pg8::Unit& u, int wr, int wc, int fr, int fq) const {
        const int row0 = u.pm * 256 + wr * 64 + fr, col0 = u.pn * 256 + wc * 32 + 8 * fq;
        if (u.job != 0) {
#pragma unroll
            for (int ai = 0; ai < 2; ++ai)
#pragma unroll
                for (int m = 0; m < 4; ++m) { const int r = row0 + ai * 128 + m * 16; float* yp = (float*)(ws + WS_YP) + ((size_t)(u.job - 1) * MS + (r - MP)) * D;
#pragma unroll
                    for (int bj = 0; bj < 2; ++bj) { const int c = col0 + bj * 128; *(f32x4*)(yp + c) = acc[ai][bj][m][0]; *(f32x4*)(yp + c + 4) = acc[ai][bj][m][1]; } }
            return;
        }
#pragma unroll
        for (int ai = 0; ai < 2; ++ai)
#pragma unroll
            for (int mh = 0; mh < 2; ++mh) {
                f32x4 xv[2][2][2];
#pragma unroll
                for (int mm = 0; mm < 2; ++mm)
#pragma unroll
                    for (int bj = 0; bj < 2; ++bj) { const float* xr = xp + (size_t)(row0 + ai * 128 + (2 * mh + mm) * 16) * D + col0 + bj * 128; xv[mm][bj][0] = *(const f32x4*)xr; xv[mm][bj][1] = *(const f32x4*)(xr + 4); }
#pragma unroll
                for (int mm = 0; mm < 2; ++mm)
#pragma unroll
                    for (int bj = 0; bj < 2; ++bj) { float* yr = out + (size_t)(row0 + ai * 128 + (2 * mh + mm) * 16) * D + col0 + bj * 128;
                        *(f32x4*)yr = acc[ai][bj][2 * mh + mm][0] + xv[mm][bj][0]; *(f32x4*)(yr + 4) = acc[ai][bj][2 * mh + mm][1] + xv[mm][bj][1]; }
            }
    }
};
__device__ __forceinline__ void p3_combine_sample(Frame& F) {
    const u32x4* ps = (const u32x4*)(F.ws + WS_PS); u32x4* mg = (u32x4*)(F.ws + WS_MERGED + (size_t)MP * 2048 * 2);
    constexpr int NV = MS * 2048 / 8;
    for (int i = F.bid * NTHREADS + F.tid; i < NV; i += F.G * NTHREADS) { const u32x4 a = ps[i], b = ps[NV + i], c = ps[2 * NV + i]; u32x4 o;
        o.x = pk2(bf2f(a.x & 0xffffu) + bf2f(b.x & 0xffffu) + bf2f(c.x & 0xffffu), bf2f(a.x >> 16) + bf2f(b.x >> 16) + bf2f(c.x >> 16));
        o.y = pk2(bf2f(a.y & 0xffffu) + bf2f(b.y & 0xffffu) + bf2f(c.y & 0xffffu), bf2f(a.y >> 16) + bf2f(b.y >> 16) + bf2f(c.y >> 16));
        o.z = pk2(bf2f(a.z & 0xffffu) + bf2f(b.z & 0xffffu) + bf2f(c.z & 0xffffu), bf2f(a.z >> 16) + bf2f(b.z >> 16) + bf2f(c.z >> 16));
        o.w = pk2(bf2f(a.w & 0xffffu) + bf2f(b.w & 0xffffu) + bf2f(c.w & 0xffffu), bf2f(a.w >> 16) + bf2f(b.w >> 16) + bf2f(c.w >> 16));
        mg[i] = o; }
}
__device__ __forceinline__ void p5_final_norm(Frame& F) {
    const int gw = F.bid * NWAVES + F.wave, NGW = F.G * NWAVES, lane = F.lane;
    const f32x4* wn = (const f32x4*)F.in[I_NORMF] + lane;
    for (int r = gw; r < M; r += NGW) {
        f32x4* y = (f32x4*)(F.out + (size_t)r * D) + lane;
        f32x4 v[8]; float s = 0.f;
        if (r >= MP) { const f32x4* xs4 = (const f32x4*)(F.in[I_XS] + (size_t)(r - MP) * D) + lane; const f32x4* yp4 = (const f32x4*)((const float*)(F.ws + WS_YP) + (size_t)(r - MP) * D) + lane;
#pragma unroll
            for (int j = 0; j < 8; ++j) { f32x4 a = xs4[64 * j];
#pragma unroll
                for (int kq = 0; kq < 4; ++kq) a = a + yp4[(size_t)kq * MS * D / 4 + 64 * j];
                v[j] = a; s += (a.x * a.x + a.y * a.y) + (a.z * a.z + a.w * a.w); } }
        else
#pragma unroll
        for (int j = 0; j < 8; ++j) { v[j] = y[64 * j]; s += (v[j].x * v[j].x + v[j].y * v[j].y) + (v[j].z * v[j].z + v[j].w * v[j].w); }
        const float sc = rsqrtf(wave_sum(s) * (1.f / D) + EPS);
#pragma unroll
        for (int j = 0; j < 8; ++j) { const f32x4 w = wn[64 * j]; f32x4 o = v[j]; o.x *= sc * w.x; o.y *= sc * w.y; o.z *= sc * w.z; o.w *= sc * w.w; y[64 * j] = o; }
    }
}

constexpr int N_PHASES = 10;
__global__ void __launch_bounds__(NTHREADS, 2) hybrid_fwd(Args args) {
    extern __shared__ __attribute__((aligned(16))) unsigned char lds_raw[];
    cg::grid_group grid = cg::this_grid();
    Frame F;
    F.lds = (LAS unsigned char*)lds_raw; F.tid = threadIdx.x; F.lane = F.tid & 63; F.wave = __builtin_amdgcn_readfirstlane(F.tid >> 6);
    F.G = gridDim.x; F.bid = blockIdx.x; F.in = args.in; F.out = args.out; F.ws = args.ws;
    const int lo = args.ph_lo, hi = args.ph_hi;
    if (lo < 0) grid.sync();
    if (F.tid < 64) ((LAS unsigned*)(F.lds + LDS_CTL))[F.tid] = 0u;
    __syncthreads();
    const XcdBarrier bar = xcd_barrier_post((unsigned*)(F.ws + WS_CTL), (volatile LAS unsigned*)(F.lds + LDS_CTL));
#define IN(k) (lo <= (k) && (k) < hi)
#define SEAM(k) do { if (IN(k) && IN((k) + 1)) xcd_barrier(bar); } while (0)
    if (IN(0)) p0_prologue(F);
    SEAM(0);
    if (IN(1)) { SchedP1 S{F.G, F.bid, F.ws, (const unsigned char*)F.out + DO_XN}; EpiP1 E{F.ws, F.out}; pg8::gemm_phase<EpiP1, SchedP1>(F.lds, D, S, E); }
    SEAM(1);
    if (IN(2)) { p2_conv(F); __syncthreads(); for (int it = F.bid; it < 256; it += F.G) mem_sample_item(F, it >> 1, it & 1); }
    SEAM(2);
    if (IN(3)) p2_prep(F);
    SEAM(3);
    if (IN(4)) {
        constexpr int GSPLIT = 512;
        if (F.bid < 128) { scan_item(F, F.bid & 15, F.bid >> 4); __syncthreads(); p2_gdn_sample(F, F.bid, 128, 0, GSPLIT); }
        else { const int wk = F.bid - 128, nwk = F.G - 128; p2_attn_prompt(F, wk, nwk); __syncthreads(); p2_swa_sample(F, wk, nwk); __syncthreads(); p2_gdn_sample(F, wk, nwk, GSPLIT, 1024); }
    }
    SEAM(4);
    if (IN(5)) { for (int it = F.bid; it < 256; it += F.G) gdn_out_item(F, it); p2_gdn_norm_sample(F); }
    SEAM(5);
    if (IN(6)) { SchedP3 S{F.G, F.bid, F.ws}; EpiP3 E{F.ws}; pg8::gemm_phase<EpiP3, SchedP3>(F.lds, 1024, S, E); }
    SEAM(6);
    if (IN(7)) p3_combine_sample(F);
    SEAM(7);
    if (IN(8)) { SchedP4 S{F.G, F.bid, F.ws}; EpiP4 E{F.ws, F.out, F.in[I_XP], F.in[I_XS]}; pg8::gemm_phase<EpiP4, SchedP4>(F.lds, D, S, E); }
    SEAM(8);
    if (IN(9)) p5_final_norm(F);
#undef IN
#undef SEAM
}

extern "C" void kernel_launch(void* const* d_in, const int* in_sizes, int n_in, void* d_out, int out_size, void* d_ws, size_t ws_size, hipStream_t stream) {
    static int grid = 0;
    if (grid == 0) {
        if (n_in != 22 || out_size != (int)O_END || ws_size < WS_END) { fprintf(stderr, "kernel_launch: unexpected shapes (n_in %d out %d ws %zu need %zu)\n", n_in, out_size, ws_size, (size_t)WS_END); grid = -1; return; }
        int dev = 0, cus = 0, per_cu = 0;
        hipGetDevice(&dev); hipDeviceGetAttribute(&cus, hipDeviceAttributeMultiprocessorCount, dev);
        hipFuncSetAttribute((const void*)hybrid_fwd, hipFuncAttributeMaxDynamicSharedMemorySize, LDS_BYTES);
        hipOccupancyMaxActiveBlocksPerMultiprocessor(&per_cu, (const void*)hybrid_fwd, NTHREADS, LDS_BYTES);
        if (per_cu < 1) { fprintf(stderr, "kernel_launch: occupancy query says %d blocks per CU\n", per_cu); grid = -1; return; }
        grid = cus;
    }
    if (grid < 0) return;
    Args a{};
    for (int i = 0; i < 22; ++i) a.in[i] = (const float*)d_in[i];
    a.out = (float*)d_out; a.ws = (unsigned char*)d_ws;
    if (hipMemsetAsync((char*)d_ws + WS_CTL, 0, XCD_BAR_WORDS * 4, stream) != hipSuccess) { fprintf(stderr, "kernel_launch: hipMemsetAsync failed\n"); return; }
#if MK_N_LAUNCHES == 1
    a.ph_lo = 0; a.ph_hi = N_PHASES;
    void* kargs[] = {&a};
    hipError_t e = hipLaunchCooperativeKernel((const void*)hybrid_fwd, dim3(grid), dim3(NTHREADS), kargs, LDS_BYTES, stream);
    if (e != hipSuccess) fprintf(stderr, "cooperative launch failed: %s (grid %d)\n", hipGetErrorString(e), grid);
#endif
}
```

```cpp
#include <hip/hip_runtime.h>
#include <hip/hip_cooperative_groups.h>
#include <cstdio>
#include <cstdint>
namespace cg = cooperative_groups;

#ifndef MK_N_LAUNCHES
#define MK_N_LAUNCHES 1
#endif

#define LAS __attribute__((address_space(3)))
typedef unsigned short bf16_t;
typedef short bf16x8 __attribute__((ext_vector_type(8)));
typedef float f32x4 __attribute__((ext_vector_type(4)));
typedef unsigned u32x4 __attribute__((ext_vector_type(4)));
typedef unsigned u32x2 __attribute__((ext_vector_type(2)));

constexpr int D = 2048, SEQ = 8192, MP = 2 * SEQ, MS = 512, M = MP + MS;
constexpr int IN_COLS = 14608;
constexpr int NIN = 58 * 256;
constexpr float EPS = 1e-6f;
__host__ __device__ __forceinline__ int win_src_col(int j) {
    if (j < 4096) return j;
    if (j < 5120) return 4112 + (j - 4096);
    if (j < 6144) return 5392 + (j - 5120);
    if (j < 7168) return 6416 + (j - 6144);
    if (j < 8192) return 7440 + (j - 7168);
    if (j < 14336) return 8464 + (j - 8192);
    if (j < 14592) return 5136 + (j - 14336);
    if (j < 14608) return 4096 + (j - 14592);
    return -1;
}
constexpr size_t O_YP = 0, O_YS = O_YP + (size_t)MP * D, O_GSP = O_YS + (size_t)MS * D, O_GCP = O_GSP + 2 * 8 * 128 * 128, O_SKP = O_GCP + 2 * 3 * 3072,
                 O_SVP = O_SKP + 2 * 128 * 128, O_MKP = O_SVP + 2 * 128 * 128, O_MVP = O_MKP + 512 * 1024, O_GSS = O_MVP + 512 * 1024,
                 O_GCS = O_GSS + (size_t)128 * 8 * 128 * 128, O_SKS = O_GCS + 128 * 3 * 3072, O_SVS = O_SKS + 128 * 128 * 128, O_END = O_SVS + 128 * 128 * 128;
static_assert(O_END == 58148864, "d_out map");
constexpr size_t al(size_t x) { return (x + 255) & ~(size_t)255; }
constexpr size_t WS_CTL = 0, WS_WB = 1u << 20, WS_WO = WS_WB + al((size_t)3 * 2048 * 1024 * 2), WS_WIN = WS_WO + al((size_t)2048 * 2048 * 2),
                 WS_WMKV = WS_WIN + al((size_t)NIN * 2048 * 2), WS_QKV = WS_WMKV + al((size_t)2048 * 2048 * 2), WS_GZ = WS_QKV + al((size_t)M * 3072 * 2),
                 WS_SQ = WS_GZ + al((size_t)M * 1024 * 2), WS_SZ = WS_SQ + al((size_t)M * 1024 * 2), WS_MQ = WS_SZ + al((size_t)M * 1024 * 2), WS_MZ = WS_MQ + al((size_t)M * 1024 * 2),
                 WS_SKV = WS_MZ + al((size_t)M * 1024 * 2), WS_GATES = WS_SKV + al((size_t)M * 256 * 2), WS_MEMN = WS_GATES + al((size_t)M * 6144 * 2),
                 WS_MEMKV = WS_MEMN + al((size_t)512 * 2048 * 2), WS_GAB = WS_MEMKV + al((size_t)512 * 2048 * 2), WS_ROWSS = WS_GAB + al((size_t)M * 16 * 4),
                 WS_G = WS_ROWSS + al((size_t)M * 4), WS_BETA = WS_G + al((size_t)M * 8 * 4), WS_BTAB = WS_BETA + al((size_t)M * 8 * 4), WS_END0 = WS_BTAB + al(16 * 128 * 4);
constexpr size_t WS_OG = WS_QKV, WS_OS = WS_OG + (size_t)M * 1024 * 2, WS_OM = WS_OS + (size_t)M * 1024 * 2, WS_MERGED = WS_SQ;
constexpr size_t WS_NEGW = WS_OG, WS_SN = WS_WIN, WS_OMS = WS_MEMN;
constexpr size_t WS_UT = WS_END0, WS_ATT = WS_UT + al((size_t)2048 * 128 * 64 * 2), WS_GC = WS_ATT + al((size_t)2048 * 64 * 64 * 2), WS_DEC = WS_GC + al((size_t)MP * 8 * 4),
                 WS_GT = WS_DEC + al((size_t)2048 * 64 * 4), WS_MVT = WS_GT + al(2048 * 4), WS_VTS = WS_MVT + al((size_t)2 * 4 * 256 * 256 * 2), WS_SSQ = WS_VTS + al((size_t)2 * 2 * 64 * SEQ * 2 + 4096), WS_SSK = WS_SSQ + al((size_t)MP * 8 * 4), WS_END = WS_SSK + al((size_t)MP * 8 * 4);
constexpr size_t WS_PS = WS_UT, WS_YP = WS_UT + (size_t)3 * MS * 2048 * 2;
static_assert((size_t)3 * MS * 2048 * 2 + (size_t)4 * MS * 2048 * 4 <= (size_t)2048 * 128 * 64 * 2, "PS/YP fit in UT");
static_assert(WS_OM + (size_t)M * 1024 * 2 <= WS_GZ && WS_MERGED + (size_t)M * 2048 * 2 <= WS_MQ, "overlays");
static_assert((size_t)2048 * 64 * 128 * 2 <= (size_t)MP * 1024 * 2 && WS_SN + (size_t)2048 * 128 * 128 * 2 <= WS_QKV, "overlays 2");
static_assert(WS_END <= 670000000, "workspace budget");
constexpr size_t DO_XN = 0, DO_QN = 0, DO_KN = (size_t)M * 1024 * 2, DO_KT = 2 * (size_t)M * 1024 * 2, DO_VT = DO_KT + (size_t)2048 * 8192 * 2, DO_VNS = DO_VT + (size_t)2048 * 8192 * 2;
static_assert(DO_VNS + (size_t)512 * 1024 * 2 <= (size_t)M * D * 4, "y scratch");

constexpr int NWAVES = 8, NTHREADS = 512;
constexpr int LDS_CTL = 147456;
constexpr int LDS_BYTES = 147456 + 256;
constexpr int LDS_BT = 139264;

__device__ __forceinline__ float bf2f(unsigned v) { return __uint_as_float(v << 16); }
__device__ __forceinline__ unsigned f2bf(float f) { unsigned u = __float_as_uint(f); return (u + 0x7fffu + ((u >> 16) & 1u)) >> 16; }
__device__ __forceinline__ unsigned pk2(float lo, float hi) { return f2bf(lo) | (f2bf(hi) << 16); }
__device__ __forceinline__ float wave_sum(float v) {
#pragma unroll
    for (int o = 1; o < 64; o <<= 1) v += __shfl_xor(v, o);
    return v;
}
__device__ __forceinline__ float wave_max(float v) {
#pragma unroll
    for (int o = 1; o < 64; o <<= 1) v = fmaxf(v, __shfl_xor(v, o));
    return v;
}
__device__ __forceinline__ float sigmoidf_(float x) { return __builtin_amdgcn_rcpf(1.f + __expf(-x)); }
__device__ __forceinline__ float siluf_(float x) { return x * __builtin_amdgcn_rcpf(1.f + __expf(-x)); }
#define LDS_WAIT() asm volatile("s_waitcnt lgkmcnt(0)" ::: "memory")

namespace pg8 {
constexpr int BM = 256, BK = 64, HALF = 128, HTB = HALF * BK * 2, STAGE_BYTES = 8 * HTB, NXCD = 8, WGM = 8;
__host__ __device__ __forceinline__ int lds_byte(int r, int c) { const int st = (r >> 4) * 2 + (c >> 5), rr = r & 15, cc = c & 31, ob = rr * 64 + cc * 2; return st * 1024 + (ob ^ (((ob >> 9) & 1) << 5)); }
__host__ __device__ __forceinline__ void stage_rc(int b, int& R, int& C) { const int st = b / 1024, sb = b % 1024, swz = sb ^ (((sb >> 9) & 1) << 5); R = (st >> 1) * 16 + swz / 64; C = (st & 1) * 32 + (swz % 64) / 2; }
__host__ __device__ __forceinline__ int perm32(int rho) { const int n = rho >> 4, i = rho & 15; return 8 * (i >> 2) + 4 * n + (i & 3); }
struct Unit { int pm, pn, job; };
__device__ __forceinline__ void tile_of(int L, int nM, int nN, int& pm, int& pn) {
    const int nwg = nM * nN; int wgid = L;
    { const int q = nwg / NXCD, r = nwg % NXCD, xcd = wgid % NXCD, off = wgid / NXCD; wgid = (xcd < r ? xcd * (q + 1) : r * (q + 1) + (xcd - r) * q) + off; }
    const int nig = WGM * nN, gid = wgid / nig, fm = gid * WGM, gsz = (nM - fm) < WGM ? (nM - fm) : WGM;
    pm = fm + ((wgid % nig) % gsz); pn = (wgid % nig) / gsz;
}
__device__ __forceinline__ unsigned cvt_pk_bf16(float lo, float hi) { unsigned r; asm volatile("v_cvt_pk_bf16_f32 %0, %1, %2" : "=v"(r) : "v"(lo), "v"(hi)); return r; }

template <class Epi, class Sched, bool ALIGN_EPI = true>
__device__ __forceinline__ void gemm_phase(LAS unsigned char* lds, const int K, const Sched& S, const Epi& E) {
    const int tid = threadIdx.x, wid = __builtin_amdgcn_readfirstlane(tid >> 6), lane = tid & 63, wr = wid >> 2, wc = wid & 3, fr = lane & 15, fq = lane >> 4;
    unsigned voffA[2], voffB[2];
#pragma unroll
    for (int i = 0; i < 2; ++i) { int R, C; stage_rc(tid * 16 + i * 8192, R, C); const int Rb = ((R & ~31) + perm32(R & 31));
        voffA[i] = (unsigned)(R * K + C) * 2u; voffB[i] = (unsigned)(Rb * K + C) * 2u; }
    const size_t kstep = (size_t)(BK * 2);
    const size_t hstep = (size_t)HALF * K * 2;
    const unsigned ldsw = (unsigned)wid * 1024u;
    const int aoff = lds_byte(wr * 64 + fr, fq * 8), boff = lds_byte(wc * 32 + fr, fq * 8);
#define PG8_SA(b, h) (((b) * 2 + (h)) * HTB)
#define PG8_SB(b, h) ((4 + (b) * 2 + (h)) * HTB)
#define PG8_STAGE(bufoff, gbase, voff) do { _Pragma("unroll") for (int _i = 0; _i < 2; ++_i) \
        __builtin_amdgcn_global_load_lds((const unsigned*)((const char*)(gbase) + (voff)[_i]), (LAS unsigned*)(lds + (bufoff) + ldsw + _i * 8192), 16, 0, 0); } while (0)
#define PG8_LDA(dst, b, h) do { _Pragma("unroll") for (int m = 0; m < 4; ++m) _Pragma("unroll") for (int k = 0; k < 2; ++k) dst[m][k] = *(const LAS bf16x8*)(lds + PG8_SA(b, h) + aoff + m * 2048 + k * 1024); } while (0)
#define PG8_LDB(dst, b, h) do { _Pragma("unroll") for (int n = 0; n < 2; ++n) _Pragma("unroll") for (int k = 0; k < 2; ++k) dst[n][k] = *(const LAS bf16x8*)(lds + PG8_SB(b, h) + boff + n * 2048 + k * 1024); } while (0)
#define PG8_MMA(ai, bj, At, Bt) do { __builtin_amdgcn_s_setprio(1); _Pragma("unroll") for (int m = 0; m < 4; ++m) _Pragma("unroll") for (int n = 0; n < 2; ++n) _Pragma("unroll") for (int k = 0; k < 2; ++k) \
        acc[ai][bj][m][n] = __builtin_amdgcn_mfma_f32_16x16x32_bf16(Bt[n][k], At[m][k], acc[ai][bj][m][n], 0, 0, 0); __builtin_amdgcn_s_setprio(0); } while (0)
#define PG8_WAIT_V(n) asm volatile("s_waitcnt vmcnt(" #n ")" ::: "memory")
#define PG8_WAIT_L(n) asm volatile("s_waitcnt lgkmcnt(" #n ")" ::: "memory")
#define PG8_BAR __builtin_amdgcn_s_barrier()
#define PG8_SCHED __builtin_amdgcn_sched_barrier(0)
    Unit cur, nxt; int ui = 0;
    if (!S.next(0, cur)) return;
    f32x4 acc[2][2][4][2];
#pragma unroll
    for (int a = 0; a < 2; ++a)
#pragma unroll
        for (int b = 0; b < 2; ++b)
#pragma unroll
            for (int m = 0; m < 4; ++m)
#pragma unroll
                for (int n = 0; n < 2; ++n) acc[a][b][m][n] = (f32x4){0.f, 0.f, 0.f, 0.f};
    bf16x8 At[4][2], B0[2][2], B1[2][2];
    const char* cA; const char* cB; S.ptrs(cur, cA, cB);
    PG8_STAGE(PG8_SB(0, 0), cB, voffB); PG8_STAGE(PG8_SB(0, 1), cB + hstep, voffB); PG8_STAGE(PG8_SA(0, 0), cA, voffA); PG8_STAGE(PG8_SA(0, 1), cA + hstep, voffA);
    if (wr == 1) PG8_BAR;
    PG8_WAIT_V(2); PG8_BAR;
    PG8_STAGE(PG8_SB(1, 0), cB + kstep, voffB); PG8_STAGE(PG8_SA(1, 0), cA + kstep, voffA); PG8_STAGE(PG8_SB(1, 1), cB + hstep + kstep, voffB);
    PG8_WAIT_V(6); PG8_BAR;
    for (;;) {
        const bool has_next = S.next(ui + 1, nxt);
        const char* nA = cA; const char* nB = cB; if (has_next) S.ptrs(nxt, nA, nB);
        const int nt = S.ntiles(cur);
        for (int t = 0; t < nt; t += 2) {
            const bool last = (t == nt - 2);
            const char* a1 = cA + (size_t)(t + 1) * kstep;
            const char* a2 = last ? nA : cA + (size_t)(t + 2) * kstep; const char* b2 = last ? nB : cB + (size_t)(t + 2) * kstep;
            const char* a3 = a2 + kstep; const char* b3 = b2 + kstep;
            PG8_LDB(B0, 0, 0); PG8_LDB(B1, 0, 1); PG8_SCHED; PG8_LDA(At, 0, 0); PG8_STAGE(PG8_SA(1, 1), a1 + hstep, voffA);
            PG8_WAIT_V(8); PG8_WAIT_L(0); PG8_BAR; PG8_MMA(0, 0, At, B0); PG8_MMA(0, 1, At, B1); PG8_BAR; PG8_SCHED;
            PG8_LDA(At, 0, 1); PG8_STAGE(PG8_SB(0, 0), b2, voffB); PG8_STAGE(PG8_SB(0, 1), b2 + hstep, voffB); PG8_STAGE(PG8_SA(0, 0), a2, voffA);
            PG8_WAIT_V(8); PG8_WAIT_L(0); PG8_BAR; PG8_MMA(1, 0, At, B0); PG8_MMA(1, 1, At, B1); PG8_BAR; PG8_SCHED;
            PG8_LDB(B0, 1, 0); PG8_LDB(B1, 1, 1); PG8_SCHED; PG8_LDA(At, 1, 0); PG8_STAGE(PG8_SA(0, 1), a2 + hstep, voffA);
            PG8_WAIT_V(8); PG8_WAIT_L(0); PG8_BAR; PG8_MMA(0, 0, At, B0); PG8_MMA(0, 1, At, B1); PG8_BAR; PG8_SCHED;
            PG8_LDA(At, 1, 1); PG8_STAGE(PG8_SB(1, 0), b3, voffB); PG8_STAGE(PG8_SB(1, 1), b3 + hstep, voffB); PG8_STAGE(PG8_SA(1, 0), a3, voffA);
            PG8_WAIT_V(8); PG8_WAIT_L(0); PG8_BAR; PG8_MMA(1, 0, At, B0); PG8_MMA(1, 1, At, B1); PG8_BAR; PG8_SCHED;
        }
        if constexpr (ALIGN_EPI) { if (wr == 0) PG8_BAR; }
        E(acc, cur, wr, wc, fr, fq);
        if (!has_next) break;
#pragma unroll
        for (int a = 0; a < 2; ++a)
#pragma unroll
            for (int b = 0; b < 2; ++b)
#pragma unroll
                for (int m = 0; m < 4; ++m)
#pragma unroll
                    for (int n = 0; n < 2; ++n) acc[a][b][m][n] = (f32x4){0.f, 0.f, 0.f, 0.f};
        cur = nxt; cA = nA; cB = nB; ++ui;
        if constexpr (ALIGN_EPI) { if (wr == 1) PG8_BAR; }
    }
    PG8_WAIT_V(0);
    if constexpr (!ALIGN_EPI) { if (wr == 0) PG8_BAR; }
    PG8_BAR;
#undef PG8_SA
#undef PG8_SB
#undef PG8_STAGE
#undef PG8_LDA
#undef PG8_LDB
#undef PG8_MMA
#undef PG8_WAIT_V
#undef PG8_WAIT_L
#undef PG8_BAR
#undef PG8_SCHED
}
}

#define XB_TMO      128
#define XB_XCNT(j)  (256  + 64 * (j))
#define XB_XSUB(j)  (1280 + 64 * (j))
#define XB_XGEN(j)  (2304 + 64 * (j))
#define XB_TOP      3328
#define XB_TOPGEN   3392
#define XCD_BAR_WORDS 3456
#define XB_SPIN_CAP (1u << 20)
__device__ __forceinline__ unsigned xb_ld(unsigned* p)              { return __hip_atomic_load(p, __ATOMIC_RELAXED, __HIP_MEMORY_SCOPE_AGENT); }
__device__ __forceinline__ unsigned xb_add(unsigned* p, unsigned v) { return __hip_atomic_fetch_add(p, v, __ATOMIC_RELAXED, __HIP_MEMORY_SCOPE_AGENT); }
__device__ __forceinline__ unsigned xb_xcc_id() { return (unsigned)__builtin_amdgcn_s_getreg((3 << 11) | 20) & 0xFu; }
#define XB_SPIN(cond, bar) do { unsigned _sp = 0; while (cond) { __builtin_amdgcn_s_sleep(1); \
    if ((++_sp & 255u) == 0u) { if (xb_ld(&(bar)[XB_TMO])) break; if (_sp > XB_SPIN_CAP) { atomicAdd(&(bar)[XB_TMO], 1u); break; } } } } while (0)
struct XcdBarrier { unsigned* bar; unsigned x; volatile LAS unsigned* st; };
__device__ __forceinline__ XcdBarrier xcd_barrier_post(unsigned* bar, volatile LAS unsigned* st) {
    XcdBarrier b; b.bar = bar; b.x = xb_xcc_id(); b.st = st;
    if (threadIdx.x == 0) (void)xb_add(&bar[XB_XCNT(b.x)], 1u);
    return b;
}
__device__ __forceinline__ void xcd_barrier_complete(unsigned* bar, unsigned x, unsigned& nloc, unsigned& nx) {
    const unsigned G = gridDim.x * gridDim.y * gridDim.z;
    unsigned sum, cnt, mine, sp = 0u;
    for (;;) {
        sum = 0u; cnt = 0u; mine = 0u;
#pragma unroll
        for (unsigned j = 0; j < 16; ++j) { const unsigned c = xb_ld(&bar[XB_XCNT(j)]); sum += c; cnt += (c > 0u) ? 1u : 0u; mine = (j == x) ? c : mine; }
        if (sum == G) break;
        __builtin_amdgcn_s_sleep(1);
        if ((++sp & 255u) == 0u) { if (xb_ld(&bar[XB_TMO])) break; if (sp > XB_SPIN_CAP) { atomicAdd(&bar[XB_TMO], 1u); break; } }
    }
    nloc = mine > 0u ? mine : 1u; nx = cnt > 0u ? cnt : 1u;
}
__device__ __forceinline__ void xcd_barrier(const XcdBarrier& b) {
    asm volatile("s_waitcnt vmcnt(0)" ::: "memory");
    __syncthreads();
    if (threadIdx.x == 0) {
        unsigned* bar = b.bar;
        __builtin_amdgcn_s_waitcnt(0);
        unsigned nloc = b.st[0], nx = b.st[1];
        if (nloc == 0u) { xcd_barrier_complete(bar, b.x, nloc, nx); b.st[0] = nloc; b.st[1] = nx; }
        const unsigned old = xb_add(&bar[XB_XSUB(b.x)], 1u);
        const unsigned gen = old / nloc;
        if (old + 1u == (gen + 1u) * nloc) {
            __builtin_amdgcn_fence(__ATOMIC_RELEASE, "agent");
            asm volatile("s_waitcnt vmcnt(0)" ::: "memory");
            const unsigned og = xb_add(&bar[XB_TOP], 1u);
            const unsigned tg = og / nx;
            if (og + 1u == (tg + 1u) * nx) xb_add(&bar[XB_TOPGEN], 1u);
            else XB_SPIN(xb_ld(&bar[XB_TOPGEN]) == tg, bar);
            __builtin_amdgcn_fence(__ATOMIC_ACQUIRE, "agent");
            xb_add(&bar[XB_XGEN(b.x)], 1u);
            asm volatile("s_waitcnt vmcnt(0)" ::: "memory");
        } else {
            XB_SPIN(xb_ld(&bar[XB_XGEN(b.x)]) == gen, bar);
            __builtin_amdgcn_fence(__ATOMIC_ACQUIRE, "agent");
            asm volatile("s_waitcnt vmcnt(0)" ::: "memory");
        }
    }
    __syncthreads();
}

struct Args { const float* in[22]; float* out; unsigned char* ws; int ph_lo, ph_hi; };
enum { I_XP = 0, I_XS, I_SGDN, I_SCONV, I_CSK, I_CSV, I_CMK, I_CMV, I_MEMP, I_NORM_IN, I_WIN, I_CONVW, I_ALOG, I_DTB, I_GNORM, I_SINKS, I_RELB, I_NORM_MEM, I_WMKV, I_WBR, I_WOUT, I_NORMF };

struct Frame {
    LAS unsigned char* lds;
    int tid, lane, wave, G, bid;
    const float* const* in; float* out; unsigned char* ws;
};

template <bool WINMAP>
__device__ __forceinline__ void p0_transpose_item(const float* W, int K, int Nsrc, bf16_t* WT, LAS bf16_t* scr, int kb, int nb, int lane) {
    constexpr int TP = 130;
    const int k0 = 64 * kb, n0 = 128 * nb;
    const int dj = n0 + 4 * (lane & 31);
    const int sc = WINMAP ? win_src_col(dj) : dj;
    f32x4 v[32];
#pragma unroll
    for (int i = 0; i < 32; ++i) { const int kk = 2 * i + (lane >> 5); v[i] = sc >= 0 ? *(const f32x4*)(W + (size_t)(k0 + kk) * Nsrc + sc) : (f32x4){0.f, 0.f, 0.f, 0.f}; }
#pragma unroll
    for (int i = 0; i < 32; ++i) { const int kk = 2 * i + (lane >> 5); LAS unsigned* d = (LAS unsigned*)(scr + kk * TP + 4 * (lane & 31)); d[0] = pk2(v[i].x, v[i].y); d[1] = pk2(v[i].z, v[i].w); }
    LDS_WAIT(); asm volatile("" ::: "memory");
#pragma unroll 4
    for (int u = 0; u < 16; ++u) { const int e = lane + 64 * u, ch = e & 7, n = e >> 3; const LAS bf16_t* s = scr + (8 * ch) * TP + n;
        u32x4 o; o.x = (unsigned)s[0] | ((unsigned)s[TP] << 16); o.y = (unsigned)s[2 * TP] | ((unsigned)s[3 * TP] << 16);
        o.z = (unsigned)s[4 * TP] | ((unsigned)s[5 * TP] << 16); o.w = (unsigned)s[6 * TP] | ((unsigned)s[7 * TP] << 16);
        *(u32x4*)(WT + (size_t)(n0 + n) * K + k0 + 8 * ch) = o; }
    LDS_WAIT(); asm volatile("" ::: "memory");
}
__device__ __forceinline__ void rms_row_to_bf16(const float* xrow, const float* w, bf16_t* orow, int lane) {
    const f32x4* xr = (const f32x4*)xrow + lane; const f32x4* wr = (const f32x4*)w + lane;
    f32x4 v[8]; float s = 0.f;
#pragma unroll
    for (int j = 0; j < 8; ++j) { v[j] = xr[64 * j]; s += (v[j].x * v[j].x + v[j].y * v[j].y) + (v[j].z * v[j].z + v[j].w * v[j].w); }
    const float r = rsqrtf(wave_sum(s) * (1.f / D) + EPS);
    unsigned long long* o8 = (unsigned long long*)orow + lane;
#pragma unroll
    for (int j = 0; j < 8; ++j) { const f32x4 ww = wr[64 * j];
        o8[64 * j] = (unsigned long long)pk2(v[j].x * r * ww.x, v[j].y * r * ww.y) | ((unsigned long long)pk2(v[j].z * r * ww.z, v[j].w * r * ww.w) << 32); }
}
__device__ __forceinline__ int t5_bucket(int n) {
    if (n < 16) return n;
    int large = 16 + (int)(logf((float)n / 16.f) / 2.0794415416798357f * 16.f);
    return large < 31 ? large : 31;
}
__device__ __forceinline__ void p0_prologue(Frame& F) {
    LAS bf16_t* scr = (LAS bf16_t*)(F.lds + F.wave * 16896);
    const int gw = F.bid * NWAVES + F.wave, NGW = F.G * NWAVES;
    constexpr int I_IN = 32 * (NIN / 128), I_MKV = 32 * 16, I_BR = 16 * 16, I_OUT = 32 * 16;
    constexpr int NITEMS = I_IN + I_MKV + 3 * I_BR + I_OUT;
    bf16_t* WINT = (bf16_t*)(F.ws + WS_WIN); bf16_t* WMKVT = (bf16_t*)(F.ws + WS_WMKV); bf16_t* WBT = (bf16_t*)(F.ws + WS_WB); bf16_t* WOT = (bf16_t*)(F.ws + WS_WO);
    for (int it = gw; it < NITEMS; it += NGW) {
        int r = it;
        if (r < I_IN) { p0_transpose_item<true>(F.in[I_WIN], D, IN_COLS, WINT, scr, r / (NIN / 128), r % (NIN / 128), F.lane); continue; } r -= I_IN;
        if (r < I_MKV) { p0_transpose_item<false>(F.in[I_WMKV], D, 2048, WMKVT, scr, r / 16, r % 16, F.lane); continue; } r -= I_MKV;
        if (r < 3 * I_BR) { const int b = r / I_BR, q = r % I_BR; p0_transpose_item<false>(F.in[I_WBR] + (size_t)b * 1024 * 2048, 1024, 2048, WBT + (size_t)b * 2048 * 1024, scr, q / 16, q % 16, F.lane); continue; } r -= 3 * I_BR;
        p0_transpose_item<false>(F.in[I_WOUT], D, 2048, WOT, scr, r / 16, r % 16, F.lane);
    }
    bf16_t* XN = (bf16_t*)((unsigned char*)F.out + DO_XN); bf16_t* MEMN = (bf16_t*)(F.ws + WS_MEMN);
    for (int m = gw; m < M + 512; m += NGW) {
        if (m < MP) rms_row_to_bf16(F.in[I_XP] + (size_t)m * D, F.in[I_NORM_IN], XN + (size_t)m * D, F.lane);
        else if (m < M) rms_row_to_bf16(F.in[I_XS] + (size_t)(m - MP) * D, F.in[I_NORM_IN], XN + (size_t)m * D, F.lane);
        else rms_row_to_bf16(F.in[I_MEMP] + (size_t)(m - M) * D, F.in[I_NORM_MEM], MEMN + (size_t)(m - M) * D, F.lane);
    }
    float* BT = (float*)(F.ws + WS_BTAB);
    for (int i = F.bid * NTHREADS + F.tid; i < 16 * 128; i += F.G * NTHREADS) { const int h = i >> 7, dist = i & 127; BT[i] = F.in[I_RELB][t5_bucket(dist) * 16 + h]; }
}

struct SchedP1 {
    int G, c; const unsigned char* ws; const unsigned char* xn;
    __device__ __forceinline__ int ntiles(const pg8::Unit&) const { return D / 64; }
    static constexpr int NM = M / 256, NN = NIN / 256, NU0 = NM * NN, NU = NU0 + 16;
    __device__ __forceinline__ bool next(int i, pg8::Unit& u) const {
        const long L = (long)i * G + c; if (L >= NU) return false;
        if (L < NU0) { pg8::tile_of((int)L, NM, NN, u.pm, u.pn); u.job = 0; } else { const int q = (int)L - NU0; u.pm = q >> 3; u.pn = q & 7; u.job = 1; }
        return true;
    }
    __device__ __forceinline__ void ptrs(const pg8::Unit& u, const char*& A, const char*& B) const {
        const size_t tstep = (size_t)256 * D * 2;
        if (u.job == 0) { A = (const char*)xn + (size_t)u.pm * tstep; B = (const char*)ws + WS_WIN + (size_t)u.pn * tstep; }
        else { A = (const char*)ws + WS_MEMN + (size_t)u.pm * tstep; B = (const char*)ws + WS_WMKV + (size_t)u.pn * tstep; }
    }
};
struct EpiP1 {
    unsigned char* ws; float* out;
    __device__ __forceinline__ void operator()(const f32x4 (&acc)[2][2][4][2], const pg8::Unit& u, int wr, int wc, int fr, int fq) const {
        const int row0 = u.pm * 256 + wr * 64 + fr;
        const int cin = wc * 32 + 8 * fq;
        if (u.job == 1) {
            bf16_t* MK = (bf16_t*)(ws + WS_MEMKV);
#pragma unroll
            for (int ai = 0; ai < 2; ++ai)
#pragma unroll
                for (int m = 0; m < 4; ++m) { const int r = row0 + ai * 128 + m * 16;
#pragma unroll
                    for (int bj = 0; bj < 2; ++bj) { const int c = u.pn * 256 + bj * 128 + cin; const f32x4 v0 = acc[ai][bj][m][0], v1 = acc[ai][bj][m][1];
                        float* o = out + (c < 1024 ? O_MKP + (size_t)r * 1024 + c : O_MVP + (size_t)r * 1024 + (c - 1024));
                        *(f32x4*)o = v0; *(f32x4*)(o + 4) = v1;
                        u32x4 w; w.x = pg8::cvt_pk_bf16(v0[0], v0[1]); w.y = pg8::cvt_pk_bf16(v0[2], v0[3]); w.z = pg8::cvt_pk_bf16(v1[0], v1[1]); w.w = pg8::cvt_pk_bf16(v1[2], v1[3]);
                        *(u32x4*)(MK + (size_t)r * 2048 + c) = w;
                        if (c >= 1024) { bf16_t* MVT = (bf16_t*)(ws + WS_MVT) + ((size_t)((r >> 8) * 4 + ((c - 1024) >> 8)) * 256 + ((c - 1024) & 255)) * 256 + (r & 255);
                            MVT[0] = (bf16_t)(w.x & 0xffffu); MVT[256] = (bf16_t)(w.x >> 16); MVT[512] = (bf16_t)(w.y & 0xffffu); MVT[768] = (bf16_t)(w.y >> 16);
                            MVT[1024] = (bf16_t)(w.z & 0xffffu); MVT[1280] = (bf16_t)(w.z >> 16); MVT[1536] = (bf16_t)(w.w & 0xffffu); MVT[1792] = (bf16_t)(w.w >> 16); } } }
            return;
        }
        const int pn = u.pn;
        if (pn == 57) {
            if (wc == 0 && fq < 2) { float* GAB = (float*)(ws + WS_GAB);
#pragma unroll
                for (int ai = 0; ai < 2; ++ai)
#pragma unroll
                    for (int m = 0; m < 4; ++m) { const int r = row0 + ai * 128 + m * 16; float* o = GAB + (size_t)r * 16 + 8 * fq; *(f32x4*)o = acc[ai][0][m][0]; *(f32x4*)(o + 4) = acc[ai][0][m][1]; } }
            return;
        }
        bf16_t* base; int ld, ct, act = 0;
        if (pn < 12) { base = (bf16_t*)(ws + WS_QKV); ld = 3072; ct = pn; }
        else if (pn < 16) { base = (bf16_t*)(ws + WS_GZ); ld = 1024; ct = pn - 12; act = 1; }
        else if (pn < 20) { base = (bf16_t*)(ws + WS_SQ); ld = 1024; ct = pn - 16; }
        else if (pn < 24) { base = (bf16_t*)(ws + WS_SZ); ld = 1024; ct = pn - 20; act = 1; }
        else if (pn < 28) { base = (bf16_t*)(ws + WS_MQ); ld = 1024; ct = pn - 24; }
        else if (pn < 32) { base = (bf16_t*)(ws + WS_MZ); ld = 1024; ct = pn - 28; act = 1; }
        else if (pn < 56) { base = (bf16_t*)(ws + WS_GATES); ld = 6144; ct = pn - 32; act = 2; }
        else { base = (bf16_t*)(ws + WS_SKV); ld = 256; ct = 0; }
#pragma unroll
        for (int ai = 0; ai < 2; ++ai)
#pragma unroll
            for (int m = 0; m < 4; ++m) { bf16_t* rowp = base + (size_t)(row0 + ai * 128 + m * 16) * ld + ct * 256 + cin;
#pragma unroll
                for (int bj = 0; bj < 2; ++bj) { f32x4 v0 = acc[ai][bj][m][0], v1 = acc[ai][bj][m][1];
                    if (act == 1) {
#pragma unroll
                        for (int j = 0; j < 4; ++j) { v0[j] = siluf_(v0[j]); v1[j] = siluf_(v1[j]); } }
                    else if (act == 2) {
#pragma unroll
                        for (int j = 0; j < 4; ++j) { v0[j] = sigmoidf_(v0[j]); v1[j] = sigmoidf_(v1[j]); } }
                    u32x4 w; w.x = pg8::cvt_pk_bf16(v0[0], v0[1]); w.y = pg8::cvt_pk_bf16(v0[2], v0[3]); w.z = pg8::cvt_pk_bf16(v1[0], v1[1]); w.w = pg8::cvt_pk_bf16(v1[2], v1[3]);
                    *(u32x4*)(rowp + bj * 128) = w;
                    if (pn == 56 && bj == 1) { const int r = row0 + ai * 128 + m * 16;
                        if (r < MP) { bf16_t* vt = (bf16_t*)(ws + WS_VTS) + ((size_t)((r >> 13) * 2 + (cin >> 6)) * 64 + (cin & 63)) * SEQ + (r & (SEQ - 1));
                            vt[0] = (bf16_t)(w.x & 0xffffu); vt[SEQ] = (bf16_t)(w.x >> 16); vt[2 * SEQ] = (bf16_t)(w.y & 0xffffu); vt[3 * SEQ] = (bf16_t)(w.y >> 16);
                            vt[4 * SEQ] = (bf16_t)(w.z & 0xffffu); vt[5 * SEQ] = (bf16_t)(w.z >> 16); vt[6 * SEQ] = (bf16_t)(w.w & 0xffffu); vt[7 * SEQ] = (bf16_t)(w.w >> 16); } } } }
    }
};

__device__ __forceinline__ void gdn_gate_scalars(Frame& F, int r, int h) {
    const float* GAB = (const float*)(F.ws + WS_GAB); float* Gp = (float*)(F.ws + WS_G); float* Bp = (float*)(F.ws + WS_BETA);
    const float gb = GAB[(size_t)r * 16 + h], ga = GAB[(size_t)r * 16 + 8 + h];
    Bp[(size_t)r * 8 + h] = sigmoidf_(gb);
    const float xx = ga + F.in[I_DTB][h]; const float sp = xx > 20.f ? xx : log1pf(expf(xx));
    Gp[(size_t)r * 8 + h] = -expf(F.in[I_ALOG][h]) * sp;
}
__device__ __forceinline__ void conv_prompt_item(Frame& F, int item) {
    const int b = item >> 7, n = item & 127, row0 = b * SEQ + 64 * n, tid = F.tid;
    const bf16_t* QKV = (const bf16_t*)(F.ws + WS_QKV);
    bf16_t* QN = (bf16_t*)((unsigned char*)F.out + DO_QN); bf16_t* KN = (bf16_t*)((unsigned char*)F.out + DO_KN);
    bf16_t* KT = (bf16_t*)((unsigned char*)F.out + DO_KT); bf16_t* VT = (bf16_t*)((unsigned char*)F.out + DO_VT);
    const float* cw = F.in[I_CONVW];
    constexpr int SP = 136;
    LAS bf16_t* slab = (LAS bf16_t*)F.lds;
    { const int tok = tid >> 3, h = tid & 7; gdn_gate_scalars(F, row0 + tok, h); }
    const int t0 = tid >> 4, cg = (tid & 15) * 8;
    LAS float* cwl = (LAS float*)(F.lds + 32768);
    for (int i = tid; i < 4 * 3072 / 4; i += NTHREADS) ((LAS f32x4*)cwl)[i] = ((const f32x4*)cw)[i];
    __syncthreads();
    struct Slab { u32x4 x[2][4]; };
#define CONV_LOAD(S_, sl_) do { const int ch_ = ((sl_) >> 3) * 1024 + ((sl_) & 7) * 128 + cg; \
        _Pragma("unroll") for (int p = 0; p < 2; ++p) _Pragma("unroll") for (int j = 0; j < 4; ++j) { const int tk = t0 + 32 * p - 3 + j; \
            S_.x[p][j] = (64 * n + tk >= 0) ? *(const u32x4*)(QKV + (size_t)(row0 + tk) * 3072 + ch_) : (u32x4){0u, 0u, 0u, 0u}; } \
        } while (0)
#define CONV_SLAB(S_, sl_) do { const int part = (sl_) >> 3, h = (sl_) & 7; f32x4 wq[4][2]; \
        _Pragma("unroll") for (int j = 0; j < 4; ++j) { wq[j][0] = *(const LAS f32x4*)(cwl + j * 3072 + part * 1024 + h * 128 + cg); wq[j][1] = *(const LAS f32x4*)(cwl + j * 3072 + part * 1024 + h * 128 + cg + 4); } \
        _Pragma("unroll") for (int p = 0; p < 2; ++p) { \
            const int tok = t0 + 32 * p, r = row0 + tok; \
            float a[8]; \
            _Pragma("unroll") for (int e = 0; e < 8; ++e) a[e] = 0.f; \
            _Pragma("unroll") for (int j = 0; j < 4; ++j) { const u32x4 v = S_.x[p][j]; \
                a[0] += bf2f(v.x & 0xffffu) * wq[j][0][0]; a[1] += bf2f(v.x >> 16) * wq[j][0][1]; a[2] += bf2f(v.y & 0xffffu) * wq[j][0][2]; a[3] += bf2f(v.y >> 16) * wq[j][0][3]; \
                a[4] += bf2f(v.z & 0xffffu) * wq[j][1][0]; a[5] += bf2f(v.z >> 16) * wq[j][1][1]; a[6] += bf2f(v.w & 0xffffu) * wq[j][1][2]; a[7] += bf2f(v.w >> 16) * wq[j][1][3]; } \
            _Pragma("unroll") for (int e = 0; e < 8; ++e) a[e] = siluf_(a[e]); \
            if (part < 2) { float ss = ((a[0] * a[0] + a[1] * a[1]) + (a[2] * a[2] + a[3] * a[3])) + ((a[4] * a[4] + a[5] * a[5]) + (a[6] * a[6] + a[7] * a[7])); \
                ss += __shfl_xor(ss, 1); ss += __shfl_xor(ss, 2); ss += __shfl_xor(ss, 4); ss += __shfl_xor(ss, 8); \
                if (cg == 0) ((float*)(F.ws + (part == 0 ? WS_SSQ : WS_SSK)))[(size_t)(row0 + t0 + 32 * p) * 8 + h] = ss; } \
            u32x4 o4; o4.x = pk2(a[0], a[1]); o4.y = pk2(a[2], a[3]); o4.z = pk2(a[4], a[5]); o4.w = pk2(a[6], a[7]); \
            const size_t o = (size_t)r * 1024 + h * 128 + cg; \
            if (part == 0) *(u32x4*)(QN + o) = o4; \
            else { if (part == 1) *(u32x4*)(KN + o) = o4; *(LAS u32x4*)(slab + tok * SP + cg) = o4; } \
            if (n == 127 && tok >= 61) { const u32x4 raw = S_.x[p][3]; float* cdst = F.out + O_GCP + ((size_t)b * 3 + (tok - 61)) * 3072 + part * 1024 + h * 128 + cg; \
                *(f32x4*)cdst = (f32x4){bf2f(raw.x & 0xffffu), bf2f(raw.x >> 16), bf2f(raw.y & 0xffffu), bf2f(raw.y >> 16)}; \
                *(f32x4*)(cdst + 4) = (f32x4){bf2f(raw.z & 0xffffu), bf2f(raw.z >> 16), bf2f(raw.w & 0xffffu), bf2f(raw.w >> 16)}; } \
        } \
        if (part > 0) { \
            __syncthreads(); \
            bf16_t* dst = (part == 1 ? KT : VT) + (size_t)((b * 8 + h) * 128 + n) * 8192; \
            _Pragma("unroll") for (int u = 0; u < 2; ++u) { const int e = tid + 512 * u, chn = 16 * (e >> 7) + (e & 15), tg = 4 * ((e >> 6) & 1) + ((e >> 4) & 3); const LAS bf16_t* s = slab + (8 * tg) * SP + chn; \
                u32x4 o4; o4.x = (unsigned)s[0] | ((unsigned)s[SP] << 16); o4.y = (unsigned)s[2 * SP] | ((unsigned)s[3 * SP] << 16); \
                o4.z = (unsigned)s[4 * SP] | ((unsigned)s[5 * SP] << 16); o4.w = (unsigned)s[6 * SP] | ((unsigned)s[7 * SP] << 16); \
                *(u32x4*)(dst + e * 8) = o4; } \
            __syncthreads(); \
        } } while (0)
    Slab s0, s1, s2;
    CONV_LOAD(s0, 0); CONV_LOAD(s1, 1);
#pragma unroll 1
    for (int sl = 0; sl < 24; sl += 3) {
        CONV_LOAD(s2, sl + 2); CONV_SLAB(s0, sl);
        if (sl + 3 < 24) CONV_LOAD(s0, sl + 3); CONV_SLAB(s1, sl + 1);
        if (sl + 4 < 24) CONV_LOAD(s1, sl + 4); CONV_SLAB(s2, sl + 2);
    }
#undef CONV_LOAD
#undef CONV_SLAB
}
__device__ __forceinline__ void conv_sample_items(Frame& F) {
    const int gw = F.bid * NWAVES + F.wave, NGW = F.G * NWAVES, lane = F.lane;
    const bf16_t* QKV = (const bf16_t*)(F.ws + WS_QKV);
    bf16_t* QN = (bf16_t*)((unsigned char*)F.out + DO_QN); bf16_t* KN = (bf16_t*)((unsigned char*)F.out + DO_KN); bf16_t* VNS = (bf16_t*)((unsigned char*)F.out + DO_VNS);
    const float* cw = F.in[I_CONVW];
    for (int it = gw; it < 128 * 8; it += NGW) {
        const int bd = it >> 3, h = it & 7;
        float xr[3][7][2], wv[3][4][2];
#pragma unroll
        for (int part = 0; part < 3; ++part) { const int ch = part * 1024 + h * 128 + 2 * lane;
#pragma unroll
            for (int i = 0; i < 3; ++i) { const float2 p2 = *(const float2*)(F.in[I_SCONV] + ((size_t)bd * 3 + i) * 3072 + ch); xr[part][i][0] = p2.x; xr[part][i][1] = p2.y; }
#pragma unroll
            for (int i = 0; i < 4; ++i) { const unsigned v = *(const unsigned*)(QKV + (size_t)(MP + bd * 4 + i) * 3072 + ch); xr[part][3 + i][0] = bf2f(v & 0xffffu); xr[part][3 + i][1] = bf2f(v >> 16); }
#pragma unroll
            for (int j = 0; j < 4; ++j) { const float2 w2 = *(const float2*)(cw + j * 3072 + ch); wv[part][j][0] = w2.x; wv[part][j][1] = w2.y; } }
#pragma unroll
        for (int s = 0; s < 4; ++s) {
            const int r = MP + bd * 4 + s;
            float y[3][2];
#pragma unroll
            for (int part = 0; part < 3; ++part) { float a0 = 0.f, a1 = 0.f;
#pragma unroll
                for (int j = 0; j < 4; ++j) { a0 += xr[part][s + j][0] * wv[part][j][0]; a1 += xr[part][s + j][1] * wv[part][j][1]; }
                y[part][0] = siluf_(a0); y[part][1] = siluf_(a1); }
            const float sq = wave_sum(y[0][0] * y[0][0] + y[0][1] * y[0][1]), sk = wave_sum(y[1][0] * y[1][0] + y[1][1] * y[1][1]);
            const float rq = rsqrtf(sq + EPS) * 0.08838834764831845f, rk = rsqrtf(sk + EPS);
            const size_t o = (size_t)r * 1024 + h * 128 + 2 * lane;
            *(unsigned*)(QN + o) = pk2(y[0][0] * rq, y[0][1] * rq);
            *(unsigned*)(KN + o) = pk2(y[1][0] * rk, y[1][1] * rk);
            *(unsigned*)(VNS + (size_t)(r - MP) * 1024 + h * 128 + 2 * lane) = pk2(y[2][0], y[2][1]);
            if (lane == 0) gdn_gate_scalars(F, r, h);
            if (s >= 1) { float* cdst = F.out + O_GCS + ((size_t)bd * 3 + (s - 1)) * 3072;
#pragma unroll
                for (int part = 0; part < 3; ++part) { const int ch = part * 1024 + h * 128 + 2 * lane; *(float2*)(cdst + ch) = make_float2(xr[part][3 + s][0], xr[part][3 + s][1]); } }
        }
    }
}
__device__ __forceinline__ void p2_conv(Frame& F) {
    for (int it = F.bid; it < 256; it += F.G) conv_prompt_item(F, it);
    conv_sample_items(F);
}

__device__ __forceinline__ f32x4 mfma16(bf16x8 a, bf16x8 b, f32x4 c) { return __builtin_amdgcn_mfma_f32_16x16x32_bf16(a, b, c, 0, 0, 0); }
__device__ __forceinline__ u32x2 pack4(f32x4 v) { u32x2 r; r.x = pk2(v[0], v[1]); r.y = pk2(v[2], v[3]); return r; }
__device__ __forceinline__ void prep_item(Frame& F, int item) {
    const int b = item >> 7, n = item & 127, row0 = b * SEQ + 64 * n, lane = F.lane, h = F.wave, c = lane & 15, q = lane >> 4;
    const int ci = (b * 8 + h) * 128 + n;
    const bf16_t* QN = (const bf16_t*)((const unsigned char*)F.out + DO_QN); const bf16_t* KN = (const bf16_t*)((const unsigned char*)F.out + DO_KN);
    const bf16_t* KT = (const bf16_t*)((const unsigned char*)F.out + DO_KT) + (size_t)ci * 8192; const bf16_t* VT = (const bf16_t*)((const unsigned char*)F.out + DO_VT) + (size_t)ci * 8192;
    bf16_t* NEGW = (bf16_t*)(F.ws + WS_NEGW) + (size_t)ci * 8192; bf16_t* UT = (bf16_t*)(F.ws + WS_UT) + (size_t)ci * 8192; bf16_t* ATT = (bf16_t*)(F.ws + WS_ATT) + (size_t)ci * 4096;
    const float* Gp = (const float*)(F.ws + WS_G); const float* Bp = (const float*)(F.ws + WS_BETA);
    float* GC = (float*)(F.ws + WS_GC); float* DEC = (float*)(F.ws + WS_DEC); float* GT = (float*)(F.ws + WS_GT);
    LAS float* Als = (LAS float*)(F.lds + h * 18432);
    LAS float* gcs = Als + 4096; LAS float* bes = gcs + 64;
    float gc = Gp[(size_t)(row0 + lane) * 8 + h];
#pragma unroll
    for (int o = 1; o < 64; o <<= 1) { const float x = __shfl_up(gc, o); if (lane >= o) gc += x; }
    const float beta = Bp[(size_t)(row0 + lane) * 8 + h];
    const float gl = __shfl(gc, 63);
    const float sk = ((const float*)(F.ws + WS_SSK))[(size_t)(row0 + lane) * 8 + h], sq = ((const float*)(F.ws + WS_SSQ))[(size_t)(row0 + lane) * 8 + h];
    const float rk = rsqrtf(sk + EPS), rq = rsqrtf(sq + EPS) * 0.08838834764831845f;
    LAS float* rks = bes + 64; LAS float* rqs = rks + 64;
    gcs[lane] = gc; bes[lane] = beta; rks[lane] = rk; rqs[lane] = rq;
    GC[(size_t)(row0 + lane) * 8 + h] = __expf(gc) * rq; DEC[(size_t)ci * 64 + lane] = __expf(gl - gc) * rk; if (lane == 0) GT[ci] = __expf(gl);
    LDS_WAIT(); asm volatile("" ::: "memory");
    bf16x8 kf[4][4];
#pragma unroll
    for (int mt = 0; mt < 4; ++mt)
#pragma unroll
        for (int s = 0; s < 4; ++s) { const size_t o = (size_t)(row0 + 16 * mt + c) * 1024 + h * 128 + 32 * s + 8 * q; kf[mt][s] = *(const bf16x8*)(KN + o); }
#pragma unroll
    for (int mi = 0; mi < 4; ++mi) {
        const int ii = 16 * mi + c; const float gci = gcs[ii], bi = bes[ii] * rks[ii], rqi = rqs[ii];
        const bf16_t* qrow_p = QN + (size_t)(row0 + ii) * 1024 + h * 128 + 8 * q;
#pragma unroll
        for (int nj = 0; nj < 4; ++nj) {
            u32x2 av; av.x = 0u; av.y = 0u;
            if (nj <= mi) {
                f32x4 dk = {0.f, 0.f, 0.f, 0.f}, dq = {0.f, 0.f, 0.f, 0.f};
#pragma unroll
                for (int s = 0; s < 4; ++s) { dk = mfma16(kf[nj][s], kf[mi][s], dk); dq = mfma16(kf[nj][s], *(const bf16x8*)(qrow_p + 32 * s), dq); }
                const f32x4 gj = *(const LAS f32x4*)(gcs + 16 * nj + 4 * q), rkj = *(const LAS f32x4*)(rks + 16 * nj + 4 * q);
                f32x4 a, at;
#pragma unroll
                for (int r = 0; r < 4; ++r) { const int jj = 16 * nj + 4 * q + r; const float e = __expf(gci - gj[r]);
                    a[r] = (ii > jj) ? bi * rkj[r] * dk[r] * e : 0.f; at[r] = (ii >= jj) ? rqi * rkj[r] * dq[r] * e : 0.f; }
                *(LAS f32x4*)(Als + ii * 64 + 16 * nj + 4 * q) = a;
                av = pack4(at);
            }
            *(u32x2*)(ATT + ii * 64 + 16 * nj + 4 * q) = av;
        }
    }
    LDS_WAIT();
    float t[64];
#pragma unroll
    for (int i = 0; i < 64; ++i) {
        float acc = (lane == i) ? 1.f : 0.f;
#pragma unroll
        for (int m4 = 0; m4 < i; m4 += 4) { const f32x4 a = *(const LAS f32x4*)(Als + i * 64 + m4);
            acc -= a[0] * t[m4]; if (m4 + 1 < i) acc -= a[1] * t[m4 + 1]; if (m4 + 2 < i) acc -= a[2] * t[m4 + 2]; if (m4 + 3 < i) acc -= a[3] * t[m4 + 3]; }
        t[i] = acc;
    }
    LAS bf16_t* T1 = (LAS bf16_t*)Als; LAS bf16_t* T2 = T1 + 64 * 72;
    const float s1 = beta, s2 = -beta * __expf(gc) * rk;
    LDS_WAIT();
#pragma unroll
    for (int i = 0; i < 64; ++i) { T1[i * 72 + lane] = (bf16_t)f2bf(t[i] * s1); T2[i * 72 + lane] = (bf16_t)f2bf(t[i] * s2); }
    LDS_WAIT();
    bf16x8 t1f[4][2], t2f[4][2];
#pragma unroll
    for (int it = 0; it < 4; ++it)
#pragma unroll
        for (int s = 0; s < 2; ++s) { t1f[it][s] = *(const LAS bf16x8*)(T1 + (16 * it + c) * 72 + 32 * s + 8 * q); t2f[it][s] = *(const LAS bf16x8*)(T2 + (16 * it + c) * 72 + 32 * s + 8 * q); }
#pragma unroll 2
    for (int dt = 0; dt < 8; ++dt) {
        bf16x8 vb[2], ka[2];
#pragma unroll
        for (int s = 0; s < 2; ++s) { vb[s] = *(const bf16x8*)(VT + ((dt * 2 + s) * 64 + lane) * 8); ka[s] = *(const bf16x8*)(KT + ((dt * 2 + s) * 64 + lane) * 8); }
#pragma unroll
        for (int it = 0; it < 4; ++it) {
            f32x4 du = {0.f, 0.f, 0.f, 0.f}, dw = {0.f, 0.f, 0.f, 0.f};
            du = mfma16(t1f[it][0], vb[0], du); dw = mfma16(ka[0], t2f[it][0], dw);
            if (it >= 2) { du = mfma16(t1f[it][1], vb[1], du); dw = mfma16(ka[1], t2f[it][1], dw); }
            *(u32x2*)(UT + (16 * dt + c) * 64 + 16 * it + 4 * q) = pack4(du);
            *(u32x2*)(NEGW + ((it * 4 + (dt >> 1)) * 64 + (2 * (dt & 1) + (q >> 1)) * 16 + c) * 8 + 4 * (q & 1)) = pack4(dw);
        }
    }
    LDS_WAIT();
}
__device__ __forceinline__ void p2_prep(Frame& F) { for (int it = F.bid; it < 256; it += F.G) { prep_item(F, it); __syncthreads(); } }

__device__ __forceinline__ void scan_item(Frame& F, int bh, int sl) {
    const int lane = F.lane, w = F.wave, c = lane & 15, q = lane >> 4, dvs = 16 * sl;
    const bf16_t* KT = (const bf16_t*)((const unsigned char*)F.out + DO_KT); const bf16_t* NEGW = (const bf16_t*)(F.ws + WS_NEGW);
    bf16_t* UT = (bf16_t*)(F.ws + WS_UT); bf16_t* SN = (bf16_t*)(F.ws + WS_SN);
    const float* DEC = (const float*)(F.ws + WS_DEC); const float* GT = (const float*)(F.ws + WS_GT);
    LAS bf16_t* SS = (LAS bf16_t*)F.lds;
    LAS bf16_t* VS = SS + 16 * 136;
    LAS bf16_t* VU = VS + 16 * 72;
    f32x4 Sacc = {0.f, 0.f, 0.f, 0.f};
    for (int e = F.tid; e < 16 * 136 / 2; e += NTHREADS) ((LAS unsigned*)SS)[e] = 0u;
    struct Ops { bf16x8 wf[4], kf[2]; u32x2 u2; f32x4 dec4; float gt; };
#define SCAN_LOAD(o, n_) do { const size_t ci__ = (size_t)bh * 128 + ((n_) < 128 ? (n_) : 127); \
        _Pragma("unroll") for (int s = 0; s < 2; ++s) o.kf[s] = *(const bf16x8*)(KT + ci__ * 8192 + ((w * 2 + s) * 64 + lane) * 8); \
        o.gt = GT[ci__]; \
        if (w < 4) { _Pragma("unroll") for (int s = 0; s < 4; ++s) o.wf[s] = *(const bf16x8*)(NEGW + ci__ * 8192 + ((w * 4 + s) * 64 + lane) * 8); \
            o.u2 = *(const u32x2*)(UT + ci__ * 8192 + (dvs + c) * 64 + 16 * w + 4 * q); o.dec4 = *(const f32x4*)(DEC + ci__ * 64 + 16 * w + 4 * q); } } while (0)
#define SCAN_STEP(o, n_) do { const size_t ci = (size_t)bh * 128 + (n_); \
        if (w < 4) { \
            f32x4 v = {bf2f(o.u2.x & 0xffffu), bf2f(o.u2.x >> 16), bf2f(o.u2.y & 0xffffu), bf2f(o.u2.y >> 16)}; \
            _Pragma("unroll") for (int s = 0; s < 4; ++s) { const bf16x8 sf = *(const LAS bf16x8*)(SS + c * 136 + 32 * s + 8 * q); v = mfma16(o.wf[s], sf, v); } \
            *(LAS u32x2*)(VU + c * 72 + 16 * w + 4 * q) = pack4(v); \
            const f32x4 vd = v * o.dec4; \
            *(LAS u32x2*)(VS + c * 72 + 16 * w + 4 * q) = pack4(vd); \
        } else if (w == 4) {   \
            _Pragma("unroll") for (int u = 0; u < 4; ++u) { const int p = lane + 64 * u, r = p >> 4, cc = p & 15; \
                *(u32x4*)(SN + ci * 16384 + (dvs + r) * 128 + cc * 8) = *(const LAS u32x4*)(SS + r * 136 + cc * 8); } \
        } \
        asm volatile("s_waitcnt lgkmcnt(0)" ::: "memory"); __builtin_amdgcn_s_barrier(); asm volatile("" ::: "memory"); \
        Sacc = Sacc * o.gt; \
        _Pragma("unroll") for (int s = 0; s < 2; ++s) { const bf16x8 vf = *(const LAS bf16x8*)(VS + c * 72 + 32 * s + 8 * q); Sacc = mfma16(o.kf[s], vf, Sacc); } \
        if (w == 5) {   \
            _Pragma("unroll") for (int u = 0; u < 2; ++u) { const int p = lane + 64 * u, r = p >> 3, cc = p & 7; \
                *(u32x4*)(UT + ci * 8192 + (dvs + r) * 64 + cc * 8) = *(const LAS u32x4*)(VU + r * 72 + cc * 8); } } \
        { const u32x2 sp = pack4(Sacc); *(LAS u32x2*)(SS + c * 136 + 16 * w + 4 * q) = sp; } \
        asm volatile("s_waitcnt lgkmcnt(0)" ::: "memory"); __builtin_amdgcn_s_barrier(); asm volatile("" ::: "memory"); } while (0)
    Ops o0, o1, o2, o3;
    SCAN_LOAD(o0, 0); SCAN_LOAD(o1, 1); SCAN_LOAD(o2, 2);
    asm volatile("s_waitcnt lgkmcnt(0)" ::: "memory"); __builtin_amdgcn_s_barrier(); asm volatile("" ::: "memory");
#pragma unroll 1
    for (int n0 = 0; n0 < 128; n0 += 4) {
        SCAN_LOAD(o3, n0 + 3); SCAN_STEP(o0, n0);
        SCAN_LOAD(o0, n0 + 4); SCAN_STEP(o1, n0 + 1);
        SCAN_LOAD(o1, n0 + 5); SCAN_STEP(o2, n0 + 2);
        SCAN_LOAD(o2, n0 + 6); SCAN_STEP(o3, n0 + 3);
    }
#undef SCAN_LOAD
#undef SCAN_STEP
    float* so = F.out + O_GSP + (size_t)bh * 16384;
#pragma unroll
    for (int r = 0; r < 4; ++r) so[(size_t)(16 * w + 4 * q + r) * 128 + dvs + c] = Sacc[r];
}

__device__ __forceinline__ void gdn_out_item(Frame& F, int item) {
    const int b = item >> 7, n = item & 127, row0 = b * SEQ + 64 * n, lane = F.lane, h = F.wave, c = lane & 15, q = lane >> 4;
    const size_t ci = (size_t)(b * 8 + h) * 128 + n;
    const bf16_t* QN = (const bf16_t*)((const unsigned char*)F.out + DO_QN);
    const bf16_t* SN = (const bf16_t*)(F.ws + WS_SN) + ci * 16384; const bf16_t* VNT = (const bf16_t*)(F.ws + WS_UT) + ci * 8192; const bf16_t* ATT = (const bf16_t*)(F.ws + WS_ATT) + ci * 4096;
    const float* GC = (const float*)(F.ws + WS_GC); const bf16_t* GZ = (const bf16_t*)(F.ws + WS_GZ); bf16_t* OG = (bf16_t*)(F.ws + WS_OG); const float* gn = F.in[I_GNORM];
    LAS bf16_t* ol = (LAS bf16_t*)(F.lds + h * 18432);
    bf16x8 qf[4][4], af[4][2]; float egc[4], ss[4];
#pragma unroll
    for (int it = 0; it < 4; ++it) { const int i = 16 * it + c; const size_t r = (size_t)row0 + i;
#pragma unroll
        for (int s = 0; s < 4; ++s) qf[it][s] = *(const bf16x8*)(QN + r * 1024 + h * 128 + 32 * s + 8 * q);
#pragma unroll
        for (int s = 0; s < 2; ++s) af[it][s] = *(const bf16x8*)(ATT + i * 64 + 32 * s + 8 * q);
        egc[it] = GC[r * 8 + h]; ss[it] = 0.f; }
#pragma unroll 1
    for (int dt = 0; dt < 8; ++dt) {
        bf16x8 sf[4], vf[2];
#pragma unroll
        for (int s = 0; s < 4; ++s) sf[s] = *(const bf16x8*)(SN + (16 * dt + c) * 128 + 32 * s + 8 * q);
#pragma unroll
        for (int s = 0; s < 2; ++s) vf[s] = *(const bf16x8*)(VNT + (16 * dt + c) * 64 + 32 * s + 8 * q);
#pragma unroll
        for (int it = 0; it < 4; ++it) {
            f32x4 a = {0.f, 0.f, 0.f, 0.f};
#pragma unroll
            for (int s = 0; s < 4; ++s) a = mfma16(sf[s], qf[it][s], a);
            a = a * egc[it];
#pragma unroll
            for (int s = 0; s < 2; ++s) a = mfma16(vf[s], af[it][s], a);
            ss[it] += (a[0] * a[0] + a[1] * a[1]) + (a[2] * a[2] + a[3] * a[3]);
            *(LAS u32x2*)(ol + (16 * it + c) * 136 + 16 * dt + 4 * q) = pack4(a);
        }
    }
    float rs[4];
#pragma unroll
    for (int it = 0; it < 4; ++it) { float s = ss[it]; s += __shfl_xor(s, 16); s += __shfl_xor(s, 32); rs[it] = rsqrtf(s * (1.f / 128.f) + EPS); }
    LDS_WAIT();
#pragma unroll
    for (int it = 0; it < 4; ++it)
#pragma unroll
        for (int dt = 0; dt < 8; ++dt) { const size_t o = ((size_t)row0 + 16 * it + c) * 1024 + h * 128 + 16 * dt + 4 * q; const u32x2 z = *(const u32x2*)(GZ + o); const f32x4 g4 = *(const f32x4*)(gn + 16 * dt + 4 * q);
            const u32x2 pv = *(const LAS u32x2*)(ol + (16 * it + c) * 136 + 16 * dt + 4 * q); f32x4 v;
            v[0] = bf2f(pv.x & 0xffffu) * rs[it] * g4[0] * bf2f(z.x & 0xffffu); v[1] = bf2f(pv.x >> 16) * rs[it] * g4[1] * bf2f(z.x >> 16);
            v[2] = bf2f(pv.y & 0xffffu) * rs[it] * g4[2] * bf2f(z.y & 0xffffu); v[3] = bf2f(pv.y >> 16) * rs[it] * g4[3] * bf2f(z.y >> 16);
            *(u32x2*)(OG + o) = pack4(v); }
    LDS_WAIT();
}

__device__ __forceinline__ void gdn_seq_item(Frame& F, int row0, int L, int h, const float* S0, float* Sout, bf16_t* OG) {
    const bf16_t* QN = (const bf16_t*)((unsigned char*)F.out + DO_QN); const bf16_t* KN = (const bf16_t*)((unsigned char*)F.out + DO_KN); const bf16_t* VNS = (const bf16_t*)((unsigned char*)F.out + DO_VNS);
    const float* Gp = (const float*)(F.ws + WS_G); const float* Bp = (const float*)(F.ws + WS_BETA);
    const int tid = F.tid, dvc = tid & 127, dkq = tid >> 7;
    constexpr int TB = 32;
    LAS float* sq = (LAS float*)F.lds;
    LAS float* sk = sq + TB * 128;
    LAS float* sv = sk + TB * 128;
    LAS float* sg = sv + TB * 128;
    LAS float* red = sg + 2 * TB;
    LAS float* redqk = red + 2 * 2 * 4 * 128;
    float S[32];
#pragma unroll
    for (int i = 0; i < 32; ++i) S[i] = S0 ? S0[(size_t)(32 * dkq + i) * 128 + dvc] : 0.f;
    int buf = 0;
    for (int t0 = 0; t0 < L; t0 += TB) {
        const int nb = (L - t0) < TB ? (L - t0) : TB;
        __syncthreads();
        for (int e = tid; e < nb * 128; e += NTHREADS) { const int tt = e >> 7, c = e & 127; const size_t o = (size_t)(row0 + t0 + tt) * 1024 + h * 128 + c;
            sq[e] = bf2f(QN[o]); sk[e] = bf2f(KN[o]); sv[e] = bf2f(VNS[o - (size_t)MP * 1024]); }
        if (tid < nb) { sg[tid] = expf(Gp[(size_t)(row0 + t0 + tid) * 8 + h]); sg[TB + tid] = Bp[(size_t)(row0 + t0 + tid) * 8 + h]; }
        __syncthreads();
        for (int tt = 0; tt < nb; ++tt) {
            const LAS float* kq = sk + tt * 128 + 32 * dkq; const LAS float* qq = sq + tt * 128 + 32 * dkq;
            float pk = 0.f, pq = 0.f, pqk = 0.f;
#pragma unroll
            for (int i = 0; i < 32; ++i) { const float kk = kq[i], qv = qq[i]; pk += kk * S[i]; pq += qv * S[i]; pqk += qv * kk; }
            LAS float* rb = red + buf * 1024;
            rb[dkq * 128 + dvc] = pk; rb[512 + dkq * 128 + dvc] = pq; if (dvc == 0) redqk[buf * 4 + dkq] = pqk;
            __syncthreads();
            const float kS = (rb[dvc] + rb[128 + dvc]) + (rb[256 + dvc] + rb[384 + dvc]);
            const float qS = (rb[512 + dvc] + rb[640 + dvc]) + (rb[768 + dvc] + rb[896 + dvc]);
            const float qk = (redqk[buf * 4] + redqk[buf * 4 + 1]) + (redqk[buf * 4 + 2] + redqk[buf * 4 + 3]);
            const float e = sg[tt], beta = sg[TB + tt];
            const float vnew = beta * (sv[tt * 128 + dvc] - e * kS);
            const float o = e * qS + qk * vnew;
#pragma unroll
            for (int i = 0; i < 32; ++i) S[i] = e * S[i] + kq[i] * vnew;
            if (dkq == 0) OG[(size_t)(row0 + t0 + tt) * 1024 + h * 128 + dvc] = (bf16_t)f2bf(o);
            buf ^= 1;
        }
    }
#pragma unroll
    for (int i = 0; i < 32; ++i) Sout[(size_t)(32 * dkq + i) * 128 + dvc] = S[i];
    __syncthreads();
}
__device__ __forceinline__ void p2_gdn_sample(Frame& F, int wk, int nwk, int lo, int hi) {
    bf16_t* OG = (bf16_t*)(F.ws + WS_OG);
    for (int q = lo + wk; q < hi; q += nwk) { const int bd = q >> 3, h = q & 7; gdn_seq_item(F, MP + bd * 4, 4, h, F.in[I_SGDN] + (size_t)q * 16384, F.out + O_GSS + (size_t)q * 16384, OG); }
}
__device__ __forceinline__ void p2_gdn_norm_sample(Frame& F) {
    const int gw = F.bid * NWAVES + F.wave, NGW = F.G * NWAVES, lane = F.lane;
    bf16_t* OG = (bf16_t*)(F.ws + WS_OG); const bf16_t* GZ = (const bf16_t*)(F.ws + WS_GZ); const float* gn = F.in[I_GNORM];
    for (int it = gw; it < MS * 8; it += NGW) {
        const size_t o = (size_t)(MP + (it >> 3)) * 1024 + (it & 7) * 128 + 2 * lane;
        const unsigned v = *(const unsigned*)(OG + o), z = *(const unsigned*)(GZ + o);
        const float a = bf2f(v & 0xffffu), b = bf2f(v >> 16);
        const float r = rsqrtf(wave_sum(a * a + b * b) * (1.f / 128.f) + EPS);
        *(unsigned*)(OG + o) = pk2(a * r * gn[2 * lane] * bf2f(z & 0xffffu), b * r * gn[2 * lane + 1] * bf2f(z >> 16));
    }
}

__device__ __forceinline__ void swa_wave_item(Frame& F, bool sample, int bidx, int t, int kv) {
    const int lane = F.lane;
    LAS float* qs = (LAS float*)(F.lds + F.wave * 8192);
    LAS float* ps = qs + 512;
    const bf16_t* SQ = (const bf16_t*)(F.ws + WS_SQ); const bf16_t* SKV = (const bf16_t*)(F.ws + WS_SKV); const bf16_t* SZ = (const bf16_t*)(F.ws + WS_SZ);
    const float* BT = (const float*)(F.ws + WS_BTAB);
    const int row = sample ? MP + bidx * 4 + t : bidx * SEQ + t;
    const int qpos = sample ? 128 + t : t;
    for (int e = lane; e < 512; e += 64) qs[e] = bf2f(SQ[(size_t)row * 1024 + kv * 512 + e]);
    LDS_WAIT();
#pragma unroll 1
    for (int u = 0; u < 2; ++u) {
        const int j = lane + 64 * u; const int kp = qpos - j;
        float kr[64];
        const bool valid = kp >= 0;
        if (valid) {
            if (sample && kp < 128) { const float* p = F.in[I_CSK] + (((size_t)bidx * 128 + kp) * 2 + kv) * 64;
#pragma unroll
                for (int d = 0; d < 64; d += 4) { const f32x4 v = *(const f32x4*)(p + d); kr[d] = v.x; kr[d + 1] = v.y; kr[d + 2] = v.z; kr[d + 3] = v.w; } }
            else { const int krow = sample ? MP + bidx * 4 + (kp - 128) : bidx * SEQ + kp; const bf16_t* p = SKV + (size_t)krow * 256 + kv * 64;
#pragma unroll
                for (int d = 0; d < 64; d += 8) { const u32x4 v = *(const u32x4*)(p + d);
                    kr[d] = bf2f(v.x & 0xffffu); kr[d + 1] = bf2f(v.x >> 16); kr[d + 2] = bf2f(v.y & 0xffffu); kr[d + 3] = bf2f(v.y >> 16);
                    kr[d + 4] = bf2f(v.z & 0xffffu); kr[d + 5] = bf2f(v.z >> 16); kr[d + 6] = bf2f(v.w & 0xffffu); kr[d + 7] = bf2f(v.w >> 16); } }
        } else {
#pragma unroll
            for (int d = 0; d < 64; ++d) kr[d] = 0.f;
        }
#pragma unroll 1
        for (int g = 0; g < 8; ++g) { float a = 0.f;
#pragma unroll
            for (int d = 0; d < 64; d += 4) { const f32x4 qv = *(const LAS f32x4*)(qs + g * 64 + d); a += kr[d] * qv.x + kr[d + 1] * qv.y + kr[d + 2] * qv.z + kr[d + 3] * qv.w; }
            ps[g * 128 + j] = valid ? a * 0.125f + BT[(kv * 8 + g) * 128 + j] : -INFINITY; }
    }
    LDS_WAIT();
    float inv[8];
#pragma unroll
    for (int g = 0; g < 8; ++g) {
        const float sink = F.in[I_SINKS][kv * 8 + g];
        const float l0 = ps[g * 128 + lane], l1 = ps[g * 128 + 64 + lane];
        const float mx = fmaxf(wave_max(fmaxf(l0, l1)), sink);
        const float p0 = __expf(l0 - mx), p1 = __expf(l1 - mx);
        const float den = wave_sum(p0 + p1) + __expf(sink - mx);
        inv[g] = 1.f / den;
        ps[g * 128 + lane] = p0; ps[g * 128 + 64 + lane] = p1;
    }
    LDS_WAIT();
    float o[8];
#pragma unroll
    for (int g = 0; g < 8; ++g) o[g] = 0.f;
#pragma unroll 1
    for (int j0 = 0; j0 < 128; j0 += 8) {
        float vv[8];
#pragma unroll
        for (int u = 0; u < 8; ++u) { int kp = qpos - (j0 + u); kp = kp < 0 ? 0 : kp;
            if (sample && kp < 128) vv[u] = F.in[I_CSV][(((size_t)bidx * 128 + kp) * 2 + kv) * 64 + lane];
            else { const int krow = sample ? MP + bidx * 4 + (kp - 128) : bidx * SEQ + kp; vv[u] = bf2f(SKV[(size_t)krow * 256 + 128 + kv * 64 + lane]); } }
#pragma unroll
        for (int u = 0; u < 8; ++u)
#pragma unroll
            for (int g = 0; g < 8; ++g) o[g] += ps[g * 128 + j0 + u] * vv[u];
    }
    bf16_t* OS = (bf16_t*)(F.ws + WS_OS);
#pragma unroll
    for (int g = 0; g < 8; ++g) { const size_t oo = (size_t)row * 1024 + (kv * 8 + g) * 64 + lane; OS[oo] = (bf16_t)f2bf(o[g] * inv[g] * bf2f(SZ[oo])); }
    LDS_WAIT();
}
__device__ __forceinline__ bf16x8 cat8(u32x2 a, u32x2 b) { u32x4 t; t.x = a.x; t.y = a.y; t.z = b.x; t.w = b.y; return __builtin_bit_cast(bf16x8, t); }
__device__ __forceinline__ void mem_mfma_item(Frame& F, int b, int h, int qt) {
    const int lane = F.lane, c = lane & 15, q = lane >> 4;
    const bf16_t* Kp = (const bf16_t*)(F.ws + WS_MEMKV) + (size_t)(b * 256) * 2048 + h * 256;
    const bf16_t* VTp = (const bf16_t*)(F.ws + WS_MVT) + (size_t)((b * 4 + h) * 256) * 256;
    const bf16_t* MQ = (const bf16_t*)(F.ws + WS_MQ); const bf16_t* MZ = (const bf16_t*)(F.ws + WS_MZ); bf16_t* OM = (bf16_t*)(F.ws + WS_OM);
    const size_t qrow = (size_t)b * SEQ + 16 * qt + c;
    bf16x8 qf[8];
#pragma unroll
    for (int s = 0; s < 8; ++s) qf[s] = *(const bf16x8*)(MQ + qrow * 1024 + h * 256 + 32 * s + 8 * q);
    f32x4 sacc[16];
#pragma unroll
    for (int mt = 0; mt < 16; ++mt) { f32x4 a = {0.f, 0.f, 0.f, 0.f};
#pragma unroll
        for (int s = 0; s < 8; ++s) a = mfma16(*(const bf16x8*)(Kp + (size_t)(16 * mt + c) * 2048 + 32 * s + 8 * q), qf[s], a);
        sacc[mt] = a; }
    float mx = -INFINITY;
#pragma unroll
    for (int mt = 0; mt < 16; ++mt) mx = fmaxf(mx, fmaxf(fmaxf(sacc[mt][0], sacc[mt][1]), fmaxf(sacc[mt][2], sacc[mt][3])));
    mx = fmaxf(mx, __shfl_xor(mx, 16)); mx = fmaxf(mx, __shfl_xor(mx, 32));
    float sum = 0.f; const float sc = 0.0625f * 1.4426950408889634f;
#pragma unroll
    for (int mt = 0; mt < 16; ++mt)
#pragma unroll
        for (int r = 0; r < 4; ++r) { const float p = exp2f((sacc[mt][r] - mx) * sc); sacc[mt][r] = p; sum += p; }
    sum += __shfl_xor(sum, 16); sum += __shfl_xor(sum, 32);
    const float inv = 1.f / sum;
    bf16x8 pf[8];
#pragma unroll
    for (int ks = 0; ks < 8; ++ks) pf[ks] = cat8(pack4(sacc[2 * ks]), pack4(sacc[2 * ks + 1]));
#pragma unroll 4
    for (int dt = 0; dt < 16; ++dt) { f32x4 o = {0.f, 0.f, 0.f, 0.f};
#pragma unroll
        for (int ks = 0; ks < 8; ++ks) { const bf16_t* vp = VTp + (size_t)(16 * dt + c) * 256 + 32 * ks + 4 * q;
            o = mfma16(cat8(*(const u32x2*)vp, *(const u32x2*)(vp + 16)), pf[ks], o); }
        const size_t oo = qrow * 1024 + h * 256 + 16 * dt + 4 * q; const u32x2 z = *(const u32x2*)(MZ + oo);
        o[0] *= inv * bf2f(z.x & 0xffffu); o[1] *= inv * bf2f(z.x >> 16); o[2] *= inv * bf2f(z.y & 0xffffu); o[3] *= inv * bf2f(z.y >> 16);
        *(u32x2*)(OM + oo) = pack4(o); }
}
__device__ __forceinline__ void swa_mfma_item(Frame& F, int b, int h, int a) {
    const int lane = F.lane, c = lane & 15, q = lane >> 4, kv = h >> 3;
    const bf16_t* SQ = (const bf16_t*)(F.ws + WS_SQ); const bf16_t* SKV = (const bf16_t*)(F.ws + WS_SKV); const bf16_t* SZ = (const bf16_t*)(F.ws + WS_SZ); bf16_t* OS = (bf16_t*)(F.ws + WS_OS);
    const bf16_t* VTp = (const bf16_t*)(F.ws + WS_VTS) + (size_t)((b * 2 + kv) * 64) * SEQ;
    const LAS float* BTl = (const LAS float*)(F.lds + LDS_BT) + h * 128;
    const size_t qrow = (size_t)b * SEQ + 16 * a + c;
    bf16x8 qf[2];
#pragma unroll
    for (int s = 0; s < 2; ++s) qf[s] = *(const bf16x8*)(SQ + qrow * 1024 + h * 64 + 32 * s + 8 * q);
    f32x4 p[10];
    const float sink = F.in[I_SINKS][h];
    float mx = sink;
#pragma unroll
    for (int u = 0; u < 9; ++u) {
        const int kbase = 16 * (a - 8 + u);
        f32x4 d = {0.f, 0.f, 0.f, 0.f};
        if (kbase >= 0) {
#pragma unroll
            for (int s = 0; s < 2; ++s) d = mfma16(*(const bf16x8*)(SKV + ((size_t)b * SEQ + kbase + c) * 256 + kv * 64 + 32 * s + 8 * q), qf[s], d);
        }
#pragma unroll
        for (int r = 0; r < 4; ++r) { const int dist = (16 * a + c) - (kbase + 4 * q + r); const bool valid = kbase >= 0 && dist >= 0 && dist < 128;
            const float l = valid ? d[r] * 0.125f + BTl[dist & 127] : -INFINITY; d[r] = l; mx = fmaxf(mx, l); }
        p[u] = d;
    }
    mx = fmaxf(mx, __shfl_xor(mx, 16)); mx = fmaxf(mx, __shfl_xor(mx, 32));
    float sum = 0.f;
#pragma unroll
    for (int u = 0; u < 9; ++u)
#pragma unroll
        for (int r = 0; r < 4; ++r) { const float e = __expf(p[u][r] - mx); p[u][r] = e; sum += e; }
    p[9] = (f32x4){0.f, 0.f, 0.f, 0.f};
    sum += __shfl_xor(sum, 16); sum += __shfl_xor(sum, 32);
    const float inv = 1.f / (sum + __expf(sink - mx));
    bf16x8 pf[5];
#pragma unroll
    for (int ks = 0; ks < 5; ++ks) pf[ks] = cat8(pack4(p[2 * ks]), pack4(p[2 * ks + 1]));
#pragma unroll
    for (int dt = 0; dt < 4; ++dt) { f32x4 o = {0.f, 0.f, 0.f, 0.f};
#pragma unroll
        for (int ks = 0; ks < 5; ++ks) { int m0 = 16 * (a - 8 + 2 * ks) + 4 * q, m1 = m0 + 16;
            m0 = m0 < 0 ? 0 : m0; m1 = m1 < 0 ? 0 : (m1 > SEQ - 4 ? SEQ - 4 : m1);
            const bf16_t* vp = VTp + (size_t)(16 * dt + c) * SEQ;
            o = mfma16(cat8(*(const u32x2*)(vp + m0), *(const u32x2*)(vp + m1)), pf[ks], o); }
        const size_t oo = qrow * 1024 + h * 64 + 16 * dt + 4 * q; const u32x2 z = *(const u32x2*)(SZ + oo);
        o[0] *= inv * bf2f(z.x & 0xffffu); o[1] *= inv * bf2f(z.x >> 16); o[2] *= inv * bf2f(z.y & 0xffffu); o[3] *= inv * bf2f(z.y >> 16);
        *(u32x2*)(OS + oo) = pack4(o); }
}
__device__ __forceinline__ void swa_wg_item(Frame& F, int b, int kv, int qb) {
    int lane_ = F.lane, tid_ = F.tid; asm volatile("" : "+v"(lane_), "+v"(tid_));
    const int lane = lane_, c = lane & 15, q = lane >> 4, tid = tid_, h = kv * 8 + F.wave;
    const bf16_t* SQ = (const bf16_t*)(F.ws + WS_SQ); const bf16_t* SKV = (const bf16_t*)(F.ws + WS_SKV); const bf16_t* SZ = (const bf16_t*)(F.ws + WS_SZ); bf16_t* OS = (bf16_t*)(F.ws + WS_OS);
    const bf16_t* VTg = (const bf16_t*)(F.ws + WS_VTS) + (size_t)((b * 2 + kv) * 64) * SEQ;
    LAS unsigned char* Kl = F.lds; LAS unsigned char* Vl = F.lds + 32768;
    const LAS float* BTl = (const LAS float*)(F.lds + LDS_BT) + h * 128;
    const int kstart = 128 * (qb - 1);
    __syncthreads();
    {   u32x4 kr[4], vr[4];
#pragma unroll
        for (int u = 0; u < 4; ++u) { const int p = tid + 512 * u, key = p >> 3, ch = p & 7;
            kr[u] = (kstart + key >= 0) ? *(const u32x4*)(SKV + ((size_t)b * SEQ + kstart + key) * 256 + kv * 64 + ch * 8) : (u32x4){0u, 0u, 0u, 0u};
            const int d = p >> 5, c16 = p & 31;
            vr[u] = (kstart + c16 * 8 >= 0) ? *(const u32x4*)(VTg + (size_t)d * SEQ + kstart + c16 * 8) : (u32x4){0u, 0u, 0u, 0u}; }
#pragma unroll
        for (int u = 0; u < 4; ++u) { const int p = tid + 512 * u, key = p >> 3, ch = p & 7;
            *(LAS u32x4*)(Kl + key * 128 + ((ch ^ ((key >> 1) & 7)) << 4)) = kr[u];
            const int d = p >> 5, c16 = p & 31;
            *(LAS u32x4*)(Vl + d * 512 + (((2 * c16) ^ (2 * (d & 15))) << 3)) = vr[u]; } }
    __syncthreads();
    const float L2E = 1.4426950408889634f;
    const float sink = F.in[I_SINKS][h] * L2E;
    float bias[9][4];
#pragma unroll
    for (int u = 0; u < 9; ++u)
#pragma unroll
        for (int r = 0; r < 4; ++r) { const int dist = 128 - 16 * u + c - 4 * q - r; bias[u][r] = (dist >= 0 && dist < 128) ? BTl[dist & 127] * L2E : -INFINITY; }
    bf16x8 qfa[8][2];
#pragma unroll
    for (int ap = 0; ap < 8; ++ap)
#pragma unroll
        for (int s = 0; s < 2; ++s) qfa[ap][s] = *(const bf16x8*)(SQ + ((size_t)b * SEQ + 128 * qb + 16 * ap + c) * 1024 + h * 64 + 32 * s + 8 * q);
#pragma unroll
    for (int ap = 0; ap < 8; ++ap) {
        const size_t qrow = (size_t)b * SEQ + 128 * qb + 16 * ap + c;
        bf16x8 qf[2]; qf[0] = qfa[ap][0]; qf[1] = qfa[ap][1];
        u32x2 zz[4];
#pragma unroll
        for (int dt = 0; dt < 4; ++dt) zz[dt] = *(const u32x2*)(SZ + qrow * 1024 + h * 64 + 16 * dt + 4 * q);
        f32x4 p[10]; float mx = sink;
#pragma unroll
        for (int u = 0; u < 9; ++u) {
            const int wt = ap + u, row = 16 * wt + c;
            f32x4 d = {0.f, 0.f, 0.f, 0.f};
#pragma unroll
            for (int s = 0; s < 2; ++s) d = mfma16(*(const LAS bf16x8*)(Kl + row * 128 + (((4 * s + q) ^ ((row >> 1) & 7)) << 4)), qf[s], d);
            const float tmask = ((qb > 0) || (wt >= 8)) ? 0.f : -INFINITY;
#pragma unroll
            for (int r = 0; r < 4; ++r) { const float l = d[r] * (0.125f * L2E) + (bias[u][r] + tmask); d[r] = l; mx = fmaxf(mx, l); }
            p[u] = d;
        }
        mx = fmaxf(mx, __shfl_xor(mx, 16)); mx = fmaxf(mx, __shfl_xor(mx, 32));
        float sum = 0.f;
#pragma unroll
        for (int u = 0; u < 9; ++u)
#pragma unroll
            for (int r = 0; r < 4; ++r) { const float e = exp2f(p[u][r] - mx); p[u][r] = e; sum += e; }
        p[9] = (f32x4){0.f, 0.f, 0.f, 0.f};
        sum += __shfl_xor(sum, 16); sum += __shfl_xor(sum, 32);
        const float inv = 1.f / (sum + exp2f(sink - mx));
        bf16x8 pf[5];
#pragma unroll
        for (int ks = 0; ks < 5; ++ks) pf[ks] = cat8(pack4(p[2 * ks]), pack4(p[2 * ks + 1]));
#pragma unroll
        for (int dt = 0; dt < 4; ++dt) { f32x4 o = {0.f, 0.f, 0.f, 0.f}; const int dd = 16 * dt + c; const LAS unsigned char* vrow = Vl + dd * 512; const int sw = 2 * (dd & 15);
#pragma unroll
            for (int ks = 0; ks < 5; ++ks) { const int wt0 = ap + 2 * ks; int wt1 = wt0 + 1; wt1 = wt1 > 15 ? 15 : wt1;
                const u32x2 v0 = *(const LAS u32x2*)(vrow + (((4 * wt0 + q) ^ sw) << 3)), v1 = *(const LAS u32x2*)(vrow + (((4 * wt1 + q) ^ sw) << 3));
                o = mfma16(cat8(v0, v1), pf[ks], o); }
            const size_t oo = qrow * 1024 + h * 64 + 16 * dt + 4 * q; const u32x2 z = zz[dt];
            o[0] *= inv * bf2f(z.x & 0xffffu); o[1] *= inv * bf2f(z.x >> 16); o[2] *= inv * bf2f(z.y & 0xffffu); o[3] *= inv * bf2f(z.y >> 16);
            *(u32x2*)(OS + oo) = pack4(o); }
        asm volatile("" ::: "memory");
    }
}
__device__ __forceinline__ void mem_wg_item(Frame& F, int b, int h, int qblk) {
    int lane_ = F.lane, tid_ = F.tid; asm volatile("" : "+v"(lane_), "+v"(tid_));
    const int lane = lane_, c = lane & 15, q = lane >> 4, tid = tid_, w = F.wave;
    const bf16_t* Kg = (const bf16_t*)(F.ws + WS_MEMKV) + (size_t)(b * 256) * 2048 + h * 256;
    const bf16_t* VTg = (const bf16_t*)(F.ws + WS_MVT) + (size_t)((b * 4 + h) * 256) * 256;
    const bf16_t* MQ = (const bf16_t*)(F.ws + WS_MQ); const bf16_t* MZ = (const bf16_t*)(F.ws + WS_MZ); bf16_t* OM = (bf16_t*)(F.ws + WS_OM);
    LAS unsigned char* L = F.lds;
    __syncthreads();
#pragma unroll
    for (int hf = 0; hf < 2; ++hf) { u32x4 kr[8];
#pragma unroll
        for (int u = 0; u < 8; ++u) { const int p = tid + 512 * (u + 8 * hf), key = p >> 5, ch = p & 31; kr[u] = *(const u32x4*)(Kg + (size_t)key * 2048 + ch * 8); }
#pragma unroll
        for (int u = 0; u < 8; ++u) { const int p = tid + 512 * (u + 8 * hf), key = p >> 5, ch = p & 31; *(LAS u32x4*)(L + key * 512 + ((ch ^ (key & 15)) << 4)) = kr[u]; } }
    __syncthreads();
    size_t qrow[2];
#pragma unroll
    for (int t = 0; t < 2; ++t) qrow[t] = (size_t)b * SEQ + 256 * qblk + 32 * w + 16 * t + c;
    f32x4 sacc[2][16];
#pragma unroll
    for (int mt = 0; mt < 16; ++mt) { sacc[0][mt] = (f32x4){0.f, 0.f, 0.f, 0.f}; sacc[1][mt] = (f32x4){0.f, 0.f, 0.f, 0.f}; }
    bf16x8 qn0 = *(const bf16x8*)(MQ + qrow[0] * 1024 + h * 256 + 8 * q), qn1 = *(const bf16x8*)(MQ + qrow[1] * 1024 + h * 256 + 8 * q);
#pragma unroll 1
    for (int s = 0; s < 8; ++s) {
        const bf16x8 q0 = qn0, q1 = qn1; const int sn = s < 7 ? s + 1 : 7;
        qn0 = *(const bf16x8*)(MQ + qrow[0] * 1024 + h * 256 + 32 * sn + 8 * q); qn1 = *(const bf16x8*)(MQ + qrow[1] * 1024 + h * 256 + 32 * sn + 8 * q);
#pragma unroll
        for (int mt = 0; mt < 16; ++mt) { const int row = 16 * mt + c;
            const bf16x8 kf = *(const LAS bf16x8*)(L + row * 512 + (((4 * s + q) ^ (row & 15)) << 4));
            sacc[0][mt] = mfma16(kf, q0, sacc[0][mt]); sacc[1][mt] = mfma16(kf, q1, sacc[1][mt]); }
        asm volatile("" ::: "memory");
    }
    float inv[2]; bf16x8 pf[2][8];
    const float sc = 0.0625f * 1.4426950408889634f;
#pragma unroll
    for (int t = 0; t < 2; ++t) { float mx = -INFINITY;
#pragma unroll
        for (int mt = 0; mt < 16; ++mt) mx = fmaxf(mx, fmaxf(fmaxf(sacc[t][mt][0], sacc[t][mt][1]), fmaxf(sacc[t][mt][2], sacc[t][mt][3])));
        mx = fmaxf(mx, __shfl_xor(mx, 16)); mx = fmaxf(mx, __shfl_xor(mx, 32));
        float sum = 0.f;
#pragma unroll
        for (int mt = 0; mt < 16; ++mt)
#pragma unroll
            for (int r = 0; r < 4; ++r) { const float e = exp2f((sacc[t][mt][r] - mx) * sc); sacc[t][mt][r] = e; sum += e; }
        sum += __shfl_xor(sum, 16); sum += __shfl_xor(sum, 32); inv[t] = 1.f / sum;
#pragma unroll
        for (int ks = 0; ks < 8; ++ks) pf[t][ks] = cat8(pack4(sacc[t][2 * ks]), pack4(sacc[t][2 * ks + 1])); }
    __syncthreads();
#pragma unroll
    for (int hf = 0; hf < 2; ++hf) { u32x4 vr[8];
#pragma unroll
        for (int u = 0; u < 8; ++u) { const int p = tid + 512 * (u + 8 * hf), d = p >> 5, c16 = p & 31; vr[u] = *(const u32x4*)(VTg + (size_t)d * 256 + c16 * 8); }
#pragma unroll
        for (int u = 0; u < 8; ++u) { const int p = tid + 512 * (u + 8 * hf), d = p >> 5, c16 = p & 31; *(LAS u32x4*)(L + d * 512 + (((2 * c16) ^ (2 * (d & 15))) << 3)) = vr[u]; } }
    __syncthreads();
    u32x2 zn0 = *(const u32x2*)(MZ + qrow[0] * 1024 + h * 256 + 4 * q), zn1 = *(const u32x2*)(MZ + qrow[1] * 1024 + h * 256 + 4 * q);
#pragma unroll 1
    for (int dt = 0; dt < 16; ++dt) { f32x4 o0 = {0.f, 0.f, 0.f, 0.f}, o1 = {0.f, 0.f, 0.f, 0.f}; const int dd = 16 * dt + c;
        const u32x2 zc0 = zn0, zc1 = zn1; const int dn = dt < 15 ? dt + 1 : 15;
        zn0 = *(const u32x2*)(MZ + qrow[0] * 1024 + h * 256 + 16 * dn + 4 * q); zn1 = *(const u32x2*)(MZ + qrow[1] * 1024 + h * 256 + 16 * dn + 4 * q); const LAS unsigned char* vrow = L + dd * 512; const int sw = 2 * (dd & 15);
#pragma unroll
        for (int ks = 0; ks < 8; ++ks) { const bf16x8 vf = cat8(*(const LAS u32x2*)(vrow + (((8 * ks + q) ^ sw) << 3)), *(const LAS u32x2*)(vrow + (((8 * ks + 4 + q) ^ sw) << 3)));
            o0 = mfma16(vf, pf[0][ks], o0); o1 = mfma16(vf, pf[1][ks], o1); }
#pragma unroll
        for (int t = 0; t < 2; ++t) { f32x4 o = t ? o1 : o0; const size_t oo = qrow[t] * 1024 + h * 256 + 16 * dt + 4 * q; const u32x2 z = t ? zc1 : zc0;
            o[0] *= inv[t] * bf2f(z.x & 0xffffu); o[1] *= inv[t] * bf2f(z.x >> 16); o[2] *= inv[t] * bf2f(z.y & 0xffffu); o[3] *= inv[t] * bf2f(z.y >> 16);
            *(u32x2*)(OM + oo) = pack4(o); }
        asm volatile("" ::: "memory"); }
}
__device__ __forceinline__ void p2_attn_prompt(Frame& F, int wk, int nwk) {
    const int gw = wk * NWAVES + F.wave, NGW = nwk * NWAVES, lane = F.lane;
    { LAS float* BTl = (LAS float*)(F.lds + LDS_BT); const float* BT = (const float*)(F.ws + WS_BTAB); for (int i = F.tid; i < 2048; i += NTHREADS) BTl[i] = BT[i]; }
    __syncthreads();
    for (int it = wk; it < 256; it += nwk) { const int qblk = it & 31, bh = it >> 5; mem_wg_item(F, bh >> 2, bh & 3, qblk); }
    for (int it = wk; it < 256; it += nwk) { const int qb = it & 63, bk = it >> 6; swa_wg_item(F, bk >> 1, bk & 1, qb); }
    __syncthreads();
    const bf16_t* SKV = (const bf16_t*)(F.ws + WS_SKV);
    for (int it = gw; it < 256; it += NGW) { const int b = it >> 7, j = it & 127; const bf16_t* pp = SKV + (size_t)(b * SEQ + SEQ - 128 + j) * 256;
        for (int cc = lane; cc < 128; cc += 64) { F.out[O_SKP + ((size_t)b * 128 + j) * 128 + cc] = bf2f(pp[cc]); F.out[O_SVP + ((size_t)b * 128 + j) * 128 + cc] = bf2f(pp[128 + cc]); } }
}
__device__ __forceinline__ void p2_swa_sample(Frame& F, int wk, int nwk) {
    const int gw = wk * NWAVES + F.wave, NGW = nwk * NWAVES, lane = F.lane;
    const bf16_t* SKV = (const bf16_t*)(F.ws + WS_SKV);
    for (int it = gw; it < MS * 2; it += NGW) { const int r = it >> 1, kv = it & 1; swa_wave_item(F, true, r >> 2, r & 3, kv); }
    { const u32x4* s4 = (const u32x4*)(F.ws + WS_OMS); u32x4* d4 = (u32x4*)(F.ws + WS_OM + (size_t)MP * 1024 * 2); for (int i = gw * 64 + lane; i < MS * 1024 / 8; i += NGW * 64) d4[i] = s4[i]; }
    { const int gt = gw * 64 + lane, NT = NGW * 64;
        for (int i = gt; i < 128 * 124 * 32; i += NT) { const int bd = i / (124 * 32), e = i - bd * (124 * 32);
            ((f32x4*)(F.out + O_SKS + (size_t)bd * 16384))[e] = ((const f32x4*)(F.in[I_CSK] + (size_t)bd * 16384 + 512))[e];
            ((f32x4*)(F.out + O_SVS + (size_t)bd * 16384))[e] = ((const f32x4*)(F.in[I_CSV] + (size_t)bd * 16384 + 512))[e]; }
        for (int i = gt; i < 128 * 4 * 128; i += NT) { const int bd = i >> 9, jj = (i >> 7) & 3, cc = i & 127; const bf16_t* pp = SKV + (size_t)(MP + bd * 4 + jj) * 256;
            F.out[O_SKS + ((size_t)bd * 128 + 124 + jj) * 128 + cc] = bf2f(pp[cc]); F.out[O_SVS + ((size_t)bd * 128 + 124 + jj) * 128 + cc] = bf2f(pp[128 + cc]); } }
}
__device__ __forceinline__ void mem_sample_item(Frame& F, int bd, int hp) {
    const int lane = F.lane, w = F.wave, tid = F.tid, hl = lane >> 5, h = 2 * hp + hl, d0 = (lane & 31) * 8;
    const bf16_t* MQ = (const bf16_t*)(F.ws + WS_MQ); const bf16_t* MZ = (const bf16_t*)(F.ws + WS_MZ); bf16_t* OM = (bf16_t*)(F.ws + WS_OM);
    LAS float* lg = (LAS float*)F.lds;
    LAS float* isum = lg + 2048;
    LAS float* po = isum + 8;
    float qr[4][8];
#pragma unroll
    for (int s = 0; s < 4; ++s) { const u32x4 v = *(const u32x4*)(MQ + (size_t)(MP + bd * 4 + s) * 1024 + h * 256 + d0);
        qr[s][0] = bf2f(v.x & 0xffffu); qr[s][1] = bf2f(v.x >> 16); qr[s][2] = bf2f(v.y & 0xffffu); qr[s][3] = bf2f(v.y >> 16);
        qr[s][4] = bf2f(v.z & 0xffffu); qr[s][5] = bf2f(v.z >> 16); qr[s][6] = bf2f(v.w & 0xffffu); qr[s][7] = bf2f(v.w >> 16); }
    const float* Kc = F.in[I_CMK] + ((size_t)bd * 256 * 4 + h) * 256 + d0; const float* Vc = F.in[I_CMV] + ((size_t)bd * 256 * 4 + h) * 256 + d0;
#pragma unroll 4
    for (int i = 0; i < 32; ++i) { const int m = w + 8 * i; const f32x4 k0 = *(const f32x4*)(Kc + (size_t)m * 1024), k1 = *(const f32x4*)(Kc + (size_t)m * 1024 + 4);
        float l[4];
#pragma unroll
        for (int s = 0; s < 4; ++s) { float a = k0.x * qr[s][0] + k0.y * qr[s][1] + k0.z * qr[s][2] + k0.w * qr[s][3] + k1.x * qr[s][4] + k1.y * qr[s][5] + k1.z * qr[s][6] + k1.w * qr[s][7];
#pragma unroll
            for (int o = 1; o < 32; o <<= 1) a += __shfl_xor(a, o);
            l[s] = a * 0.0625f; }
        if ((lane & 31) == 0) {
#pragma unroll
            for (int s = 0; s < 4; ++s) lg[(hl * 4 + s) * 256 + m] = l[s]; } }
    __syncthreads();
    { const int pr = w; float l4[4];
#pragma unroll
        for (int u = 0; u < 4; ++u) l4[u] = lg[pr * 256 + lane + 64 * u];
        const float mx = wave_max(fmaxf(fmaxf(l4[0], l4[1]), fmaxf(l4[2], l4[3]))); float s = 0.f;
#pragma unroll
        for (int u = 0; u < 4; ++u) { l4[u] = __expf(l4[u] - mx); s += l4[u]; lg[pr * 256 + lane + 64 * u] = l4[u]; }
        s = wave_sum(s); if (lane == 0) isum[pr] = 1.f / s; }
    __syncthreads();
    float o[4][8];
#pragma unroll
    for (int s = 0; s < 4; ++s)
#pragma unroll
        for (int j = 0; j < 8; ++j) o[s][j] = 0.f;
#pragma unroll 4
    for (int i = 0; i < 32; ++i) { const int m = w + 8 * i; const f32x4 v0 = *(const f32x4*)(Vc + (size_t)m * 1024), v1 = *(const f32x4*)(Vc + (size_t)m * 1024 + 4);
#pragma unroll
        for (int s = 0; s < 4; ++s) { const float p = lg[(hl * 4 + s) * 256 + m];
            o[s][0] += p * v0.x; o[s][1] += p * v0.y; o[s][2] += p * v0.z; o[s][3] += p * v0.w; o[s][4] += p * v1.x; o[s][5] += p * v1.y; o[s][6] += p * v1.z; o[s][7] += p * v1.w; } }
#pragma unroll
    for (int s = 0; s < 4; ++s) { LAS float* pp = po + ((w * 4 + s) * 512 + hl * 256 + d0);
        *(LAS f32x4*)pp = (f32x4){o[s][0], o[s][1], o[s][2], o[s][3]}; *(LAS f32x4*)(pp + 4) = (f32x4){o[s][4], o[s][5], o[s][6], o[s][7]}; }
    __syncthreads();
#pragma unroll
    for (int u = 0; u < 4; ++u) { const int e = tid + 512 * u, s = e >> 9, cc = e & 511; float a = 0.f;
#pragma unroll
        for (int ww = 0; ww < 8; ++ww) a += po[(ww * 4 + s) * 512 + cc];
        const int hh = 2 * hp + (cc >> 8); const size_t oo = (size_t)(MP + bd * 4 + s) * 1024 + hh * 256 + (cc & 255);
        ((bf16_t*)(F.ws + WS_OMS))[oo - (size_t)MP * 1024] = (bf16_t)f2bf(a * isum[(cc >> 8) * 4 + s] * bf2f(MZ[oo])); }
    __syncthreads();
}

struct SchedP3 {
    int G, c; const unsigned char* ws;
    __device__ __forceinline__ int ntiles(const pg8::Unit&) const { return 1024 / 64; }
    __device__ __forceinline__ bool next(int i, pg8::Unit& u) const {
        if (i < 6) { const int round = i / 3, b = i - round * 3; pg8::tile_of(round * G + c, 64, 8, u.pm, u.pn); u.job = b; return true; }
        if (i == 6 && c < 48) { u.pm = 64 + c / 24; const int rem = c % 24; u.pn = rem / 3; u.job = rem % 3; return true; }
        return false;
    }
    __device__ __forceinline__ void ptrs(const pg8::Unit& u, const char*& A, const char*& B) const {
        A = (const char*)ws + WS_OG + (size_t)u.job * M * 1024 * 2 + (size_t)u.pm * 256 * 1024 * 2;
        B = (const char*)ws + WS_WB + (size_t)u.job * 2048 * 1024 * 2 + (size_t)u.pn * 256 * 1024 * 2;
    }
};
struct EpiP3 {
    unsigned char* ws;
    __device__ __forceinline__ void operator()(const f32x4 (&acc)[2][2][4][2], const pg8::Unit& u, int wr, int wc, int fr, int fq) const {
        const int row0 = u.pm * 256 + wr * 64 + fr, col0 = u.pn * 256 + wc * 32 + 8 * fq, b = u.job;
        const bf16_t* GT = (const bf16_t*)(ws + WS_GATES); bf16_t* MG = (bf16_t*)(ws + WS_MERGED);
        const bool rmw = (b > 0) && (u.pm < 64);
#pragma unroll
        for (int ai = 0; ai < 2; ++ai) {
            u32x4 g[4][2], p[4][2];
#pragma unroll
            for (int m = 0; m < 4; ++m)
#pragma unroll
                for (int bj = 0; bj < 2; ++bj) { const int r = row0 + ai * 128 + m * 16, c = col0 + bj * 128;
                    g[m][bj] = *(const u32x4*)(GT + (size_t)r * 6144 + b * 2048 + c);
                    p[m][bj] = rmw ? *(const u32x4*)(MG + (size_t)r * 2048 + c) : (u32x4){0u, 0u, 0u, 0u}; }
#pragma unroll
            for (int m = 0; m < 4; ++m)
#pragma unroll
                for (int bj = 0; bj < 2; ++bj) { const int r = row0 + ai * 128 + m * 16, c = col0 + bj * 128;
                    const u32x4 gg = g[m][bj], pp = p[m][bj];
                    f32x4 v0 = acc[ai][bj][m][0], v1 = acc[ai][bj][m][1];
                    v0[0] = v0[0] * bf2f(gg.x & 0xffffu) + bf2f(pp.x & 0xffffu); v0[1] = v0[1] * bf2f(gg.x >> 16) + bf2f(pp.x >> 16); v0[2] = v0[2] * bf2f(gg.y & 0xffffu) + bf2f(pp.y & 0xffffu); v0[3] = v0[3] * bf2f(gg.y >> 16) + bf2f(pp.y >> 16);
                    v1[0] = v1[0] * bf2f(gg.z & 0xffffu) + bf2f(pp.z & 0xffffu); v1[1] = v1[1] * bf2f(gg.z >> 16) + bf2f(pp.z >> 16); v1[2] = v1[2] * bf2f(gg.w & 0xffffu) + bf2f(pp.w & 0xffffu); v1[3] = v1[3] * bf2f(gg.w >> 16) + bf2f(pp.w >> 16);
                    u32x4 w; w.x = pg8::cvt_pk_bf16(v0[0], v0[1]); w.y = pg8::cvt_pk_bf16(v0[2], v0[3]); w.z = pg8::cvt_pk_bf16(v1[0], v1[1]); w.w = pg8::cvt_pk_bf16(v1[2], v1[3]);
                    u32x4* mp = u.pm < 64 ? (u32x4*)(MG + (size_t)r * 2048 + c) : (u32x4*)((bf16_t*)(ws + WS_PS) + ((size_t)b * MS + (r - MP)) * 2048 + c);
                    *mp = w; }
        }
    }
};

struct SchedP4 {
    int G, c; const unsigned char* ws;
    __device__ __forceinline__ int ntiles(const pg8::Unit& u) const { return u.job == 0 ? D / 64 : 512 / 64; }
    __device__ __forceinline__ bool next(int i, pg8::Unit& u) const {
        if (i < 2) { pg8::tile_of(i * G + c, 64, 8, u.pm, u.pn); u.job = 0; return true; }
        if (i == 2 && c < 64) { u.pm = 64 + c / 32; const int rem = c % 32; u.pn = rem / 4; u.job = 1 + (rem & 3); return true; }
        return false;
    }
    __device__ __forceinline__ void ptrs(const pg8::Unit& u, const char*& A, const char*& B) const {
        const size_t ko = u.job == 0 ? 0 : (size_t)(u.job - 1) * 512 * 2;
        A = (const char*)ws + WS_MERGED + (size_t)u.pm * 256 * 2048 * 2 + ko; B = (const char*)ws + WS_WO + (size_t)u.pn * 256 * 2048 * 2 + ko;
    }
};
struct EpiP4 {
    unsigned char* ws; float* out; const float* xp; const float* xs;
    __device__ __forceinline__ void operator()(const f32x4 (&acc)[2][2][4][2], const pg8::Unit& u, int wr, int wc, int fr, int fq) const {
        const int row0 = u.pm * 256 + wr * 64 + fr, col0 = u.pn * 256 + wc * 32 + 8 * fq;
        if (u.job != 0) {
#pragma unroll
            for (int ai = 0; ai < 2; ++ai)
#pragma unroll
                for (int m = 0; m < 4; ++m) { const int r = row0 + ai * 128 + m * 16; float* yp = (float*)(ws + WS_YP) + ((size_t)(u.job - 1) * MS + (r - MP)) * D;
#pragma unroll
                    for (int bj = 0; bj < 2; ++bj) { const int c = col0 + bj * 128; *(f32x4*)(yp + c) = acc[ai][bj][m][0]; *(f32x4*)(yp + c + 4) = acc[ai][bj][m][1]; } }
            return;
        }
#pragma unroll
        for (int ai = 0; ai < 2; ++ai)
#pragma unroll
            for (int mh = 0; mh < 2; ++mh) {
                f32x4 xv[2][2][2];
#pragma unroll
                for (int mm = 0; mm < 2; ++mm)
#pragma unroll
                    for (int bj = 0; bj < 2; ++bj) { const float* xr = xp + (size_t)(row0 + ai * 128 + (2 * mh + mm) * 16) * D + col0 + bj * 128; xv[mm][bj][0] = *(const f32x4*)xr; xv[mm][bj][1] = *(const f32x4*)(xr + 4); }
#pragma unroll
                for (int mm = 0; mm < 2; ++mm)
#pragma unroll
                    for (int bj = 0; bj < 2; ++bj) { float* yr = out + (size_t)(row0 + ai * 128 + (2 * mh + mm) * 16) * D + col0 + bj * 128;
                        *(f32x4*)yr = acc[ai][bj][2 * mh + mm][0] + xv[mm][bj][0]; *(f32x4*)(yr + 4) = acc[ai][bj][2 * mh + mm][1] + xv[mm][bj][1]; }
            }
    }
};
__device__ __forceinline__ void p3_combine_sample(Frame& F) {
    const u32x4* ps = (const u32x4*)(F.ws + WS_PS); u32x4* mg = (u32x4*)(F.ws + WS_MERGED + (size_t)MP * 2048 * 2);
    constexpr int NV = MS * 2048 / 8;
    for (int i = F.bid * NTHREADS + F.tid; i < NV; i += F.G * NTHREADS) { const u32x4 a = ps[i], b = ps[NV + i], c = ps[2 * NV + i]; u32x4 o;
        o.x = pk2(bf2f(a.x & 0xffffu) + bf2f(b.x & 0xffffu) + bf2f(c.x & 0xffffu), bf2f(a.x >> 16) + bf2f(b.x >> 16) + bf2f(c.x >> 16));
        o.y = pk2(bf2f(a.y & 0xffffu) + bf2f(b.y & 0xffffu) + bf2f(c.y & 0xffffu), bf2f(a.y >> 16) + bf2f(b.y >> 16) + bf2f(c.y >> 16));
        o.z = pk2(bf2f(a.z & 0xffffu) + bf2f(b.z & 0xffffu) + bf2f(c.z & 0xffffu), bf2f(a.z >> 16) + bf2f(b.z >> 16) + bf2f(c.z >> 16));
        o.w = pk2(bf2f(a.w & 0xffffu) + bf2f(b.w & 0xffffu) + bf2f(c.w & 0xffffu), bf2f(a.w >> 16) + bf2f(b.w >> 16) + bf2f(c.w >> 16));
        mg[i] = o; }
}
__device__ __forceinline__ void p5_final_norm(Frame& F) {
    const int gw = F.bid * NWAVES + F.wave, NGW = F.G * NWAVES, lane = F.lane;
    const f32x4* wn = (const f32x4*)F.in[I_NORMF] + lane;
    for (int r = gw; r < M; r += NGW) {
        f32x4* y = (f32x4*)(F.out + (size_t)r * D) + lane;
        f32x4 v[8]; float s = 0.f;
        if (r >= MP) { const f32x4* xs4 = (const f32x4*)(F.in[I_XS] + (size_t)(r - MP) * D) + lane; const f32x4* yp4 = (const f32x4*)((const float*)(F.ws + WS_YP) + (size_t)(r - MP) * D) + lane;
#pragma unroll
            for (int j = 0; j < 8; ++j) { f32x4 a = xs4[64 * j];
#pragma unroll
                for (int kq = 0; kq < 4; ++kq) a = a + yp4[(size_t)kq * MS * D / 4 + 64 * j];
                v[j] = a; s += (a.x * a.x + a.y * a.y) + (a.z * a.z + a.w * a.w); } }
        else
#pragma unroll
        for (int j = 0; j < 8; ++j) { v[j] = y[64 * j]; s += (v[j].x * v[j].x + v[j].y * v[j].y) + (v[j].z * v[j].z + v[j].w * v[j].w); }
        const float sc = rsqrtf(wave_sum(s) * (1.f / D) + EPS);
#pragma unroll
        for (int j = 0; j < 8; ++j) { const f32x4 w = wn[64 * j]; f32x4 o = v[j]; o.x *= sc * w.x; o.y *= sc * w.y; o.z *= sc * w.z; o.w *= sc * w.w; y[64 * j] = o; }
    }
}

constexpr int N_PHASES = 10;
__global__ void __launch_bounds__(NTHREADS, 2) hybrid_fwd(Args args) {
    extern __shared__ __attribute__((aligned(16))) unsigned char lds_raw[];
    cg::grid_group grid = cg::this_grid();
    Frame F;
    F.lds = (LAS unsigned char*)lds_raw; F.tid = threadIdx.x; F.lane = F.tid & 63; F.wave = __builtin_amdgcn_readfirstlane(F.tid >> 6);
    F.G = gridDim.x; F.bid = blockIdx.x; F.in = args.in; F.out = args.out; F.ws = args.ws;
    const int lo = args.ph_lo, hi = args.ph_hi;
    if (lo < 0) grid.sync();
    if (F.tid < 64) ((LAS unsigned*)(F.lds + LDS_CTL))[F.tid] = 0u;
    __syncthreads();
    const XcdBarrier bar = xcd_barrier_post((unsigned*)(F.ws + WS_CTL), (volatile LAS unsigned*)(F.lds + LDS_CTL));
#define IN(k) (lo <= (k) && (k) < hi)
#define SEAM(k) do { if (IN(k) && IN((k) + 1)) xcd_barrier(bar); } while (0)
    if (IN(0)) p0_prologue(F);
    SEAM(0);
    if (IN(1)) { SchedP1 S{F.G, F.bid, F.ws, (const unsigned char*)F.out + DO_XN}; EpiP1 E{F.ws, F.out}; pg8::gemm_phase<EpiP1, SchedP1>(F.lds, D, S, E); }
    SEAM(1);
    if (IN(2)) { p2_conv(F); __syncthreads(); for (int it = F.bid; it < 256; it += F.G) mem_sample_item(F, it >> 1, it & 1); }
    SEAM(2);
    if (IN(3)) p2_prep(F);
    SEAM(3);
    if (IN(4)) {
        constexpr int GSPLIT = 512;
        if (F.bid < 128) { scan_item(F, F.bid & 15, F.bid >> 4); __syncthreads(); p2_gdn_sample(F, F.bid, 128, 0, GSPLIT); }
        else { const int wk = F.bid - 128, nwk = F.G - 128; p2_attn_prompt(F, wk, nwk); __syncthreads(); p2_swa_sample(F, wk, nwk); __syncthreads(); p2_gdn_sample(F, wk, nwk, GSPLIT, 1024); }
    }
    SEAM(4);
    if (IN(5)) { for (int it = F.bid; it < 256; it += F.G) gdn_out_item(F, it); p2_gdn_norm_sample(F); }
    SEAM(5);
    if (IN(6)) { SchedP3 S{F.G, F.bid, F.ws}; EpiP3 E{F.ws}; pg8::gemm_phase<EpiP3, SchedP3>(F.lds, 1024, S, E); }
    SEAM(6);
    if (IN(7)) p3_combine_sample(F);
    SEAM(7);
    if (IN(8)) { SchedP4 S{F.G, F.bid, F.ws}; EpiP4 E{F.ws, F.out, F.in[I_XP], F.in[I_XS]}; pg8::gemm_phase<EpiP4, SchedP4>(F.lds, D, S, E); }
    SEAM(8);
    if (IN(9)) p5_final_norm(F);
#undef IN
#undef SEAM
}

extern "C" void kernel_launch(void* const* d_in, const int* in_sizes, int n_in, void* d_out, int out_size, void* d_ws, size_t ws_size, hipStream_t stream) {
    static int grid = 0;
    if (grid == 0) {
        if (n_in != 22 || out_size != (int)O_END || ws_size < WS_END) { fprintf(stderr, "kernel_launch: unexpected shapes (n_in %d out %d ws %zu need %zu)\n", n_in, out_size, ws_size, (size_t)WS_END); grid = -1; return; }
        int dev = 0, cus = 0, per_cu = 0;
        hipGetDevice(&dev); hipDeviceGetAttribute(&cus, hipDeviceAttributeMultiprocessorCount, dev);
        hipFuncSetAttribute((const void*)hybrid_fwd, hipFuncAttributeMaxDynamicSharedMemorySize, LDS_BYTES);
        hipOccupancyMaxActiveBlocksPerMultiprocessor(&per_cu, (const void*)hybrid_fwd, NTHREADS, LDS_BYTES);
        if (per_cu < 1) { fprintf(stderr, "kernel_launch: occupancy query says %d blocks per CU\n", per_cu); grid = -1; return; }
        grid = cus;
    }
    if (grid < 0) return;
    Args a{};
    for (int i = 0; i < 22; ++i) a.in[i] = (const float*)d_in[i];
    a.out = (float*)d_out; a.ws = (unsigned char*)d_ws;
    if (hipMemsetAsync((char*)d_ws + WS_CTL, 0, XCD_BAR_WORDS * 4, stream) != hipSuccess) { fprintf(stderr, "kernel_launch: hipMemsetAsync failed\n"); return; }
#if MK_N_LAUNCHES == 1
    a.ph_lo = 0; a.ph_hi = N_PHASES;
    void* kargs[] = {&a};
    hipError_t e = hipLaunchCooperativeKernel((const void*)hybrid_fwd, dim3(grid), dim3(NTHREADS), kargs, LDS_BYTES, stream);
    if (e != hipSuccess) fprintf(stderr, "cooperative launch failed: %s (grid %d)\n", hipGetErrorString(e), grid);
#endif
}
```

```cpp
#include <hip/hip_runtime.h>
#include <hip/hip_cooperative_groups.h>
#include <cstdio>
#include <cstdint>
namespace cg = cooperative_groups;

#ifndef MK_N_LAUNCHES
#define MK_N_LAUNCHES 1
#endif

#define LAS __attribute__((address_space(3)))
typedef unsigned short bf16_t;
typedef short bf16x8 __attribute__((ext_vector_type(8)));
typedef float f32x4 __attribute__((ext_vector_type(4)));
typedef unsigned u32x4 __attribute__((ext_vector_type(4)));
typedef unsigned u32x2 __attribute__((ext_vector_type(2)));

constexpr int D = 2048, SEQ = 8192, MP = 2 * SEQ, MS = 512, M = MP + MS;
constexpr int IN_COLS = 14608;
constexpr int NIN = 58 * 256;
constexpr float EPS = 1e-6f;
__host__ __device__ __forceinline__ int win_src_col(int j) {
    if (j < 4096) return j;
    if (j < 5120) return 4112 + (j - 4096);
    if (j < 6144) return 5392 + (j - 5120);
    if (j < 7168) return 6416 + (j - 6144);
    if (j < 8192) return 7440 + (j - 7168);
    if (j < 14336) return 8464 + (j - 8192);
    if (j < 14592) return 5136 + (j - 14336);
    if (j < 14608) return 4096 + (j - 14592);
    return -1;
}
constexpr size_t O_YP = 0, O_YS = O_YP + (size_t)MP * D, O_GSP = O_YS + (size_t)MS * D, O_GCP = O_GSP + 2 * 8 * 128 * 128, O_SKP = O_GCP + 2 * 3 * 3072,
                 O_SVP = O_SKP + 2 * 128 * 128, O_MKP = O_SVP + 2 * 128 * 128, O_MVP = O_MKP + 512 * 1024, O_GSS = O_MVP + 512 * 1024,
                 O_GCS = O_GSS + (size_t)128 * 8 * 128 * 128, O_SKS = O_GCS + 128 * 3 * 3072, O_SVS = O_SKS + 128 * 128 * 128, O_END = O_SVS + 128 * 128 * 128;
static_assert(O_END == 58148864, "d_out map");
constexpr size_t al(size_t x) { return (x + 255) & ~(size_t)255; }
constexpr size_t WS_CTL = 0, WS_WB = 1u << 20, WS_WO = WS_WB + al((size_t)3 * 2048 * 1024 * 2), WS_WIN = WS_WO + al((size_t)2048 * 2048 * 2),
                 WS_WMKV = WS_WIN + al((size_t)NIN * 2048 * 2), WS_QKV = WS_WMKV + al((size_t)2048 * 2048 * 2), WS_GZ = WS_QKV + al((size_t)M * 3072 * 2),
                 WS_SQ = WS_GZ + al((size_t)M * 1024 * 2), WS_SZ = WS_SQ + al((size_t)M * 1024 * 2), WS_MQ = WS_SZ + al((size_t)M * 1024 * 2), WS_MZ = WS_MQ + al((size_t)M * 1024 * 2),
                 WS_SKV = WS_MZ + al((size_t)M * 1024 * 2), WS_GATES = WS_SKV + al((size_t)M * 256 * 2), WS_MEMN = WS_GATES + al((size_t)M * 6144 * 2),
                 WS_MEMKV = WS_MEMN + al((size_t)512 * 2048 * 2), WS_GAB = WS_MEMKV + al((size_t)512 * 2048 * 2), WS_ROWSS = WS_GAB + al((size_t)M * 16 * 4),
                 WS_G = WS_ROWSS + al((size_t)M * 4), WS_BETA = WS_G + al((size_t)M * 8 * 4), WS_BTAB = WS_BETA + al((size_t)M * 8 * 4), WS_END0 = WS_BTAB + al(16 * 128 * 4);
constexpr size_t WS_OG = WS_QKV, WS_OS = WS_OG + (size_t)M * 1024 * 2, WS_OM = WS_OS + (size_t)M * 1024 * 2, WS_MERGED = WS_SQ;
constexpr size_t WS_NEGW = WS_OG, WS_SN = WS_WIN, WS_OMS = WS_MEMN;
constexpr size_t WS_UT = WS_END0, WS_ATT = WS_UT + al((size_t)2048 * 128 * 64 * 2), WS_GC = WS_ATT + al((size_t)2048 * 64 * 64 * 2), WS_DEC = WS_GC + al((size_t)MP * 8 * 4),
                 WS_GT = WS_DEC + al((size_t)2048 * 64 * 4), WS_MVT = WS_GT + al(2048 * 4), WS_VTS = WS_MVT + al((size_t)2 * 4 * 256 * 256 * 2), WS_SSQ = WS_VTS + al((size_t)2 * 2 * 64 * SEQ * 2 + 4096), WS_SSK = WS_SSQ + al((size_t)MP * 8 * 4), WS_END = WS_SSK + al((size_t)MP * 8 * 4);
constexpr size_t WS_PS = WS_UT, WS_YP = WS_UT + (size_t)3 * MS * 2048 * 2;
static_assert((size_t)3 * MS * 2048 * 2 + (size_t)4 * MS * 2048 * 4 <= (size_t)2048 * 128 * 64 * 2, "PS/YP fit in UT");
static_assert(WS_OM + (size_t)M * 1024 * 2 <= WS_GZ && WS_MERGED + (size_t)M * 2048 * 2 <= WS_MQ, "overlays");
static_assert((size_t)2048 * 64 * 128 * 2 <= (size_t)MP * 1024 * 2 && WS_SN + (size_t)2048 * 128 * 128 * 2 <= WS_QKV, "overlays 2");
static_assert(WS_END <= 670000000, "workspace budget");
constexpr size_t DO_XN = 0, DO_QN = 0, DO_KN = (size_t)M * 1024 * 2, DO_KT = 2 * (size_t)M * 1024 * 2, DO_VT = DO_KT + (size_t)2048 * 8192 * 2, DO_VNS = DO_VT + (size_t)2048 * 8192 * 2;
static_assert(DO_VNS + (size_t)512 * 1024 * 2 <= (size_t)M * D * 4, "y scratch");

constexpr int NWAVES = 8, NTHREADS = 512;
constexpr int LDS_CTL = 147456;
constexpr int LDS_BYTES = 147456 + 256;
constexpr int LDS_BT = 139264;

__device__ __forceinline__ float bf2f(unsigned v) { return __uint_as_float(v << 16); }
__device__ __forceinline__ unsigned f2bf(float f) { unsigned u = __float_as_uint(f); return (u + 0x7fffu + ((u >> 16) & 1u)) >> 16; }
__device__ __forceinline__ unsigned pk2(float lo, float hi) { return f2bf(lo) | (f2bf(hi) << 16); }
__device__ __forceinline__ float wave_sum(float v) {
#pragma unroll
    for (int o = 1; o < 64; o <<= 1) v += __shfl_xor(v, o);
    return v;
}
__device__ __forceinline__ float wave_max(float v) {
#pragma unroll
    for (int o = 1; o < 64; o <<= 1) v = fmaxf(v, __shfl_xor(v, o));
    return v;
}
__device__ __forceinline__ float sigmoidf_(float x) { return __builtin_amdgcn_rcpf(1.f + __expf(-x)); }
__device__ __forceinline__ float siluf_(float x) { return x * __builtin_amdgcn_rcpf(1.f + __expf(-x)); }
#define LDS_WAIT() asm volatile("s_waitcnt lgkmcnt(0)" ::: "memory")

namespace pg8 {
constexpr int BM = 256, BK = 64, HALF = 128, HTB = HALF * BK * 2, STAGE_BYTES = 8 * HTB, NXCD = 8, WGM = 8;
__host__ __device__ __forceinline__ int lds_byte(int r, int c) { const int st = (r >> 4) * 2 + (c >> 5), rr = r & 15, cc = c & 31, ob = rr * 64 + cc * 2; return st * 1024 + (ob ^ (((ob >> 9) & 1) << 5)); }
__host__ __device__ __forceinline__ void stage_rc(int b, int& R, int& C) { const int st = b / 1024, sb = b % 1024, swz = sb ^ (((sb >> 9) & 1) << 5); R = (st >> 1) * 16 + swz / 64; C = (st & 1) * 32 + (swz % 64) / 2; }
__host__ __device__ __forceinline__ int perm32(int rho) { const int n = rho >> 4, i = rho & 15; return 8 * (i >> 2) + 4 * n + (i & 3); }
struct Unit { int pm, pn, job; };
__device__ __forceinline__ void tile_of(int L, int nM, int nN, int& pm, int& pn) {
    const int nwg = nM * nN; int wgid = L;
    { const int q = nwg / NXCD, r = nwg % NXCD, xcd = wgid % NXCD, off = wgid / NXCD; wgid = (xcd < r ? xcd * (q + 1) : r * (q + 1) + (xcd - r) * q) + off; }
    const int nig = WGM * nN, gid = wgid / nig, fm = gid * WGM, gsz = (nM - fm) < WGM ? (nM - fm) : WGM;
    pm = fm + ((wgid % nig) % gsz); pn = (wgid % nig) / gsz;
}
__device__ __forceinline__ unsigned cvt_pk_bf16(float lo, float hi) { unsigned r; asm volatile("v_cvt_pk_bf16_f32 %0, %1, %2" : "=v"(r) : "v"(lo), "v"(hi)); return r; }

template <class Epi, class Sched, bool ALIGN_EPI = true>
__device__ __forceinline__ void gemm_phase(LAS unsigned char* lds, const int K, const Sched& S, const Epi& E) {
    const int tid = threadIdx.x, wid = __builtin_amdgcn_readfirstlane(tid >> 6), lane = tid & 63, wr = wid >> 2, wc = wid & 3, fr = lane & 15, fq = lane >> 4;
    unsigned voffA[2], voffB[2];
#pragma unroll
    for (int i = 0; i < 2; ++i) { int R, C; stage_rc(tid * 16 + i * 8192, R, C); const int Rb = ((R & ~31) + perm32(R & 31));
        voffA[i] = (unsigned)(R * K + C) * 2u; voffB[i] = (unsigned)(Rb * K + C) * 2u; }
    const size_t kstep = (size_t)(BK * 2);
    const size_t hstep = (size_t)HALF * K * 2;
    const unsigned ldsw = (unsigned)wid * 1024u;
    const int aoff = lds_byte(wr * 64 + fr, fq * 8), boff = lds_byte(wc * 32 + fr, fq * 8);
#define PG8_SA(b, h) (((b) * 2 + (h)) * HTB)
#define PG8_SB(b, h) ((4 + (b) * 2 + (h)) * HTB)
#define PG8_STAGE(bufoff, gbase, voff) do { _Pragma("unroll") for (int _i = 0; _i < 2; ++_i) \
        __builtin_amdgcn_global_load_lds((const unsigned*)((const char*)(gbase) + (voff)[_i]), (LAS unsigned*)(lds + (bufoff) + ldsw + _i * 8192), 16, 0, 0); } while (0)
#define PG8_LDA(dst, b, h) do { _Pragma("unroll") for (int m = 0; m < 4; ++m) _Pragma("unroll") for (int k = 0; k < 2; ++k) dst[m][k] = *(const LAS bf16x8*)(lds + PG8_SA(b, h) + aoff + m * 2048 + k * 1024); } while (0)
#define PG8_LDB(dst, b, h) do { _Pragma("unroll") for (int n = 0; n < 2; ++n) _Pragma("unroll") for (int k = 0; k < 2; ++k) dst[n][k] = *(const LAS bf16x8*)(lds + PG8_SB(b, h) + boff + n * 2048 + k * 1024); } while (0)
#define PG8_MMA(ai, bj, At, Bt) do { __builtin_amdgcn_s_setprio(1); _Pragma("unroll") for (int m = 0; m < 4; ++m) _Pragma("unroll") for (int n = 0; n < 2; ++n) _Pragma("unroll") for (int k = 0; k < 2; ++k) \
        acc[ai][bj][m][n] = __builtin_amdgcn_mfma_f32_16x16x32_bf16(Bt[n][k], At[m][k], acc[ai][bj][m][n], 0, 0, 0); __builtin_amdgcn_s_setprio(0); } while (0)
#define PG8_WAIT_V(n) asm volatile("s_waitcnt vmcnt(" #n ")" ::: "memory")
#define PG8_WAIT_L(n) asm volatile("s_waitcnt lgkmcnt(" #n ")" ::: "memory")
#define PG8_BAR __builtin_amdgcn_s_barrier()
#define PG8_SCHED __builtin_amdgcn_sched_barrier(0)
    Unit cur, nxt; int ui = 0;
    if (!S.next(0, cur)) return;
    f32x4 acc[2][2][4][2];
#pragma unroll
    for (int a = 0; a < 2; ++a)
#pragma unroll
        for (int b = 0; b < 2; ++b)
#pragma unroll
            for (int m = 0; m < 4; ++m)
#pragma unroll
                for (int n = 0; n < 2; ++n) acc[a][b][m][n] = (f32x4){0.f, 0.f, 0.f, 0.f};
    bf16x8 At[4][2], B0[2][2], B1[2][2];
    const char* cA; const char* cB; S.ptrs(cur, cA, cB);
    PG8_STAGE(PG8_SB(0, 0), cB, voffB); PG8_STAGE(PG8_SB(0, 1), cB + hstep, voffB); PG8_STAGE(PG8_SA(0, 0), cA, voffA); PG8_STAGE(PG8_SA(0, 1), cA + hstep, voffA);
    if (wr == 1) PG8_BAR;
    PG8_WAIT_V(2); PG8_BAR;
    PG8_STAGE(PG8_SB(1, 0), cB + kstep, voffB); PG8_STAGE(PG8_SA(1, 0), cA + kstep, voffA); PG8_STAGE(PG8_SB(1, 1), cB + hstep + kstep, voffB);
    PG8_WAIT_V(6); PG8_BAR;
    for (;;) {
        const bool has_next = S.next(ui + 1, nxt);
        const char* nA = cA; const char* nB = cB; if (has_next) S.ptrs(nxt, nA, nB);
        const int nt = S.ntiles(cur);
        for (int t = 0; t < nt; t += 2) {
            const bool last = (t == nt - 2);
            const char* a1 = cA + (size_t)(t + 1) * kstep;
            const char* a2 = last ? nA : cA + (size_t)(t + 2) * kstep; const char* b2 = last ? nB : cB + (size_t)(t + 2) * kstep;
            const char* a3 = a2 + kstep; const char* b3 = b2 + kstep;
            PG8_LDB(B0, 0, 0); PG8_LDB(B1, 0, 1); PG8_SCHED; PG8_LDA(At, 0, 0); PG8_STAGE(PG8_SA(1, 1), a1 + hstep, voffA);
            PG8_WAIT_V(8); PG8_WAIT_L(0); PG8_BAR; PG8_MMA(0, 0, At, B0); PG8_MMA(0, 1, At, B1); PG8_BAR; PG8_SCHED;
            PG8_LDA(At, 0, 1); PG8_STAGE(PG8_SB(0, 0), b2, voffB); PG8_STAGE(PG8_SB(0, 1), b2 + hstep, voffB); PG8_STAGE(PG8_SA(0, 0), a2, voffA);
            PG8_WAIT_V(8); PG8_WAIT_L(0); PG8_BAR; PG8_MMA(1, 0, At, B0); PG8_MMA(1, 1, At, B1); PG8_BAR; PG8_SCHED;
            PG8_LDB(B0, 1, 0); PG8_LDB(B1, 1, 1); PG8_SCHED; PG8_LDA(At, 1, 0); PG8_STAGE(PG8_SA(0, 1), a2 + hstep, voffA);
            PG8_WAIT_V(8); PG8_WAIT_L(0); PG8_BAR; PG8_MMA(0, 0, At, B0); PG8_MMA(0, 1, At, B1); PG8_BAR; PG8_SCHED;
            PG8_LDA(At, 1, 1); PG8_STAGE(PG8_SB(1, 0), b3, voffB); PG8_STAGE(PG8_SB(1, 1), b3 + hstep, voffB); PG8_STAGE(PG8_SA(1, 0), a3, voffA);
            PG8_WAIT_V(8); PG8_WAIT_L(0); PG8_BAR; PG8_MMA(1, 0, At, B0); PG8_MMA(1, 1, At, B1); PG8_BAR; PG8_SCHED;
        }
        if constexpr (ALIGN_EPI) { if (wr == 0) PG8_BAR; }
        E(acc, cur, wr, wc, fr, fq);
        if (!has_next) break;
#pragma unroll
        for (int a = 0; a < 2; ++a)
#pragma unroll
            for (int b = 0; b < 2; ++b)
#pragma unroll
                for (int m = 0; m < 4; ++m)
#pragma unroll
                    for (int n = 0; n < 2; ++n) acc[a][b][m][n] = (f32x4){0.f, 0.f, 0.f, 0.f};
        cur = nxt; cA = nA; cB = nB; ++ui;
        if constexpr (ALIGN_EPI) { if (wr == 1) PG8_BAR; }
    }
    PG8_WAIT_V(0);
    if constexpr (!ALIGN_EPI) { if (wr == 0) PG8_BAR; }
    PG8_BAR;
#undef PG8_SA
#undef PG8_SB
#undef PG8_STAGE
#undef PG8_LDA
#undef PG8_LDB
#undef PG8_MMA
#undef PG8_WAIT_V
#undef PG8_WAIT_L
#undef PG8_BAR
#undef PG8_SCHED
}
}

#define XB_TMO      128
#define XB_XCNT(j)  (256  + 64 * (j))
#define XB_XSUB(j)  (1280 + 64 * (j))
#define XB_XGEN(j)  (2304 + 64 * (j))
#define XB_TOP      3328
#define XB_TOPGEN   3392
#define XCD_BAR_WORDS 3456
#define XB_SPIN_CAP (1u << 20)
__device__ __forceinline__ unsigned xb_ld(unsigned* p)              { return __hip_atomic_load(p, __ATOMIC_RELAXED, __HIP_MEMORY_SCOPE_AGENT); }
__device__ __forceinline__ unsigned xb_add(unsigned* p, unsigned v) { return __hip_atomic_fetch_add(p, v, __ATOMIC_RELAXED, __HIP_MEMORY_SCOPE_AGENT); }
__device__ __forceinline__ unsigned xb_xcc_id() { return (unsigned)__builtin_amdgcn_s_getreg((3 << 11) | 20) & 0xFu; }
#define XB_SPIN(cond, bar) do { unsigned _sp = 0; while (cond) { __builtin_amdgcn_s_sleep(1); \
    if ((++_sp & 255u) == 0u) { if (xb_ld(&(bar)[XB_TMO])) break; if (_sp > XB_SPIN_CAP) { atomicAdd(&(bar)[XB_TMO], 1u); break; } } } } while (0)
struct XcdBarrier { unsigned* bar; unsigned x; volatile LAS unsigned* st; };
__device__ __forceinline__ XcdBarrier xcd_barrier_post(unsigned* bar, volatile LAS unsigned* st) {
    XcdBarrier b; b.bar = bar; b.x = xb_xcc_id(); b.st = st;
    if (threadIdx.x == 0) (void)xb_add(&bar[XB_XCNT(b.x)], 1u);
    return b;
}
__device__ __forceinline__ void xcd_barrier_complete(unsigned* bar, unsigned x, unsigned& nloc, unsigned& nx) {
    const unsigned G = gridDim.x * gridDim.y * gridDim.z;
    unsigned sum, cnt, mine, sp = 0u;
    for (;;) {
        sum = 0u; cnt = 0u; mine = 0u;
#pragma unroll
        for (unsigned j = 0; j < 16; ++j) { const unsigned c = xb_ld(&bar[XB_XCNT(j)]); sum += c; cnt += (c > 0u) ? 1u : 0u; mine = (j == x) ? c : mine; }
        if (sum == G) break;
        __builtin_amdgcn_s_sleep(1);
        if ((++sp & 255u) == 0u) { if (xb_ld(&bar[XB_TMO])) break; if (sp > XB_SPIN_CAP) { atomicAdd(&bar[XB_TMO], 1u); break; } }
    }
    nloc = mine > 0u ? mine : 1u; nx = cnt > 0u ? cnt : 1u;
}
__device__ __forceinline__ void xcd_barrier(const XcdBarrier& b) {
    asm volatile("s_waitcnt vmcnt(0)" ::: "memory");
    __syncthreads();
    if (threadIdx.x == 0) {
        unsigned* bar = b.bar;
        __builtin_amdgcn_s_waitcnt(0);
        unsigned nloc = b.st[0], nx = b.st[1];
        if (nloc == 0u) { xcd_barrier_complete(bar, b.x, nloc, nx); b.st[0] = nloc; b.st[1] = nx; }
        const unsigned old = xb_add(&bar[XB_XSUB(b.x)], 1u);
        const unsigned gen = old / nloc;
        if (old + 1u == (gen + 1u) * nloc) {
            __builtin_amdgcn_fence(__ATOMIC_RELEASE, "agent");
            asm volatile("s_waitcnt vmcnt(0)" ::: "memory");
            const unsigned og = xb_add(&bar[XB_TOP], 1u);
            const unsigned tg = og / nx;
            if (og + 1u == (tg + 1u) * nx) xb_add(&bar[XB_TOPGEN], 1u);
            else XB_SPIN(xb_ld(&bar[XB_TOPGEN]) == tg, bar);
            __builtin_amdgcn_fence(__ATOMIC_ACQUIRE, "agent");
            xb_add(&bar[XB_XGEN(b.x)], 1u);
            asm volatile("s_waitcnt vmcnt(0)" ::: "memory");
        } else {
            XB_SPIN(xb_ld(&bar[XB_XGEN(b.x)]) == gen, bar);
            __builtin_amdgcn_fence(__ATOMIC_ACQUIRE, "agent");
            asm volatile("s_waitcnt vmcnt(0)" ::: "memory");
        }
    }
    __syncthreads();
}

struct Args { const float* in[22]; float* out; unsigned char* ws; int ph_lo, ph_hi; };
enum { I_XP = 0, I_XS, I_SGDN, I_SCONV, I_CSK, I_CSV, I_CMK, I_CMV, I_MEMP, I_NORM_IN, I_WIN, I_CONVW, I_ALOG, I_DTB, I_GNORM, I_SINKS, I_RELB, I_NORM_MEM, I_WMKV, I_WBR, I_WOUT, I_NORMF };

struct Frame {
    LAS unsigned char* lds;
    int tid, lane, wave, G, bid;
    const float* const* in; float* out; unsigned char* ws;
};

template <bool WINMAP>
__device__ __forceinline__ void p0_transpose_item(const float* W, int K, int Nsrc, bf16_t* WT, LAS bf16_t* scr, int kb, int nb, int lane) {
    constexpr int TP = 130;
    const int k0 = 64 * kb, n0 = 128 * nb;
    const int dj = n0 + 4 * (lane & 31);
    const int sc = WINMAP ? win_src_col(dj) : dj;
    f32x4 v[32];
#pragma unroll
    for (int i = 0; i < 32; ++i) { const int kk = 2 * i + (lane >> 5); v[i] = sc >= 0 ? *(const f32x4*)(W + (size_t)(k0 + kk) * Nsrc + sc) : (f32x4){0.f, 0.f, 0.f, 0.f}; }
#pragma unroll
    for (int i = 0; i < 32; ++i) { const int kk = 2 * i + (lane >> 5); LAS unsigned* d = (LAS unsigned*)(scr + kk * TP + 4 * (lane & 31)); d[0] = pk2(v[i].x, v[i].y); d[1] = pk2(v[i].z, v[i].w); }
    LDS_WAIT(); asm volatile("" ::: "memory");
#pragma unroll 4
    for (int u = 0; u < 16; ++u) { const int e = lane + 64 * u, ch = e & 7, n = e >> 3; const LAS bf16_t* s = scr + (8 * ch) * TP + n;
        u32x4 o; o.x = (unsigned)s[0] | ((unsigned)s[TP] << 16); o.y = (unsigned)s[2 * TP] | ((unsigned)s[3 * TP] << 16);
        o.z = (unsigned)s[4 * TP] | ((unsigned)s[5 * TP] << 16); o.w = (unsigned)s[6 * TP] | ((unsigned)s[7 * TP] << 16);
        *(u32x4*)(WT + (size_t)(n0 + n) * K + k0 + 8 * ch) = o; }
    LDS_WAIT(); asm volatile("" ::: "memory");
}
__device__ __forceinline__ void rms_row_to_bf16(const float* xrow, const float* w, bf16_t* orow, int lane) {
    const f32x4* xr = (const f32x4*)xrow + lane; const f32x4* wr = (const f32x4*)w + lane;
    f32x4 v[8]; float s = 0.f;
#pragma unroll
    for (int j = 0; j < 8; ++j) { v[j] = xr[64 * j]; s += (v[j].x * v[j].x + v[j].y * v[j].y) + (v[j].z * v[j].z + v[j].w * v[j].w); }
    const float r = rsqrtf(wave_sum(s) * (1.f / D) + EPS);
    unsigned long long* o8 = (unsigned long long*)orow + lane;
#pragma unroll
    for (int j = 0; j < 8; ++j) { const f32x4 ww = wr[64 * j];
        o8[64 * j] = (unsigned long long)pk2(v[j].x * r * ww.x, v[j].y * r * ww.y) | ((unsigned long long)pk2(v[j].z * r * ww.z, v[j].w * r * ww.w) << 32); }
}
__device__ __forceinline__ int t5_bucket(int n) {
    if (n < 16) return n;
    int large = 16 + (int)(logf((float)n / 16.f) / 2.0794415416798357f * 16.f);
    return large < 31 ? large : 31;
}
__device__ __forceinline__ void p0_prologue(Frame& F) {
    LAS bf16_t* scr = (LAS bf16_t*)(F.lds + F.wave * 16896);
    const int gw = F.bid * NWAVES + F.wave, NGW = F.G * NWAVES;
    constexpr int I_IN = 32 * (NIN / 128), I_MKV = 32 * 16, I_BR = 16 * 16, I_OUT = 32 * 16;
    constexpr int NITEMS = I_IN + I_MKV + 3 * I_BR + I_OUT;
    bf16_t* WINT = (bf16_t*)(F.ws + WS_WIN); bf16_t* WMKVT = (bf16_t*)(F.ws + WS_WMKV); bf16_t* WBT = (bf16_t*)(F.ws + WS_WB); bf16_t* WOT = (bf16_t*)(F.ws + WS_WO);
    for (int it = gw; it < NITEMS; it += NGW) {
        int r = it;
        if (r < I_IN) { p0_transpose_item<true>(F.in[I_WIN], D, IN_COLS, WINT, scr, r / (NIN / 128), r % (NIN / 128), F.lane); continue; } r -= I_IN;
        if (r < I_MKV) { p0_transpose_item<false>(F.in[I_WMKV], D, 2048, WMKVT, scr, r / 16, r % 16, F.lane); continue; } r -= I_MKV;
        if (r < 3 * I_BR) { const int b = r / I_BR, q = r % I_BR; p0_transpose_item<false>(F.in[I_WBR] + (size_t)b * 1024 * 2048, 1024, 2048, WBT + (size_t)b * 2048 * 1024, scr, q / 16, q % 16, F.lane); continue; } r -= 3 * I_BR;
        p0_transpose_item<false>(F.in[I_WOUT], D, 2048, WOT, scr, r / 16, r % 16, F.lane);
    }
    bf16_t* XN = (bf16_t*)((unsigned char*)F.out + DO_XN); bf16_t* MEMN = (bf16_t*)(F.ws + WS_MEMN);
    for (int m = gw; m < M + 512; m += NGW) {
        if (m < MP) rms_row_to_bf16(F.in[I_XP] + (size_t)m * D, F.in[I_NORM_IN], XN + (size_t)m * D, F.lane);
        else if (m < M) rms_row_to_bf16(F.in[I_XS] + (size_t)(m - MP) * D, F.in[I_NORM_IN], XN + (size_t)m * D, F.lane);
        else rms_row_to_bf16(F.in[I_MEMP] + (size_t)(m - M) * D, F.in[I_NORM_MEM], MEMN + (size_t)(m - M) * D, F.lane);
    }
    float* BT = (float*)(F.ws + WS_BTAB);
    for (int i = F.bid * NTHREADS + F.tid; i < 16 * 128; i += F.G * NTHREADS) { const int h = i >> 7, dist = i & 127; BT[i] = F.in[I_RELB][t5_bucket(dist) * 16 + h]; }
}

struct SchedP1 {
    int G, c; const unsigned char* ws; const unsigned char* xn;
    __device__ __forceinline__ int ntiles(const pg8::Unit&) const { return D / 64; }
    static constexpr int NM = M / 256, NN = NIN / 256, NU0 = NM * NN, NU = NU0 + 16;
    __device__ __forceinline__ bool next(int i, pg8::Unit& u) const {
        const long L = (long)i * G + c; if (L >= NU) return false;
        if (L < NU0) { pg8::tile_of((int)L, NM, NN, u.pm, u.pn); u.job = 0; } else { const int q = (int)L - NU0; u.pm = q >> 3; u.pn = q & 7; u.job = 1; }
        return true;
    }
    __device__ __forceinline__ void ptrs(const pg8::Unit& u, const char*& A, const char*& B) const {
        const size_t tstep = (size_t)256 * D * 2;
        if (u.job == 0) { A = (const char*)xn + (size_t)u.pm * tstep; B = (const char*)ws + WS_WIN + (size_t)u.pn * tstep; }
        else { A = (const char*)ws + WS_MEMN + (size_t)u.pm * tstep; B = (const char*)ws + WS_WMKV + (size_t)u.pn * tstep; }
    }
};
struct EpiP1 {
    unsigned char* ws; float* out;
    __device__ __forceinline__ void operator()(const f32x4 (&acc)[2][2][4][2], const pg8::Unit& u, int wr, int wc, int fr, int fq) const {
        const int row0 = u.pm * 256 + wr * 64 + fr;
        const int cin = wc * 32 + 8 * fq;
        if (u.job == 1) {
            bf16_t* MK = (bf16_t*)(ws + WS_MEMKV);
#pragma unroll
            for (int ai = 0; ai < 2; ++ai)
#pragma unroll
                for (int m = 0; m < 4; ++m) { const int r = row0 + ai * 128 + m * 16;
#pragma unroll
                    for (int bj = 0; bj < 2; ++bj) { const int c = u.pn * 256 + bj * 128 + cin; const f32x4 v0 = acc[ai][bj][m][0], v1 = acc[ai][bj][m][1];
                        float* o = out + (c < 1024 ? O_MKP + (size_t)r * 1024 + c : O_MVP + (size_t)r * 1024 + (c - 1024));
                        *(f32x4*)o = v0; *(f32x4*)(o + 4) = v1;
                        u32x4 w; w.x = pg8::cvt_pk_bf16(v0[0], v0[1]); w.y = pg8::cvt_pk_bf16(v0[2], v0[3]); w.z = pg8::cvt_pk_bf16(v1[0], v1[1]); w.w = pg8::cvt_pk_bf16(v1[2], v1[3]);
                        *(u32x4*)(MK + (size_t)r * 2048 + c) = w;
                        if (c >= 1024) { bf16_t* MVT = (bf16_t*)(ws + WS_MVT) + ((size_t)((r >> 8) * 4 + ((c - 1024) >> 8)) * 256 + ((c - 1024) & 255)) * 256 + (r & 255);
                            MVT[0] = (bf16_t)(w.x & 0xffffu); MVT[256] = (bf16_t)(w.x >> 16); MVT[512] = (bf16_t)(w.y & 0xffffu); MVT[768] = (bf16_t)(w.y >> 16);
                            MVT[1024] = (bf16_t)(w.z & 0xffffu); MVT[1280] = (bf16_t)(w.z >> 16); MVT[1536] = (bf16_t)(w.w & 0xffffu); MVT[1792] = (bf16_t)(w.w >> 16); } } }
            return;
        }
        const int pn = u.pn;
        if (pn == 57) {
            if (wc == 0 && fq < 2) { float* GAB = (float*)(ws + WS_GAB);
#pragma unroll
                for (int ai = 0; ai < 2; ++ai)
#pragma unroll
                    for (int m = 0; m < 4; ++m) { const int r = row0 + ai * 128 + m * 16; float* o = GAB + (size_t)r * 16 + 8 * fq; *(f32x4*)o = acc[ai][0][m][0]; *(f32x4*)(o + 4) = acc[ai][0][m][1]; } }
            return;
        }
        bf16_t* base; int ld, ct, act = 0;
        if (pn < 12) { base = (bf16_t*)(ws + WS_QKV); ld = 3072; ct = pn; }
        else if (pn < 16) { base = (bf16_t*)(ws + WS_GZ); ld = 1024; ct = pn - 12; act = 1; }
        else if (pn < 20) { base = (bf16_t*)(ws + WS_SQ); ld = 1024; ct = pn - 16; }
        else if (pn < 24) { base = (bf16_t*)(ws + WS_SZ); ld = 1024; ct = pn - 20; act = 1; }
        else if (pn < 28) { base = (bf16_t*)(ws + WS_MQ); ld = 1024; ct = pn - 24; }
        else if (pn < 32) { base = (bf16_t*)(ws + WS_MZ); ld = 1024; ct = pn - 28; act = 1; }
        else if (pn < 56) { base = (bf16_t*)(ws + WS_GATES); ld = 6144; ct = pn - 32; act = 2; }
        else { base = (bf16_t*)(ws + WS_SKV); ld = 256; ct = 0; }
#pragma unroll
        for (int ai = 0; ai < 2; ++ai)
#pragma unroll
            for (int m = 0; m < 4; ++m) { bf16_t* rowp = base + (size_t)(row0 + ai * 128 + m * 16) * ld + ct * 256 + cin;
#pragma unroll
                for (int bj = 0; bj < 2; ++bj) { f32x4 v0 = acc[ai][bj][m][0], v1 = acc[ai][bj][m][1];
                    if (act == 1) {
#pragma unroll
                        for (int j = 0; j < 4; ++j) { v0[j] = siluf_(v0[j]); v1[j] = siluf_(v1[j]); } }
                    else if (act == 2) {
#pragma unroll
                        for (int j = 0; j < 4; ++j) { v0[j] = sigmoidf_(v0[j]); v1[j] = sigmoidf_(v1[j]); } }
                    u32x4 w; w.x = pg8::cvt_pk_bf16(v0[0], v0[1]); w.y = pg8::cvt_pk_bf16(v0[2], v0[3]); w.z = pg8::cvt_pk_bf16(v1[0], v1[1]); w.w = pg8::cvt_pk_bf16(v1[2], v1[3]);
                    *(u32x4*)(rowp + bj * 128) = w;
                    if (pn == 56 && bj == 1) { const int r = row0 + ai * 128 + m * 16;
                        if (r < MP) { bf16_t* vt = (bf16_t*)(ws + WS_VTS) + ((size_t)((r >> 13) * 2 + (cin >> 6)) * 64 + (cin & 63)) * SEQ + (r & (SEQ - 1));
                            vt[0] = (bf16_t)(w.x & 0xffffu); vt[SEQ] = (bf16_t)(w.x >> 16); vt[2 * SEQ] = (bf16_t)(w.y & 0xffffu); vt[3 * SEQ] = (bf16_t)(w.y >> 16);
                            vt[4 * SEQ] = (bf16_t)(w.z & 0xffffu); vt[5 * SEQ] = (bf16_t)(w.z >> 16); vt[6 * SEQ] = (bf16_t)(w.w & 0xffffu); vt[7 * SEQ] = (bf16_t)(w.w >> 16); } } } }
    }
};

__device__ __forceinline__ void gdn_gate_scalars(Frame& F, int r, int h) {
    const float* GAB = (const float*)(F.ws + WS_GAB); float* Gp = (float*)(F.ws + WS_G); float* Bp = (float*)(F.ws + WS_BETA);
    const float gb = GAB[(size_t)r * 16 + h], ga = GAB[(size_t)r * 16 + 8 + h];
    Bp[(size_t)r * 8 + h] = sigmoidf_(gb);
    const float xx = ga + F.in[I_DTB][h]; const float sp = xx > 20.f ? xx : log1pf(expf(xx));
    Gp[(size_t)r * 8 + h] = -expf(F.in[I_ALOG][h]) * sp;
}
__device__ __forceinline__ void conv_prompt_item(Frame& F, int item) {
    const int b = item >> 7, n = item & 127, row0 = b * SEQ + 64 * n, tid = F.tid;
    const bf16_t* QKV = (const bf16_t*)(F.ws + WS_QKV);
    bf16_t* QN = (bf16_t*)((unsigned char*)F.out + DO_QN); bf16_t* KN = (bf16_t*)((unsigned char*)F.out + DO_KN);
    bf16_t* KT = (bf16_t*)((unsigned char*)F.out + DO_KT); bf16_t* VT = (bf16_t*)((unsigned char*)F.out + DO_VT);
    const float* cw = F.in[I_CONVW];
    constexpr int SP = 136;
    LAS bf16_t* slab = (LAS bf16_t*)F.lds;
    { const int tok = tid >> 3, h = tid & 7; gdn_gate_scalars(F, row0 + tok, h); }
    const int t0 = tid >> 4, cg = (tid & 15) * 8;
    LAS float* cwl = (LAS float*)(F.lds + 32768);
    for (int i = tid; i < 4 * 3072 / 4; i += NTHREADS) ((LAS f32x4*)cwl)[i] = ((const f32x4*)cw)[i];
    __syncthreads();
    struct Slab { u32x4 x[2][4]; };
#define CONV_LOAD(S_, sl_) do { const int ch_ = ((sl_) >> 3) * 1024 + ((sl_) & 7) * 128 + cg; \
        _Pragma("unroll") for (int p = 0; p < 2; ++p) _Pragma("unroll") for (int j = 0; j < 4; ++j) { const int tk = t0 + 32 * p - 3 + j; \
            S_.x[p][j] = (64 * n + tk >= 0) ? *(const u32x4*)(QKV + (size_t)(row0 + tk) * 3072 + ch_) : (u32x4){0u, 0u, 0u, 0u}; } \
        } while (0)
#define CONV_SLAB(S_, sl_) do { const int part = (sl_) >> 3, h = (sl_) & 7; f32x4 wq[4][2]; \
        _Pragma("unroll") for (int j = 0; j < 4; ++j) { wq[j][0] = *(const LAS f32x4*)(cwl + j * 3072 + part * 1024 + h * 128 + cg); wq[j][1] = *(const LAS f32x4*)(cwl + j * 3072 + part * 1024 + h * 128 + cg + 4); } \
        _Pragma("unroll") for (int p = 0; p < 2; ++p) { \
            const int tok = t0 + 32 * p, r = row0 + tok; \
            float a[8]; \
            _Pragma("unroll") for (int e = 0; e < 8; ++e) a[e] = 0.f; \
            _Pragma("unroll") for (int j = 0; j < 4; ++j) { const u32x4 v = S_.x[p][j]; \
                a[0] += bf2f(v.x & 0xffffu) * wq[j][0][0]; a[1] += bf2f(v.x >> 16) * wq[j][0][1]; a[2] += bf2f(v.y & 0xffffu) * wq[j][0][2]; a[3] += bf2f(v.y >> 16) * wq[j][0][3]; \
                a[4] += bf2f(v.z & 0xffffu) * wq[j][1][0]; a[5] += bf2f(v.z >> 16) * wq[j][1][1]; a[6] += bf2f(v.w & 0xffffu) * wq[j][1][2]; a[7] += bf2f(v.w >> 16) * wq[j][1][3]; } \
            _Pragma("unroll") for (int e = 0; e < 8; ++e) a[e] = siluf_(a[e]); \
            if (part < 2) { float ss = ((a[0] * a[0] + a[1] * a[1]) + (a[2] * a[2] + a[3] * a[3])) + ((a[4] * a[4] + a[5] * a[5]) + (a[6] * a[6] + a[7] * a[7])); \
                ss += __shfl_xor(ss, 1); ss += __shfl_xor(ss, 2); ss += __shfl_xor(ss, 4); ss += __shfl_xor(ss, 8); \
                if (cg == 0) ((float*)(F.ws + (part == 0 ? WS_SSQ : WS_SSK)))[(size_t)(row0 + t0 + 32 * p) * 8 + h] = ss; } \
            u32x4 o4; o4.x = pk2(a[0], a[1]); o4.y = pk2(a[2], a[3]); o4.z = pk2(a[4], a[5]); o4.w = pk2(a[6], a[7]); \
            const size_t o = (size_t)r * 1024 + h * 128 + cg; \
            if (part == 0) *(u32x4*)(QN + o) = o4; \
            else { if (part == 1) *(u32x4*)(KN + o) = o4; *(LAS u32x4*)(slab + tok * SP + cg) = o4; } \
            if (n == 127 && tok >= 61) { const u32x4 raw = S_.x[p][3]; float* cdst = F.out + O_GCP + ((size_t)b * 3 + (tok - 61)) * 3072 + part * 1024 + h * 128 + cg; \
                *(f32x4*)cdst = (f32x4){bf2f(raw.x & 0xffffu), bf2f(raw.x >> 16), bf2f(raw.y & 0xffffu), bf2f(raw.y >> 16)}; \
                *(f32x4*)(cdst + 4) = (f32x4){bf2f(raw.z & 0xffffu), bf2f(raw.z >> 16), bf2f(raw.w & 0xffffu), bf2f(raw.w >> 16)}; } \
        } \
        if (part > 0) { \
            __syncthreads(); \
            bf16_t* dst = (part == 1 ? KT : VT) + (size_t)((b * 8 + h) * 128 + n) * 8192; \
            _Pragma("unroll") for (int u = 0; u < 2; ++u) { const int e = tid + 512 * u, chn = 16 * (e >> 7) + (e & 15), tg = 4 * ((e >> 6) & 1) + ((e >> 4) & 3); const LAS bf16_t* s = slab + (8 * tg) * SP + chn; \
                u32x4 o4; o4.x = (unsigned)s[0] | ((unsigned)s[SP] << 16); o4.y = (unsigned)s[2 * SP] | ((unsigned)s[3 * SP] << 16); \
                o4.z = (unsigned)s[4 * SP] | ((unsigned)s[5 * SP] << 16); o4.w = (unsigned)s[6 * SP] | ((unsigned)s[7 * SP] << 16); \
                *(u32x4*)(dst + e * 8) = o4; } \
            __syncthreads(); \
        } } while (0)
    Slab s0, s1, s2;
    CONV_LOAD(s0, 0); CONV_LOAD(s1, 1);
#pragma unroll 1
    for (int sl = 0; sl < 24; sl += 3) {
        CONV_LOAD(s2, sl + 2); CONV_SLAB(s0, sl);
        if (sl + 3 < 24) CONV_LOAD(s0, sl + 3); CONV_SLAB(s1, sl + 1);
        if (sl + 4 < 24) CONV_LOAD(s1, sl + 4); CONV_SLAB(s2, sl + 2);
    }
#undef CONV_LOAD
#undef CONV_SLAB
}
__device__ __forceinline__ void conv_sample_items(Frame& F) {
    const int gw = F.bid * NWAVES + F.wave, NGW = F.G * NWAVES, lane = F.lane;
    const bf16_t* QKV = (const bf16_t*)(F.ws + WS_QKV);
    bf16_t* QN = (bf16_t*)((unsigned char*)F.out + DO_QN); bf16_t* KN = (bf16_t*)((unsigned char*)F.out + DO_KN); bf16_t* VNS = (bf16_t*)((unsigned char*)F.out + DO_VNS);
    const float* cw = F.in[I_CONVW];
    for (int it = gw; it < 128 * 8; it += NGW) {
        const int bd = it >> 3, h = it & 7;
        float xr[3][7][2], wv[3][4][2];
#pragma unroll
        for (int part = 0; part < 3; ++part) { const int ch = part * 1024 + h * 128 + 2 * lane;
#pragma unroll
            for (int i = 0; i < 3; ++i) { const float2 p2 = *(const float2*)(F.in[I_SCONV] + ((size_t)bd * 3 + i) * 3072 + ch); xr[part][i][0] = p2.x; xr[part][i][1] = p2.y; }
#pragma unroll
            for (int i = 0; i < 4; ++i) { const unsigned v = *(const unsigned*)(QKV + (size_t)(MP + bd * 4 + i) * 3072 + ch); xr[part][3 + i][0] = bf2f(v & 0xffffu); xr[part][3 + i][1] = bf2f(v >> 16); }
#pragma unroll
            for (int j = 0; j < 4; ++j) { const float2 w2 = *(const float2*)(cw + j * 3072 + ch); wv[part][j][0] = w2.x; wv[part][j][1] = w2.y; } }
#pragma unroll
        for (int s = 0; s < 4; ++s) {
            const int r = MP + bd * 4 + s;
            float y[3][2];
#pragma unroll
            for (int part = 0; part < 3; ++part) { float a0 = 0.f, a1 = 0.f;
#pragma unroll
                for (int j = 0; j < 4; ++j) { a0 += xr[part][s + j][0] * wv[part][j][0]; a1 += xr[part][s + j][1] * wv[part][j][1]; }
                y[part][0] = siluf_(a0); y[part][1] = siluf_(a1); }
            const float sq = wave_sum(y[0][0] * y[0][0] + y[0][1] * y[0][1]), sk = wave_sum(y[1][0] * y[1][0] + y[1][1] * y[1][1]);
            const float rq = rsqrtf(sq + EPS) * 0.08838834764831845f, rk = rsqrtf(sk + EPS);
            const size_t o = (size_t)r * 1024 + h * 128 + 2 * lane;
            *(unsigned*)(QN + o) = pk2(y[0][0] * rq, y[0][1] * rq);
            *(unsigned*)(KN + o) = pk2(y[1][0] * rk, y[1][1] * rk);
            *(unsigned*)(VNS + (size_t)(r - MP) * 1024 + h * 128 + 2 * lane) = pk2(y[2][0], y[2][1]);
            if (lane == 0) gdn_gate_scalars(F, r, h);
            if (s >= 1) { float* cdst = F.out + O_GCS + ((size_t)bd * 3 + (s - 1)) * 3072;
#pragma unroll
                for (int part = 0; part < 3; ++part) { const int ch = part * 1024 + h * 128 + 2 * lane; *(float2*)(cdst + ch) = make_float2(xr[part][3 + s][0], xr[part][3 + s][1]); } }
        }
    }
}
__device__ __forceinline__ void p2_conv(Frame& F) {
    for (int it = F.bid; it < 256; it += F.G) conv_prompt_item(F, it);
    conv_sample_items(F);
}

__device__ __forceinline__ f32x4 mfma16(bf16x8 a, bf16x8 b, f32x4 c) { return __builtin_amdgcn_mfma_f32_16x16x32_bf16(a, b, c, 0, 0, 0); }
__device__ __forceinline__ u32x2 pack4(f32x4 v) { u32x2 r; r.x = pk2(v[0], v[1]); r.y = pk2(v[2], v[3]); return r; }
__device__ __forceinline__ void prep_item(Frame& F, int item) {
    const int b = item >> 7, n = item & 127, row0 = b * SEQ + 64 * n, lane = F.lane, h = F.wave, c = lane & 15, q = lane >> 4;
    const int ci = (b * 8 + h) * 128 + n;
    const bf16_t* QN = (const bf16_t*)((const unsigned char*)F.out + DO_QN); const bf16_t* KN = (const bf16_t*)((const unsigned char*)F.out + DO_KN);
    const bf16_t* KT = (const bf16_t*)((const unsigned char*)F.out + DO_KT) + (size_t)ci * 8192; const bf16_t* VT = (const bf16_t*)((const unsigned char*)F.out + DO_VT) + (size_t)ci * 8192;
    bf16_t* NEGW = (bf16_t*)(F.ws + WS_NEGW) + (size_t)ci * 8192; bf16_t* UT = (bf16_t*)(F.ws + WS_UT) + (size_t)ci * 8192; bf16_t* ATT = (bf16_t*)(F.ws + WS_ATT) + (size_t)ci * 4096;
    const float* Gp = (const float*)(F.ws + WS_G); const float* Bp = (const float*)(F.ws + WS_BETA);
    float* GC = (float*)(F.ws + WS_GC); float* DEC = (float*)(F.ws + WS_DEC); float* GT = (float*)(F.ws + WS_GT);
    LAS float* Als = (LAS float*)(F.lds + h * 18432);
    LAS float* gcs = Als + 4096; LAS float* bes = gcs + 64;
    float gc = Gp[(size_t)(row0 + lane) * 8 + h];
#pragma unroll
    for (int o = 1; o < 64; o <<= 1) { const float x = __shfl_up(gc, o); if (lane >= o) gc += x; }
    const float beta = Bp[(size_t)(row0 + lane) * 8 + h];
    const float gl = __shfl(gc, 63);
    const float sk = ((const float*)(F.ws + WS_SSK))[(size_t)(row0 + lane) * 8 + h], sq = ((const float*)(F.ws + WS_SSQ))[(size_t)(row0 + lane) * 8 + h];
    const float rk = rsqrtf(sk + EPS), rq = rsqrtf(sq + EPS) * 0.08838834764831845f;
    LAS float* rks = bes + 64; LAS float* rqs = rks + 64;
    gcs[lane] = gc; bes[lane] = beta; rks[lane] = rk; rqs[lane] = rq;
    GC[(size_t)(row0 + lane) * 8 + h] = __expf(gc) * rq; DEC[(size_t)ci * 64 + lane] = __expf(gl - gc) * rk; if (lane == 0) GT[ci] = __expf(gl);
    LDS_WAIT(); asm volatile("" ::: "memory");
    bf16x8 kf[4][4];
#pragma unroll
    for (int mt = 0; mt < 4; ++mt)
#pragma unroll
        for (int s = 0; s < 4; ++s) { const size_t o = (size_t)(row0 + 16 * mt + c) * 1024 + h * 128 + 32 * s + 8 * q; kf[mt][s] = *(const bf16x8*)(KN + o); }
#pragma unroll
    for (int mi = 0; mi < 4; ++mi) {
        const int ii = 16 * mi + c; const float gci = gcs[ii], bi = bes[ii] * rks[ii], rqi = rqs[ii];
        const bf16_t* qrow_p = QN + (size_t)(row0 + ii) * 1024 + h * 128 + 8 * q;
#pragma unroll
        for (int nj = 0; nj < 4; ++nj) {
            u32x2 av; av.x = 0u; av.y = 0u;
            if (nj <= mi) {
                f32x4 dk = {0.f, 0.f, 0.f, 0.f}, dq = {0.f, 0.f, 0.f, 0.f};
#pragma unroll
                for (int s = 0; s < 4; ++s) { dk = mfma16(kf[nj][s], kf[mi][s], dk); dq = mfma16(kf[nj][s], *(const bf16x8*)(qrow_p + 32 * s), dq); }
                const f32x4 gj = *(const LAS f32x4*)(gcs + 16 * nj + 4 * q), rkj = *(const LAS f32x4*)(rks + 16 * nj + 4 * q);
                f32x4 a, at;
#pragma unroll
                for (int r = 0; r < 4; ++r) { const int jj = 16 * nj + 4 * q + r; const float e = __expf(gci - gj[r]);
                    a[r] = (ii > jj) ? bi * rkj[r] * dk[r] * e : 0.f; at[r] = (ii >= jj) ? rqi * rkj[r] * dq[r] * e : 0.f; }
                *(LAS f32x4*)(Als + ii * 64 + 16 * nj + 4 * q) = a;
                av = pack4(at);
            }
            *(u32x2*)(ATT + ((mi * 2 + (nj >> 1)) * 64 + (2 * (nj & 1) + (q >> 1)) * 16 + c) * 8 + 4 * (q & 1)) = av;
        }
    }
    LDS_WAIT();
    float t[64];
#pragma unroll
    for (int i = 0; i < 64; ++i) {
        float acc = (lane == i) ? 1.f : 0.f;
#pragma unroll
        for (int m4 = 0; m4 < i; m4 += 4) { const f32x4 a = *(const LAS f32x4*)(Als + i * 64 + m4);
            acc -= a[0] * t[m4]; if (m4 + 1 < i) acc -= a[1] * t[m4 + 1]; if (m4 + 2 < i) acc -= a[2] * t[m4 + 2]; if (m4 + 3 < i) acc -= a[3] * t[m4 + 3]; }
        t[i] = acc;
    }
    LAS bf16_t* T1 = (LAS bf16_t*)Als; LAS bf16_t* T2 = T1 + 64 * 72;
    const float s1 = beta, s2 = -beta * __expf(gc) * rk;
    LDS_WAIT();
#pragma unroll
    for (int i = 0; i < 64; ++i) { T1[i * 72 + lane] = (bf16_t)f2bf(t[i] * s1); T2[i * 72 + lane] = (bf16_t)f2bf(t[i] * s2); }
    LDS_WAIT();
    bf16x8 t1f[4][2], t2f[4][2];
#pragma unroll
    for (int it = 0; it < 4; ++it)
#pragma unroll
        for (int s = 0; s < 2; ++s) { t1f[it][s] = *(const LAS bf16x8*)(T1 + (16 * it + c) * 72 + 32 * s + 8 * q); t2f[it][s] = *(const LAS bf16x8*)(T2 + (16 * it + c) * 72 + 32 * s + 8 * q); }
#pragma unroll 2
    for (int dt = 0; dt < 8; ++dt) {
        bf16x8 vb[2], ka[2];
#pragma unroll
        for (int s = 0; s < 2; ++s) { vb[s] = *(const bf16x8*)(VT + ((dt * 2 + s) * 64 + lane) * 8); ka[s] = *(const bf16x8*)(KT + ((dt * 2 + s) * 64 + lane) * 8); }
#pragma unroll
        for (int it = 0; it < 4; ++it) {
            f32x4 du = {0.f, 0.f, 0.f, 0.f}, dw = {0.f, 0.f, 0.f, 0.f};
            du = mfma16(t1f[it][0], vb[0], du); dw = mfma16(ka[0], t2f[it][0], dw);
            if (it >= 2) { du = mfma16(t1f[it][1], vb[1], du); dw = mfma16(ka[1], t2f[it][1], dw); }
            *(u32x2*)(UT + ((dt * 2 + (it >> 1)) * 64 + (2 * (it & 1) + (q >> 1)) * 16 + c) * 8 + 4 * (q & 1)) = pack4(du);
            *(u32x2*)(NEGW + ((it * 4 + (dt >> 1)) * 64 + (2 * (dt & 1) + (q >> 1)) * 16 + c) * 8 + 4 * (q & 1)) = pack4(dw);
        }
    }
    LDS_WAIT();
}
__device__ __forceinline__ void p2_prep(Frame& F) { for (int it = F.bid; it < 256; it += F.G) { prep_item(F, it); __syncthreads(); } }

__device__ __forceinline__ void scan_item(Frame& F, int bh, int sl) {
    const int lane = F.lane, w = F.wave, c = lane & 15, q = lane >> 4, dvs = 16 * sl;
    const bf16_t* KT = (const bf16_t*)((const unsigned char*)F.out + DO_KT); const bf16_t* NEGW = (const bf16_t*)(F.ws + WS_NEGW);
    bf16_t* UT = (bf16_t*)(F.ws + WS_UT); bf16_t* SN = (bf16_t*)(F.ws + WS_SN);
    const float* DEC = (const float*)(F.ws + WS_DEC); const float* GT = (const float*)(F.ws + WS_GT);
    LAS bf16_t* SS = (LAS bf16_t*)F.lds;
    LAS bf16_t* VS = SS + 16 * 136;
    LAS bf16_t* VU = VS + 16 * 72;
    f32x4 Sacc = {0.f, 0.f, 0.f, 0.f};
    for (int e = F.tid; e < 16 * 136 / 2; e += NTHREADS) ((LAS unsigned*)SS)[e] = 0u;
    struct Ops { bf16x8 wf[4], kf[2]; u32x2 u2; f32x4 dec4; float gt; };
#define SCAN_LOAD(o, n_) do { const size_t ci__ = (size_t)bh * 128 + ((n_) < 128 ? (n_) : 127); \
        _Pragma("unroll") for (int s = 0; s < 2; ++s) o.kf[s] = *(const bf16x8*)(KT + ci__ * 8192 + ((w * 2 + s) * 64 + lane) * 8); \
        o.gt = GT[ci__]; \
        if (w < 4) { _Pragma("unroll") for (int s = 0; s < 4; ++s) o.wf[s] = *(const bf16x8*)(NEGW + ci__ * 8192 + ((w * 4 + s) * 64 + lane) * 8); \
            o.u2 = *(const u32x2*)(UT + ci__ * 8192 + ((sl * 2 + (w >> 1)) * 64 + (2 * (w & 1) + (q >> 1)) * 16 + c) * 8 + 4 * (q & 1)); o.dec4 = *(const f32x4*)(DEC + ci__ * 64 + 16 * w + 4 * q); } } while (0)
#define SCAN_STEP(o, n_) do { const size_t ci = (size_t)bh * 128 + (n_); \
        if (w < 4) { \
            f32x4 v = {bf2f(o.u2.x & 0xffffu), bf2f(o.u2.x >> 16), bf2f(o.u2.y & 0xffffu), bf2f(o.u2.y >> 16)}; \
            _Pragma("unroll") for (int s = 0; s < 4; ++s) { const bf16x8 sf = *(const LAS bf16x8*)(SS + c * 136 + 32 * s + 8 * q); v = mfma16(o.wf[s], sf, v); } \
            *(LAS u32x2*)(VU + c * 72 + 16 * w + 4 * q) = pack4(v); \
            const f32x4 vd = v * o.dec4; \
            *(LAS u32x2*)(VS + c * 72 + 16 * w + 4 * q) = pack4(vd); \
        } else if (w == 4) {   \
            _Pragma("unroll") for (int u = 0; u < 4; ++u) {   \
                *(u32x4*)(SN + ci * 16384 + ((sl * 4 + u) * 64 + lane) * 8) = *(const LAS u32x4*)(SS + c * 136 + 32 * u + 8 * q); } \
        } \
        asm volatile("s_waitcnt lgkmcnt(0)" ::: "memory"); __builtin_amdgcn_s_barrier(); asm volatile("" ::: "memory"); \
        Sacc = Sacc * o.gt; \
        _Pragma("unroll") for (int s = 0; s < 2; ++s) { const bf16x8 vf = *(const LAS bf16x8*)(VS + c * 72 + 32 * s + 8 * q); Sacc = mfma16(o.kf[s], vf, Sacc); } \
        if (w == 5) {   \
            _Pragma("unroll") for (int u = 0; u < 2; ++u) { \
                *(u32x4*)(UT + ci * 8192 + ((sl * 2 + u) * 64 + lane) * 8) = *(const LAS u32x4*)(VU + c * 72 + 32 * u + 8 * q); } } \
        { const u32x2 sp = pack4(Sacc); *(LAS u32x2*)(SS + c * 136 + 16 * w + 4 * q) = sp; } \
        asm volatile("s_waitcnt lgkmcnt(0)" ::: "memory"); __builtin_amdgcn_s_barrier(); asm volatile("" ::: "memory"); } while (0)
    Ops o0, o1, o2, o3;
    SCAN_LOAD(o0, 0); SCAN_LOAD(o1, 1); SCAN_LOAD(o2, 2);
    asm volatile("s_waitcnt lgkmcnt(0)" ::: "memory"); __builtin_amdgcn_s_barrier(); asm volatile("" ::: "memory");
#pragma unroll 1
    for (int n0 = 0; n0 < 128; n0 += 4) {
        SCAN_LOAD(o3, n0 + 3); SCAN_STEP(o0, n0);
        SCAN_LOAD(o0, n0 + 4); SCAN_STEP(o1, n0 + 1);
        SCAN_LOAD(o1, n0 + 5); SCAN_STEP(o2, n0 + 2);
        SCAN_LOAD(o2, n0 + 6); SCAN_STEP(o3, n0 + 3);
    }
#undef SCAN_LOAD
#undef SCAN_STEP
    float* so = F.out + O_GSP + (size_t)bh * 16384;
#pragma unroll
    for (int r = 0; r < 4; ++r) so[(size_t)(16 * w + 4 * q + r) * 128 + dvs + c] = Sacc[r];
}

__device__ __forceinline__ void gdn_out_item(Frame& F, int item) {
    const int b = item >> 7, n = item & 127, row0 = b * SEQ + 64 * n, lane = F.lane, h = F.wave, c = lane & 15, q = lane >> 4;
    const size_t ci = (size_t)(b * 8 + h) * 128 + n;
    const bf16_t* QN = (const bf16_t*)((const unsigned char*)F.out + DO_QN);
    const bf16_t* SN = (const bf16_t*)(F.ws + WS_SN) + ci * 16384; const bf16_t* VNT = (const bf16_t*)(F.ws + WS_UT) + ci * 8192; const bf16_t* ATT = (const bf16_t*)(F.ws + WS_ATT) + ci * 4096;
    const float* GC = (const float*)(F.ws + WS_GC); const bf16_t* GZ = (const bf16_t*)(F.ws + WS_GZ); bf16_t* OG = (bf16_t*)(F.ws + WS_OG); const float* gn = F.in[I_GNORM];
    LAS bf16_t* ol = (LAS bf16_t*)(F.lds + h * 18432);
    bf16x8 qf[4][4], af[4][2]; float egc[4], ss[4];
#pragma unroll
    for (int it = 0; it < 4; ++it) { const int i = 16 * it + c; const size_t r = (size_t)row0 + i;
#pragma unroll
        for (int s = 0; s < 4; ++s) qf[it][s] = *(const bf16x8*)(QN + r * 1024 + h * 128 + 32 * s + 8 * q);
#pragma unroll
        for (int s = 0; s < 2; ++s) af[it][s] = *(const bf16x8*)(ATT + ((it * 2 + s) * 64 + lane) * 8);
        egc[it] = GC[r * 8 + h]; ss[it] = 0.f; }
#pragma unroll 1
    for (int dt = 0; dt < 8; ++dt) {
        bf16x8 sf[4], vf[2];
#pragma unroll
        for (int s = 0; s < 4; ++s) sf[s] = *(const bf16x8*)(SN + ((dt * 4 + s) * 64 + lane) * 8);
#pragma unroll
        for (int s = 0; s < 2; ++s) vf[s] = *(const bf16x8*)(VNT + ((dt * 2 + s) * 64 + lane) * 8);
#pragma unroll
        for (int it = 0; it < 4; ++it) {
            f32x4 a = {0.f, 0.f, 0.f, 0.f};
#pragma unroll
            for (int s = 0; s < 4; ++s) a = mfma16(sf[s], qf[it][s], a);
            a = a * egc[it];
#pragma unroll
            for (int s = 0; s < 2; ++s) a = mfma16(vf[s], af[it][s], a);
            ss[it] += (a[0] * a[0] + a[1] * a[1]) + (a[2] * a[2] + a[3] * a[3]);
            *(LAS u32x2*)(ol + (16 * it + c) * 136 + 16 * dt + 4 * q) = pack4(a);
        }
    }
    float rs[4];
#pragma unroll
    for (int it = 0; it < 4; ++it) { float s = ss[it]; s += __shfl_xor(s, 16); s += __shfl_xor(s, 32); rs[it] = rsqrtf(s * (1.f / 128.f) + EPS); }
    LDS_WAIT();
#pragma unroll
    for (int it = 0; it < 4; ++it)
#pragma unroll
        for (int dt = 0; dt < 8; ++dt) { const size_t o = ((size_t)row0 + 16 * it + c) * 1024 + h * 128 + 16 * dt + 4 * q; const u32x2 z = *(const u32x2*)(GZ + o); const f32x4 g4 = *(const f32x4*)(gn + 16 * dt + 4 * q);
            const u32x2 pv = *(const LAS u32x2*)(ol + (16 * it + c) * 136 + 16 * dt + 4 * q); f32x4 v;
            v[0] = bf2f(pv.x & 0xffffu) * rs[it] * g4[0] * bf2f(z.x & 0xffffu); v[1] = bf2f(pv.x >> 16) * rs[it] * g4[1] * bf2f(z.x >> 16);
            v[2] = bf2f(pv.y & 0xffffu) * rs[it] * g4[2] * bf2f(z.y & 0xffffu); v[3] = bf2f(pv.y >> 16) * rs[it] * g4[3] * bf2f(z.y >> 16);
            *(u32x2*)(OG + o) = pack4(v); }
    LDS_WAIT();
}

__device__ __forceinline__ void gdn_seq_item(Frame& F, int row0, int L, int h, const float* S0, float* Sout, bf16_t* OG) {
    const bf16_t* QN = (const bf16_t*)((unsigned char*)F.out + DO_QN); const bf16_t* KN = (const bf16_t*)((unsigned char*)F.out + DO_KN); const bf16_t* VNS = (const bf16_t*)((unsigned char*)F.out + DO_VNS);
    const float* Gp = (const float*)(F.ws + WS_G); const float* Bp = (const float*)(F.ws + WS_BETA);
    const int tid = F.tid, dvc = tid & 127, dkq = tid >> 7;
    constexpr int TB = 32;
    LAS float* sq = (LAS float*)F.lds;
    LAS float* sk = sq + TB * 128;
    LAS float* sv = sk + TB * 128;
    LAS float* sg = sv + TB * 128;
    LAS float* red = sg + 2 * TB;
    LAS float* redqk = red + 2 * 2 * 4 * 128;
    float S[32];
#pragma unroll
    for (int i = 0; i < 32; ++i) S[i] = S0 ? S0[(size_t)(32 * dkq + i) * 128 + dvc] : 0.f;
    int buf = 0;
    for (int t0 = 0; t0 < L; t0 += TB) {
        const int nb = (L - t0) < TB ? (L - t0) : TB;
        __syncthreads();
        for (int e = tid; e < nb * 128; e += NTHREADS) { const int tt = e >> 7, c = e & 127; const size_t o = (size_t)(row0 + t0 + tt) * 1024 + h * 128 + c;
            sq[e] = bf2f(QN[o]); sk[e] = bf2f(KN[o]); sv[e] = bf2f(VNS[o - (size_t)MP * 1024]); }
        if (tid < nb) { sg[tid] = expf(Gp[(size_t)(row0 + t0 + tid) * 8 + h]); sg[TB + tid] = Bp[(size_t)(row0 + t0 + tid) * 8 + h]; }
        __syncthreads();
        for (int tt = 0; tt < nb; ++tt) {
            const LAS float* kq = sk + tt * 128 + 32 * dkq; const LAS float* qq = sq + tt * 128 + 32 * dkq;
            float pk = 0.f, pq = 0.f, pqk = 0.f;
#pragma unroll
            for (int i = 0; i < 32; ++i) { const float kk = kq[i], qv = qq[i]; pk += kk * S[i]; pq += qv * S[i]; pqk += qv * kk; }
            LAS float* rb = red + buf * 1024;
            rb[dkq * 128 + dvc] = pk; rb[512 + dkq * 128 + dvc] = pq; if (dvc == 0) redqk[buf * 4 + dkq] = pqk;
            __syncthreads();
            const float kS = (rb[dvc] + rb[128 + dvc]) + (rb[256 + dvc] + rb[384 + dvc]);
            const float qS = (rb[512 + dvc] + rb[640 + dvc]) + (rb[768 + dvc] + rb[896 + dvc]);
            const float qk = (redqk[buf * 4] + redqk[buf * 4 + 1]) + (redqk[buf * 4 + 2] + redqk[buf * 4 + 3]);
            const float e = sg[tt], beta = sg[TB + tt];
            const float vnew = beta * (sv[tt * 128 + dvc] - e * kS);
            const float o = e * qS + qk * vnew;
#pragma unroll
            for (int i = 0; i < 32; ++i) S[i] = e * S[i] + kq[i] * vnew;
            if (dkq == 0) OG[(size_t)(row0 + t0 + tt) * 1024 + h * 128 + dvc] = (bf16_t)f2bf(o);
            buf ^= 1;
        }
    }
#pragma unroll
    for (int i = 0; i < 32; ++i) Sout[(size_t)(32 * dkq + i) * 128 + dvc] = S[i];
    __syncthreads();
}
__device__ __forceinline__ void p2_gdn_sample(Frame& F, int wk, int nwk, int lo, int hi) {
    bf16_t* OG = (bf16_t*)(F.ws + WS_OG);
    for (int q = lo + wk; q < hi; q += nwk) { const int bd = q >> 3, h = q & 7; gdn_seq_item(F, MP + bd * 4, 4, h, F.in[I_SGDN] + (size_t)q * 16384, F.out + O_GSS + (size_t)q * 16384, OG); }
}
__device__ __forceinline__ void p2_gdn_norm_sample(Frame& F) {
    const int gw = F.bid * NWAVES + F.wave, NGW = F.G * NWAVES, lane = F.lane;
    bf16_t* OG = (bf16_t*)(F.ws + WS_OG); const bf16_t* GZ = (const bf16_t*)(F.ws + WS_GZ); const float* gn = F.in[I_GNORM];
    for (int it = gw; it < MS * 8; it += NGW) {
        const size_t o = (size_t)(MP + (it >> 3)) * 1024 + (it & 7) * 128 + 2 * lane;
        const unsigned v = *(const unsigned*)(OG + o), z = *(const unsigned*)(GZ + o);
        const float a = bf2f(v & 0xffffu), b = bf2f(v >> 16);
        const float r = rsqrtf(wave_sum(a * a + b * b) * (1.f / 128.f) + EPS);
        *(unsigned*)(OG + o) = pk2(a * r * gn[2 * lane] * bf2f(z & 0xffffu), b * r * gn[2 * lane + 1] * bf2f(z >> 16));
    }
}

__device__ __forceinline__ void swa_wave_item(Frame& F, bool sample, int bidx, int t, int kv) {
    const int lane = F.lane;
    LAS float* qs = (LAS float*)(F.lds + F.wave * 8192);
    LAS float* ps = qs + 512;
    const bf16_t* SQ = (const bf16_t*)(F.ws + WS_SQ); const bf16_t* SKV = (const bf16_t*)(F.ws + WS_SKV); const bf16_t* SZ = (const bf16_t*)(F.ws + WS_SZ);
    const float* BT = (const float*)(F.ws + WS_BTAB);
    const int row = sample ? MP + bidx * 4 + t : bidx * SEQ + t;
    const int qpos = sample ? 128 + t : t;
    for (int e = lane; e < 512; e += 64) qs[e] = bf2f(SQ[(size_t)row * 1024 + kv * 512 + e]);
    LDS_WAIT();
#pragma unroll 1
    for (int u = 0; u < 2; ++u) {
        const int j = lane + 64 * u; const int kp = qpos - j;
        float kr[64];
        const bool valid = kp >= 0;
        if (valid) {
            if (sample && kp < 128) { const float* p = F.in[I_CSK] + (((size_t)bidx * 128 + kp) * 2 + kv) * 64;
#pragma unroll
                for (int d = 0; d < 64; d += 4) { const f32x4 v = *(const f32x4*)(p + d); kr[d] = v.x; kr[d + 1] = v.y; kr[d + 2] = v.z; kr[d + 3] = v.w; } }
            else { const int krow = sample ? MP + bidx * 4 + (kp - 128) : bidx * SEQ + kp; const bf16_t* p = SKV + (size_t)krow * 256 + kv * 64;
#pragma unroll
                for (int d = 0; d < 64; d += 8) { const u32x4 v = *(const u32x4*)(p + d);
                    kr[d] = bf2f(v.x & 0xffffu); kr[d + 1] = bf2f(v.x >> 16); kr[d + 2] = bf2f(v.y & 0xffffu); kr[d + 3] = bf2f(v.y >> 16);
                    kr[d + 4] = bf2f(v.z & 0xffffu); kr[d + 5] = bf2f(v.z >> 16); kr[d + 6] = bf2f(v.w & 0xffffu); kr[d + 7] = bf2f(v.w >> 16); } }
        } else {
#pragma unroll
            for (int d = 0; d < 64; ++d) kr[d] = 0.f;
        }
#pragma unroll 1
        for (int g = 0; g < 8; ++g) { float a = 0.f;
#pragma unroll
            for (int d = 0; d < 64; d += 4) { const f32x4 qv = *(const LAS f32x4*)(qs + g * 64 + d); a += kr[d] * qv.x + kr[d + 1] * qv.y + kr[d + 2] * qv.z + kr[d + 3] * qv.w; }
            ps[g * 128 + j] = valid ? a * 0.125f + BT[(kv * 8 + g) * 128 + j] : -INFINITY; }
    }
    LDS_WAIT();
    float inv[8];
#pragma unroll
    for (int g = 0; g < 8; ++g) {
        const float sink = F.in[I_SINKS][kv * 8 + g];
        const float l0 = ps[g * 128 + lane], l1 = ps[g * 128 + 64 + lane];
        const float mx = fmaxf(wave_max(fmaxf(l0, l1)), sink);
        const float p0 = __expf(l0 - mx), p1 = __expf(l1 - mx);
        const float den = wave_sum(p0 + p1) + __expf(sink - mx);
        inv[g] = 1.f / den;
        ps[g * 128 + lane] = p0; ps[g * 128 + 64 + lane] = p1;
    }
    LDS_WAIT();
    float o[8];
#pragma unroll
    for (int g = 0; g < 8; ++g) o[g] = 0.f;
#pragma unroll 1
    for (int j0 = 0; j0 < 128; j0 += 8) {
        float vv[8];
#pragma unroll
        for (int u = 0; u < 8; ++u) { int kp = qpos - (j0 + u); kp = kp < 0 ? 0 : kp;
            if (sample && kp < 128) vv[u] = F.in[I_CSV][(((size_t)bidx * 128 + kp) * 2 + kv) * 64 + lane];
            else { const int krow = sample ? MP + bidx * 4 + (kp - 128) : bidx * SEQ + kp; vv[u] = bf2f(SKV[(size_t)krow * 256 + 128 + kv * 64 + lane]); } }
#pragma unroll
        for (int u = 0; u < 8; ++u)
#pragma unroll
            for (int g = 0; g < 8; ++g) o[g] += ps[g * 128 + j0 + u] * vv[u];
    }
    bf16_t* OS = (bf16_t*)(F.ws + WS_OS);
#pragma unroll
    for (int g = 0; g < 8; ++g) { const size_t oo = (size_t)row * 1024 + (kv * 8 + g) * 64 + lane; OS[oo] = (bf16_t)f2bf(o[g] * inv[g] * bf2f(SZ[oo])); }
    LDS_WAIT();
}
__device__ __forceinline__ bf16x8 cat8(u32x2 a, u32x2 b) { u32x4 t; t.x = a.x; t.y = a.y; t.z = b.x; t.w = b.y; return __builtin_bit_cast(bf16x8, t); }
__device__ __forceinline__ void mem_mfma_item(Frame& F, int b, int h, int qt) {
    const int lane = F.lane, c = lane & 15, q = lane >> 4;
    const bf16_t* Kp = (const bf16_t*)(F.ws + WS_MEMKV) + (size_t)(b * 256) * 2048 + h * 256;
    const bf16_t* VTp = (const bf16_t*)(F.ws + WS_MVT) + (size_t)((b * 4 + h) * 256) * 256;
    const bf16_t* MQ = (const bf16_t*)(F.ws + WS_MQ); const bf16_t* MZ = (const bf16_t*)(F.ws + WS_MZ); bf16_t* OM = (bf16_t*)(F.ws + WS_OM);
    const size_t qrow = (size_t)b * SEQ + 16 * qt + c;
    bf16x8 qf[8];
#pragma unroll
    for (int s = 0; s < 8; ++s) qf[s] = *(const bf16x8*)(MQ + qrow * 1024 + h * 256 + 32 * s + 8 * q);
    f32x4 sacc[16];
#pragma unroll
    for (int mt = 0; mt < 16; ++mt) { f32x4 a = {0.f, 0.f, 0.f, 0.f};
#pragma unroll
        for (int s = 0; s < 8; ++s) a = mfma16(*(const bf16x8*)(Kp + (size_t)(16 * mt + c) * 2048 + 32 * s + 8 * q), qf[s], a);
        sacc[mt] = a; }
    float mx = -INFINITY;
#pragma unroll
    for (int mt = 0; mt < 16; ++mt) mx = fmaxf(mx, fmaxf(fmaxf(sacc[mt][0], sacc[mt][1]), fmaxf(sacc[mt][2], sacc[mt][3])));
    mx = fmaxf(mx, __shfl_xor(mx, 16)); mx = fmaxf(mx, __shfl_xor(mx, 32));
    float sum = 0.f; const float sc = 0.0625f * 1.4426950408889634f;
#pragma unroll
    for (int mt = 0; mt < 16; ++mt)
#pragma unroll
        for (int r = 0; r < 4; ++r) { const float p = exp2f((sacc[mt][r] - mx) * sc); sacc[mt][r] = p; sum += p; }
    sum += __shfl_xor(sum, 16); sum += __shfl_xor(sum, 32);
    const float inv = 1.f / sum;
    bf16x8 pf[8];
#pragma unroll
    for (int ks = 0; ks < 8; ++ks) pf[ks] = cat8(pack4(sacc[2 * ks]), pack4(sacc[2 * ks + 1]));
#pragma unroll 4
    for (int dt = 0; dt < 16; ++dt) { f32x4 o = {0.f, 0.f, 0.f, 0.f};
#pragma unroll
        for (int ks = 0; ks < 8; ++ks) { const bf16_t* vp = VTp + (size_t)(16 * dt + c) * 256 + 32 * ks + 4 * q;
            o = mfma16(cat8(*(const u32x2*)vp, *(const u32x2*)(vp + 16)), pf[ks], o); }
        const size_t oo = qrow * 1024 + h * 256 + 16 * dt + 4 * q; const u32x2 z = *(const u32x2*)(MZ + oo);
        o[0] *= inv * bf2f(z.x & 0xffffu); o[1] *= inv * bf2f(z.x >> 16); o[2] *= inv * bf2f(z.y & 0xffffu); o[3] *= inv * bf2f(z.y >> 16);
        *(u32x2*)(OM + oo) = pack4(o); }
}
__device__ __forceinline__ void swa_mfma_item(Frame& F, int b, int h, int a) {
    const int lane = F.lane, c = lane & 15, q = lane >> 4, kv = h >> 3;
    const bf16_t* SQ = (const bf16_t*)(F.ws + WS_SQ); const bf16_t* SKV = (const bf16_t*)(F.ws + WS_SKV); const bf16_t* SZ = (const bf16_t*)(F.ws + WS_SZ); bf16_t* OS = (bf16_t*)(F.ws + WS_OS);
    const bf16_t* VTp = (const bf16_t*)(F.ws + WS_VTS) + (size_t)((b * 2 + kv) * 64) * SEQ;
    const LAS float* BTl = (const LAS float*)(F.lds + LDS_BT) + h * 128;
    const size_t qrow = (size_t)b * SEQ + 16 * a + c;
    bf16x8 qf[2];
#pragma unroll
    for (int s = 0; s < 2; ++s) qf[s] = *(const bf16x8*)(SQ + qrow * 1024 + h * 64 + 32 * s + 8 * q);
    f32x4 p[10];
    const float sink = F.in[I_SINKS][h];
    float mx = sink;
#pragma unroll
    for (int u = 0; u < 9; ++u) {
        const int kbase = 16 * (a - 8 + u);
        f32x4 d = {0.f, 0.f, 0.f, 0.f};
        if (kbase >= 0) {
#pragma unroll
            for (int s = 0; s < 2; ++s) d = mfma16(*(const bf16x8*)(SKV + ((size_t)b * SEQ + kbase + c) * 256 + kv * 64 + 32 * s + 8 * q), qf[s], d);
        }
#pragma unroll
        for (int r = 0; r < 4; ++r) { const int dist = (16 * a + c) - (kbase + 4 * q + r); const bool valid = kbase >= 0 && dist >= 0 && dist < 128;
            const float l = valid ? d[r] * 0.125f + BTl[dist & 127] : -INFINITY; d[r] = l; mx = fmaxf(mx, l); }
        p[u] = d;
    }
    mx = fmaxf(mx, __shfl_xor(mx, 16)); mx = fmaxf(mx, __shfl_xor(mx, 32));
    float sum = 0.f;
#pragma unroll
    for (int u = 0; u < 9; ++u)
#pragma unroll
        for (int r = 0; r < 4; ++r) { const float e = __expf(p[u][r] - mx); p[u][r] = e; sum += e; }
    p[9] = (f32x4){0.f, 0.f, 0.f, 0.f};
    sum += __shfl_xor(sum, 16); sum += __shfl_xor(sum, 32);
    const float inv = 1.f / (sum + __expf(sink - mx));
    bf16x8 pf[5];
#pragma unroll
    for (int ks = 0; ks < 5; ++ks) pf[ks] = cat8(pack4(p[2 * ks]), pack4(p[2 * ks + 1]));
#pragma unroll
    for (int dt = 0; dt < 4; ++dt) { f32x4 o = {0.f, 0.f, 0.f, 0.f};
#pragma unroll
        for (int ks = 0; ks < 5; ++ks) { int m0 = 16 * (a - 8 + 2 * ks) + 4 * q, m1 = m0 + 16;
            m0 = m0 < 0 ? 0 : m0; m1 = m1 < 0 ? 0 : (m1 > SEQ - 4 ? SEQ - 4 : m1);
            const bf16_t* vp = VTp + (size_t)(16 * dt + c) * SEQ;
            o = mfma16(cat8(*(const u32x2*)(vp + m0), *(const u32x2*)(vp + m1)), pf[ks], o); }
        const size_t oo = qrow * 1024 + h * 64 + 16 * dt + 4 * q; const u32x2 z = *(const u32x2*)(SZ + oo);
        o[0] *= inv * bf2f(z.x & 0xffffu); o[1] *= inv * bf2f(z.x >> 16); o[2] *= inv * bf2f(z.y & 0xffffu); o[3] *= inv * bf2f(z.y >> 16);
        *(u32x2*)(OS + oo) = pack4(o); }
}
__device__ __forceinline__ void swa_wg_item(Frame& F, int b, int kv, int qb) {
    int lane_ = F.lane, tid_ = F.tid; asm volatile("" : "+v"(lane_), "+v"(tid_));
    const int lane = lane_, c = lane & 15, q = lane >> 4, tid = tid_, h = kv * 8 + F.wave;
    const bf16_t* SQ = (const bf16_t*)(F.ws + WS_SQ); const bf16_t* SKV = (const bf16_t*)(F.ws + WS_SKV); const bf16_t* SZ = (const bf16_t*)(F.ws + WS_SZ); bf16_t* OS = (bf16_t*)(F.ws + WS_OS);
    const bf16_t* VTg = (const bf16_t*)(F.ws + WS_VTS) + (size_t)((b * 2 + kv) * 64) * SEQ;
    LAS unsigned char* Kl = F.lds; LAS unsigned char* Vl = F.lds + 32768;
    const LAS float* BTl = (const LAS float*)(F.lds + LDS_BT) + h * 128;
    const int kstart = 128 * (qb - 1);
    __syncthreads();
    {   u32x4 kr[4], vr[4];
#pragma unroll
        for (int u = 0; u < 4; ++u) { const int p = tid + 512 * u, key = p >> 3, ch = p & 7;
            kr[u] = (kstart + key >= 0) ? *(const u32x4*)(SKV + ((size_t)b * SEQ + kstart + key) * 256 + kv * 64 + ch * 8) : (u32x4){0u, 0u, 0u, 0u};
            const int d = p >> 5, c16 = p & 31;
            vr[u] = (kstart + c16 * 8 >= 0) ? *(const u32x4*)(VTg + (size_t)d * SEQ + kstart + c16 * 8) : (u32x4){0u, 0u, 0u, 0u}; }
#pragma unroll
        for (int u = 0; u < 4; ++u) { const int p = tid + 512 * u, key = p >> 3, ch = p & 7;
            *(LAS u32x4*)(Kl + key * 128 + ((ch ^ ((key >> 1) & 7)) << 4)) = kr[u];
            const int d = p >> 5, c16 = p & 31;
            *(LAS u32x4*)(Vl + d * 512 + (((2 * c16) ^ (2 * (d & 15))) << 3)) = vr[u]; } }
    __syncthreads();
    const float L2E = 1.4426950408889634f;
    const float sink = F.in[I_SINKS][h] * L2E;
    float bias[9][4];
#pragma unroll
    for (int u = 0; u < 9; ++u)
#pragma unroll
        for (int r = 0; r < 4; ++r) { const int dist = 128 - 16 * u + c - 4 * q - r; bias[u][r] = (dist >= 0 && dist < 128) ? BTl[dist & 127] * L2E : -INFINITY; }
    bf16x8 qfa[8][2];
#pragma unroll
    for (int ap = 0; ap < 8; ++ap)
#pragma unroll
        for (int s = 0; s < 2; ++s) qfa[ap][s] = *(const bf16x8*)(SQ + ((size_t)b * SEQ + 128 * qb + 16 * ap + c) * 1024 + h * 64 + 32 * s + 8 * q);
#pragma unroll
    for (int ap = 0; ap < 8; ++ap) {
        const size_t qrow = (size_t)b * SEQ + 128 * qb + 16 * ap + c;
        bf16x8 qf[2]; qf[0] = qfa[ap][0]; qf[1] = qfa[ap][1];
        u32x2 zz[4];
#pragma unroll
        for (int dt = 0; dt < 4; ++dt) zz[dt] = *(const u32x2*)(SZ + qrow * 1024 + h * 64 + 16 * dt + 4 * q);
        f32x4 p[10]; float mx = sink;
#pragma unroll
        for (int u = 0; u < 9; ++u) {
            const int wt = ap + u, row = 16 * wt + c;
            f32x4 d = {0.f, 0.f, 0.f, 0.f};
#pragma unroll
            for (int s = 0; s < 2; ++s) d = mfma16(*(const LAS bf16x8*)(Kl + row * 128 + (((4 * s + q) ^ ((row >> 1) & 7)) << 4)), qf[s], d);
            const float tmask = ((qb > 0) || (wt >= 8)) ? 0.f : -INFINITY;
#pragma unroll
            for (int r = 0; r < 4; ++r) { const float l = d[r] * (0.125f * L2E) + (bias[u][r] + tmask); d[r] = l; mx = fmaxf(mx, l); }
            p[u] = d;
        }
        mx = fmaxf(mx, __shfl_xor(mx, 16)); mx = fmaxf(mx, __shfl_xor(mx, 32));
        float sum = 0.f;
#pragma unroll
        for (int u = 0; u < 9; ++u)
#pragma unroll
            for (int r = 0; r < 4; ++r) { const float e = exp2f(p[u][r] - mx); p[u][r] = e; sum += e; }
        p[9] = (f32x4){0.f, 0.f, 0.f, 0.f};
        sum += __shfl_xor(sum, 16); sum += __shfl_xor(sum, 32);
        const float inv = 1.f / (sum + exp2f(sink - mx));
        bf16x8 pf[5];
#pragma unroll
        for (int ks = 0; ks < 5; ++ks) pf[ks] = cat8(pack4(p[2 * ks]), pack4(p[2 * ks + 1]));
#pragma unroll
        for (int dt = 0; dt < 4; ++dt) { f32x4 o = {0.f, 0.f, 0.f, 0.f}; const int dd = 16 * dt + c; const LAS unsigned char* vrow = Vl + dd * 512; const int sw = 2 * (dd & 15);
#pragma unroll
            for (int ks = 0; ks < 5; ++ks) { const int wt0 = ap + 2 * ks; int wt1 = wt0 + 1; wt1 = wt1 > 15 ? 15 : wt1;
                const u32x2 v0 = *(const LAS u32x2*)(vrow + (((4 * wt0 + q) ^ sw) << 3)), v1 = *(const LAS u32x2*)(vrow + (((4 * wt1 + q) ^ sw) << 3));
                o = mfma16(cat8(v0, v1), pf[ks], o); }
            const size_t oo = qrow * 1024 + h * 64 + 16 * dt + 4 * q; const u32x2 z = zz[dt];
            o[0] *= inv * bf2f(z.x & 0xffffu); o[1] *= inv * bf2f(z.x >> 16); o[2] *= inv * bf2f(z.y & 0xffffu); o[3] *= inv * bf2f(z.y >> 16);
            *(u32x2*)(OS + oo) = pack4(o); }
        asm volatile("" ::: "memory");
    }
}
__device__ __forceinline__ void mem_wg_item(Frame& F, int b, int h, int qblk) {
    int lane_ = F.lane, tid_ = F.tid; asm volatile("" : "+v"(lane_), "+v"(tid_));
    const int lane = lane_, c = lane & 15, q = lane >> 4, tid = tid_, w = F.wave;
    const bf16_t* Kg = (const bf16_t*)(F.ws + WS_MEMKV) + (size_t)(b * 256) * 2048 + h * 256;
    const bf16_t* VTg = (const bf16_t*)(F.ws + WS_MVT) + (size_t)((b * 4 + h) * 256) * 256;
    const bf16_t* MQ = (const bf16_t*)(F.ws + WS_MQ); const bf16_t* MZ = (const bf16_t*)(F.ws + WS_MZ); bf16_t* OM = (bf16_t*)(F.ws + WS_OM);
    LAS unsigned char* L = F.lds;
    __syncthreads();
#pragma unroll
    for (int hf = 0; hf < 2; ++hf) { u32x4 kr[8];
#pragma unroll
        for (int u = 0; u < 8; ++u) { const int p = tid + 512 * (u + 8 * hf), key = p >> 5, ch = p & 31; kr[u] = *(const u32x4*)(Kg + (size_t)key * 2048 + ch * 8); }
#pragma unroll
        for (int u = 0; u < 8; ++u) { const int p = tid + 512 * (u + 8 * hf), key = p >> 5, ch = p & 31; *(LAS u32x4*)(L + key * 512 + ((ch ^ (key & 15)) << 4)) = kr[u]; } }
    __syncthreads();
    size_t qrow[2];
#pragma unroll
    for (int t = 0; t < 2; ++t) qrow[t] = (size_t)b * SEQ + 256 * qblk + 32 * w + 16 * t + c;
    f32x4 sacc[2][16];
#pragma unroll
    for (int mt = 0; mt < 16; ++mt) { sacc[0][mt] = (f32x4){0.f, 0.f, 0.f, 0.f}; sacc[1][mt] = (f32x4){0.f, 0.f, 0.f, 0.f}; }
    bf16x8 qn0 = *(const bf16x8*)(MQ + qrow[0] * 1024 + h * 256 + 8 * q), qn1 = *(const bf16x8*)(MQ + qrow[1] * 1024 + h * 256 + 8 * q);
#pragma unroll 1
    for (int s = 0; s < 8; ++s) {
        const bf16x8 q0 = qn0, q1 = qn1; const int sn = s < 7 ? s + 1 : 7;
        qn0 = *(const bf16x8*)(MQ + qrow[0] * 1024 + h * 256 + 32 * sn + 8 * q); qn1 = *(const bf16x8*)(MQ + qrow[1] * 1024 + h * 256 + 32 * sn + 8 * q);
#pragma unroll
        for (int mt = 0; mt < 16; ++mt) { const int row = 16 * mt + c;
            const bf16x8 kf = *(const LAS bf16x8*)(L + row * 512 + (((4 * s + q) ^ (row & 15)) << 4));
            sacc[0][mt] = mfma16(kf, q0, sacc[0][mt]); sacc[1][mt] = mfma16(kf, q1, sacc[1][mt]); }
        asm volatile("" ::: "memory");
    }
    float inv[2]; bf16x8 pf[2][8];
    const float sc = 0.0625f * 1.4426950408889634f;
#pragma unroll
    for (int t = 0; t < 2; ++t) { float mx = -INFINITY;
#pragma unroll
        for (int mt = 0; mt < 16; ++mt) mx = fmaxf(mx, fmaxf(fmaxf(sacc[t][mt][0], sacc[t][mt][1]), fmaxf(sacc[t][mt][2], sacc[t][mt][3])));
        mx = fmaxf(mx, __shfl_xor(mx, 16)); mx = fmaxf(mx, __shfl_xor(mx, 32));
        float sum = 0.f;
#pragma unroll
        for (int mt = 0; mt < 16; ++mt)
#pragma unroll
            for (int r = 0; r < 4; ++r) { const float e = exp2f((sacc[t][mt][r] - mx) * sc); sacc[t][mt][r] = e; sum += e; }
        sum += __shfl_xor(sum, 16); sum += __shfl_xor(sum, 32); inv[t] = 1.f / sum;
#pragma unroll
        for (int ks = 0; ks < 8; ++ks) pf[t][ks] = cat8(pack4(sacc[t][2 * ks]), pack4(sacc[t][2 * ks + 1])); }
    __syncthreads();
#pragma unroll
    for (int hf = 0; hf < 2; ++hf) { u32x4 vr[8];
#pragma unroll
        for (int u = 0; u < 8; ++u) { const int p = tid + 512 * (u + 8 * hf), d = p >> 5, c16 = p & 31; vr[u] = *(const u32x4*)(VTg + (size_t)d * 256 + c16 * 8); }
#pragma unroll
        for (int u = 0; u < 8; ++u) { const int p = tid + 512 * (u + 8 * hf), d = p >> 5, c16 = p & 31; *(LAS u32x4*)(L + d * 512 + (((2 * c16) ^ (2 * (d & 15))) << 3)) = vr[u]; } }
    __syncthreads();
    u32x2 zn0 = *(const u32x2*)(MZ + qrow[0] * 1024 + h * 256 + 4 * q), zn1 = *(const u32x2*)(MZ + qrow[1] * 1024 + h * 256 + 4 * q);
#pragma unroll 1
    for (int dt = 0; dt < 16; ++dt) { f32x4 o0 = {0.f, 0.f, 0.f, 0.f}, o1 = {0.f, 0.f, 0.f, 0.f}; const int dd = 16 * dt + c;
        const u32x2 zc0 = zn0, zc1 = zn1; const int dn = dt < 15 ? dt + 1 : 15;
        zn0 = *(const u32x2*)(MZ + qrow[0] * 1024 + h * 256 + 16 * dn + 4 * q); zn1 = *(const u32x2*)(MZ + qrow[1] * 1024 + h * 256 + 16 * dn + 4 * q); const LAS unsigned char* vrow = L + dd * 512; const int sw = 2 * (dd & 15);
#pragma unroll
        for (int ks = 0; ks < 8; ++ks) { const bf16x8 vf = cat8(*(const LAS u32x2*)(vrow + (((8 * ks + q) ^ sw) << 3)), *(const LAS u32x2*)(vrow + (((8 * ks + 4 + q) ^ sw) << 3)));
            o0 = mfma16(vf, pf[0][ks], o0); o1 = mfma16(vf, pf[1][ks], o1); }
#pragma unroll
        for (int t = 0; t < 2; ++t) { f32x4 o = t ? o1 : o0; const size_t oo = qrow[t] * 1024 + h * 256 + 16 * dt + 4 * q; const u32x2 z = t ? zc1 : zc0;
            o[0] *= inv[t] * bf2f(z.x & 0xffffu); o[1] *= inv[t] * bf2f(z.x >> 16); o[2] *= inv[t] * bf2f(z.y & 0xffffu); o[3] *= inv[t] * bf2f(z.y >> 16);
            *(u32x2*)(OM + oo) = pack4(o); }
        asm volatile("" ::: "memory"); }
}
__device__ __forceinline__ void p2_attn_prompt(Frame& F, int wk, int nwk) {
    const int gw = wk * NWAVES + F.wave, NGW = nwk * NWAVES, lane = F.lane;
    { LAS float* BTl = (LAS float*)(F.lds + LDS_BT); const float* BT = (const float*)(F.ws + WS_BTAB); for (int i = F.tid; i < 2048; i += NTHREADS) BTl[i] = BT[i]; }
    __syncthreads();
    for (int it = wk; it < 256; it += nwk) { const int qblk = it & 31, bh = it >> 5; mem_wg_item(F, bh >> 2, bh & 3, qblk); }
    for (int it = wk; it < 256; it += nwk) { const int qb = it & 63, bk = it >> 6; swa_wg_item(F, bk >> 1, bk & 1, qb); }
    __syncthreads();
    const bf16_t* SKV = (const bf16_t*)(F.ws + WS_SKV);
    for (int it = gw; it < 256; it += NGW) { const int b = it >> 7, j = it & 127; const bf16_t* pp = SKV + (size_t)(b * SEQ + SEQ - 128 + j) * 256;
        for (int cc = lane; cc < 128; cc += 64) { F.out[O_SKP + ((size_t)b * 128 + j) * 128 + cc] = bf2f(pp[cc]); F.out[O_SVP + ((size_t)b * 128 + j) * 128 + cc] = bf2f(pp[128 + cc]); } }
}
__device__ __forceinline__ void p2_swa_sample(Frame& F, int wk, int nwk) {
    const int gw = wk * NWAVES + F.wave, NGW = nwk * NWAVES, lane = F.lane;
    const bf16_t* SKV = (const bf16_t*)(F.ws + WS_SKV);
    for (int it = gw; it < MS * 2; it += NGW) { const int r = it >> 1, kv = it & 1; swa_wave_item(F, true, r >> 2, r & 3, kv); }
    { const u32x4* s4 = (const u32x4*)(F.ws + WS_OMS); u32x4* d4 = (u32x4*)(F.ws + WS_OM + (size_t)MP * 1024 * 2); for (int i = gw * 64 + lane; i < MS * 1024 / 8; i += NGW * 64) d4[i] = s4[i]; }
    { const int gt = gw * 64 + lane, NT = NGW * 64;
        for (int i = gt; i < 128 * 124 * 32; i += NT) { const int bd = i / (124 * 32), e = i - bd * (124 * 32);
            ((f32x4*)(F.out + O_SKS + (size_t)bd * 16384))[e] = ((const f32x4*)(F.in[I_CSK] + (size_t)bd * 16384 + 512))[e];
            ((f32x4*)(F.out + O_SVS + (size_t)bd * 16384))[e] = ((const f32x4*)(F.in[I_CSV] + (size_t)bd * 16384 + 512))[e]; }
        for (int i = gt; i < 128 * 4 * 128; i += NT) { const int bd = i >> 9, jj = (i >> 7) & 3, cc = i & 127; const bf16_t* pp = SKV + (size_t)(MP + bd * 4 + jj) * 256;
            F.out[O_SKS + ((size_t)bd * 128 + 124 + jj) * 128 + cc] = bf2f(pp[cc]); F.out[O_SVS + ((size_t)bd * 128 + 124 + jj) * 128 + cc] = bf2f(pp[128 + cc]); } }
}
__device__ __forceinline__ void mem_sample_item(Frame& F, int bd, int hp) {
    const int lane = F.lane, w = F.wave, tid = F.tid, hl = lane >> 5, h = 2 * hp + hl, d0 = (lane & 31) * 8;
    const bf16_t* MQ = (const bf16_t*)(F.ws + WS_MQ); const bf16_t* MZ = (const bf16_t*)(F.ws + WS_MZ); bf16_t* OM = (bf16_t*)(F.ws + WS_OM);
    LAS float* lg = (LAS float*)F.lds;
    LAS float* isum = lg + 2048;
    LAS float* po = isum + 8;
    float qr[4][8];
#pragma unroll
    for (int s = 0; s < 4; ++s) { const u32x4 v = *(const u32x4*)(MQ + (size_t)(MP + bd * 4 + s) * 1024 + h * 256 + d0);
        qr[s][0] = bf2f(v.x & 0xffffu); qr[s][1] = bf2f(v.x >> 16); qr[s][2] = bf2f(v.y & 0xffffu); qr[s][3] = bf2f(v.y >> 16);
        qr[s][4] = bf2f(v.z & 0xffffu); qr[s][5] = bf2f(v.z >> 16); qr[s][6] = bf2f(v.w & 0xffffu); qr[s][7] = bf2f(v.w >> 16); }
    const float* Kc = F.in[I_CMK] + ((size_t)bd * 256 * 4 + h) * 256 + d0; const float* Vc = F.in[I_CMV] + ((size_t)bd * 256 * 4 + h) * 256 + d0;
#pragma unroll 4
    for (int i = 0; i < 32; ++i) { const int m = w + 8 * i; const f32x4 k0 = *(const f32x4*)(Kc + (size_t)m * 1024), k1 = *(const f32x4*)(Kc + (size_t)m * 1024 + 4);
        float l[4];
#pragma unroll
        for (int s = 0; s < 4; ++s) { float a = k0.x * qr[s][0] + k0.y * qr[s][1] + k0.z * qr[s][2] + k0.w * qr[s][3] + k1.x * qr[s][4] + k1.y * qr[s][5] + k1.z * qr[s][6] + k1.w * qr[s][7];
#pragma unroll
            for (int o = 1; o < 32; o <<= 1) a += __shfl_xor(a, o);
            l[s] = a * 0.0625f; }
        if ((lane & 31) == 0) {
#pragma unroll
            for (int s = 0; s < 4; ++s) lg[(hl * 4 + s) * 256 + m] = l[s]; } }
    __syncthreads();
    { const int pr = w; float l4[4];
#pragma unroll
        for (int u = 0; u < 4; ++u) l4[u] = lg[pr * 256 + lane + 64 * u];
        const float mx = wave_max(fmaxf(fmaxf(l4[0], l4[1]), fmaxf(l4[2], l4[3]))); float s = 0.f;
#pragma unroll
        for (int u = 0; u < 4; ++u) { l4[u] = __expf(l4[u] - mx); s += l4[u]; lg[pr * 256 + lane + 64 * u] = l4[u]; }
        s = wave_sum(s); if (lane == 0) isum[pr] = 1.f / s; }
    __syncthreads();
    float o[4][8];
#pragma unroll
    for (int s = 0; s < 4; ++s)
#pragma unroll
        for (int j = 0; j < 8; ++j) o[s][j] = 0.f;
#pragma unroll 4
    for (int i = 0; i < 32; ++i) { const int m = w + 8 * i; const f32x4 v0 = *(const f32x4*)(Vc + (size_t)m * 1024), v1 = *(const f32x4*)(Vc + (size_t)m * 1024 + 4);
#pragma unroll
        for (int s = 0; s < 4; ++s) { const float p = lg[(hl * 4 + s) * 256 + m];
            o[s][0] += p * v0.x; o[s][1] += p * v0.y; o[s][2] += p * v0.z; o[s][3] += p * v0.w; o[s][4] += p * v1.x; o[s][5] += p * v1.y; o[s][6] += p * v1.z; o[s][7] += p * v1.w; } }
#pragma unroll
    for (int s = 0; s < 4; ++s) { LAS float* pp = po + ((w * 4 + s) * 512 + hl * 256 + d0);
        *(LAS f32x4*)pp = (f32x4){o[s][0], o[s][1], o[s][2], o[s][3]}; *(LAS f32x4*)(pp + 4) = (f32x4){o[s][4], o[s][5], o[s][6], o[s][7]}; }
    __syncthreads();
#pragma unroll
    for (int u = 0; u < 4; ++u) { const int e = tid + 512 * u, s = e >> 9, cc = e & 511; float a = 0.f;
#pragma unroll
        for (int ww = 0; ww < 8; ++ww) a += po[(ww * 4 + s) * 512 + cc];
        const int hh = 2 * hp + (cc >> 8); const size_t oo = (size_t)(MP + bd * 4 + s) * 1024 + hh * 256 + (cc & 255);
        ((bf16_t*)(F.ws + WS_OMS))[oo - (size_t)MP * 1024] = (bf16_t)f2bf(a * isum[(cc >> 8) * 4 + s] * bf2f(MZ[oo])); }
    __syncthreads();
}

struct SchedP3 {
    int G, c; const unsigned char* ws;
    __device__ __forceinline__ int ntiles(const pg8::Unit&) const { return 1024 / 64; }
    __device__ __forceinline__ bool next(int i, pg8::Unit& u) const {
        if (i < 6) { const int round = i / 3, b = i - round * 3; pg8::tile_of(round * G + c, 64, 8, u.pm, u.pn); u.job = b; return true; }
        if (i == 6 && c < 48) { u.pm = 64 + c / 24; const int rem = c % 24; u.pn = rem / 3; u.job = rem % 3; return true; }
        return false;
    }
    __device__ __forceinline__ void ptrs(const pg8::Unit& u, const char*& A, const char*& B) const {
        A = (const char*)ws + WS_OG + (size_t)u.job * M * 1024 * 2 + (size_t)u.pm * 256 * 1024 * 2;
        B = (const char*)ws + WS_WB + (size_t)u.job * 2048 * 1024 * 2 + (size_t)u.pn * 256 * 1024 * 2;
    }
};
struct EpiP3 {
    unsigned char* ws;
    __device__ __forceinline__ void operator()(const f32x4 (&acc)[2][2][4][2], const pg8::Unit& u, int wr, int wc, int fr, int fq) const {
        const int row0 = u.pm * 256 + wr * 64 + fr, col0 = u.pn * 256 + wc * 32 + 8 * fq, b = u.job;
        const bf16_t* GT = (const bf16_t*)(ws + WS_GATES); bf16_t* MG = (bf16_t*)(ws + WS_MERGED);
        const bool rmw = (b > 0) && (u.pm < 64);
#pragma unroll
        for (int ai = 0; ai < 2; ++ai) {
            u32x4 g[4][2], p[4][2];
#pragma unroll
            for (int m = 0; m < 4; ++m)
#pragma unroll
                for (int bj = 0; bj < 2; ++bj) { const int r = row0 + ai * 128 + m * 16, c = col0 + bj * 128;
                    g[m][bj] = *(const u32x4*)(GT + (size_t)r * 6144 + b * 2048 + c);
                    p[m][bj] = rmw ? *(const u32x4*)(MG + (size_t)r * 2048 + c) : (u32x4){0u, 0u, 0u, 0u}; }
#pragma unroll
            for (int m = 0; m < 4; ++m)
#pragma unroll
                for (int bj = 0; bj < 2; ++bj) { const int r = row0 + ai * 128 + m * 16, c = col0 + bj * 128;
                    const u32x4 gg = g[m][bj], pp = p[m][bj];
                    f32x4 v0 = acc[ai][bj][m][0], v1 = acc[ai][bj][m][1];
                    v0[0] = v0[0] * bf2f(gg.x & 0xffffu) + bf2f(pp.x & 0xffffu); v0[1] = v0[1] * bf2f(gg.x >> 16) + bf2f(pp.x >> 16); v0[2] = v0[2] * bf2f(gg.y & 0xffffu) + bf2f(pp.y & 0xffffu); v0[3] = v0[3] * bf2f(gg.y >> 16) + bf2f(pp.y >> 16);
                    v1[0] = v1[0] * bf2f(gg.z & 0xffffu) + bf2f(pp.z & 0xffffu); v1[1] = v1[1] * bf2f(gg.z >> 16) + bf2f(pp.z >> 16); v1[2] = v1[2] * bf2f(gg.w & 0xffffu) + bf2f(pp.w & 0xffffu); v1[3] = v1[3] * bf2f(gg.w >> 16) + bf2f(pp.w >> 16);
                    u32x4 w; w.x = pg8::cvt_pk_bf16(v0[0], v0[1]); w.y = pg8::cvt_pk_bf16(v0[2], v0[3]); w.z = pg8::cvt_pk_bf16(v1[0], v1[1]); w.w = pg8::cvt_pk_bf16(v1[2], v1[3]);
                    u32x4* mp = u.pm < 64 ? (u32x4*)(MG + (size_t)r * 2048 + c) : (u32x4*)((bf16_t*)(ws + WS_PS) + ((size_t)b * MS + (r - MP)) * 2048 + c);
                    *mp = w; }
        }
    }
};

struct SchedP4 {
    int G, c; const unsigned char* ws;
    __device__ __forceinline__ int ntiles(const pg8::Unit& u) const { return u.job == 0 ? D / 64 : 512 / 64; }
    __device__ __forceinline__ bool next(int i, pg8::Unit& u) const {
        if (i < 2) { pg8::tile_of(i * G + c, 64, 8, u.pm, u.pn); u.job = 0; return true; }
        if (i == 2 && c < 64) { u.pm = 64 + c / 32; const int rem = c % 32; u.pn = rem / 4; u.job = 1 + (rem & 3); return true; }
        return false;
    }
    __device__ __forceinline__ void ptrs(const pg8::Unit& u, const char*& A, const char*& B) const {
        const size_t ko = u.job == 0 ? 0 : (size_t)(u.job - 1) * 512 * 2;
        A = (const char*)ws + WS_MERGED + (size_t)u.pm * 256 * 2048 * 2 + ko; B = (const char*)ws + WS_WO + (size_t)u.pn * 256 * 2048 * 2 + ko;
    }
};
struct EpiP4 {
    unsigned char* ws; float* out; const float* xp; const float* xs;
    __device__ __forceinline__ void operator()(const f32x4 (&acc)[2][2][4][2], const pg8::Unit& u, int wr, int wc, int fr, int fq) const {
        const int row0 = u.pm * 256 + wr * 64 + fr, col0 = u.pn * 256 + wc * 32 + 8 * fq;
        if (u.job != 0) {
#pragma unroll
            for (int ai = 0; ai < 2; ++ai)
#pragma unroll
                for (int m = 0; m < 4; ++m) { const int r = row0 + ai * 128 + m * 16; float* yp = (float*)(ws + WS_YP) + ((size_t)(u.job - 1) * MS + (r - MP)) * D;
#pragma unroll
                    for (int bj = 0; bj < 2; ++bj) { const int c = col0 + bj * 128; *(f32x4*)(yp + c) = acc[ai][bj][m][0]; *(f32x4*)(yp + c + 4) = acc[ai][bj][m][1]; } }
            return;
        }
#pragma unroll
        for (int ai = 0; ai < 2; ++ai)
#pragma unroll
            for (int mh = 0; mh < 2; ++mh) {
                f32x4 xv[2][2][2];
#pragma unroll
                for (int mm = 0; mm < 2; ++mm)
#pragma unroll
                    for (int bj = 0; bj < 2; ++bj) { const float* xr = xp + (size_t)(row0 + ai * 128 + (2 * mh + mm) * 16) * D + col0 + bj * 128; xv[mm][bj][0] = *(const f32x4*)xr; xv[mm][bj][1] = *(const f32x4*)(xr + 4); }
#pragma unroll
                for (int mm = 0; mm < 2; ++mm)
#pragma unroll
                    for (int bj = 0; bj < 2; ++bj) { float* yr = out + (size_t)(row0 + ai * 128 + (2 * mh + mm) * 16) * D + col0 + bj * 128;
                        *(f32x4*)yr = acc[ai][bj][2 * mh + mm][0] + xv[mm][bj][0]; *(f32x4*)(yr + 4) = acc[ai][bj][2 * mh + mm][1] + xv[mm][bj][1]; }
            }
    }
};
__device__ __forceinline__ void p3_combine_sample(Frame& F) {
    const u32x4* ps = (const u32x4*)(F.ws + WS_PS); u32x4* mg = (u32x4*)(F.ws + WS_MERGED + (size_t)MP * 2048 * 2);
    constexpr int NV = MS * 2048 / 8;
    for (int i = F.bid * NTHREADS + F.tid; i < NV; i += F.G * NTHREADS) { const u32x4 a = ps[i], b = ps[NV + i], c = ps[2 * NV + i]; u32x4 o;
        o.x = pk2(bf2f(a.x & 0xffffu) + bf2f(b.x & 0xffffu) + bf2f(c.x & 0xffffu), bf2f(a.x >> 16) + bf2f(b.x >> 16) + bf2f(c.x >> 16));
        o.y = pk2(bf2f(a.y & 0xffffu) + bf2f(b.y & 0xffffu) + bf2f(c.y & 0xffffu), bf2f(a.y >> 16) + bf2f(b.y >> 16) + bf2f(c.y >> 16));
        o.z = pk2(bf2f(a.z & 0xffffu) + bf2f(b.z & 0xffffu) + bf2f(c.z & 0xffffu), bf2f(a.z >> 16) + bf2f(b.z >> 16) + bf2f(c.z >> 16));
        o.w = pk2(bf2f(a.w & 0xffffu) + bf2f(b.w & 0xffffu) + bf2f(c.w & 0xffffu), bf2f(a.w >> 16) + bf2f(b.w >> 16) + bf2f(c.w >> 16));
        mg[i] = o; }
}
__device__ __forceinline__ void p5_final_norm(Frame& F) {
    const int gw = F.bid * NWAVES + F.wave, NGW = F.G * NWAVES, lane = F.lane;
    const f32x4* wn = (const f32x4*)F.in[I_NORMF] + lane;
    for (int r = gw; r < M; r += NGW) {
        f32x4* y = (f32x4*)(F.out + (size_t)r * D) + lane;
        f32x4 v[8]; float s = 0.f;
        if (r >= MP) { const f32x4* xs4 = (const f32x4*)(F.in[I_XS] + (size_t)(r - MP) * D) + lane; const f32x4* yp4 = (const f32x4*)((const float*)(F.ws + WS_YP) + (size_t)(r - MP) * D) + lane;
#pragma unroll
            for (int j = 0; j < 8; ++j) { f32x4 a = xs4[64 * j];
#pragma unroll
                for (int kq = 0; kq < 4; ++kq) a = a + yp4[(size_t)kq * MS * D / 4 + 64 * j];
                v[j] = a; s += (a.x * a.x + a.y * a.y) + (a.z * a.z + a.w * a.w); } }
        else
#pragma unroll
        for (int j = 0; j < 8; ++j) { v[j] = y[64 * j]; s += (v[j].x * v[j].x + v[j].y * v[j].y) + (v[j].z * v[j].z + v[j].w * v[j].w); }
        const float sc = rsqrtf(wave_sum(s) * (1.f / D) + EPS);
#pragma unroll
        for (int j = 0; j < 8; ++j) { const f32x4 w = wn[64 * j]; f32x4 o = v[j]; o.x *= sc * w.x; o.y *= sc * w.y; o.z *= sc * w.z; o.w *= sc * w.w; y[64 * j] = o; }
    }
}

constexpr int N_PHASES = 10;
__global__ void __launch_bounds__(NTHREADS, 2) hybrid_fwd(Args args) {
    extern __shared__ __attribute__((aligned(16))) unsigned char lds_raw[];
    cg::grid_group grid = cg::this_grid();
    Frame F;
    F.lds = (LAS unsigned char*)lds_raw; F.tid = threadIdx.x; F.lane = F.tid & 63; F.wave = __builtin_amdgcn_readfirstlane(F.tid >> 6);
    F.G = gridDim.x; F.bid = blockIdx.x; F.in = args.in; F.out = args.out; F.ws = args.ws;
    const int lo = args.ph_lo, hi = args.ph_hi;
    if (lo < 0) grid.sync();
    if (F.tid < 64) ((LAS unsigned*)(F.lds + LDS_CTL))[F.tid] = 0u;
    __syncthreads();
    const XcdBarrier bar = xcd_barrier_post((unsigned*)(F.ws + WS_CTL), (volatile LAS unsigned*)(F.lds + LDS_CTL));
#define IN(k) (lo <= (k) && (k) < hi)
#define SEAM(k) do { if (IN(k) && IN((k) + 1)) xcd_barrier(bar); } while (0)
    if (IN(0)) p0_prologue(F);
    SEAM(0);
    if (IN(1)) { SchedP1 S{F.G, F.bid, F.ws, (const unsigned char*)F.out + DO_XN}; EpiP1 E{F.ws, F.out}; pg8::gemm_phase<EpiP1, SchedP1>(F.lds, D, S, E); }
    SEAM(1);
    if (IN(2)) { p2_conv(F); __syncthreads(); for (int it = F.bid; it < 256; it += F.G) mem_sample_item(F, it >> 1, it & 1); }
    SEAM(2);
    if (IN(3)) p2_prep(F);
    SEAM(3);
    if (IN(4)) {
        constexpr int GSPLIT = 512;
        if (F.bid < 128) { scan_item(F, F.bid & 15, F.bid >> 4); __syncthreads(); p2_gdn_sample(F, F.bid, 128, 0, GSPLIT); }
        else { const int wk = F.bid - 128, nwk = F.G - 128; p2_attn_prompt(F, wk, nwk); __syncthreads(); p2_swa_sample(F, wk, nwk); __syncthreads(); p2_gdn_sample(F, wk, nwk, GSPLIT, 1024); }
    }
    SEAM(4);
    if (IN(5)) { for (int it = F.bid; it < 256; it += F.G) gdn_out_item(F, it); p2_gdn_norm_sample(F); }
    SEAM(5);
    if (IN(6)) { SchedP3 S{F.G, F.bid, F.ws}; EpiP3 E{F.ws}; pg8::gemm_phase<EpiP3, SchedP3>(F.lds, 1024, S, E); }
    SEAM(6);
    if (IN(7)) p3_combine_sample(F);
    SEAM(7);
    if (IN(8)) { SchedP4 S{F.G, F.bid, F.ws}; EpiP4 E{F.ws, F.out, F.in[I_XP], F.in[I_XS]}; pg8::gemm_phase<EpiP4, SchedP4>(F.lds, D, S, E); }
    SEAM(8);
    if (IN(9)) p5_final_norm(F);
#undef IN
#undef SEAM
}

extern "C" void kernel_launch(void* const* d_in, const int* in_sizes, int n_in, void* d_out, int out_size, void* d_ws, size_t ws_size, hipStream_t stream) {
    static int grid = 0;
    if (grid == 0) {
        if (n_in != 22 || out_size != (int)O_END || ws_size < WS_END) { fprintf(stderr, "kernel_launch: unexpected shapes (n_in %d out %d ws %zu need %zu)\n", n_in, out_size, ws_size, (size_t)WS_END); grid = -1; return; }
        int dev = 0, cus = 0, per_cu = 0;
        hipGetDevice(&dev); hipDeviceGetAttribute(&cus, hipDeviceAttributeMultiprocessorCount, dev);
        hipFuncSetAttribute((const void*)hybrid_fwd, hipFuncAttributeMaxDynamicSharedMemorySize, LDS_BYTES);
        hipOccupancyMaxActiveBlocksPerMultiprocessor(&per_cu, (const void*)hybrid_fwd, NTHREADS, LDS_BYTES);
        if (per_cu < 1) { fprintf(stderr, "kernel_launch: occupancy query says %d blocks per CU\n", per_cu); grid = -1; return; }
        grid = cus;
    }
    if (grid < 0) return;
    Args a{};
    for (int i = 0; i < 22; ++i) a.in[i] = (const float*)d_in[i];
    a.out = (float*)d_out; a.ws = (unsigned char*)d_ws;
    if (hipMemsetAsync((char*)d_ws + WS_CTL, 0, XCD_BAR_WORDS * 4, stream) != hipSuccess) { fprintf(stderr, "kernel_launch: hipMemsetAsync failed\n"); return; }
#if MK_N_LAUNCHES == 1
    a.ph_lo = 0; a.ph_hi = N_PHASES;
    void* kargs[] = {&a};
    hipError_t e = hipLaunchCooperativeKernel((const void*)hybrid_fwd, dim3(grid), dim3(NTHREADS), kargs, LDS_BYTES, stream);
    if (e != hipSuccess) fprintf(stderr, "cooperative launch failed: %s (grid %d)\n", hipGetErrorString(e), grid);
#endif
}
```

```cpp
#include <hip/hip_runtime.h>
#include <hip/hip_cooperative_groups.h>
#include <cstdio>
#include <cstdint>
namespace cg = cooperative_groups;

#ifndef MK_N_LAUNCHES
#define MK_N_LAUNCHES 1
#endif

#define LAS __attribute__((address_space(3)))
typedef unsigned short bf16_t;
typedef short bf16x8 __attribute__((ext_vector_type(8)));
typedef float f32x4 __attribute__((ext_vector_type(4)));
typedef unsigned u32x4 __attribute__((ext_vector_type(4)));
typedef unsigned u32x2 __attribute__((ext_vector_type(2)));

constexpr int D = 2048, SEQ = 8192, MP = 2 * SEQ, MS = 512, M = MP + MS;
constexpr int IN_COLS = 14608;
constexpr int NIN = 58 * 256;
constexpr float EPS = 1e-6f;
__host__ __device__ __forceinline__ int win_src_col(int j) {
    if (j < 4096) return j;
    if (j < 5120) return 4112 + (j - 4096);
    if (j < 6144) return 5392 + (j - 5120);
    if (j < 7168) return 6416 + (j - 6144);
    if (j < 8192) return 7440 + (j - 7168);
    if (j < 14336) return 8464 + (j - 8192);
    if (j < 14592) return 5136 + (j - 14336);
    if (j < 14608) return 4096 + (j - 14592);
    return -1;
}
constexpr size_t O_YP = 0, O_YS = O_YP + (size_t)MP * D, O_GSP = O_YS + (size_t)MS * D, O_GCP = O_GSP + 2 * 8 * 128 * 128, O_SKP = O_GCP + 2 * 3 * 3072,
                 O_SVP = O_SKP + 2 * 128 * 128, O_MKP = O_SVP + 2 * 128 * 128, O_MVP = O_MKP + 512 * 1024, O_GSS = O_MVP + 512 * 1024,
                 O_GCS = O_GSS + (size_t)128 * 8 * 128 * 128, O_SKS = O_GCS + 128 * 3 * 3072, O_SVS = O_SKS + 128 * 128 * 128, O_END = O_SVS + 128 * 128 * 128;
static_assert(O_END == 58148864, "d_out map");
constexpr size_t al(size_t x) { return (x + 255) & ~(size_t)255; }
constexpr size_t WS_CTL = 0, WS_WB = 1u << 20, WS_WO = WS_WB + al((size_t)3 * 2048 * 1024 * 2), WS_WIN = WS_WO + al((size_t)2048 * 2048 * 2),
                 WS_WMKV = WS_WIN + al((size_t)NIN * 2048 * 2), WS_QKV = WS_WMKV + al((size_t)2048 * 2048 * 2), WS_GZ = WS_QKV + al((size_t)M * 3072 * 2),
                 WS_SQ = WS_GZ + al((size_t)M * 1024 * 2), WS_SZ = WS_SQ + al((size_t)M * 1024 * 2), WS_MQ = WS_SZ + al((size_t)M * 1024 * 2), WS_MZ = WS_MQ + al((size_t)M * 1024 * 2),
                 WS_SKV = WS_MZ + al((size_t)M * 1024 * 2), WS_GATES = WS_SKV + al((size_t)M * 256 * 2), WS_MEMN = WS_GATES + al((size_t)M * 6144 * 2),
                 WS_MEMKV = WS_MEMN + al((size_t)512 * 2048 * 2), WS_GAB = WS_MEMKV + al((size_t)512 * 2048 * 2), WS_ROWSS = WS_GAB + al((size_t)M * 16 * 4),
                 WS_G = WS_ROWSS + al((size_t)M * 4), WS_BETA = WS_G + al((size_t)M * 8 * 4), WS_BTAB = WS_BETA + al((size_t)M * 8 * 4), WS_END0 = WS_BTAB + al(16 * 128 * 4);
constexpr size_t WS_OG = WS_QKV, WS_OS = WS_OG + (size_t)M * 1024 * 2, WS_OM = WS_OS + (size_t)M * 1024 * 2, WS_MERGED = WS_SQ;
constexpr size_t WS_NEGW = WS_OG, WS_SN = WS_WIN, WS_OMS = WS_MEMN;
constexpr size_t WS_UT = WS_END0, WS_ATT = WS_UT + al((size_t)2048 * 128 * 64 * 2), WS_GC = WS_ATT + al((size_t)2048 * 64 * 64 * 2), WS_DEC = WS_GC + al((size_t)MP * 8 * 4),
                 WS_GT = WS_DEC + al((size_t)2048 * 64 * 4), WS_MVT = WS_GT + al(2048 * 4), WS_VTS = WS_MVT + al((size_t)2 * 4 * 256 * 256 * 2), WS_SSQ = WS_VTS + al((size_t)2 * 2 * 64 * SEQ * 2 + 4096), WS_SSK = WS_SSQ + al((size_t)MP * 8 * 4), WS_END = WS_SSK + al((size_t)MP * 8 * 4);
constexpr size_t WS_PS = WS_UT, WS_YP = WS_UT + (size_t)3 * MS * 2048 * 2;
static_assert((size_t)3 * MS * 2048 * 2 + (size_t)4 * MS * 2048 * 4 <= (size_t)2048 * 128 * 64 * 2, "PS/YP fit in UT");
static_assert(WS_OM + (size_t)M * 1024 * 2 <= WS_GZ && WS_MERGED + (size_t)M * 2048 * 2 <= WS_MQ, "overlays");
static_assert((size_t)2048 * 64 * 128 * 2 <= (size_t)MP * 1024 * 2 && WS_SN + (size_t)2048 * 128 * 128 * 2 <= WS_QKV, "overlays 2");
static_assert(WS_END <= 670000000, "workspace budget");
constexpr size_t DO_XN = 0, DO_QN = 0, DO_KN = (size_t)M * 1024 * 2, DO_KT = 2 * (size_t)M * 1024 * 2, DO_VT = DO_KT + (size_t)2048 * 8192 * 2, DO_VNS = DO_VT + (size_t)2048 * 8192 * 2;
static_assert(DO_VNS + (size_t)512 * 1024 * 2 <= (size_t)M * D * 4, "y scratch");

constexpr int NWAVES = 8, NTHREADS = 512;
constexpr int LDS_CTL = 147456;
constexpr int LDS_BYTES = 147456 + 256;
constexpr int LDS_BT = 139264;

__device__ __forceinline__ float bf2f(unsigned v) { return __uint_as_float(v << 16); }
__device__ __forceinline__ unsigned f2bf(float f) { unsigned u = __float_as_uint(f); return (u + 0x7fffu + ((u >> 16) & 1u)) >> 16; }
__device__ __forceinline__ unsigned pk2(float lo, float hi) { return f2bf(lo) | (f2bf(hi) << 16); }
__device__ __forceinline__ float wave_sum(float v) {
#pragma unroll
    for (int o = 1; o < 64; o <<= 1) v += __shfl_xor(v, o);
    return v;
}
__device__ __forceinline__ float wave_max(float v) {
#pragma unroll
    for (int o = 1; o < 64; o <<= 1) v = fmaxf(v, __shfl_xor(v, o));
    return v;
}
__device__ __forceinline__ float sigmoidf_(float x) { return __builtin_amdgcn_rcpf(1.f + __expf(-x)); }
__device__ __forceinline__ float siluf_(float x) { return x * __builtin_amdgcn_rcpf(1.f + __expf(-x)); }
#define LDS_WAIT() asm volatile("s_waitcnt lgkmcnt(0)" ::: "memory")

namespace pg8 {
constexpr int BM = 256, BK = 64, HALF = 128, HTB = HALF * BK * 2, STAGE_BYTES = 8 * HTB, NXCD = 8, WGM = 8;
__host__ __device__ __forceinline__ int lds_byte(int r, int c) { const int st = (r >> 4) * 2 + (c >> 5), rr = r & 15, cc = c & 31, ob = rr * 64 + cc * 2; return st * 1024 + (ob ^ (((ob >> 9) & 1) << 5)); }
__host__ __device__ __forceinline__ void stage_rc(int b, int& R, int& C) { const int st = b / 1024, sb = b % 1024, swz = sb ^ (((sb >> 9) & 1) << 5); R = (st >> 1) * 16 + swz / 64; C = (st & 1) * 32 + (swz % 64) / 2; }
__host__ __device__ __forceinline__ int perm32(int rho) { const int n = rho >> 4, i = rho & 15; return 8 * (i >> 2) + 4 * n + (i & 3); }
struct Unit { int pm, pn, job; };
__device__ __forceinline__ void tile_of(int L, int nM, int nN, int& pm, int& pn) {
    const int nwg = nM * nN; int wgid = L;
    { const int q = nwg / NXCD, r = nwg % NXCD, xcd = wgid % NXCD, off = wgid / NXCD; wgid = (xcd < r ? xcd * (q + 1) : r * (q + 1) + (xcd - r) * q) + off; }
    const int nig = WGM * nN, gid = wgid / nig, fm = gid * WGM, gsz = (nM - fm) < WGM ? (nM - fm) : WGM;
    pm = fm + ((wgid % nig) % gsz); pn = (wgid % nig) / gsz;
}
__device__ __forceinline__ unsigned cvt_pk_bf16(float lo, float hi) { unsigned r; asm volatile("v_cvt_pk_bf16_f32 %0, %1, %2" : "=v"(r) : "v"(lo), "v"(hi)); return r; }

template <class Epi, class Sched, bool ALIGN_EPI = true>
__device__ __forceinline__ void gemm_phase(LAS unsigned char* lds, const int K, const Sched& S, const Epi& E) {
    const int tid = threadIdx.x, wid = __builtin_amdgcn_readfirstlane(tid >> 6), lane = tid & 63, wr = wid >> 2, wc = wid & 3, fr = lane & 15, fq = lane >> 4;
    unsigned voffA[2], voffB[2];
#pragma unroll
    for (int i = 0; i < 2; ++i) { int R, C; stage_rc(tid * 16 + i * 8192, R, C); const int Rb = ((R & ~31) + perm32(R & 31));
        voffA[i] = (unsigned)(R * K + C) * 2u; voffB[i] = (unsigned)(Rb * K + C) * 2u; }
    const size_t kstep = (size_t)(BK * 2);
    const size_t hstep = (size_t)HALF * K * 2;
    const unsigned ldsw = (unsigned)wid * 1024u;
    const int aoff = lds_byte(wr * 64 + fr, fq * 8), boff = lds_byte(wc * 32 + fr, fq * 8);
#define PG8_SA(b, h) (((b) * 2 + (h)) * HTB)
#define PG8_SB(b, h) ((4 + (b) * 2 + (h)) * HTB)
#define PG8_STAGE(bufoff, gbase, voff) do { _Pragma("unroll") for (int _i = 0; _i < 2; ++_i) \
        __builtin_amdgcn_global_load_lds((const unsigned*)((const char*)(gbase) + (voff)[_i]), (LAS unsigned*)(lds + (bufoff) + ldsw + _i * 8192), 16, 0, 0); } while (0)
#define PG8_LDA(dst, b, h) do { _Pragma("unroll") for (int m = 0; m < 4; ++m) _Pragma("unroll") for (int k = 0; k < 2; ++k) dst[m][k] = *(const LAS bf16x8*)(lds + PG8_SA(b, h) + aoff + m * 2048 + k * 1024); } while (0)
#define PG8_LDB(dst, b, h) do { _Pragma("unroll") for (int n = 0; n < 2; ++n) _Pragma("unroll") for (int k = 0; k < 2; ++k) dst[n][k] = *(const LAS bf16x8*)(lds + PG8_SB(b, h) + boff + n * 2048 + k * 1024); } while (0)
#define PG8_MMA(ai, bj, At, Bt) do { __builtin_amdgcn_s_setprio(1); _Pragma("unroll") for (int m = 0; m < 4; ++m) _Pragma("unroll") for (int n = 0; n < 2; ++n) _Pragma("unroll") for (int k = 0; k < 2; ++k) \
        acc[ai][bj][m][n] = __builtin_amdgcn_mfma_f32_16x16x32_bf16(Bt[n][k], At[m][k], acc[ai][bj][m][n], 0, 0, 0); __builtin_amdgcn_s_setprio(0); } while (0)
#define PG8_WAIT_V(n) asm volatile("s_waitcnt vmcnt(" #n ")" ::: "memory")
#define PG8_WAIT_L(n) asm volatile("s_waitcnt lgkmcnt(" #n ")" ::: "memory")
#define PG8_BAR __builtin_amdgcn_s_barrier()
#define PG8_SCHED __builtin_amdgcn_sched_barrier(0)
    Unit cur, nxt; int ui = 0;
    if (!S.next(0, cur)) return;
    f32x4 acc[2][2][4][2];
#pragma unroll
    for (int a = 0; a < 2; ++a)
#pragma unroll
        for (int b = 0; b < 2; ++b)
#pragma unroll
            for (int m = 0; m < 4; ++m)
#pragma unroll
                for (int n = 0; n < 2; ++n) acc[a][b][m][n] = (f32x4){0.f, 0.f, 0.f, 0.f};
    bf16x8 At[4][2], B0[2][2], B1[2][2];
    const char* cA; const char* cB; S.ptrs(cur, cA, cB);
    PG8_STAGE(PG8_SB(0, 0), cB, voffB); PG8_STAGE(PG8_SB(0, 1), cB + hstep, voffB); PG8_STAGE(PG8_SA(0, 0), cA, voffA); PG8_STAGE(PG8_SA(0, 1), cA + hstep, voffA);
    if (wr == 1) PG8_BAR;
    PG8_WAIT_V(2); PG8_BAR;
    PG8_STAGE(PG8_SB(1, 0), cB + kstep, voffB); PG8_STAGE(PG8_SA(1, 0), cA + kstep, voffA); PG8_STAGE(PG8_SB(1, 1), cB + hstep + kstep, voffB);
    PG8_WAIT_V(6); PG8_BAR;
    for (;;) {
        const bool has_next = S.next(ui + 1, nxt);
        const char* nA = cA; const char* nB = cB; if (has_next) S.ptrs(nxt, nA, nB);
        const int nt = S.ntiles(cur);
        for (int t = 0; t < nt; t += 2) {
            const bool last = (t == nt - 2);
            const char* a1 = cA + (size_t)(t + 1) * kstep;
            const char* a2 = last ? nA : cA + (size_t)(t + 2) * kstep; const char* b2 = last ? nB : cB + (size_t)(t + 2) * kstep;
            const char* a3 = a2 + kstep; const char* b3 = b2 + kstep;
            PG8_LDB(B0, 0, 0); PG8_LDB(B1, 0, 1); PG8_SCHED; PG8_LDA(At, 0, 0); PG8_STAGE(PG8_SA(1, 1), a1 + hstep, voffA);
            PG8_WAIT_V(8); PG8_WAIT_L(0); PG8_BAR; PG8_MMA(0, 0, At, B0); PG8_MMA(0, 1, At, B1); PG8_BAR; PG8_SCHED;
            PG8_LDA(At, 0, 1); PG8_STAGE(PG8_SB(0, 0), b2, voffB); PG8_STAGE(PG8_SB(0, 1), b2 + hstep, voffB); PG8_STAGE(PG8_SA(0, 0), a2, voffA);
            PG8_WAIT_V(8); PG8_WAIT_L(0); PG8_BAR; PG8_MMA(1, 0, At, B0); PG8_MMA(1, 1, At, B1); PG8_BAR; PG8_SCHED;
            PG8_LDB(B0, 1, 0); PG8_LDB(B1, 1, 1); PG8_SCHED; PG8_LDA(At, 1, 0); PG8_STAGE(PG8_SA(0, 1), a2 + hstep, voffA);
            PG8_WAIT_V(8); PG8_WAIT_L(0); PG8_BAR; PG8_MMA(0, 0, At, B0); PG8_MMA(0, 1, At, B1); PG8_BAR; PG8_SCHED;
            PG8_LDA(At, 1, 1); PG8_STAGE(PG8_SB(1, 0), b3, voffB); PG8_STAGE(PG8_SB(1, 1), b3 + hstep, voffB); PG8_STAGE(PG8_SA(1, 0), a3, voffA);
            PG8_WAIT_V(8); PG8_WAIT_L(0); PG8_BAR; PG8_MMA(1, 0, At, B0); PG8_MMA(1, 1, At, B1); PG8_BAR; PG8_SCHED;
        }
        if constexpr (ALIGN_EPI) { if (wr == 0) PG8_BAR; }
        E(acc, cur, wr, wc, fr, fq);
        if (!has_next) break;
#pragma unroll
        for (int a = 0; a < 2; ++a)
#pragma unroll
            for (int b = 0; b < 2; ++b)
#pragma unroll
                for (int m = 0; m < 4; ++m)
#pragma unroll
                    for (int n = 0; n < 2; ++n) acc[a][b][m][n] = (f32x4){0.f, 0.f, 0.f, 0.f};
        cur = nxt; cA = nA; cB = nB; ++ui;
        if constexpr (ALIGN_EPI) { if (wr == 1) PG8_BAR; }
    }
    PG8_WAIT_V(0);
    if constexpr (!ALIGN_EPI) { if (wr == 0) PG8_BAR; }
    PG8_BAR;
#undef PG8_SA
#undef PG8_SB
#undef PG8_STAGE
#undef PG8_LDA
#undef PG8_LDB
#undef PG8_MMA
#undef PG8_WAIT_V
#undef PG8_WAIT_L
#undef PG8_BAR
#undef PG8_SCHED
}
}

#define XB_TMO      128
#define XB_XCNT(j)  (256  + 64 * (j))
#define XB_XSUB(j)  (1280 + 64 * (j))
#define XB_XGEN(j)  (2304 + 64 * (j))
#define XB_TOP      3328
#define XB_TOPGEN   3392
#define XCD_BAR_WORDS 3456
#define XB_SPIN_CAP (1u << 20)
__device__ __forceinline__ unsigned xb_ld(unsigned* p)              { return __hip_atomic_load(p, __ATOMIC_RELAXED, __HIP_MEMORY_SCOPE_AGENT); }
__device__ __forceinline__ unsigned xb_add(unsigned* p, unsigned v) { return __hip_atomic_fetch_add(p, v, __ATOMIC_RELAXED, __HIP_MEMORY_SCOPE_AGENT); }
__device__ __forceinline__ unsigned xb_xcc_id() { return (unsigned)__builtin_amdgcn_s_getreg((3 << 11) | 20) & 0xFu; }
#define XB_SPIN(cond, bar) do { unsigned _sp = 0; while (cond) { __builtin_amdgcn_s_sleep(1); \
    if ((++_sp & 255u) == 0u) { if (xb_ld(&(bar)[XB_TMO])) break; if (_sp > XB_SPIN_CAP) { atomicAdd(&(bar)[XB_TMO], 1u); break; } } } } while (0)
struct XcdBarrier { unsigned* bar; unsigned x; volatile LAS unsigned* st; };
__device__ __forceinline__ XcdBarrier xcd_barrier_post(unsigned* bar, volatile LAS unsigned* st) {
    XcdBarrier b; b.bar = bar; b.x = xb_xcc_id(); b.st = st;
    if (threadIdx.x == 0) (void)xb_add(&bar[XB_XCNT(b.x)], 1u);
    return b;
}
__device__ __forceinline__ void xcd_barrier_complete(unsigned* bar, unsigned x, unsigned& nloc, unsigned& nx) {
    const unsigned G = gridDim.x * gridDim.y * gridDim.z;
    unsigned sum, cnt, mine, sp = 0u;
    for (;;) {
        sum = 0u; cnt = 0u; mine = 0u;
#pragma unroll
        for (unsigned j = 0; j < 16; ++j) { const unsigned c = xb_ld(&bar[XB_XCNT(j)]); sum += c; cnt += (c > 0u) ? 1u : 0u; mine = (j == x) ? c : mine; }
        if (sum == G) break;
        __builtin_amdgcn_s_sleep(1);
        if ((++sp & 255u) == 0u) { if (xb_ld(&bar[XB_TMO])) break; if (sp > XB_SPIN_CAP) { atomicAdd(&bar[XB_TMO], 1u); break; } }
    }
    nloc = mine > 0u ? mine : 1u; nx = cnt > 0u ? cnt : 1u;
}
__device__ __forceinline__ void xcd_barrier(const XcdBarrier& b) {
    asm volatile("s_waitcnt vmcnt(0)" ::: "memory");
    __syncthreads();
    if (threadIdx.x == 0) {
        unsigned* bar = b.bar;
        __builtin_amdgcn_s_waitcnt(0);
        unsigned nloc = b.st[0], nx = b.st[1];
        if (nloc == 0u) { xcd_barrier_complete(bar, b.x, nloc, nx); b.st[0] = nloc; b.st[1] = nx; }
        const unsigned old = xb_add(&bar[XB_XSUB(b.x)], 1u);
        const unsigned gen = old / nloc;
        if (old + 1u == (gen + 1u) * nloc) {
            __builtin_amdgcn_fence(__ATOMIC_RELEASE, "agent");
            asm volatile("s_waitcnt vmcnt(0)" ::: "memory");
            const unsigned og = xb_add(&bar[XB_TOP], 1u);
            const unsigned tg = og / nx;
            if (og + 1u == (tg + 1u) * nx) xb_add(&bar[XB_TOPGEN], 1u);
            else XB_SPIN(xb_ld(&bar[XB_TOPGEN]) == tg, bar);
            __builtin_amdgcn_fence(__ATOMIC_ACQUIRE, "agent");
            xb_add(&bar[XB_XGEN(b.x)], 1u);
            asm volatile("s_waitcnt vmcnt(0)" ::: "memory");
        } else {
            XB_SPIN(xb_ld(&bar[XB_XGEN(b.x)]) == gen, bar);
            __builtin_amdgcn_fence(__ATOMIC_ACQUIRE, "agent");
            asm volatile("s_waitcnt vmcnt(0)" ::: "memory");
        }
    }
    __syncthreads();
}

struct Args { const float* in[22]; float* out; unsigned char* ws; int ph_lo, ph_hi; };
enum { I_XP = 0, I_XS, I_SGDN, I_SCONV, I_CSK, I_CSV, I_CMK, I_CMV, I_MEMP, I_NORM_IN, I_WIN, I_CONVW, I_ALOG, I_DTB, I_GNORM, I_SINKS, I_RELB, I_NORM_MEM, I_WMKV, I_WBR, I_WOUT, I_NORMF };

struct Frame {
    LAS unsigned char* lds;
    int tid, lane, wave, G, bid;
    const float* const* in; float* out; unsigned char* ws;
};

template <bool WINMAP>
__device__ __forceinline__ void p0_transpose_item(const float* W, int K, int Nsrc, bf16_t* WT, LAS bf16_t* scr, int kb, int nb, int lane) {
    constexpr int TP = 130;
    const int k0 = 64 * kb, n0 = 128 * nb;
    const int dj = n0 + 4 * (lane & 31);
    const int sc = WINMAP ? win_src_col(dj) : dj;
    f32x4 v[32];
#pragma unroll
    for (int i = 0; i < 32; ++i) { const int kk = 2 * i + (lane >> 5); v[i] = sc >= 0 ? *(const f32x4*)(W + (size_t)(k0 + kk) * Nsrc + sc) : (f32x4){0.f, 0.f, 0.f, 0.f}; }
#pragma unroll
    for (int i = 0; i < 32; ++i) { const int kk = 2 * i + (lane >> 5); LAS unsigned* d = (LAS unsigned*)(scr + kk * TP + 4 * (lane & 31)); d[0] = pk2(v[i].x, v[i].y); d[1] = pk2(v[i].z, v[i].w); }
    LDS_WAIT(); asm volatile("" ::: "memory");
#pragma unroll 4
    for (int u = 0; u < 16; ++u) { const int e = lane + 64 * u, ch = e & 7, n = e >> 3; const LAS bf16_t* s = scr + (8 * ch) * TP + n;
        u32x4 o; o.x = (unsigned)s[0] | ((unsigned)s[TP] << 16); o.y = (unsigned)s[2 * TP] | ((unsigned)s[3 * TP] << 16);
        o.z = (unsigned)s[4 * TP] | ((unsigned)s[5 * TP] << 16); o.w = (unsigned)s[6 * TP] | ((unsigned)s[7 * TP] << 16);
        *(u32x4*)(WT + (size_t)(n0 + n) * K + k0 + 8 * ch) = o; }
    LDS_WAIT(); asm volatile("" ::: "memory");
}
__device__ __forceinline__ void rms_row_to_bf16(const float* xrow, const float* w, bf16_t* orow, int lane) {
    const f32x4* xr = (const f32x4*)xrow + lane; const f32x4* wr = (const f32x4*)w + lane;
    f32x4 v[8]; float s = 0.f;
#pragma unroll
    for (int j = 0; j < 8; ++j) { v[j] = xr[64 * j]; s += (v[j].x * v[j].x + v[j].y * v[j].y) + (v[j].z * v[j].z + v[j].w * v[j].w); }
    const float r = rsqrtf(wave_sum(s) * (1.f / D) + EPS);
    unsigned long long* o8 = (unsigned long long*)orow + lane;
#pragma unroll
    for (int j = 0; j < 8; ++j) { const f32x4 ww = wr[64 * j];
        o8[64 * j] = (unsigned long long)pk2(v[j].x * r * ww.x, v[j].y * r * ww.y) | ((unsigned long long)pk2(v[j].z * r * ww.z, v[j].w * r * ww.w) << 32); }
}
__device__ __forceinline__ int t5_bucket(int n) {
    if (n < 16) return n;
    int large = 16 + (int)(logf((float)n / 16.f) / 2.0794415416798357f * 16.f);
    return large < 31 ? large : 31;
}
__device__ __forceinline__ void p0_prologue(Frame& F) {
    LAS bf16_t* scr = (LAS bf16_t*)(F.lds + F.wave * 16896);
    const int gw = F.bid * NWAVES + F.wave, NGW = F.G * NWAVES;
    constexpr int I_IN = 32 * (NIN / 128), I_MKV = 32 * 16, I_BR = 16 * 16, I_OUT = 32 * 16;
    constexpr int NITEMS = I_IN + I_MKV + 3 * I_BR + I_OUT;
    bf16_t* WINT = (bf16_t*)(F.ws + WS_WIN); bf16_t* WMKVT = (bf16_t*)(F.ws + WS_WMKV); bf16_t* WBT = (bf16_t*)(F.ws + WS_WB); bf16_t* WOT = (bf16_t*)(F.ws + WS_WO);
    for (int it = gw; it < NITEMS; it += NGW) {
        int r = it;
        if (r < I_IN) { p0_transpose_item<true>(F.in[I_WIN], D, IN_COLS, WINT, scr, r / (NIN / 128), r % (NIN / 128), F.lane); continue; } r -= I_IN;
        if (r < I_MKV) { p0_transpose_item<false>(F.in[I_WMKV], D, 2048, WMKVT, scr, r / 16, r % 16, F.lane); continue; } r -= I_MKV;
        if (r < 3 * I_BR) { const int b = r / I_BR, q = r % I_BR; p0_transpose_item<false>(F.in[I_WBR] + (size_t)b * 1024 * 2048, 1024, 2048, WBT + (size_t)b * 2048 * 1024, scr, q / 16, q % 16, F.lane); continue; } r -= 3 * I_BR;
        p0_transpose_item<false>(F.in[I_WOUT], D, 2048, WOT, scr, r / 16, r % 16, F.lane);
    }
    bf16_t* XN = (bf16_t*)((unsigned char*)F.out + DO_XN); bf16_t* MEMN = (bf16_t*)(F.ws + WS_MEMN);
    for (int m = gw; m < M + 512; m += NGW) {
        if (m < MP) rms_row_to_bf16(F.in[I_XP] + (size_t)m * D, F.in[I_NORM_IN], XN + (size_t)m * D, F.lane);
        else if (m < M) rms_row_to_bf16(F.in[I_XS] + (size_t)(m - MP) * D, F.in[I_NORM_IN], XN + (size_t)m * D, F.lane);
        else rms_row_to_bf16(F.in[I_MEMP] + (size_t)(m - M) * D, F.in[I_NORM_MEM], MEMN + (size_t)(m - M) * D, F.lane);
    }
    float* BT = (float*)(F.ws + WS_BTAB);
    for (int i = F.bid * NTHREADS + F.tid; i < 16 * 128; i += F.G * NTHREADS) { const int h = i >> 7, dist = i & 127; BT[i] = F.in[I_RELB][t5_bucket(dist) * 16 + h]; }
}

struct SchedP1 {
    int G, c; const unsigned char* ws; const unsigned char* xn;
    __device__ __forceinline__ int ntiles(const pg8::Unit&) const { return D / 64; }
    static constexpr int NM = M / 256, NN = NIN / 256, NU0 = NM * NN, NU = NU0 + 16;
    __device__ __forceinline__ bool next(int i, pg8::Unit& u) const {
        const long L = (long)i * G + c; if (L >= NU) return false;
        if (L < NU0) { pg8::tile_of((int)L, NM, NN, u.pm, u.pn); u.job = 0; } else { const int q = (int)L - NU0; u.pm = q >> 3; u.pn = q & 7; u.job = 1; }
        return true;
    }
    __device__ __forceinline__ void ptrs(const pg8::Unit& u, const char*& A, const char*& B) const {
        const size_t tstep = (size_t)256 * D * 2;
        if (u.job == 0) { A = (const char*)xn + (size_t)u.pm * tstep; B = (const char*)ws + WS_WIN + (size_t)u.pn * tstep; }
        else { A = (const char*)ws + WS_MEMN + (size_t)u.pm * tstep; B = (const char*)ws + WS_WMKV + (size_t)u.pn * tstep; }
    }
};
struct EpiP1 {
    unsigned char* ws; float* out;
    __device__ __forceinline__ void operator()(const f32x4 (&acc)[2][2][4][2], const pg8::Unit& u, int wr, int wc, int fr, int fq) const {
        const int row0 = u.pm * 256 + wr * 64 + fr;
        const int cin = wc * 32 + 8 * fq;
        if (u.job == 1) {
            bf16_t* MK = (bf16_t*)(ws + WS_MEMKV);
#pragma unroll
            for (int ai = 0; ai < 2; ++ai)
#pragma unroll
                for (int m = 0; m < 4; ++m) { const int r = row0 + ai * 128 + m * 16;
#pragma unroll
                    for (int bj = 0; bj < 2; ++bj) { const int c = u.pn * 256 + bj * 128 + cin; const f32x4 v0 = acc[ai][bj][m][0], v1 = acc[ai][bj][m][1];
                        float* o = out + (c < 1024 ? O_MKP + (size_t)r * 1024 + c : O_MVP + (size_t)r * 1024 + (c - 1024));
                        *(f32x4*)o = v0; *(f32x4*)(o + 4) = v1;
                        u32x4 w; w.x = pg8::cvt_pk_bf16(v0[0], v0[1]); w.y = pg8::cvt_pk_bf16(v0[2], v0[3]); w.z = pg8::cvt_pk_bf16(v1[0], v1[1]); w.w = pg8::cvt_pk_bf16(v1[2], v1[3]);
                        *(u32x4*)(MK + (size_t)r * 2048 + c) = w;
                        if (c >= 1024) { bf16_t* MVT = (bf16_t*)(ws + WS_MVT) + ((size_t)((r >> 8) * 4 + ((c - 1024) >> 8)) * 256 + ((c - 1024) & 255)) * 256 + (r & 255);
                            MVT[0] = (bf16_t)(w.x & 0xffffu); MVT[256] = (bf16_t)(w.x >> 16); MVT[512] = (bf16_t)(w.y & 0xffffu); MVT[768] = (bf16_t)(w.y >> 16);
                            MVT[1024] = (bf16_t)(w.z & 0xffffu); MVT[1280] = (bf16_t)(w.z >> 16); MVT[1536] = (bf16_t)(w.w & 0xffffu); MVT[1792] = (bf16_t)(w.w >> 16); } } }
            return;
        }
        const int pn = u.pn;
        if (pn == 57) {
            if (wc == 0 && fq < 2) { float* GAB = (float*)(ws + WS_GAB);
#pragma unroll
                for (int ai = 0; ai < 2; ++ai)
#pragma unroll
                    for (int m = 0; m < 4; ++m) { const int r = row0 + ai * 128 + m * 16; float* o = GAB + (size_t)r * 16 + 8 * fq; *(f32x4*)o = acc[ai][0][m][0]; *(f32x4*)(o + 4) = acc[ai][0][m][1]; } }
            return;
        }
        bf16_t* base; int ld, ct, act = 0;
        if (pn < 12) { base = (bf16_t*)(ws + WS_QKV); ld = 3072; ct = pn; }
        else if (pn < 16) { base = (bf16_t*)(ws + WS_GZ); ld = 1024; ct = pn - 12; act = 1; }
        else if (pn < 20) { base = (bf16_t*)(ws + WS_SQ); ld = 1024; ct = pn - 16; }
        else if (pn < 24) { base = (bf16_t*)(ws + WS_SZ); ld = 1024; ct = pn - 20; act = 1; }
        else if (pn < 28) { base = (bf16_t*)(ws + WS_MQ); ld = 1024; ct = pn - 24; }
        else if (pn < 32) { base = (bf16_t*)(ws + WS_MZ); ld = 1024; ct = pn - 28; act = 1; }
        else if (pn < 56) { base = (bf16_t*)(ws + WS_GATES); ld = 6144; ct = pn - 32; act = 2; }
        else { base = (bf16_t*)(ws + WS_SKV); ld = 256; ct = 0; }
#pragma unroll
        for (int ai = 0; ai < 2; ++ai)
#pragma unroll
            for (int m = 0; m < 4; ++m) { bf16_t* rowp = base + (size_t)(row0 + ai * 128 + m * 16) * ld + ct * 256 + cin;
#pragma unroll
                for (int bj = 0; bj < 2; ++bj) { f32x4 v0 = acc[ai][bj][m][0], v1 = acc[ai][bj][m][1];
                    if (act == 1) {
#pragma unroll
                        for (int j = 0; j < 4; ++j) { v0[j] = siluf_(v0[j]); v1[j] = siluf_(v1[j]); } }
                    else if (act == 2) {
#pragma unroll
                        for (int j = 0; j < 4; ++j) { v0[j] = sigmoidf_(v0[j]); v1[j] = sigmoidf_(v1[j]); } }
                    u32x4 w; w.x = pg8::cvt_pk_bf16(v0[0], v0[1]); w.y = pg8::cvt_pk_bf16(v0[2], v0[3]); w.z = pg8::cvt_pk_bf16(v1[0], v1[1]); w.w = pg8::cvt_pk_bf16(v1[2], v1[3]);
                    *(u32x4*)(rowp + bj * 128) = w;
                    if (pn == 56 && bj == 1) { const int r = row0 + ai * 128 + m * 16;
                        if (r < MP) { bf16_t* vt = (bf16_t*)(ws + WS_VTS) + ((size_t)((r >> 13) * 2 + (cin >> 6)) * 64 + (cin & 63)) * SEQ + (r & (SEQ - 1));
                            vt[0] = (bf16_t)(w.x & 0xffffu); vt[SEQ] = (bf16_t)(w.x >> 16); vt[2 * SEQ] = (bf16_t)(w.y & 0xffffu); vt[3 * SEQ] = (bf16_t)(w.y >> 16);
                            vt[4 * SEQ] = (bf16_t)(w.z & 0xffffu); vt[5 * SEQ] = (bf16_t)(w.z >> 16); vt[6 * SEQ] = (bf16_t)(w.w & 0xffffu); vt[7 * SEQ] = (bf16_t)(w.w >> 16); } } } }
    }
};

__device__ __forceinline__ void gdn_gate_scalars(Frame& F, int r, int h) {
    const float* GAB = (const float*)(F.ws + WS_GAB); float* Gp = (float*)(F.ws + WS_G); float* Bp = (float*)(F.ws + WS_BETA);
    const float gb = GAB[(size_t)r * 16 + h], ga = GAB[(size_t)r * 16 + 8 + h];
    Bp[(size_t)r * 8 + h] = sigmoidf_(gb);
    const float xx = ga + F.in[I_DTB][h]; const float sp = xx > 20.f ? xx : log1pf(expf(xx));
    Gp[(size_t)r * 8 + h] = -expf(F.in[I_ALOG][h]) * sp;
}
__device__ __forceinline__ void conv_prompt_item(Frame& F, int item) {
    const int b = item >> 7, n = item & 127, row0 = b * SEQ + 64 * n, tid = F.tid;
    const bf16_t* QKV = (const bf16_t*)(F.ws + WS_QKV);
    bf16_t* QN = (bf16_t*)((unsigned char*)F.out + DO_QN); bf16_t* KN = (bf16_t*)((unsigned char*)F.out + DO_KN);
    bf16_t* KT = (bf16_t*)((unsigned char*)F.out + DO_KT); bf16_t* VT = (bf16_t*)((unsigned char*)F.out + DO_VT);
    const float* cw = F.in[I_CONVW];
    constexpr int SP = 136;
    LAS bf16_t* slab = (LAS bf16_t*)F.lds;
    { const int tok = tid >> 3, h = tid & 7; gdn_gate_scalars(F, row0 + tok, h); }
    const int t0 = tid >> 4, cg = (tid & 15) * 8;
    LAS float* cwl = (LAS float*)(F.lds + 32768);
    for (int i = tid; i < 4 * 3072 / 4; i += NTHREADS) ((LAS f32x4*)cwl)[i] = ((const f32x4*)cw)[i];
    __syncthreads();
    struct Slab { u32x4 x[2][4]; };
#define CONV_LOAD(S_, sl_) do { const int ch_ = ((sl_) >> 3) * 1024 + ((sl_) & 7) * 128 + cg; \
        _Pragma("unroll") for (int p = 0; p < 2; ++p) _Pragma("unroll") for (int j = 0; j < 4; ++j) { const int tk = t0 + 32 * p - 3 + j; \
            S_.x[p][j] = (64 * n + tk >= 0) ? *(const u32x4*)(QKV + (size_t)(row0 + tk) * 3072 + ch_) : (u32x4){0u, 0u, 0u, 0u}; } \
        } while (0)
#define CONV_SLAB(S_, sl_) do { const int part = (sl_) >> 3, h = (sl_) & 7; f32x4 wq[4][2]; \
        _Pragma("unroll") for (int j = 0; j < 4; ++j) { wq[j][0] = *(const LAS f32x4*)(cwl + j * 3072 + part * 1024 + h * 128 + cg); wq[j][1] = *(const LAS f32x4*)(cwl + j * 3072 + part * 1024 + h * 128 + cg + 4); } \
        _Pragma("unroll") for (int p = 0; p < 2; ++p) { \
            const int tok = t0 + 32 * p, r = row0 + tok; \
            float a[8]; \
            _Pragma("unroll") for (int e = 0; e < 8; ++e) a[e] = 0.f; \
            _Pragma("unroll") for (int j = 0; j < 4; ++j) { const u32x4 v = S_.x[p][j]; \
                a[0] += bf2f(v.x & 0xffffu) * wq[j][0][0]; a[1] += bf2f(v.x >> 16) * wq[j][0][1]; a[2] += bf2f(v.y & 0xffffu) * wq[j][0][2]; a[3] += bf2f(v.y >> 16) * wq[j][0][3]; \
                a[4] += bf2f(v.z & 0xffffu) * wq[j][1][0]; a[5] += bf2f(v.z >> 16) * wq[j][1][1]; a[6] += bf2f(v.w & 0xffffu) * wq[j][1][2]; a[7] += bf2f(v.w >> 16) * wq[j][1][3]; } \
            _Pragma("unroll") for (int e = 0; e < 8; ++e) a[e] = siluf_(a[e]); \
            if (part < 2) { float ss = ((a[0] * a[0] + a[1] * a[1]) + (a[2] * a[2] + a[3] * a[3])) + ((a[4] * a[4] + a[5] * a[5]) + (a[6] * a[6] + a[7] * a[7])); \
                ss += __shfl_xor(ss, 1); ss += __shfl_xor(ss, 2); ss += __shfl_xor(ss, 4); ss += __shfl_xor(ss, 8); \
                if (cg == 0) ((float*)(F.ws + (part == 0 ? WS_SSQ : WS_SSK)))[(size_t)(row0 + t0 + 32 * p) * 8 + h] = ss; } \
            u32x4 o4; o4.x = pk2(a[0], a[1]); o4.y = pk2(a[2], a[3]); o4.z = pk2(a[4], a[5]); o4.w = pk2(a[6], a[7]); \
            const size_t o = (size_t)r * 1024 + h * 128 + cg; \
            if (part == 0) *(u32x4*)(QN + o) = o4; \
            else { if (part == 1) *(u32x4*)(KN + o) = o4; *(LAS u32x4*)(slab + tok * SP + cg) = o4; } \
            if (n == 127 && tok >= 61) { const u32x4 raw = S_.x[p][3]; float* cdst = F.out + O_GCP + ((size_t)b * 3 + (tok - 61)) * 3072 + part * 1024 + h * 128 + cg; \
                *(f32x4*)cdst = (f32x4){bf2f(raw.x & 0xffffu), bf2f(raw.x >> 16), bf2f(raw.y & 0xffffu), bf2f(raw.y >> 16)}; \
                *(f32x4*)(cdst + 4) = (f32x4){bf2f(raw.z & 0xffffu), bf2f(raw.z >> 16), bf2f(raw.w & 0xffffu), bf2f(raw.w >> 16)}; } \
        } \
        if (part > 0) { \
            __syncthreads(); \
            bf16_t* dst = (part == 1 ? KT : VT) + (size_t)((b * 8 + h) * 128 + n) * 8192; \
            _Pragma("unroll") for (int u = 0; u < 2; ++u) { const int e = tid + 512 * u, chn = 16 * (e >> 7) + (e & 15), tg = 4 * ((e >> 6) & 1) + ((e >> 4) & 3); const LAS bf16_t* s = slab + (8 * tg) * SP + chn; \
                u32x4 o4; o4.x = (unsigned)s[0] | ((unsigned)s[SP] << 16); o4.y = (unsigned)s[2 * SP] | ((unsigned)s[3 * SP] << 16); \
                o4.z = (unsigned)s[4 * SP] | ((unsigned)s[5 * SP] << 16); o4.w = (unsigned)s[6 * SP] | ((unsigned)s[7 * SP] << 16); \
                *(u32x4*)(dst + e * 8) = o4; } \
            __syncthreads(); \
        } } while (0)
    Slab s0, s1, s2;
    CONV_LOAD(s0, 0); CONV_LOAD(s1, 1);
#pragma unroll 1
    for (int sl = 0; sl < 24; sl += 3) {
        CONV_LOAD(s2, sl + 2); CONV_SLAB(s0, sl);
        if (sl + 3 < 24) CONV_LOAD(s0, sl + 3); CONV_SLAB(s1, sl + 1);
        if (sl + 4 < 24) CONV_LOAD(s1, sl + 4); CONV_SLAB(s2, sl + 2);
    }
#undef CONV_LOAD
#undef CONV_SLAB
}
__device__ __forceinline__ void conv_sample_items(Frame& F) {
    const int gw = F.bid * NWAVES + F.wave, NGW = F.G * NWAVES, lane = F.lane;
    const bf16_t* QKV = (const bf16_t*)(F.ws + WS_QKV);
    bf16_t* QN = (bf16_t*)((unsigned char*)F.out + DO_QN); bf16_t* KN = (bf16_t*)((unsigned char*)F.out + DO_KN); bf16_t* VNS = (bf16_t*)((unsigned char*)F.out + DO_VNS);
    const float* cw = F.in[I_CONVW];
    for (int it = gw; it < 128 * 8; it += NGW) {
        const int bd = it >> 3, h = it & 7;
        float xr[3][7][2], wv[3][4][2];
#pragma unroll
        for (int part = 0; part < 3; ++part) { const int ch = part * 1024 + h * 128 + 2 * lane;
#pragma unroll
            for (int i = 0; i < 3; ++i) { const float2 p2 = *(const float2*)(F.in[I_SCONV] + ((size_t)bd * 3 + i) * 3072 + ch); xr[part][i][0] = p2.x; xr[part][i][1] = p2.y; }
#pragma unroll
            for (int i = 0; i < 4; ++i) { const unsigned v = *(const unsigned*)(QKV + (size_t)(MP + bd * 4 + i) * 3072 + ch); xr[part][3 + i][0] = bf2f(v & 0xffffu); xr[part][3 + i][1] = bf2f(v >> 16); }
#pragma unroll
            for (int j = 0; j < 4; ++j) { const float2 w2 = *(const float2*)(cw + j * 3072 + ch); wv[part][j][0] = w2.x; wv[part][j][1] = w2.y; } }
#pragma unroll
        for (int s = 0; s < 4; ++s) {
            const int r = MP + bd * 4 + s;
            float y[3][2];
#pragma unroll
            for (int part = 0; part < 3; ++part) { float a0 = 0.f, a1 = 0.f;
#pragma unroll
                for (int j = 0; j < 4; ++j) { a0 += xr[part][s + j][0] * wv[part][j][0]; a1 += xr[part][s + j][1] * wv[part][j][1]; }
                y[part][0] = siluf_(a0); y[part][1] = siluf_(a1); }
            const float sq = wave_sum(y[0][0] * y[0][0] + y[0][1] * y[0][1]), sk = wave_sum(y[1][0] * y[1][0] + y[1][1] * y[1][1]);
            const float rq = rsqrtf(sq + EPS) * 0.08838834764831845f, rk = rsqrtf(sk + EPS);
            const size_t o = (size_t)r * 1024 + h * 128 + 2 * lane;
            *(unsigned*)(QN + o) = pk2(y[0][0] * rq, y[0][1] * rq);
            *(unsigned*)(KN + o) = pk2(y[1][0] * rk, y[1][1] * rk);
            *(unsigned*)(VNS + (size_t)(r - MP) * 1024 + h * 128 + 2 * lane) = pk2(y[2][0], y[2][1]);
            if (lane == 0) gdn_gate_scalars(F, r, h);
            if (s >= 1) { float* cdst = F.out + O_GCS + ((size_t)bd * 3 + (s - 1)) * 3072;
#pragma unroll
                for (int part = 0; part < 3; ++part) { const int ch = part * 1024 + h * 128 + 2 * lane; *(float2*)(cdst + ch) = make_float2(xr[part][3 + s][0], xr[part][3 + s][1]); } }
        }
    }
}
__device__ __forceinline__ void p2_conv(Frame& F) {
    for (int it = F.bid; it < 256; it += F.G) conv_prompt_item(F, it);
    conv_sample_items(F);
}

__device__ __forceinline__ f32x4 mfma16(bf16x8 a, bf16x8 b, f32x4 c) { return __builtin_amdgcn_mfma_f32_16x16x32_bf16(a, b, c, 0, 0, 0); }
__device__ __forceinline__ u32x2 pack4(f32x4 v) { u32x2 r; r.x = pk2(v[0], v[1]); r.y = pk2(v[2], v[3]); return r; }
__device__ __forceinline__ void prep_item(Frame& F, int item) {
    const int b = item >> 7, n = item & 127, row0 = b * SEQ + 64 * n, lane = F.lane, h = F.wave, c = lane & 15, q = lane >> 4;
    const int ci = (b * 8 + h) * 128 + n;
    const bf16_t* QN = (const bf16_t*)((const unsigned char*)F.out + DO_QN); const bf16_t* KN = (const bf16_t*)((const unsigned char*)F.out + DO_KN);
    const bf16_t* KT = (const bf16_t*)((const unsigned char*)F.out + DO_KT) + (size_t)ci * 8192; const bf16_t* VT = (const bf16_t*)((const unsigned char*)F.out + DO_VT) + (size_t)ci * 8192;
    bf16_t* NEGW = (bf16_t*)(F.ws + WS_NEGW) + (size_t)ci * 8192; bf16_t* UT = (bf16_t*)(F.ws + WS_UT) + (size_t)ci * 8192; bf16_t* ATT = (bf16_t*)(F.ws + WS_ATT) + (size_t)ci * 4096;
    const float* Gp = (const float*)(F.ws + WS_G); const float* Bp = (const float*)(F.ws + WS_BETA);
    float* GC = (float*)(F.ws + WS_GC); float* DEC = (float*)(F.ws + WS_DEC); float* GT = (float*)(F.ws + WS_GT);
    LAS float* Als = (LAS float*)(F.lds + h * 18432);
    LAS float* gcs = Als + 4096; LAS float* bes = gcs + 64;
    float gc = Gp[(size_t)(row0 + lane) * 8 + h];
#pragma unroll
    for (int o = 1; o < 64; o <<= 1) { const float x = __shfl_up(gc, o); if (lane >= o) gc += x; }
    const float beta = Bp[(size_t)(row0 + lane) * 8 + h];
    const float gl = __shfl(gc, 63);
    const float sk = ((const float*)(F.ws + WS_SSK))[(size_t)(row0 + lane) * 8 + h], sq = ((const float*)(F.ws + WS_SSQ))[(size_t)(row0 + lane) * 8 + h];
    const float rk = rsqrtf(sk + EPS), rq = rsqrtf(sq + EPS) * 0.08838834764831845f;
    LAS float* rks = bes + 64; LAS float* rqs = rks + 64;
    gcs[lane] = gc; bes[lane] = beta; rks[lane] = rk; rqs[lane] = rq;
    GC[(size_t)(row0 + lane) * 8 + h] = __expf(gc) * rq; DEC[(size_t)ci * 64 + lane] = __expf(gl - gc) * rk; if (lane == 0) GT[ci] = __expf(gl);
    LDS_WAIT(); asm volatile("" ::: "memory");
    bf16x8 kf[4][4];
#pragma unroll
    for (int mt = 0; mt < 4; ++mt)
#pragma unroll
        for (int s = 0; s < 4; ++s) { const size_t o = (size_t)(row0 + 16 * mt + c) * 1024 + h * 128 + 32 * s + 8 * q; kf[mt][s] = *(const bf16x8*)(KN + o); }
#pragma unroll
    for (int mi = 0; mi < 4; ++mi) {
        const int ii = 16 * mi + c; const float gci = gcs[ii], bi = bes[ii] * rks[ii], rqi = rqs[ii];
        const bf16_t* qrow_p = QN + (size_t)(row0 + ii) * 1024 + h * 128 + 8 * q;
#pragma unroll
        for (int nj = 0; nj < 4; ++nj) {
            u32x2 av; av.x = 0u; av.y = 0u;
            if (nj <= mi) {
                f32x4 dk = {0.f, 0.f, 0.f, 0.f}, dq = {0.f, 0.f, 0.f, 0.f};
#pragma unroll
                for (int s = 0; s < 4; ++s) { dk = mfma16(kf[nj][s], kf[mi][s], dk); dq = mfma16(kf[nj][s], *(const bf16x8*)(qrow_p + 32 * s), dq); }
                const f32x4 gj = *(const LAS f32x4*)(gcs + 16 * nj + 4 * q), rkj = *(const LAS f32x4*)(rks + 16 * nj + 4 * q);
                f32x4 a, at;
#pragma unroll
                for (int r = 0; r < 4; ++r) { const int jj = 16 * nj + 4 * q + r; const float e = __expf(gci - gj[r]);
                    a[r] = (ii > jj) ? bi * rkj[r] * dk[r] * e : 0.f; at[r] = (ii >= jj) ? rqi * rkj[r] * dq[r] * e : 0.f; }
                *(LAS f32x4*)(Als + ii * 64 + 16 * nj + 4 * q) = a;
                av = pack4(at);
            }
            *(u32x2*)(ATT + ((mi * 2 + (nj >> 1)) * 64 + (2 * (nj & 1) + (q >> 1)) * 16 + c) * 8 + 4 * (q & 1)) = av;
        }
    }
    LDS_WAIT();
    float t[64];
#pragma unroll
    for (int i = 0; i < 64; ++i) {
        float acc = (lane == i) ? 1.f : 0.f;
#pragma unroll
        for (int m4 = 0; m4 < i; m4 += 4) { const f32x4 a = *(const LAS f32x4*)(Als + i * 64 + m4);
            acc -= a[0] * t[m4]; if (m4 + 1 < i) acc -= a[1] * t[m4 + 1]; if (m4 + 2 < i) acc -= a[2] * t[m4 + 2]; if (m4 + 3 < i) acc -= a[3] * t[m4 + 3]; }
        t[i] = acc;
    }
    LAS bf16_t* T1 = (LAS bf16_t*)Als; LAS bf16_t* T2 = T1 + 64 * 72;
    const float s1 = beta, s2 = -beta * __expf(gc) * rk;
    LDS_WAIT();
#pragma unroll
    for (int i = 0; i < 64; ++i) { T1[i * 72 + lane] = (bf16_t)f2bf(t[i] * s1); T2[i * 72 + lane] = (bf16_t)f2bf(t[i] * s2); }
    LDS_WAIT();
    bf16x8 t1f[4][2], t2f[4][2];
#pragma unroll
    for (int it = 0; it < 4; ++it)
#pragma unroll
        for (int s = 0; s < 2; ++s) { t1f[it][s] = *(const LAS bf16x8*)(T1 + (16 * it + c) * 72 + 32 * s + 8 * q); t2f[it][s] = *(const LAS bf16x8*)(T2 + (16 * it + c) * 72 + 32 * s + 8 * q); }
#pragma unroll 2
    for (int dt = 0; dt < 8; ++dt) {
        bf16x8 vb[2], ka[2];
#pragma unroll
        for (int s = 0; s < 2; ++s) { vb[s] = *(const bf16x8*)(VT + ((dt * 2 + s) * 64 + lane) * 8); ka[s] = *(const bf16x8*)(KT + ((dt * 2 + s) * 64 + lane) * 8); }
#pragma unroll
        for (int it = 0; it < 4; ++it) {
            f32x4 du = {0.f, 0.f, 0.f, 0.f}, dw = {0.f, 0.f, 0.f, 0.f};
            du = mfma16(t1f[it][0], vb[0], du); dw = mfma16(ka[0], t2f[it][0], dw);
            if (it >= 2) { du = mfma16(t1f[it][1], vb[1], du); dw = mfma16(ka[1], t2f[it][1], dw); }
            *(u32x2*)(UT + ((dt * 2 + (it >> 1)) * 64 + (2 * (it & 1) + (q >> 1)) * 16 + c) * 8 + 4 * (q & 1)) = pack4(du);
            *(u32x2*)(NEGW + ((it * 4 + (dt >> 1)) * 64 + (2 * (dt & 1) + (q >> 1)) * 16 + c) * 8 + 4 * (q & 1)) = pack4(dw);
        }
    }
    LDS_WAIT();
}
__device__ __forceinline__ void p2_prep(Frame& F) { for (int it = F.bid; it < 256; it += F.G) { prep_item(F, it); __syncthreads(); } }

__device__ __forceinline__ void scan_item(Frame& F, int bh, int sl) {
    const int lane = F.lane, w = F.wave, c = lane & 15, q = lane >> 4, dvs = 16 * sl;
    const bf16_t* KT = (const bf16_t*)((const unsigned char*)F.out + DO_KT); const bf16_t* NEGW = (const bf16_t*)(F.ws + WS_NEGW);
    bf16_t* UT = (bf16_t*)(F.ws + WS_UT); bf16_t* SN = (bf16_t*)(F.ws + WS_SN);
    const float* DEC = (const float*)(F.ws + WS_DEC); const float* GT = (const float*)(F.ws + WS_GT);
    LAS bf16_t* SS = (LAS bf16_t*)F.lds;
    LAS bf16_t* VS = SS + 16 * 136;
    LAS bf16_t* VU = VS + 16 * 72;
    f32x4 Sacc = {0.f, 0.f, 0.f, 0.f};
    for (int e = F.tid; e < 16 * 136 / 2; e += NTHREADS) ((LAS unsigned*)SS)[e] = 0u;
    struct Ops { bf16x8 wf[4], kf[2]; u32x2 u2; f32x4 dec4; float gt; };
#define SCAN_LOAD(o, n_) do { const size_t ci__ = (size_t)bh * 128 + ((n_) < 128 ? (n_) : 127); \
        _Pragma("unroll") for (int s = 0; s < 2; ++s) o.kf[s] = *(const bf16x8*)(KT + ci__ * 8192 + ((w * 2 + s) * 64 + lane) * 8); \
        o.gt = GT[ci__]; \
        if (w < 4) { _Pragma("unroll") for (int s = 0; s < 4; ++s) o.wf[s] = *(const bf16x8*)(NEGW + ci__ * 8192 + ((w * 4 + s) * 64 + lane) * 8); \
            o.u2 = *(const u32x2*)(UT + ci__ * 8192 + ((sl * 2 + (w >> 1)) * 64 + (2 * (w & 1) + (q >> 1)) * 16 + c) * 8 + 4 * (q & 1)); o.dec4 = *(const f32x4*)(DEC + ci__ * 64 + 16 * w + 4 * q); } } while (0)
#define SCAN_STEP(o, n_) do { const size_t ci = (size_t)bh * 128 + (n_); \
        if (w < 4) { \
            f32x4 v = {bf2f(o.u2.x & 0xffffu), bf2f(o.u2.x >> 16), bf2f(o.u2.y & 0xffffu), bf2f(o.u2.y >> 16)}; \
            _Pragma("unroll") for (int s = 0; s < 4; ++s) { const bf16x8 sf = *(const LAS bf16x8*)(SS + c * 136 + 32 * s + 8 * q); v = mfma16(o.wf[s], sf, v); } \
            *(LAS u32x2*)(VU + c * 72 + 16 * w + 4 * q) = pack4(v); \
            const f32x4 vd = v * o.dec4; \
            *(LAS u32x2*)(VS + c * 72 + 16 * w + 4 * q) = pack4(vd); \
        } else if (w == 4) {   \
            _Pragma("unroll") for (int u = 0; u < 4; ++u) {   \
                *(u32x4*)(SN + ci * 16384 + ((sl * 4 + u) * 64 + lane) * 8) = *(const LAS u32x4*)(SS + c * 136 + 32 * u + 8 * q); } \
        } \
        asm volatile("s_waitcnt lgkmcnt(0)" ::: "memory"); __builtin_amdgcn_s_barrier(); asm volatile("" ::: "memory"); \
        Sacc = Sacc * o.gt; \
        _Pragma("unroll") for (int s = 0; s < 2; ++s) { const bf16x8 vf = *(const LAS bf16x8*)(VS + c * 72 + 32 * s + 8 * q); Sacc = mfma16(o.kf[s], vf, Sacc); } \
        if (w == 5) {   \
            _Pragma("unroll") for (int u = 0; u < 2; ++u) { \
                *(u32x4*)(UT + ci * 8192 + ((sl * 2 + u) * 64 + lane) * 8) = *(const LAS u32x4*)(VU + c * 72 + 32 * u + 8 * q); } } \
        { const u32x2 sp = pack4(Sacc); *(LAS u32x2*)(SS + c * 136 + 16 * w + 4 * q) = sp; } \
        asm volatile("s_waitcnt lgkmcnt(0)" ::: "memory"); __builtin_amdgcn_s_barrier(); asm volatile("" ::: "memory"); } while (0)
    Ops o0, o1, o2, o3;
    SCAN_LOAD(o0, 0); SCAN_LOAD(o1, 1); SCAN_LOAD(o2, 2);
    asm volatile("s_waitcnt lgkmcnt(0)" ::: "memory"); __builtin_amdgcn_s_barrier(); asm volatile("" ::: "memory");
#pragma unroll 1
    for (int n0 = 0; n0 < 128; n0 += 4) {
        SCAN_LOAD(o3, n0 + 3); SCAN_STEP(o0, n0);
        SCAN_LOAD(o0, n0 + 4); SCAN_STEP(o1, n0 + 1);
        SCAN_LOAD(o1, n0 + 5); SCAN_STEP(o2, n0 + 2);
        SCAN_LOAD(o2, n0 + 6); SCAN_STEP(o3, n0 + 3);
    }
#undef SCAN_LOAD
#undef SCAN_STEP
    float* so = F.out + O_GSP + (size_t)bh * 16384;
#pragma unroll
    for (int r = 0; r < 4; ++r) so[(size_t)(16 * w + 4 * q + r) * 128 + dvs + c] = Sacc[r];
}

__device__ __forceinline__ void gdn_out_item(Frame& F, int item) {
    const int b = item >> 7, n = item & 127, row0 = b * SEQ + 64 * n, lane = F.lane, h = F.wave, c = lane & 15, q = lane >> 4;
    const size_t ci = (size_t)(b * 8 + h) * 128 + n;
    const bf16_t* QN = (const bf16_t*)((const unsigned char*)F.out + DO_QN);
    const bf16_t* SN = (const bf16_t*)(F.ws + WS_SN) + ci * 16384; const bf16_t* VNT = (const bf16_t*)(F.ws + WS_UT) + ci * 8192; const bf16_t* ATT = (const bf16_t*)(F.ws + WS_ATT) + ci * 4096;
    const float* GC = (const float*)(F.ws + WS_GC); const bf16_t* GZ = (const bf16_t*)(F.ws + WS_GZ); bf16_t* OG = (bf16_t*)(F.ws + WS_OG); const float* gn = F.in[I_GNORM];
    LAS bf16_t* ol = (LAS bf16_t*)(F.lds + h * 18432);
    bf16x8 qf[4][4], af[4][2]; float egc[4], ss[4];
#pragma unroll
    for (int it = 0; it < 4; ++it) { const int i = 16 * it + c; const size_t r = (size_t)row0 + i;
#pragma unroll
        for (int s = 0; s < 4; ++s) qf[it][s] = *(const bf16x8*)(QN + r * 1024 + h * 128 + 32 * s + 8 * q);
#pragma unroll
        for (int s = 0; s < 2; ++s) af[it][s] = *(const bf16x8*)(ATT + ((it * 2 + s) * 64 + lane) * 8);
        egc[it] = GC[r * 8 + h]; ss[it] = 0.f; }
#pragma unroll 1
    for (int dt = 0; dt < 8; ++dt) {
        bf16x8 sf[4], vf[2];
#pragma unroll
        for (int s = 0; s < 4; ++s) sf[s] = *(const bf16x8*)(SN + ((dt * 4 + s) * 64 + lane) * 8);
#pragma unroll
        for (int s = 0; s < 2; ++s) vf[s] = *(const bf16x8*)(VNT + ((dt * 2 + s) * 64 + lane) * 8);
#pragma unroll
        for (int it = 0; it < 4; ++it) {
            f32x4 a = {0.f, 0.f, 0.f, 0.f};
#pragma unroll
            for (int s = 0; s < 4; ++s) a = mfma16(sf[s], qf[it][s], a);
            a = a * egc[it];
#pragma unroll
            for (int s = 0; s < 2; ++s) a = mfma16(vf[s], af[it][s], a);
            ss[it] += (a[0] * a[0] + a[1] * a[1]) + (a[2] * a[2] + a[3] * a[3]);
            *(LAS u32x2*)(ol + (16 * it + c) * 136 + 16 * dt + 4 * q) = pack4(a);
        }
    }
    float rs[4];
#pragma unroll
    for (int it = 0; it < 4; ++it) { float s = ss[it]; s += __shfl_xor(s, 16); s += __shfl_xor(s, 32); rs[it] = rsqrtf(s * (1.f / 128.f) + EPS); }
    LDS_WAIT();
#pragma unroll
    for (int it = 0; it < 4; ++it)
#pragma unroll
        for (int dt = 0; dt < 8; ++dt) { const size_t o = ((size_t)row0 + 16 * it + c) * 1024 + h * 128 + 16 * dt + 4 * q; const u32x2 z = *(const u32x2*)(GZ + o); const f32x4 g4 = *(const f32x4*)(gn + 16 * dt + 4 * q);
            const u32x2 pv = *(const LAS u32x2*)(ol + (16 * it + c) * 136 + 16 * dt + 4 * q); f32x4 v;
            v[0] = bf2f(pv.x & 0xffffu) * rs[it] * g4[0] * bf2f(z.x & 0xffffu); v[1] = bf2f(pv.x >> 16) * rs[it] * g4[1] * bf2f(z.x >> 16);
            v[2] = bf2f(pv.y & 0xffffu) * rs[it] * g4[2] * bf2f(z.y & 0xffffu); v[3] = bf2f(pv.y >> 16) * rs[it] * g4[3] * bf2f(z.y >> 16);
            *(u32x2*)(OG + o) = pack4(v); }
    LDS_WAIT();
}

__device__ __forceinline__ void gdn_seq_item(Frame& F, int row0, int L, int h, const float* S0, float* Sout, bf16_t* OG) {
    const bf16_t* QN = (const bf16_t*)((unsigned char*)F.out + DO_QN); const bf16_t* KN = (const bf16_t*)((unsigned char*)F.out + DO_KN); const bf16_t* VNS = (const bf16_t*)((unsigned char*)F.out + DO_VNS);
    const float* Gp = (const float*)(F.ws + WS_G); const float* Bp = (const float*)(F.ws + WS_BETA);
    const int tid = F.tid, dvc = tid & 127, dkq = tid >> 7;
    constexpr int TB = 32;
    LAS float* sq = (LAS float*)F.lds;
    LAS float* sk = sq + TB * 128;
    LAS float* sv = sk + TB * 128;
    LAS float* sg = sv + TB * 128;
    LAS float* red = sg + 2 * TB;
    LAS float* redqk = red + 2 * 2 * 4 * 128;
    float S[32];
#pragma unroll
    for (int i = 0; i < 32; ++i) S[i] = S0 ? S0[(size_t)(32 * dkq + i) * 128 + dvc] : 0.f;
    int buf = 0;
    for (int t0 = 0; t0 < L; t0 += TB) {
        const int nb = (L - t0) < TB ? (L - t0) : TB;
        __syncthreads();
        for (int e = tid; e < nb * 128; e += NTHREADS) { const int tt = e >> 7, c = e & 127; const size_t o = (size_t)(row0 + t0 + tt) * 1024 + h * 128 + c;
            sq[e] = bf2f(QN[o]); sk[e] = bf2f(KN[o]); sv[e] = bf2f(VNS[o - (size_t)MP * 1024]); }
        if (tid < nb) { sg[tid] = expf(Gp[(size_t)(row0 + t0 + tid) * 8 + h]); sg[TB + tid] = Bp[(size_t)(row0 + t0 + tid) * 8 + h]; }
        __syncthreads();
        for (int tt = 0; tt < nb; ++tt) {
            const LAS float* kq = sk + tt * 128 + 32 * dkq; const LAS float* qq = sq + tt * 128 + 32 * dkq;
            float pk = 0.f, pq = 0.f, pqk = 0.f;
#pragma unroll
            for (int i = 0; i < 32; ++i) { const float kk = kq[i], qv = qq[i]; pk += kk * S[i]; pq += qv * S[i]; pqk += qv * kk; }
            LAS float* rb = red + buf * 1024;
            rb[dkq * 128 + dvc] = pk; rb[512 + dkq * 128 + dvc] = pq; if (dvc == 0) redqk[buf * 4 + dkq] = pqk;
            __syncthreads();
            const float kS = (rb[dvc] + rb[128 + dvc]) + (rb[256 + dvc] + rb[384 + dvc]);
            const float qS = (rb[512 + dvc] + rb[640 + dvc]) + (rb[768 + dvc] + rb[896 + dvc]);
            const float qk = (redqk[buf * 4] + redqk[buf * 4 + 1]) + (redqk[buf * 4 + 2] + redqk[buf * 4 + 3]);
            const float e = sg[tt], beta = sg[TB + tt];
            const float vnew = beta * (sv[tt * 128 + dvc] - e * kS);
            const float o = e * qS + qk * vnew;
#pragma unroll
            for (int i = 0; i < 32; ++i) S[i] = e * S[i] + kq[i] * vnew;
            if (dkq == 0) OG[(size_t)(row0 + t0 + tt) * 1024 + h * 128 + dvc] = (bf16_t)f2bf(o);
            buf ^= 1;
        }
    }
#pragma unroll
    for (int i = 0; i < 32; ++i) Sout[(size_t)(32 * dkq + i) * 128 + dvc] = S[i];
    __syncthreads();
}
__device__ __forceinline__ void p2_gdn_sample(Frame& F, int wk, int nwk, int lo, int hi) {
    bf16_t* OG = (bf16_t*)(F.ws + WS_OG);
    for (int q = lo + wk; q < hi; q += nwk) { const int bd = q >> 3, h = q & 7; gdn_seq_item(F, MP + bd * 4, 4, h, F.in[I_SGDN] + (size_t)q * 16384, F.out + O_GSS + (size_t)q * 16384, OG); }
}
__device__ __forceinline__ void p2_gdn_norm_sample(Frame& F) {
    const int gw = F.bid * NWAVES + F.wave, NGW = F.G * NWAVES, lane = F.lane;
    bf16_t* OG = (bf16_t*)(F.ws + WS_OG); const bf16_t* GZ = (const bf16_t*)(F.ws + WS_GZ); const float* gn = F.in[I_GNORM];
    for (int it = gw; it < MS * 8; it += NGW) {
        const size_t o = (size_t)(MP + (it >> 3)) * 1024 + (it & 7) * 128 + 2 * lane;
        const unsigned v = *(const unsigned*)(OG + o), z = *(const unsigned*)(GZ + o);
        const float a = bf2f(v & 0xffffu), b = bf2f(v >> 16);
        const float r = rsqrtf(wave_sum(a * a + b * b) * (1.f / 128.f) + EPS);
        *(unsigned*)(OG + o) = pk2(a * r * gn[2 * lane] * bf2f(z & 0xffffu), b * r * gn[2 * lane + 1] * bf2f(z >> 16));
    }
}

__device__ __forceinline__ void swa_wave_item(Frame& F, bool sample, int bidx, int t, int kv) {
    const int lane = F.lane;
    LAS float* qs = (LAS float*)(F.lds + F.wave * 8192);
    LAS float* ps = qs + 512;
    const bf16_t* SQ = (const bf16_t*)(F.ws + WS_SQ); const bf16_t* SKV = (const bf16_t*)(F.ws + WS_SKV); const bf16_t* SZ = (const bf16_t*)(F.ws + WS_SZ);
    const float* BT = (const float*)(F.ws + WS_BTAB);
    const int row = sample ? MP + bidx * 4 + t : bidx * SEQ + t;
    const int qpos = sample ? 128 + t : t;
    for (int e = lane; e < 512; e += 64) qs[e] = bf2f(SQ[(size_t)row * 1024 + kv * 512 + e]);
    LDS_WAIT();
#pragma unroll 1
    for (int u = 0; u < 2; ++u) {
        const int j = lane + 64 * u; const int kp = qpos - j;
        float kr[64];
        const bool valid = kp >= 0;
        if (valid) {
            if (sample && kp < 128) { const float* p = F.in[I_CSK] + (((size_t)bidx * 128 + kp) * 2 + kv) * 64;
#pragma unroll
                for (int d = 0; d < 64; d += 4) { const f32x4 v = *(const f32x4*)(p + d); kr[d] = v.x; kr[d + 1] = v.y; kr[d + 2] = v.z; kr[d + 3] = v.w; } }
            else { const int krow = sample ? MP + bidx * 4 + (kp - 128) : bidx * SEQ + kp; const bf16_t* p = SKV + (size_t)krow * 256 + kv * 64;
#pragma unroll
                for (int d = 0; d < 64; d += 8) { const u32x4 v = *(const u32x4*)(p + d);
                    kr[d] = bf2f(v.x & 0xffffu); kr[d + 1] = bf2f(v.x >> 16); kr[d + 2] = bf2f(v.y & 0xffffu); kr[d + 3] = bf2f(v.y >> 16);
                    kr[d + 4] = bf2f(v.z & 0xffffu); kr[d + 5] = bf2f(v.z >> 16); kr[d + 6] = bf2f(v.w & 0xffffu); kr[d + 7] = bf2f(v.w >> 16); } }
        } else {
#pragma unroll
            for (int d = 0; d < 64; ++d) kr[d] = 0.f;
        }
#pragma unroll 1
        for (int g = 0; g < 8; ++g) { float a = 0.f;
#pragma unroll
            for (int d = 0; d < 64; d += 4) { const f32x4 qv = *(const LAS f32x4*)(qs + g * 64 + d); a += kr[d] * qv.x + kr[d + 1] * qv.y + kr[d + 2] * qv.z + kr[d + 3] * qv.w; }
            ps[g * 128 + j] = valid ? a * 0.125f + BT[(kv * 8 + g) * 128 + j] : -INFINITY; }
    }
    LDS_WAIT();
    float inv[8];
#pragma unroll
    for (int g = 0; g < 8; ++g) {
        const float sink = F.in[I_SINKS][kv * 8 + g];
        const float l0 = ps[g * 128 + lane], l1 = ps[g * 128 + 64 + lane];
        const float mx = fmaxf(wave_max(fmaxf(l0, l1)), sink);
        const float p0 = __expf(l0 - mx), p1 = __expf(l1 - mx);
        const float den = wave_sum(p0 + p1) + __expf(sink - mx);
        inv[g] = 1.f / den;
        ps[g * 128 + lane] = p0; ps[g * 128 + 64 + lane] = p1;
    }
    LDS_WAIT();
    float o[8];
#pragma unroll
    for (int g = 0; g < 8; ++g) o[g] = 0.f;
#pragma unroll 1
    for (int j0 = 0; j0 < 128; j0 += 8) {
        float vv[8];
#pragma unroll
        for (int u = 0; u < 8; ++u) { int kp = qpos - (j0 + u); kp = kp < 0 ? 0 : kp;
            if (sample && kp < 128) vv[u] = F.in[I_CSV][(((size_t)bidx * 128 + kp) * 2 + kv) * 64 + lane];
            else { const int krow = sample ? MP + bidx * 4 + (kp - 128) : bidx * SEQ + kp; vv[u] = bf2f(SKV[(size_t)krow * 256 + 128 + kv * 64 + lane]); } }
#pragma unroll
        for (int u = 0; u < 8; ++u)
#pragma unroll
            for (int g = 0; g < 8; ++g) o[g] += ps[g * 128 + j0 + u] * vv[u];
    }
    bf16_t* OS = (bf16_t*)(F.ws + WS_OS);
#pragma unroll
    for (int g = 0; g < 8; ++g) { const size_t oo = (size_t)row * 1024 + (kv * 8 + g) * 64 + lane; OS[oo] = (bf16_t)f2bf(o[g] * inv[g] * bf2f(SZ[oo])); }
    LDS_WAIT();
}
__device__ __forceinline__ bf16x8 cat8(u32x2 a, u32x2 b) { u32x4 t; t.x = a.x; t.y = a.y; t.z = b.x; t.w = b.y; return __builtin_bit_cast(bf16x8, t); }
__device__ __forceinline__ void mem_mfma_item(Frame& F, int b, int h, int qt) {
    const int lane = F.lane, c = lane & 15, q = lane >> 4;
    const bf16_t* Kp = (const bf16_t*)(F.ws + WS_MEMKV) + (size_t)(b * 256) * 2048 + h * 256;
    const bf16_t* VTp = (const bf16_t*)(F.ws + WS_MVT) + (size_t)((b * 4 + h) * 256) * 256;
    const bf16_t* MQ = (const bf16_t*)(F.ws + WS_MQ); const bf16_t* MZ = (const bf16_t*)(F.ws + WS_MZ); bf16_t* OM = (bf16_t*)(F.ws + WS_OM);
    const size_t qrow = (size_t)b * SEQ + 16 * qt + c;
    bf16x8 qf[8];
#pragma unroll
    for (int s = 0; s < 8; ++s) qf[s] = *(const bf16x8*)(MQ + qrow * 1024 + h * 256 + 32 * s + 8 * q);
    f32x4 sacc[16];
#pragma unroll
    for (int mt = 0; mt < 16; ++mt) { f32x4 a = {0.f, 0.f, 0.f, 0.f};
#pragma unroll
        for (int s = 0; s < 8; ++s) a = mfma16(*(const bf16x8*)(Kp + (size_t)(16 * mt + c) * 2048 + 32 * s + 8 * q), qf[s], a);
        sacc[mt] = a; }
    float mx = -INFINITY;
#pragma unroll
    for (int mt = 0; mt < 16; ++mt) mx = fmaxf(mx, fmaxf(fmaxf(sacc[mt][0], sacc[mt][1]), fmaxf(sacc[mt][2], sacc[mt][3])));
    mx = fmaxf(mx, __shfl_xor(mx, 16)); mx = fmaxf(mx, __shfl_xor(mx, 32));
    float sum = 0.f; const float sc = 0.0625f * 1.4426950408889634f;
#pragma unroll
    for (int mt = 0; mt < 16; ++mt)
#pragma unroll
        for (int r = 0; r < 4; ++r) { const float p = exp2f((sacc[mt][r] - mx) * sc); sacc[mt][r] = p; sum += p; }
    sum += __shfl_xor(sum, 16); sum += __shfl_xor(sum, 32);
    const float inv = 1.f / sum;
    bf16x8 pf[8];
#pragma unroll
    for (int ks = 0; ks < 8; ++ks) pf[ks] = cat8(pack4(sacc[2 * ks]), pack4(sacc[2 * ks + 1]));
#pragma unroll 4
    for (int dt = 0; dt < 16; ++dt) { f32x4 o = {0.f, 0.f, 0.f, 0.f};
#pragma unroll
        for (int ks = 0; ks < 8; ++ks) { const bf16_t* vp = VTp + (size_t)(16 * dt + c) * 256 + 32 * ks + 4 * q;
            o = mfma16(cat8(*(const u32x2*)vp, *(const u32x2*)(vp + 16)), pf[ks], o); }
        const size_t oo = qrow * 1024 + h * 256 + 16 * dt + 4 * q; const u32x2 z = *(const u32x2*)(MZ + oo);
        o[0] *= inv * bf2f(z.x & 0xffffu); o[1] *= inv * bf2f(z.x >> 16); o[2] *= inv * bf2f(z.y & 0xffffu); o[3] *= inv * bf2f(z.y >> 16);
        *(u32x2*)(OM + oo) = pack4(o); }
}
__device__ __forceinline__ void swa_mfma_item(Frame& F, int b, int h, int a) {
    const int lane = F.lane, c = lane & 15, q = lane >> 4, kv = h >> 3;
    const bf16_t* SQ = (const bf16_t*)(F.ws + WS_SQ); const bf16_t* SKV = (const bf16_t*)(F.ws + WS_SKV); const bf16_t* SZ = (const bf16_t*)(F.ws + WS_SZ); bf16_t* OS = (bf16_t*)(F.ws + WS_OS);
    const bf16_t* VTp = (const bf16_t*)(F.ws + WS_VTS) + (size_t)((b * 2 + kv) * 64) * SEQ;
    const LAS float* BTl = (const LAS float*)(F.lds + LDS_BT) + h * 128;
    const size_t qrow = (size_t)b * SEQ + 16 * a + c;
    bf16x8 qf[2];
#pragma unroll
    for (int s = 0; s < 2; ++s) qf[s] = *(const bf16x8*)(SQ + qrow * 1024 + h * 64 + 32 * s + 8 * q);
    f32x4 p[10];
    const float sink = F.in[I_SINKS][h];
    float mx = sink;
#pragma unroll
    for (int u = 0; u < 9; ++u) {
        const int kbase = 16 * (a - 8 + u);
        f32x4 d = {0.f, 0.f, 0.f, 0.f};
        if (kbase >= 0) {
#pragma unroll
            for (int s = 0; s < 2; ++s) d = mfma16(*(const bf16x8*)(SKV + ((size_t)b * SEQ + kbase + c) * 256 + kv * 64 + 32 * s + 8 * q), qf[s], d);
        }
#pragma unroll
        for (int r = 0; r < 4; ++r) { const int dist = (16 * a + c) - (kbase + 4 * q + r); const bool valid = kbase >= 0 && dist >= 0 && dist < 128;
            const float l = valid ? d[r] * 0.125f + BTl[dist & 127] : -INFINITY; d[r] = l; mx = fmaxf(mx, l); }
        p[u] = d;
    }
    mx = fmaxf(mx, __shfl_xor(mx, 16)); mx = fmaxf(mx, __shfl_xor(mx, 32));
    float sum = 0.f;
#pragma unroll
    for (int u = 0; u < 9; ++u)
#pragma unroll
        for (int r = 0; r < 4; ++r) { const float e = __expf(p[u][r] - mx); p[u][r] = e; sum += e; }
    p[9] = (f32x4){0.f, 0.f, 0.f, 0.f};
    sum += __shfl_xor(sum, 16); sum += __shfl_xor(sum, 32);
    const float inv = 1.f / (sum + __expf(sink - mx));
    bf16x8 pf[5];
#pragma unroll
    for (int ks = 0; ks < 5; ++ks) pf[ks] = cat8(pack4(p[2 * ks]), pack4(p[2 * ks + 1]));
#pragma unroll
    for (int dt = 0; dt < 4; ++dt) { f32x4 o = {0.f, 0.f, 0.f, 0.f};
#pragma unroll
        for (int ks = 0; ks < 5; ++ks) { int m0 = 16 * (a - 8 + 2 * ks) + 4 * q, m1 = m0 + 16;
            m0 = m0 < 0 ? 0 : m0; m1 = m1 < 0 ? 0 : (m1 > SEQ - 4 ? SEQ - 4 : m1);
            const bf16_t* vp = VTp + (size_t)(16 * dt + c) * SEQ;
            o = mfma16(cat8(*(const u32x2*)(vp + m0), *(const u32x2*)(vp + m1)), pf[ks], o); }
        const size_t oo = qrow * 1024 + h * 64 + 16 * dt + 4 * q; const u32x2 z = *(const u32x2*)(SZ + oo);
        o[0] *= inv * bf2f(z.x & 0xffffu); o[1] *= inv * bf2f(z.x >> 16); o[2] *= inv * bf2f(z.y & 0xffffu); o[3] *= inv * bf2f(z.y >> 16);
        *(u32x2*)(OS + oo) = pack4(o); }
}
__device__ __forceinline__ void swa_wg_item(Frame& F, int b, int kv, int qb) {
    int lane_ = F.lane, tid_ = F.tid; asm volatile("" : "+v"(lane_), "+v"(tid_));
    const int lane = lane_, c = lane & 15, q = lane >> 4, tid = tid_, h = kv * 8 + F.wave;
    const bf16_t* SQ = (const bf16_t*)(F.ws + WS_SQ); const bf16_t* SKV = (const bf16_t*)(F.ws + WS_SKV); const bf16_t* SZ = (const bf16_t*)(F.ws + WS_SZ); bf16_t* OS = (bf16_t*)(F.ws + WS_OS);
    const bf16_t* VTg = (const bf16_t*)(F.ws + WS_VTS) + (size_t)((b * 2 + kv) * 64) * SEQ;
    LAS unsigned char* Kl = F.lds; LAS unsigned char* Vl = F.lds + 32768;
    const LAS float* BTl = (const LAS float*)(F.lds + LDS_BT) + h * 128;
    const int kstart = 128 * (qb - 1);
    __syncthreads();
    {   u32x4 kr[4], vr[4];
#pragma unroll
        for (int u = 0; u < 4; ++u) { const int p = tid + 512 * u, key = p >> 3, ch = p & 7;
            kr[u] = (kstart + key >= 0) ? *(const u32x4*)(SKV + ((size_t)b * SEQ + kstart + key) * 256 + kv * 64 + ch * 8) : (u32x4){0u, 0u, 0u, 0u};
            const int d = p >> 5, c16 = p & 31;
            vr[u] = (kstart + c16 * 8 >= 0) ? *(const u32x4*)(VTg + (size_t)d * SEQ + kstart + c16 * 8) : (u32x4){0u, 0u, 0u, 0u}; }
#pragma unroll
        for (int u = 0; u < 4; ++u) { const int p = tid + 512 * u, key = p >> 3, ch = p & 7;
            *(LAS u32x4*)(Kl + key * 128 + ((ch ^ ((key >> 1) & 7)) << 4)) = kr[u];
            const int d = p >> 5, c16 = p & 31;
            *(LAS u32x4*)(Vl + d * 512 + (((2 * c16) ^ (2 * (d & 15))) << 3)) = vr[u]; } }
    __syncthreads();
    const float L2E = 1.4426950408889634f;
    const float sink = F.in[I_SINKS][h] * L2E;
    float bias[9][4];
#pragma unroll
    for (int u = 0; u < 9; ++u)
#pragma unroll
        for (int r = 0; r < 4; ++r) { const int dist = 128 - 16 * u + c - 4 * q - r; bias[u][r] = (dist >= 0 && dist < 128) ? BTl[dist & 127] * L2E : -INFINITY; }
    bf16x8 qfa[8][2];
#pragma unroll
    for (int ap = 0; ap < 8; ++ap)
#pragma unroll
        for (int s = 0; s < 2; ++s) qfa[ap][s] = *(const bf16x8*)(SQ + ((size_t)b * SEQ + 128 * qb + 16 * ap + c) * 1024 + h * 64 + 32 * s + 8 * q);
#pragma unroll
    for (int ap = 0; ap < 8; ++ap) {
        const size_t qrow = (size_t)b * SEQ + 128 * qb + 16 * ap + c;
        bf16x8 qf[2]; qf[0] = qfa[ap][0]; qf[1] = qfa[ap][1];
        u32x2 zz[4];
#pragma unroll
        for (int dt = 0; dt < 4; ++dt) zz[dt] = *(const u32x2*)(SZ + qrow * 1024 + h * 64 + 16 * dt + 4 * q);
        f32x4 p[10]; float mx = sink;
#pragma unroll
        for (int u = 0; u < 9; ++u) {
            const int wt = ap + u, row = 16 * wt + c;
            f32x4 d = {0.f, 0.f, 0.f, 0.f};
#pragma unroll
            for (int s = 0; s < 2; ++s) d = mfma16(*(const LAS bf16x8*)(Kl + row * 128 + (((4 * s + q) ^ ((row >> 1) & 7)) << 4)), qf[s], d);
            const float tmask = ((qb > 0) || (wt >= 8)) ? 0.f : -INFINITY;
#pragma unroll
            for (int r = 0; r < 4; ++r) { const float l = d[r] * (0.125f * L2E) + (bias[u][r] + tmask); d[r] = l; mx = fmaxf(mx, l); }
            p[u] = d;
        }
        mx = fmaxf(mx, __shfl_xor(mx, 16)); mx = fmaxf(mx, __shfl_xor(mx, 32));
        float sum = 0.f;
#pragma unroll
        for (int u = 0; u < 9; ++u)
#pragma unroll
            for (int r = 0; r < 4; ++r) { const float e = exp2f(p[u][r] - mx); p[u][r] = e; sum += e; }
        p[9] = (f32x4){0.f, 0.f, 0.f, 0.f};
        sum += __shfl_xor(sum, 16); sum += __shfl_xor(sum, 32);
        const float inv = 1.f / (sum + exp2f(sink - mx));
        bf16x8 pf[5];
#pragma unroll
        for (int ks = 0; ks < 5; ++ks) pf[ks] = cat8(pack4(p[2 * ks]), pack4(p[2 * ks + 1]));
#pragma unroll
        for (int dt = 0; dt < 4; ++dt) { f32x4 o = {0.f, 0.f, 0.f, 0.f}; const int dd = 16 * dt + c; const LAS unsigned char* vrow = Vl + dd * 512; const int sw = 2 * (dd & 15);
#pragma unroll
            for (int ks = 0; ks < 5; ++ks) { const int wt0 = ap + 2 * ks; int wt1 = wt0 + 1; wt1 = wt1 > 15 ? 15 : wt1;
                const u32x2 v0 = *(const LAS u32x2*)(vrow + (((4 * wt0 + q) ^ sw) << 3)), v1 = *(const LAS u32x2*)(vrow + (((4 * wt1 + q) ^ sw) << 3));
                o = mfma16(cat8(v0, v1), pf[ks], o); }
            const size_t oo = qrow * 1024 + h * 64 + 16 * dt + 4 * q; const u32x2 z = zz[dt];
            o[0] *= inv * bf2f(z.x & 0xffffu); o[1] *= inv * bf2f(z.x >> 16); o[2] *= inv * bf2f(z.y & 0xffffu); o[3] *= inv * bf2f(z.y >> 16);
            *(u32x2*)(OS + oo) = pack4(o); }
        asm volatile("" ::: "memory");
    }
}
__device__ __forceinline__ void mem_wg_item(Frame& F, int b, int h, int qblk) {
    int lane_ = F.lane, tid_ = F.tid; asm volatile("" : "+v"(lane_), "+v"(tid_));
    const int lane = lane_, c = lane & 15, q = lane >> 4, tid = tid_, w = F.wave;
    const bf16_t* Kg = (const bf16_t*)(F.ws + WS_MEMKV) + (size_t)(b * 256) * 2048 + h * 256;
    const bf16_t* VTg = (const bf16_t*)(F.ws + WS_MVT) + (size_t)((b * 4 + h) * 256) * 256;
    const bf16_t* MQ = (const bf16_t*)(F.ws + WS_MQ); const bf16_t* MZ = (const bf16_t*)(F.ws + WS_MZ); bf16_t* OM = (bf16_t*)(F.ws + WS_OM);
    LAS unsigned char* L = F.lds;
    __syncthreads();
#pragma unroll
    for (int hf = 0; hf < 2; ++hf) { u32x4 kr[8];
#pragma unroll
        for (int u = 0; u < 8; ++u) { const int p = tid + 512 * (u + 8 * hf), key = p >> 5, ch = p & 31; kr[u] = *(const u32x4*)(Kg + (size_t)key * 2048 + ch * 8); }
#pragma unroll
        for (int u = 0; u < 8; ++u) { const int p = tid + 512 * (u + 8 * hf), key = p >> 5, ch = p & 31; *(LAS u32x4*)(L + key * 512 + ((ch ^ (key & 15)) << 4)) = kr[u]; } }
    __syncthreads();
    size_t qrow[2];
#pragma unroll
    for (int t = 0; t < 2; ++t) qrow[t] = (size_t)b * SEQ + 256 * qblk + 32 * w + 16 * t + c;
    f32x4 sacc[2][16];
#pragma unroll
    for (int mt = 0; mt < 16; ++mt) { sacc[0][mt] = (f32x4){0.f, 0.f, 0.f, 0.f}; sacc[1][mt] = (f32x4){0.f, 0.f, 0.f, 0.f}; }
    bf16x8 qn0 = *(const bf16x8*)(MQ + qrow[0] * 1024 + h * 256 + 8 * q), qn1 = *(const bf16x8*)(MQ + qrow[1] * 1024 + h * 256 + 8 * q);
#pragma unroll 1
    for (int s = 0; s < 8; ++s) {
        const bf16x8 q0 = qn0, q1 = qn1; const int sn = s < 7 ? s + 1 : 7;
        qn0 = *(const bf16x8*)(MQ + qrow[0] * 1024 + h * 256 + 32 * sn + 8 * q); qn1 = *(const bf16x8*)(MQ + qrow[1] * 1024 + h * 256 + 32 * sn + 8 * q);
#pragma unroll
        for (int mt = 0; mt < 16; ++mt) { const int row = 16 * mt + c;
            const bf16x8 kf = *(const LAS bf16x8*)(L + row * 512 + (((4 * s + q) ^ (row & 15)) << 4));
            sacc[0][mt] = mfma16(kf, q0, sacc[0][mt]); sacc[1][mt] = mfma16(kf, q1, sacc[1][mt]); }
        asm volatile("" ::: "memory");
    }
    float inv[2]; bf16x8 pf[2][8];
    const float sc = 0.0625f * 1.4426950408889634f;
#pragma unroll
    for (int t = 0; t < 2; ++t) { float mx = -INFINITY;
#pragma unroll
        for (int mt = 0; mt < 16; ++mt) mx = fmaxf(mx, fmaxf(fmaxf(sacc[t][mt][0], sacc[t][mt][1]), fmaxf(sacc[t][mt][2], sacc[t][mt][3])));
        mx = fmaxf(mx, __shfl_xor(mx, 16)); mx = fmaxf(mx, __shfl_xor(mx, 32));
        float sum = 0.f;
#pragma unroll
        for (int mt = 0; mt < 16; ++mt)
#pragma unroll
            for (int r = 0; r < 4; ++r) { const float e = exp2f((sacc[t][mt][r] - mx) * sc); sacc[t][mt][r] = e; sum += e; }
        sum += __shfl_xor(sum, 16); sum += __shfl_xor(sum, 32); inv[t] = 1.f / sum;
#pragma unroll
        for (int ks = 0; ks < 8; ++ks) pf[t][ks] = cat8(pack4(sacc[t][2 * ks]), pack4(sacc[t][2 * ks + 1])); }
    __syncthreads();
#pragma unroll
    for (int hf = 0; hf < 2; ++hf) { u32x4 vr[8];
#pragma unroll
        for (int u = 0; u < 8; ++u) { const int p = tid + 512 * (u + 8 * hf), d = p >> 5, c16 = p & 31; vr[u] = *(const u32x4*)(VTg + (size_t)d * 256 + c16 * 8); }
#pragma unroll
        for (int u = 0; u < 8; ++u) { const int p = tid + 512 * (u + 8 * hf), d = p >> 5, c16 = p & 31; *(LAS u32x4*)(L + d * 512 + (((2 * c16) ^ (2 * (d & 15))) << 3)) = vr[u]; } }
    __syncthreads();
    u32x2 zn0 = *(const u32x2*)(MZ + qrow[0] * 1024 + h * 256 + 4 * q), zn1 = *(const u32x2*)(MZ + qrow[1] * 1024 + h * 256 + 4 * q);
#pragma unroll 1
    for (int dt = 0; dt < 16; ++dt) { f32x4 o0 = {0.f, 0.f, 0.f, 0.f}, o1 = {0.f, 0.f, 0.f, 0.f}; const int dd = 16 * dt + c;
        const u32x2 zc0 = zn0, zc1 = zn1; const int dn = dt < 15 ? dt + 1 : 15;
        zn0 = *(const u32x2*)(MZ + qrow[0] * 1024 + h * 256 + 16 * dn + 4 * q); zn1 = *(const u32x2*)(MZ + qrow[1] * 1024 + h * 256 + 16 * dn + 4 * q); const LAS unsigned char* vrow = L + dd * 512; const int sw = 2 * (dd & 15);
#pragma unroll
        for (int ks = 0; ks < 8; ++ks) { const bf16x8 vf = cat8(*(const LAS u32x2*)(vrow + (((8 * ks + q) ^ sw) << 3)), *(const LAS u32x2*)(vrow + (((8 * ks + 4 + q) ^ sw) << 3)));
            o0 = mfma16(vf, pf[0][ks], o0); o1 = mfma16(vf, pf[1][ks], o1); }
#pragma unroll
        for (int t = 0; t < 2; ++t) { f32x4 o = t ? o1 : o0; const size_t oo = qrow[t] * 1024 + h * 256 + 16 * dt + 4 * q; const u32x2 z = t ? zc1 : zc0;
            o[0] *= inv[t] * bf2f(z.x & 0xffffu); o[1] *= inv[t] * bf2f(z.x >> 16); o[2] *= inv[t] * bf2f(z.y & 0xffffu); o[3] *= inv[t] * bf2f(z.y >> 16);
            *(u32x2*)(OM + oo) = pack4(o); }
        asm volatile("" ::: "memory"); }
}
__device__ __forceinline__ void p2_attn_prompt(Frame& F, int wk, int nwk) {
    const int gw = wk * NWAVES + F.wave, NGW = nwk * NWAVES, lane = F.lane;
    { LAS float* BTl = (LAS float*)(F.lds + LDS_BT); const float* BT = (const float*)(F.ws + WS_BTAB); for (int i = F.tid; i < 2048; i += NTHREADS) BTl[i] = BT[i]; }
    __syncthreads();
    for (int it = wk; it < 256; it += nwk) { const int qblk = it & 31, bh = it >> 5; mem_wg_item(F, bh >> 2, bh & 3, qblk); }
    for (int it = wk; it < 256; it += nwk) { const int qb = it & 63, bk = it >> 6; swa_wg_item(F, bk >> 1, bk & 1, qb); }
    __syncthreads();
    const bf16_t* SKV = (const bf16_t*)(F.ws + WS_SKV);
    for (int it = gw; it < 256; it += NGW) { const int b = it >> 7, j = it & 127; const bf16_t* pp = SKV + (size_t)(b * SEQ + SEQ - 128 + j) * 256;
        for (int cc = lane; cc < 128; cc += 64) { F.out[O_SKP + ((size_t)b * 128 + j) * 128 + cc] = bf2f(pp[cc]); F.out[O_SVP + ((size_t)b * 128 + j) * 128 + cc] = bf2f(pp[128 + cc]); } }
}
__device__ __forceinline__ void p2_swa_sample(Frame& F, int wk, int nwk) {
    const int gw = wk * NWAVES + F.wave, NGW = nwk * NWAVES, lane = F.lane;
    const bf16_t* SKV = (const bf16_t*)(F.ws + WS_SKV);
    for (int it = gw; it < MS * 2; it += NGW) { const int r = it >> 1, kv = it & 1; swa_wave_item(F, true, r >> 2, r & 3, kv); }
    { const u32x4* s4 = (const u32x4*)(F.ws + WS_OMS); u32x4* d4 = (u32x4*)(F.ws + WS_OM + (size_t)MP * 1024 * 2); for (int i = gw * 64 + lane; i < MS * 1024 / 8; i += NGW * 64) d4[i] = s4[i]; }
    { const int gt = gw * 64 + lane, NT = NGW * 64;
        for (int i = gt; i < 128 * 124 * 32; i += NT) { const int bd = i / (124 * 32), e = i - bd * (124 * 32);
            ((f32x4*)(F.out + O_SKS + (size_t)bd * 16384))[e] = ((const f32x4*)(F.in[I_CSK] + (size_t)bd * 16384 + 512))[e];
            ((f32x4*)(F.out + O_SVS + (size_t)bd * 16384))[e] = ((const f32x4*)(F.in[I_CSV] + (size_t)bd * 16384 + 512))[e]; }
        for (int i = gt; i < 128 * 4 * 128; i += NT) { const int bd = i >> 9, jj = (i >> 7) & 3, cc = i & 127; const bf16_t* pp = SKV + (size_t)(MP + bd * 4 + jj) * 256;
            F.out[O_SKS + ((size_t)bd * 128 + 124 + jj) * 128 + cc] = bf2f(pp[cc]); F.out[O_SVS + ((size_t)bd * 128 + 124 + jj) * 128 + cc] = bf2f(pp[128 + cc]); } }
}
__device__ __forceinline__ void mem_sample_item(Frame& F, int bd, int hp) {
    const int lane = F.lane, w = F.wave, tid = F.tid, hl = lane >> 5, h = 2 * hp + hl, d0 = (lane & 31) * 8;
    const bf16_t* MQ = (const bf16_t*)(F.ws + WS_MQ); const bf16_t* MZ = (const bf16_t*)(F.ws + WS_MZ); bf16_t* OM = (bf16_t*)(F.ws + WS_OM);
    LAS float* lg = (LAS float*)F.lds;
    LAS float* isum = lg + 2048;
    LAS float* po = isum + 8;
    float qr[4][8];
#pragma unroll
    for (int s = 0; s < 4; ++s) { const u32x4 v = *(const u32x4*)(MQ + (size_t)(MP + bd * 4 + s) * 1024 + h * 256 + d0);
        qr[s][0] = bf2f(v.x & 0xffffu); qr[s][1] = bf2f(v.x >> 16); qr[s][2] = bf2f(v.y & 0xffffu); qr[s][3] = bf2f(v.y >> 16);
        qr[s][4] = bf2f(v.z & 0xffffu); qr[s][5] = bf2f(v.z >> 16); qr[s][6] = bf2f(v.w & 0xffffu); qr[s][7] = bf2f(v.w >> 16); }
    const float* Kc = F.in[I_CMK] + ((size_t)bd * 256 * 4 + h) * 256 + d0; const float* Vc = F.in[I_CMV] + ((size_t)bd * 256 * 4 + h) * 256 + d0;
#pragma unroll 4
    for (int i = 0; i < 32; ++i) { const int m = w + 8 * i; const f32x4 k0 = *(const f32x4*)(Kc + (size_t)m * 1024), k1 = *(const f32x4*)(Kc + (size_t)m * 1024 + 4);
        float l[4];
#pragma unroll
        for (int s = 0; s < 4; ++s) { float a = k0.x * qr[s][0] + k0.y * qr[s][1] + k0.z * qr[s][2] + k0.w * qr[s][3] + k1.x * qr[s][4] + k1.y * qr[s][5] + k1.z * qr[s][6] + k1.w * qr[s][7];
#pragma unroll
            for (int o = 1; o < 32; o <<= 1) a += __shfl_xor(a, o);
            l[s] = a * 0.0625f; }
        if ((lane & 31) == 0) {
#pragma unroll
            for (int s = 0; s < 4; ++s) lg[(hl * 4 + s) * 256 + m] = l[s]; } }
    __syncthreads();
    { const int pr = w; float l4[4];
#pragma unroll
        for (int u = 0; u < 4; ++u) l4[u] = lg[pr * 256 + lane + 64 * u];
        const float mx = wave_max(fmaxf(fmaxf(l4[0], l4[1]), fmaxf(l4[2], l4[3]))); float s = 0.f;
#pragma unroll
        for (int u = 0; u < 4; ++u) { l4[u] = __expf(l4[u] - mx); s += l4[u]; lg[pr * 256 + lane + 64 * u] = l4[u]; }
        s = wave_sum(s); if (lane == 0) isum[pr] = 1.f / s; }
    __syncthreads();
    float o[4][8];
#pragma unroll
    for (int s = 0; s < 4; ++s)
#pragma unroll
        for (int j = 0; j < 8; ++j) o[s][j] = 0.f;
#pragma unroll 4
    for (int i = 0; i < 32; ++i) { const int m = w + 8 * i; const f32x4 v0 = *(const f32x4*)(Vc + (size_t)m * 1024), v1 = *(const f32x4*)(Vc + (size_t)m * 1024 + 4);
#pragma unroll
        for (int s = 0; s < 4; ++s) { const float p = lg[(hl * 4 + s) * 256 + m];
            o[s][0] += p * v0.x; o[s][1] += p * v0.y; o[s][2] += p * v0.z; o[s][3] += p * v0.w; o[s][4] += p * v1.x; o[s][5] += p * v1.y; o[s][6] += p * v1.z; o[s][7] += p * v1.w; } }
#pragma unroll
    for (int s = 0; s < 4; ++s) { LAS float* pp = po + ((w * 4 + s) * 512 + hl * 256 + d0);
        *(LAS f32x4*)pp = (f32x4){o[s][0], o[s][1], o[s][2], o[s][3]}; *(LAS f32x4*)(pp + 4) = (f32x4){o[s][4], o[s][5], o[s][6], o[s][7]}; }
    __syncthreads();
#pragma unroll
    for (int u = 0; u < 4; ++u) { const int e = tid + 512 * u, s = e >> 9, cc = e & 511; float a = 0.f;
#pragma unroll
        for (int ww = 0; ww < 8; ++ww) a += po[(ww * 4 + s) * 512 + cc];
        const int hh = 2 * hp + (cc >> 8); const size_t oo = (size_t)(MP + bd * 4 + s) * 1024 + hh * 256 + (cc & 255);
        ((bf16_t*)(F.ws + WS_OMS))[oo - (size_t)MP * 1024] = (bf16_t)f2bf(a * isum[(cc >> 8) * 4 + s] * bf2f(MZ[oo])); }
    __syncthreads();
}

struct SchedP3 {
    int G, c; const unsigned char* ws;
    __device__ __forceinline__ int ntiles(const pg8::Unit&) const { return 1024 / 64; }
    __device__ __forceinline__ bool next(int i, pg8::Unit& u) const {
        if (i < 6) { const int round = i / 3, b = i - round * 3; pg8::tile_of(round * G + c, 64, 8, u.pm, u.pn); u.job = b; return true; }
        if (i == 6 && c < 48) { u.pm = 64 + c / 24; const int rem = c % 24; u.pn = rem / 3; u.job = rem % 3; return true; }
        return false;
    }
    __device__ __forceinline__ void ptrs(const pg8::Unit& u, const char*& A, const char*& B) const {
        A = (const char*)ws + WS_OG + (size_t)u.job * M * 1024 * 2 + (size_t)u.pm * 256 * 1024 * 2;
        B = (const char*)ws + WS_WB + (size_t)u.job * 2048 * 1024 * 2 + (size_t)u.pn * 256 * 1024 * 2;
    }
};
struct EpiP3 {
    unsigned char* ws;
    __device__ __forceinline__ void operator()(const f32x4 (&acc)[2][2][4][2], const pg8::Unit& u, int wr, int wc, int fr, int fq) const {
        const int row0 = u.pm * 256 + wr * 64 + fr, col0 = u.pn * 256 + wc * 32 + 8 * fq, b = u.job;
        const bf16_t* GT = (const bf16_t*)(ws + WS_GATES); bf16_t* MG = (bf16_t*)(ws + WS_MERGED);
        const bool rmw = (b > 0) && (u.pm < 64);
#pragma unroll
        for (int ai = 0; ai < 2; ++ai) {
            u32x4 g[4][2], p[4][2];
#pragma unroll
            for (int m = 0; m < 4; ++m)
#pragma unroll
                for (int bj = 0; bj < 2; ++bj) { const int r = row0 + ai * 128 + m * 16, c = col0 + bj * 128;
                    g[m][bj] = *(const u32x4*)(GT + (size_t)r * 6144 + b * 2048 + c);
                    p[m][bj] = rmw ? *(const u32x4*)(MG + (size_t)r * 2048 + c) : (u32x4){0u, 0u, 0u, 0u}; }
#pragma unroll
            for (int m = 0; m < 4; ++m)
#pragma unroll
                for (int bj = 0; bj < 2; ++bj) { const int r = row0 + ai * 128 + m * 16, c = col0 + bj * 128;
                    const u32x4 gg = g[m][bj], pp = p[m][bj];
                    f32x4 v0 = acc[ai][bj][m][0], v1 = acc[ai][bj][m][1];
                    v0[0] = v0[0] * bf2f(gg.x & 0xffffu) + bf2f(pp.x & 0xffffu); v0[1] = v0[1] * bf2f(gg.x >> 16) + bf2f(pp.x >> 16); v0[2] = v0[2] * bf2f(gg.y & 0xffffu) + bf2f(pp.y & 0xffffu); v0[3] = v0[3] * bf2f(gg.y >> 16) + bf2f(pp.y >> 16);
                    v1[0] = v1[0] * bf2f(gg.z & 0xffffu) + bf2f(pp.z & 0xffffu); v1[1] = v1[1] * bf2f(gg.z >> 16) + bf2f(pp.z >> 16); v1[2] = v1[2] * bf2f(gg.w & 0xffffu) + bf2f(pp.w & 0xffffu); v1[3] = v1[3] * bf2f(gg.w >> 16) + bf2f(pp.w >> 16);
                    u32x4 w; w.x = pg8::cvt_pk_bf16(v0[0], v0[1]); w.y = pg8::cvt_pk_bf16(v0[2], v0[3]); w.z = pg8::cvt_pk_bf16(v1[0], v1[1]); w.w = pg8::cvt_pk_bf16(v1[2], v1[3]);
                    u32x4* mp = u.pm < 64 ? (u32x4*)(MG + (size_t)r * 2048 + c) : (u32x4*)((bf16_t*)(ws + WS_PS) + ((size_t)b * MS + (r - MP)) * 2048 + c);
                    *mp = w; }
        }
    }
};

struct SchedP4 {
    int G, c; const unsigned char* ws;
    __device__ __forceinline__ int ntiles(const pg8::Unit& u) const { return u.job == 0 ? D / 64 : 512 / 64; }
    __device__ __forceinline__ bool next(int i, pg8::Unit& u) const {
        if (i < 2) { pg8::tile_of(i * G + c, 64, 8, u.pm, u.pn); u.job = 0; return true; }
        if (i == 2 && c < 64) { u.pm = 64 + c / 32; const int rem = c % 32; u.pn = rem / 4; u.job = 1 + (rem & 3); return true; }
        return false;
    }
    __device__ __forceinline__ void ptrs(const pg8::Unit& u, const char*& A, const char*& B) const {
        const size_t ko = u.job == 0 ? 0 : (size_t)(u.job - 1) * 512 * 2;
        A = (const char*)ws + WS_MERGED + (size_t)u.pm * 256 * 2048 * 2 + ko; B = (const char*)ws + WS_WO + (size_t)u.pn * 256 * 2048 * 2 + ko;
    }
};
struct EpiP4 {
    unsigned char* ws; float* out; const float* xp; const float* xs;
    __device__ __forceinline__ void operator()(const f32x4 (&acc)[2][2][4][2], const pg8::Unit& u, int wr, int wc, int fr, int fq) const {
        const int row0 = u.pm * 256 + wr * 64 + fr, col0 = u.pn * 256 + wc * 32 + 8 * fq;
        if (u.job != 0) {
#pragma unroll
            for (int ai = 0; ai < 2; ++ai)
#pragma unroll
                for (int m = 0; m < 4; ++m) { const int r = row0 + ai * 128 + m * 16; float* yp = (float*)(ws + WS_YP) + ((size_t)(u.job - 1) * MS + (r - MP)) * D;
#pragma unroll
                    for (int bj = 0; bj < 2; ++bj) { const int c = col0 + bj * 128; *(f32x4*)(yp + c) = acc[ai][bj][m][0]; *(f32x4*)(yp + c + 4) = acc[ai][bj][m][1]; } }
            return;
        }
#pragma unroll
        for (int ai = 0; ai < 2; ++ai)
#pragma unroll
            for (int mh = 0; mh < 2; ++mh) {
                f32x4 xv[2][2][2];
#pragma unroll
                for (int mm = 0; mm < 2; ++mm)
#pragma unroll
                    for (int bj = 0; bj < 2; ++bj) { const float* xr = xp + (size_t)(row0 + ai * 128 + (2 * mh + mm) * 16) * D + col0 + bj * 128; xv[mm][bj][0] = *(const f32x4*)xr; xv[mm][bj][1] = *(const f32x4*)(xr + 4); }
#pragma unroll
                for (int mm = 0; mm < 2; ++mm)
#pragma unroll
                    for (int bj = 0; bj < 2; ++bj) { float* yr = out + (size_t)(row0 + ai * 128 + (2 * mh + mm) * 16) * D + col0 + bj * 128;
                        *(f32x4*)yr = acc[ai][bj][2 * mh + mm][0] + xv[mm][bj][0]; *(f32x4*)(yr + 4) = acc[ai][bj][2 * mh + mm][1] + xv[mm][bj][1]; }
            }
    }
};
__device__ __forceinline__ void p3_combine_sample(Frame& F) {
    const u32x4* ps = (const u32x4*)(F.ws + WS_PS); u32x4* mg = (u32x4*)(F.ws + WS_MERGED + (size_t)MP * 2048 * 2);
    constexpr int NV = MS * 2048 / 8;
    for (int i = F.bid * NTHREADS + F.tid; i < NV; i += F.G * NTHREADS) { const u32x4 a = ps[i], b = ps[NV + i], c = ps[2 * NV + i]; u32x4 o;
        o.x = pk2(bf2f(a.x & 0xffffu) + bf2f(b.x & 0xffffu) + bf2f(c.x & 0xffffu), bf2f(a.x >> 16) + bf2f(b.x >> 16) + bf2f(c.x >> 16));
        o.y = pk2(bf2f(a.y & 0xffffu) + bf2f(b.y & 0xffffu) + bf2f(c.y & 0xffffu), bf2f(a.y >> 16) + bf2f(b.y >> 16) + bf2f(c.y >> 16));
        o.z = pk2(bf2f(a.z & 0xffffu) + bf2f(b.z & 0xffffu) + bf2f(c.z & 0xffffu), bf2f(a.z >> 16) + bf2f(b.z >> 16) + bf2f(c.z >> 16));
        o.w = pk2(bf2f(a.w & 0xffffu) + bf2f(b.w & 0xffffu) + bf2f(c.w & 0xffffu), bf2f(a.w >> 16) + bf2f(b.w >> 16) + bf2f(c.w >> 16));
        mg[i] = o; }
}
__device__ __forceinline__ void p5_final_norm(Frame& F) {
    const int gw = F.bid * NWAVES + F.wave, NGW = F.G * NWAVES, lane = F.lane;
    const f32x4* wn = (const f32x4*)F.in[I_NORMF] + lane;
    for (int r = gw; r < M; r += NGW) {
        f32x4* y = (f32x4*)(F.out + (size_t)r * D) + lane;
        f32x4 v[8]; float s = 0.f;
        if (r >= MP) { const f32x4* xs4 = (const f32x4*)(F.in[I_XS] + (size_t)(r - MP) * D) + lane; const f32x4* yp4 = (const f32x4*)((const float*)(F.ws + WS_YP) + (size_t)(r - MP) * D) + lane;
#pragma unroll
            for (int j = 0; j < 8; ++j) { f32x4 a = xs4[64 * j];
#pragma unroll
                for (int kq = 0; kq < 4; ++kq) a = a + yp4[(size_t)kq * MS * D / 4 + 64 * j];
                v[j] = a; s += (a.x * a.x + a.y * a.y) + (a.z * a.z + a.w * a.w); } }
        else
#pragma unroll
        for (int j = 0; j < 8; ++j) { v[j] = y[64 * j]; s += (v[j].x * v[j].x + v[j].y * v[j].y) + (v[j].z * v[j].z + v[j].w * v[j].w); }
        const float sc = rsqrtf(wave_sum(s) * (1.f / D) + EPS);
#pragma unroll
        for (int j = 0; j < 8; ++j) { const f32x4 w = wn[64 * j]; f32x4 o = v[j]; o.x *= sc * w.x; o.y *= sc * w.y; o.z *= sc * w.z; o.w *= sc * w.w; y[64 * j] = o; }
    }
}

constexpr int N_PHASES = 10;
__global__ void __launch_bounds__(NTHREADS, 2) hybrid_fwd(Args args) {
    extern __shared__ __attribute__((aligned(16))) unsigned char lds_raw[];
    cg::grid_group grid = cg::this_grid();
    Frame F;
    F.lds = (LAS unsigned char*)lds_raw; F.tid = threadIdx.x; F.lane = F.tid & 63; F.wave = __builtin_amdgcn_readfirstlane(F.tid >> 6);
    F.G = gridDim.x; F.bid = blockIdx.x; F.in = args.in; F.out = args.out; F.ws = args.ws;
    const int lo = args.ph_lo, hi = args.ph_hi;
    if (lo < 0) grid.sync();
    if (F.tid < 64) ((LAS unsigned*)(F.lds + LDS_CTL))[F.tid] = 0u;
    __syncthreads();
    const XcdBarrier bar = xcd_barrier_post((unsigned*)(F.ws + WS_CTL), (volatile LAS unsigned*)(F.lds + LDS_CTL));
#define IN(k) (lo <= (k) && (k) < hi)
#define SEAM(k) do { if (IN(k) && IN((k) + 1)) xcd_barrier(bar); } while (0)
    if (IN(0)) p0_prologue(F);
    SEAM(0);
    if (IN(1)) { SchedP1 S{F.G, F.bid, F.ws, (const unsigned char*)F.out + DO_XN}; EpiP1 E{F.ws, F.out}; pg8::gemm_phase<EpiP1, SchedP1>(F.lds, D, S, E); }
    SEAM(1);
    if (IN(2)) { p2_conv(F); __syncthreads(); for (int it = F.bid; it < 256; it += F.G) mem_sample_item(F, it >> 1, it & 1); }
    SEAM(2);
    if (IN(3)) p2_prep(F);
    SEAM(3);
    if (IN(4)) {
        constexpr int GSPLIT = 1024;
        if (F.bid < 128) { scan_item(F, F.bid & 15, F.bid >> 4); __syncthreads(); p2_gdn_sample(F, F.bid, 128, 0, GSPLIT); }
        else { const int wk = F.bid - 128, nwk = F.G - 128; p2_attn_prompt(F, wk, nwk); __syncthreads(); p2_swa_sample(F, wk, nwk); __syncthreads(); p2_gdn_sample(F, wk, nwk, GSPLIT, 1024); }
    }
    SEAM(4);
    if (IN(5)) { for (int it = F.bid; it < 256; it += F.G) gdn_out_item(F, it); p2_gdn_norm_sample(F); }
    SEAM(5);
    if (IN(6)) { SchedP3 S{F.G, F.bid, F.ws}; EpiP3 E{F.ws}; pg8::gemm_phase<EpiP3, SchedP3>(F.lds, 1024, S, E); }
    SEAM(6);
    if (IN(7)) p3_combine_sample(F);
    SEAM(7);
    if (IN(8)) { SchedP4 S{F.G, F.bid, F.ws}; EpiP4 E{F.ws, F.out, F.in[I_XP], F.in[I_XS]}; pg8::gemm_phase<EpiP4, SchedP4>(F.lds, D, S, E); }
    SEAM(8);
    if (IN(9)) p5_final_norm(F);
#undef IN
#undef SEAM
}

extern "C" void kernel_launch(void* const* d_in, const int* in_sizes, int n_in, void* d_out, int out_size, void* d_ws, size_t ws_size, hipStream_t stream) {
    static int grid = 0;
    if (grid == 0) {
        if (n_in != 22 || out_size != (int)O_END || ws_size < WS_END) { fprintf(stderr, "kernel_launch: unexpected shapes (n_in %d out %d ws %zu need %zu)\n", n_in, out_size, ws_size, (size_t)WS_END); grid = -1; return; }
        int dev = 0, cus = 0, per_cu = 0;
        hipGetDevice(&dev); hipDeviceGetAttribute(&cus, hipDeviceAttributeMultiprocessorCount, dev);
        hipFuncSetAttribute((const void*)hybrid_fwd, hipFuncAttributeMaxDynamicSharedMemorySize, LDS_BYTES);
        hipOccupancyMaxActiveBlocksPerMultiprocessor(&per_cu, (const void*)hybrid_fwd, NTHREADS, LDS_BYTES);
        if (per_cu < 1) { fprintf(stderr, "kernel_launch: occupancy query says %d blocks per CU\n", per_cu); grid = -1; return; }
        grid = cus;
    }
    if (grid < 0) return;
    Args a{};
    for (int i = 0; i < 22; ++i) a.in[i] = (const float*)d_in[i];
    a.out = (float*)d_out; a.ws = (unsigned char*)d_ws;
    if (hipMemsetAsync((char*)d_ws + WS_CTL, 0, XCD_BAR_WORDS * 4, stream) != hipSuccess) { fprintf(stderr, "kernel_launch: hipMemsetAsync failed\n"); return; }
#if MK_N_LAUNCHES == 1
    a.ph_lo = 0; a.ph_hi = N_PHASES;
    void* kargs[] = {&a};
    hipError_t e = hipLaunchCooperativeKernel((const void*)hybrid_fwd, dim3(grid), dim3(NTHREADS), kargs, LDS_BYTES, stream);
    if (e != hipSuccess) fprintf(stderr, "cooperative launch failed: %s (grid %d)\n", hipGetErrorString(e), grid);
#endif
}
```

```cpp
#include <hip/hip_runtime.h>
#include <hip/hip_cooperative_groups.h>
#include <cstdio>
#include <cstdint>
namespace cg = cooperative_groups;

#ifndef MK_N_LAUNCHES
#define MK_N_LAUNCHES 1
#endif

#define LAS __attribute__((address_space(3)))
typedef unsigned short bf16_t;
typedef short bf16x8 __attribute__((ext_vector_type(8)));
typedef float f32x4 __attribute__((ext_vector_type(4)));
typedef unsigned u32x4 __attribute__((ext_vector_type(4)));
typedef unsigned u32x2 __attribute__((ext_vector_type(2)));

constexpr int D = 2048, SEQ = 8192, MP = 2 * SEQ, MS = 512, M = MP + MS;
constexpr int IN_COLS = 14608;
constexpr int NIN = 58 * 256;
constexpr float EPS = 1e-6f;
__host__ __device__ __forceinline__ int win_src_col(int j) {
    if (j < 4096) return j;
    if (j < 5120) return 4112 + (j - 4096);
    if (j < 6144) return 5392 + (j - 5120);
    if (j < 7168) return 6416 + (j - 6144);
    if (j < 8192) return 7440 + (j - 7168);
    if (j < 14336) return 8464 + (j - 8192);
    if (j < 14592) return 5136 + (j - 14336);
    if (j < 14608) return 4096 + (j - 14592);
    return -1;
}
constexpr size_t O_YP = 0, O_YS = O_YP + (size_t)MP * D, O_GSP = O_YS + (size_t)MS * D, O_GCP = O_GSP + 2 * 8 * 128 * 128, O_SKP = O_GCP + 2 * 3 * 3072,
                 O_SVP = O_SKP + 2 * 128 * 128, O_MKP = O_SVP + 2 * 128 * 128, O_MVP = O_MKP + 512 * 1024, O_GSS = O_MVP + 512 * 1024,
                 O_GCS = O_GSS + (size_t)128 * 8 * 128 * 128, O_SKS = O_GCS + 128 * 3 * 3072, O_SVS = O_SKS + 128 * 128 * 128, O_END = O_SVS + 128 * 128 * 128;
static_assert(O_END == 58148864, "d_out map");
constexpr size_t al(size_t x) { return (x + 255) & ~(size_t)255; }
constexpr size_t WS_CTL = 0, WS_WB = 1u << 20, WS_WO = WS_WB + al((size_t)3 * 2048 * 1024 * 2), WS_WIN = WS_WO + al((size_t)2048 * 2048 * 2),
                 WS_WMKV = WS_WIN + al((size_t)NIN * 2048 * 2), WS_QKV = WS_WMKV + al((size_t)2048 * 2048 * 2), WS_GZ = WS_QKV + al((size_t)M * 3072 * 2),
                 WS_SQ = WS_GZ + al((size_t)M * 1024 * 2), WS_SZ = WS_SQ + al((size_t)M * 1024 * 2), WS_MQ = WS_SZ + al((size_t)M * 1024 * 2), WS_MZ = WS_MQ + al((size_t)M * 1024 * 2),
                 WS_SKV = WS_MZ + al((size_t)M * 1024 * 2), WS_GATES = WS_SKV + al((size_t)M * 256 * 2), WS_MEMN = WS_GATES + al((size_t)M * 6144 * 2),
                 WS_MEMKV = WS_MEMN + al((size_t)512 * 2048 * 2), WS_GAB = WS_MEMKV + al((size_t)512 * 2048 * 2), WS_ROWSS = WS_GAB + al((size_t)M * 16 * 4),
                 WS_G = WS_ROWSS + al((size_t)M * 4), WS_BETA = WS_G + al((size_t)M * 8 * 4), WS_BTAB = WS_BETA + al((size_t)M * 8 * 4), WS_END0 = WS_BTAB + al(16 * 128 * 4);
constexpr size_t WS_OG = WS_QKV, WS_OS = WS_OG + (size_t)M * 1024 * 2, WS_OM = WS_OS + (size_t)M * 1024 * 2, WS_MERGED = WS_SQ;
constexpr size_t WS_NEGW = WS_OG, WS_SN = WS_WIN, WS_OMS = WS_MEMN;
constexpr size_t WS_UT = WS_END0, WS_ATT = WS_UT + al((size_t)2048 * 128 * 64 * 2), WS_GC = WS_ATT + al((size_t)2048 * 64 * 64 * 2), WS_DEC = WS_GC + al((size_t)MP * 8 * 4),
                 WS_GT = WS_DEC + al((size_t)2048 * 64 * 4), WS_MVT = WS_GT + al(2048 * 4), WS_VTS = WS_MVT + al((size_t)2 * 4 * 256 * 256 * 2), WS_SSQ = WS_VTS + al((size_t)2 * 2 * 64 * SEQ * 2 + 4096), WS_SSK = WS_SSQ + al((size_t)MP * 8 * 4), WS_END = WS_SSK + al((size_t)MP * 8 * 4);
constexpr size_t WS_PS = WS_UT, WS_YP = WS_UT + (size_t)3 * MS * 2048 * 2;
static_assert((size_t)3 * MS * 2048 * 2 + (size_t)4 * MS * 2048 * 4 <= (size_t)2048 * 128 * 64 * 2, "PS/YP fit in UT");
static_assert(WS_OM + (size_t)M * 1024 * 2 <= WS_GZ && WS_MERGED + (size_t)M * 2048 * 2 <= WS_MQ, "overlays");
static_assert((size_t)2048 * 64 * 128 * 2 <= (size_t)MP * 1024 * 2 && WS_SN + (size_t)2048 * 128 * 128 * 2 <= WS_QKV, "overlays 2");
static_assert(WS_END <= 670000000, "workspace budget");
constexpr size_t DO_XN = 0, DO_QN = 0, DO_KN = (size_t)M * 1024 * 2, DO_KT = 2 * (size_t)M * 1024 * 2, DO_VT = DO_KT + (size_t)2048 * 8192 * 2, DO_VNS = DO_VT + (size_t)2048 * 8192 * 2;
static_assert(DO_VNS + (size_t)512 * 1024 * 2 <= (size_t)M * D * 4, "y scratch");

constexpr int NWAVES = 8, NTHREADS = 512;
constexpr int LDS_CTL = 147456;
constexpr int LDS_BYTES = 147456 + 256;
constexpr int LDS_BT = 139264;

__device__ __forceinline__ float bf2f(unsigned v) { return __uint_as_float(v << 16); }
__device__ __forceinline__ unsigned f2bf(float f) { unsigned u = __float_as_uint(f); return (u + 0x7fffu + ((u >> 16) & 1u)) >> 16; }
__device__ __forceinline__ unsigned pk2(float lo, float hi) { return f2bf(lo) | (f2bf(hi) << 16); }
__device__ __forceinline__ float wave_sum(float v) {
#pragma unroll
    for (int o = 1; o < 64; o <<= 1) v += __shfl_xor(v, o);
    return v;
}
__device__ __forceinline__ float wave_max(float v) {
#pragma unroll
    for (int o = 1; o < 64; o <<= 1) v = fmaxf(v, __shfl_xor(v, o));
    return v;
}
__device__ __forceinline__ float sigmoidf_(float x) { return __builtin_amdgcn_rcpf(1.f + __expf(-x)); }
__device__ __forceinline__ float siluf_(float x) { return x * __builtin_amdgcn_rcpf(1.f + __expf(-x)); }
#define LDS_WAIT() asm volatile("s_waitcnt lgkmcnt(0)" ::: "memory")

namespace pg8 {
constexpr int BM = 256, BK = 64, HALF = 128, HTB = HALF * BK * 2, STAGE_BYTES = 8 * HTB, NXCD = 8, WGM = 8;
__host__ __device__ __forceinline__ int lds_byte(int r, int c) { const int st = (r >> 4) * 2 + (c >> 5), rr = r & 15, cc = c & 31, ob = rr * 64 + cc * 2; return st * 1024 + (ob ^ (((ob >> 9) & 1) << 5)); }
__host__ __device__ __forceinline__ void stage_rc(int b, int& R, int& C) { const int st = b / 1024, sb = b % 1024, swz = sb ^ (((sb >> 9) & 1) << 5); R = (st >> 1) * 16 + swz / 64; C = (st & 1) * 32 + (swz % 64) / 2; }
__host__ __device__ __forceinline__ int perm32(int rho) { const int n = rho >> 4, i = rho & 15; return 8 * (i >> 2) + 4 * n + (i & 3); }
struct Unit { int pm, pn, job; };
__device__ __forceinline__ void tile_of(int L, int nM, int nN, int& pm, int& pn) {
    const int nwg = nM * nN; int wgid = L;
    { const int q = nwg / NXCD, r = nwg % NXCD, xcd = wgid % NXCD, off = wgid / NXCD; wgid = (xcd < r ? xcd * (q + 1) : r * (q + 1) + (xcd - r) * q) + off; }
    const int nig = WGM * nN, gid = wgid / nig, fm = gid * WGM, gsz = (nM - fm) < WGM ? (nM - fm) : WGM;
    pm = fm + ((wgid % nig) % gsz); pn = (wgid % nig) / gsz;
}
__device__ __forceinline__ unsigned cvt_pk_bf16(float lo, float hi) { unsigned r; asm volatile("v_cvt_pk_bf16_f32 %0, %1, %2" : "=v"(r) : "v"(lo), "v"(hi)); return r; }

template <class Epi, class Sched, bool ALIGN_EPI = true>
__device__ __forceinline__ void gemm_phase(LAS unsigned char* lds, const int K, const Sched& S, const Epi& E) {
    const int tid = threadIdx.x, wid = __builtin_amdgcn_readfirstlane(tid >> 6), lane = tid & 63, wr = wid >> 2, wc = wid & 3, fr = lane & 15, fq = lane >> 4;
    unsigned voffA[2], voffB[2];
#pragma unroll
    for (int i = 0; i < 2; ++i) { int R, C; stage_rc(tid * 16 + i * 8192, R, C); const int Rb = ((R & ~31) + perm32(R & 31));
        voffA[i] = (unsigned)(R * K + C) * 2u; voffB[i] = (unsigned)(Rb * K + C) * 2u; }
    const size_t kstep = (size_t)(BK * 2);
    const size_t hstep = (size_t)HALF * K * 2;
    const unsigned ldsw = (unsigned)wid * 1024u;
    const int aoff = lds_byte(wr * 64 + fr, fq * 8), boff = lds_byte(wc * 32 + fr, fq * 8);
#define PG8_SA(b, h) (((b) * 2 + (h)) * HTB)
#define PG8_SB(b, h) ((4 + (b) * 2 + (h)) * HTB)
#define PG8_STAGE(bufoff, gbase, voff) do { _Pragma("unroll") for (int _i = 0; _i < 2; ++_i) \
        __builtin_amdgcn_global_load_lds((const unsigned*)((const char*)(gbase) + (voff)[_i]), (LAS unsigned*)(lds + (bufoff) + ldsw + _i * 8192), 16, 0, 0); } while (0)
#define PG8_LDA(dst, b, h) do { _Pragma("unroll") for (int m = 0; m < 4; ++m) _Pragma("unroll") for (int k = 0; k < 2; ++k) dst[m][k] = *(const LAS bf16x8*)(lds + PG8_SA(b, h) + aoff + m * 2048 + k * 1024); } while (0)
#define PG8_LDB(dst, b, h) do { _Pragma("unroll") for (int n = 0; n < 2; ++n) _Pragma("unroll") for (int k = 0; k < 2; ++k) dst[n][k] = *(const LAS bf16x8*)(lds + PG8_SB(b, h) + boff + n * 2048 + k * 1024); } while (0)
#define PG8_MMA(ai, bj, At, Bt) do { __builtin_amdgcn_s_setprio(1); _Pragma("unroll") for (int m = 0; m < 4; ++m) _Pragma("unroll") for (int n = 0; n < 2; ++n) _Pragma("unroll") for (int k = 0; k < 2; ++k) \
        acc[ai][bj][m][n] = __builtin_amdgcn_mfma_f32_16x16x32_bf16(Bt[n][k], At[m][k], acc[ai][bj][m][n], 0, 0, 0); __builtin_amdgcn_s_setprio(0); } while (0)
#define PG8_WAIT_V(n) asm volatile("s_waitcnt vmcnt(" #n ")" ::: "memory")
#define PG8_WAIT_L(n) asm volatile("s_waitcnt lgkmcnt(" #n ")" ::: "memory")
#define PG8_BAR __builtin_amdgcn_s_barrier()
#define PG8_SCHED __builtin_amdgcn_sched_barrier(0)
    Unit cur, nxt; int ui = 0;
    if (!S.next(0, cur)) return;
    f32x4 acc[2][2][4][2];
#pragma unroll
    for (int a = 0; a < 2; ++a)
#pragma unroll
        for (int b = 0; b < 2; ++b)
#pragma unroll
            for (int m = 0; m < 4; ++m)
#pragma unroll
                for (int n = 0; n < 2; ++n) acc[a][b][m][n] = (f32x4){0.f, 0.f, 0.f, 0.f};
    bf16x8 At[4][2], B0[2][2], B1[2][2];
    const char* cA; const char* cB; S.ptrs(cur, cA, cB);
    PG8_STAGE(PG8_SB(0, 0), cB, voffB); PG8_STAGE(PG8_SB(0, 1), cB + hstep, voffB); PG8_STAGE(PG8_SA(0, 0), cA, voffA); PG8_STAGE(PG8_SA(0, 1), cA + hstep, voffA);
    if (wr == 1) PG8_BAR;
    PG8_WAIT_V(2); PG8_BAR;
    PG8_STAGE(PG8_SB(1, 0), cB + kstep, voffB); PG8_STAGE(PG8_SA(1, 0), cA + kstep, voffA); PG8_STAGE(PG8_SB(1, 1), cB + hstep + kstep, voffB);
    PG8_WAIT_V(6); PG8_BAR;
    for (;;) {
        const bool has_next = S.next(ui + 1, nxt);
        const char* nA = cA; const char* nB = cB; if (has_next) S.ptrs(nxt, nA, nB);
        const int nt = S.ntiles(cur);
        for (int t = 0; t < nt; t += 2) {
            const bool last = (t == nt - 2);
            const char* a1 = cA + (size_t)(t + 1) * kstep;
            const char* a2 = last ? nA : cA + (size_t)(t + 2) * kstep; const char* b2 = last ? nB : cB + (size_t)(t + 2) * kstep;
            const char* a3 = a2 + kstep; const char* b3 = b2 + kstep;
            PG8_LDB(B0, 0, 0); PG8_LDB(B1, 0, 1); PG8_SCHED; PG8_LDA(At, 0, 0); PG8_STAGE(PG8_SA(1, 1), a1 + hstep, voffA);
            PG8_WAIT_V(8); PG8_WAIT_L(0); PG8_BAR; PG8_MMA(0, 0, At, B0); PG8_MMA(0, 1, At, B1); PG8_BAR; PG8_SCHED;
            PG8_LDA(At, 0, 1); PG8_STAGE(PG8_SB(0, 0), b2, voffB); PG8_STAGE(PG8_SB(0, 1), b2 + hstep, voffB); PG8_STAGE(PG8_SA(0, 0), a2, voffA);
            PG8_WAIT_V(8); PG8_WAIT_L(0); PG8_BAR; PG8_MMA(1, 0, At, B0); PG8_MMA(1, 1, At, B1); PG8_BAR; PG8_SCHED;
            PG8_LDB(B0, 1, 0); PG8_LDB(B1, 1, 1); PG8_SCHED; PG8_LDA(At, 1, 0); PG8_STAGE(PG8_SA(0, 1), a2 + hstep, voffA);
            PG8_WAIT_V(8); PG8_WAIT_L(0); PG8_BAR; PG8_MMA(0, 0, At, B0); PG8_MMA(0, 1, At, B1); PG8_BAR; PG8_SCHED;
            PG8_LDA(At, 1, 1); PG8_STAGE(PG8_SB(1, 0), b3, voffB); PG8_STAGE(PG8_SB(1, 1), b3 + hstep, voffB); PG8_STAGE(PG8_SA(1, 0), a3, voffA);
            PG8_WAIT_V(8); PG8_WAIT_L(0); PG8_BAR; PG8_MMA(1, 0, At, B0); PG8_MMA(1, 1, At, B1); PG8_BAR; PG8_SCHED;
        }
        if constexpr (ALIGN_EPI) { if (wr == 0) PG8_BAR; }
        E(acc, cur, wr, wc, fr, fq);
        if (!has_next) break;
#pragma unroll
        for (int a = 0; a < 2; ++a)
#pragma unroll
            for (int b = 0; b < 2; ++b)
#pragma unroll
                for (int m = 0; m < 4; ++m)
#pragma unroll
                    for (int n = 0; n < 2; ++n) acc[a][b][m][n] = (f32x4){0.f, 0.f, 0.f, 0.f};
        cur = nxt; cA = nA; cB = nB; ++ui;
        if constexpr (ALIGN_EPI) { if (wr == 1) PG8_BAR; }
    }
    PG8_WAIT_V(0);
    if constexpr (!ALIGN_EPI) { if (wr == 0) PG8_BAR; }
    PG8_BAR;
#undef PG8_SA
#undef PG8_SB
#undef PG8_STAGE
#undef PG8_LDA
#undef PG8_LDB
#undef PG8_MMA
#undef PG8_WAIT_V
#undef PG8_WAIT_L
#undef PG8_BAR
#undef PG8_SCHED
}
}

#define XB_TMO      128
#define XB_XCNT(j)  (256  + 64 * (j))
#define XB_XSUB(j)  (1280 + 64 * (j))
#define XB_XGEN(j)  (2304 + 64 * (j))
#define XB_TOP      3328
#define XB_TOPGEN   3392
#define XCD_BAR_WORDS 3456
#define XB_SPIN_CAP (1u << 20)
__device__ __forceinline__ unsigned xb_ld(unsigned* p)              { return __hip_atomic_load(p, __ATOMIC_RELAXED, __HIP_MEMORY_SCOPE_AGENT); }
__device__ __forceinline__ unsigned xb_add(unsigned* p, unsigned v) { return __hip_atomic_fetch_add(p, v, __ATOMIC_RELAXED, __HIP_MEMORY_SCOPE_AGENT); }
__device__ __forceinline__ unsigned xb_xcc_id() { return (unsigned)__builtin_amdgcn_s_getreg((3 << 11) | 20) & 0xFu; }
#define XB_SPIN(cond, bar) do { unsigned _sp = 0; while (cond) { __builtin_amdgcn_s_sleep(1); \
    if ((++_sp & 255u) == 0u) { if (xb_ld(&(bar)[XB_TMO])) break; if (_sp > XB_SPIN_CAP) { atomicAdd(&(bar)[XB_TMO], 1u); break; } } } } while (0)
struct XcdBarrier { unsigned* bar; unsigned x; volatile LAS unsigned* st; };
__device__ __forceinline__ XcdBarrier xcd_barrier_post(unsigned* bar, volatile LAS unsigned* st) {
    XcdBarrier b; b.bar = bar; b.x = xb_xcc_id(); b.st = st;
    if (threadIdx.x == 0) (void)xb_add(&bar[XB_XCNT(b.x)], 1u);
    return b;
}
__device__ __forceinline__ void xcd_barrier_complete(unsigned* bar, unsigned x, unsigned& nloc, unsigned& nx) {
    const unsigned G = gridDim.x * gridDim.y * gridDim.z;
    unsigned sum, cnt, mine, sp = 0u;
    for (;;) {
        sum = 0u; cnt = 0u; mine = 0u;
#pragma unroll
        for (unsigned j = 0; j < 16; ++j) { const unsigned c = xb_ld(&bar[XB_XCNT(j)]); sum += c; cnt += (c > 0u) ? 1u : 0u; mine = (j == x) ? c : mine; }
        if (sum == G) break;
        __builtin_amdgcn_s_sleep(1);
        if ((++sp & 255u) == 0u) { if (xb_ld(&bar[XB_TMO])) break; if (sp > XB_SPIN_CAP) { atomicAdd(&bar[XB_TMO], 1u); break; } }
    }
    nloc = mine > 0u ? mine : 1u; nx = cnt > 0u ? cnt : 1u;
}
__device__ __forceinline__ void xcd_barrier(const XcdBarrier& b) {
    asm volatile("s_waitcnt vmcnt(0)" ::: "memory");
    __syncthreads();
    if (threadIdx.x == 0) {
        unsigned* bar = b.bar;
        __builtin_amdgcn_s_waitcnt(0);
        unsigned nloc = b.st[0], nx = b.st[1];
        if (nloc == 0u) { xcd_barrier_complete(bar, b.x, nloc, nx); b.st[0] = nloc; b.st[1] = nx; }
        const unsigned old = xb_add(&bar[XB_XSUB(b.x)], 1u);
        const unsigned gen = old / nloc;
        if (old + 1u == (gen + 1u) * nloc) {
            __builtin_amdgcn_fence(__ATOMIC_RELEASE, "agent");
            asm volatile("s_waitcnt vmcnt(0)" ::: "memory");
            const unsigned og = xb_add(&bar[XB_TOP], 1u);
            const unsigned tg = og / nx;
            if (og + 1u == (tg + 1u) * nx) xb_add(&bar[XB_TOPGEN], 1u);
            else XB_SPIN(xb_ld(&bar[XB_TOPGEN]) == tg, bar);
            __builtin_amdgcn_fence(__ATOMIC_ACQUIRE, "agent");
            xb_add(&bar[XB_XGEN(b.x)], 1u);
            asm volatile("s_waitcnt vmcnt(0)" ::: "memory");
        } else {
            XB_SPIN(xb_ld(&bar[XB_XGEN(b.x)]) == gen, bar);
            __builtin_amdgcn_fence(__ATOMIC_ACQUIRE, "agent");
            asm volatile("s_waitcnt vmcnt(0)" ::: "memory");
        }
    }
    __syncthreads();
}

struct Args { const float* in[22]; float* out; unsigned char* ws; int ph_lo, ph_hi; };
enum { I_XP = 0, I_XS, I_SGDN, I_SCONV, I_CSK, I_CSV, I_CMK, I_CMV, I_MEMP, I_NORM_IN, I_WIN, I_CONVW, I_ALOG, I_DTB, I_GNORM, I_SINKS, I_RELB, I_NORM_MEM, I_WMKV, I_WBR, I_WOUT, I_NORMF };

struct Frame {
    LAS unsigned char* lds;
    int tid, lane, wave, G, bid;
    const float* const* in; float* out; unsigned char* ws;
};

template <bool WINMAP>
__device__ __forceinline__ void p0_transpose_item(const float* W, int K, int Nsrc, bf16_t* WT, LAS bf16_t* scr, int kb, int nb, int lane) {
    constexpr int TP = 130;
    const int k0 = 64 * kb, n0 = 128 * nb;
    const int dj = n0 + 4 * (lane & 31);
    const int sc = WINMAP ? win_src_col(dj) : dj;
    f32x4 v[32];
#pragma unroll
    for (int i = 0; i < 32; ++i) { const int kk = 2 * i + (lane >> 5); v[i] = sc >= 0 ? *(const f32x4*)(W + (size_t)(k0 + kk) * Nsrc + sc) : (f32x4){0.f, 0.f, 0.f, 0.f}; }
#pragma unroll
    for (int i = 0; i < 32; ++i) { const int kk = 2 * i + (lane >> 5); LAS unsigned* d = (LAS unsigned*)(scr + kk * TP + 4 * (lane & 31)); d[0] = pk2(v[i].x, v[i].y); d[1] = pk2(v[i].z, v[i].w); }
    LDS_WAIT(); asm volatile("" ::: "memory");
#pragma unroll 4
    for (int u = 0; u < 16; ++u) { const int e = lane + 64 * u, ch = e & 7, n = e >> 3; const LAS bf16_t* s = scr + (8 * ch) * TP + n;
        u32x4 o; o.x = (unsigned)s[0] | ((unsigned)s[TP] << 16); o.y = (unsigned)s[2 * TP] | ((unsigned)s[3 * TP] << 16);
        o.z = (unsigned)s[4 * TP] | ((unsigned)s[5 * TP] << 16); o.w = (unsigned)s[6 * TP] | ((unsigned)s[7 * TP] << 16);
        *(u32x4*)(WT + (size_t)(n0 + n) * K + k0 + 8 * ch) = o; }
    LDS_WAIT(); asm volatile("" ::: "memory");
}
__device__ __forceinline__ void rms_row_to_bf16(const float* xrow, const float* w, bf16_t* orow, int lane) {
    const f32x4* xr = (const f32x4*)xrow + lane; const f32x4* wr = (const f32x4*)w + lane;
    f32x4 v[8]; float s = 0.f;
#pragma unroll
    for (int j = 0; j < 8; ++j) { v[j] = xr[64 * j]; s += (v[j].x * v[j].x + v[j].y * v[j].y) + (v[j].z * v[j].z + v[j].w * v[j].w); }
    const float r = rsqrtf(wave_sum(s) * (1.f / D) + EPS);
    unsigned long long* o8 = (unsigned long long*)orow + lane;
#pragma unroll
    for (int j = 0; j < 8; ++j) { const f32x4 ww = wr[64 * j];
        o8[64 * j] = (unsigned long long)pk2(v[j].x * r * ww.x, v[j].y * r * ww.y) | ((unsigned long long)pk2(v[j].z * r * ww.z, v[j].w * r * ww.w) << 32); }
}
__device__ __forceinline__ int t5_bucket(int n) {
    if (n < 16) return n;
    int large = 16 + (int)(logf((float)n / 16.f) / 2.0794415416798357f * 16.f);
    return large < 31 ? large : 31;
}
__device__ __forceinline__ void p0_prologue(Frame& F) {
    LAS bf16_t* scr = (LAS bf16_t*)(F.lds + F.wave * 16896);
    const int gw = F.bid * NWAVES + F.wave, NGW = F.G * NWAVES;
    constexpr int I_IN = 32 * (NIN / 128), I_MKV = 32 * 16, I_BR = 16 * 16, I_OUT = 32 * 16;
    constexpr int NITEMS = I_IN + I_MKV + 3 * I_BR + I_OUT;
    bf16_t* WINT = (bf16_t*)(F.ws + WS_WIN); bf16_t* WMKVT = (bf16_t*)(F.ws + WS_WMKV); bf16_t* WBT = (bf16_t*)(F.ws + WS_WB); bf16_t* WOT = (bf16_t*)(F.ws + WS_WO);
    for (int it = gw; it < NITEMS; it += NGW) {
        int r = it;
        if (r < I_IN) { p0_transpose_item<true>(F.in[I_WIN], D, IN_COLS, WINT, scr, r / (NIN / 128), r % (NIN / 128), F.lane); continue; } r -= I_IN;
        if (r < I_MKV) { p0_transpose_item<false>(F.in[I_WMKV], D, 2048, WMKVT, scr, r / 16, r % 16, F.lane); continue; } r -= I_MKV;
        if (r < 3 * I_BR) { const int b = r / I_BR, q = r % I_BR; p0_transpose_item<false>(F.in[I_WBR] + (size_t)b * 1024 * 2048, 1024, 2048, WBT + (size_t)b * 2048 * 1024, scr, q / 16, q % 16, F.lane); continue; } r -= 3 * I_BR;
        p0_transpose_item<false>(F.in[I_WOUT], D, 2048, WOT, scr, r / 16, r % 16, F.lane);
    }
    bf16_t* XN = (bf16_t*)((unsigned char*)F.out + DO_XN); bf16_t* MEMN = (bf16_t*)(F.ws + WS_MEMN);
    for (int m = gw; m < M + 512; m += NGW) {
        if (m < MP) rms_row_to_bf16(F.in[I_XP] + (size_t)m * D, F.in[I_NORM_IN], XN + (size_t)m * D, F.lane);
        else if (m < M) rms_row_to_bf16(F.in[I_XS] + (size_t)(m - MP) * D, F.in[I_NORM_IN], XN + (size_t)m * D, F.lane);
        else rms_row_to_bf16(F.in[I_MEMP] + (size_t)(m - M) * D, F.in[I_NORM_MEM], MEMN + (size_t)(m - M) * D, F.lane);
    }
    float* BT = (float*)(F.ws + WS_BTAB);
    for (int i = F.bid * NTHREADS + F.tid; i < 16 * 128; i += F.G * NTHREADS) { const int h = i >> 7, dist = i & 127; BT[i] = F.in[I_RELB][t5_bucket(dist) * 16 + h]; }
}

struct SchedP1 {
    int G, c; const unsigned char* ws; const unsigned char* xn;
    __device__ __forceinline__ int ntiles(const pg8::Unit&) const { return D / 64; }
    static constexpr int NM = M / 256, NN = NIN / 256, NU0 = NM * NN, NU = NU0 + 16;
    __device__ __forceinline__ bool next(int i, pg8::Unit& u) const {
        const long L = (long)i * G + c; if (L >= NU) return false;
        if (L < NU0) { pg8::tile_of((int)L, NM, NN, u.pm, u.pn); u.job = 0; } else { const int q = (int)L - NU0; u.pm = q >> 3; u.pn = q & 7; u.job = 1; }
        return true;
    }
    __device__ __forceinline__ void ptrs(const pg8::Unit& u, const char*& A, const char*& B) const {
        const size_t tstep = (size_t)256 * D * 2;
        if (u.job == 0) { A = (const char*)xn + (size_t)u.pm * tstep; B = (const char*)ws + WS_WIN + (size_t)u.pn * tstep; }
        else { A = (const char*)ws + WS_MEMN + (size_t)u.pm * tstep; B = (const char*)ws + WS_WMKV + (size_t)u.pn * tstep; }
    }
};
struct EpiP1 {
    unsigned char* ws; float* out;
    __device__ __forceinline__ void operator()(const f32x4 (&acc)[2][2][4][2], const pg8::Unit& u, int wr, int wc, int fr, int fq) const {
        const int row0 = u.pm * 256 + wr * 64 + fr;
        const int cin = wc * 32 + 8 * fq;
        if (u.job == 1) {
            bf16_t* MK = (bf16_t*)(ws + WS_MEMKV);
#pragma unroll
            for (int ai = 0; ai < 2; ++ai)
#pragma unroll
                for (int m = 0; m < 4; ++m) { const int r = row0 + ai * 128 + m * 16;
#pragma unroll
                    for (int bj = 0; bj < 2; ++bj) { const int c = u.pn * 256 + bj * 128 + cin; const f32x4 v0 = acc[ai][bj][m][0], v1 = acc[ai][bj][m][1];
                        float* o = out + (c < 1024 ? O_MKP + (size_t)r * 1024 + c : O_MVP + (size_t)r * 1024 + (c - 1024));
                        *(f32x4*)o = v0; *(f32x4*)(o + 4) = v1;
                        u32x4 w; w.x = pg8::cvt_pk_bf16(v0[0], v0[1]); w.y = pg8::cvt_pk_bf16(v0[2], v0[3]); w.z = pg8::cvt_pk_bf16(v1[0], v1[1]); w.w = pg8::cvt_pk_bf16(v1[2], v1[3]);
                        *(u32x4*)(MK + (size_t)r * 2048 + c) = w;
                        if (c >= 1024) { bf16_t* MVT = (bf16_t*)(ws + WS_MVT) + ((size_t)((r >> 8) * 4 + ((c - 1024) >> 8)) * 256 + ((c - 1024) & 255)) * 256 + (r & 255);
                            MVT[0] = (bf16_t)(w.x & 0xffffu); MVT[256] = (bf16_t)(w.x >> 16); MVT[512] = (bf16_t)(w.y & 0xffffu); MVT[768] = (bf16_t)(w.y >> 16);
                            MVT[1024] = (bf16_t)(w.z & 0xffffu); MVT[1280] = (bf16_t)(w.z >> 16); MVT[1536] = (bf16_t)(w.w & 0xffffu); MVT[1792] = (bf16_t)(w.w >> 16); } } }
            return;
        }
        const int pn = u.pn;
        if (pn == 57) {
            if (wc == 0 && fq < 2) { float* GAB = (float*)(ws + WS_GAB);
#pragma unroll
                for (int ai = 0; ai < 2; ++ai)
#pragma unroll
                    for (int m = 0; m < 4; ++m) { const int r = row0 + ai * 128 + m * 16; float* o = GAB + (size_t)r * 16 + 8 * fq; *(f32x4*)o = acc[ai][0][m][0]; *(f32x4*)(o + 4) = acc[ai][0][m][1]; } }
            return;
        }
        bf16_t* base; int ld, ct, act = 0;
        if (pn < 12) { base = (bf16_t*)(ws + WS_QKV); ld = 3072; ct = pn; }
        else if (pn < 16) { base = (bf16_t*)(ws + WS_GZ); ld = 1024; ct = pn - 12; act = 1; }
        else if (pn < 20) { base = (bf16_t*)(ws + WS_SQ); ld = 1024; ct = pn - 16; }
        else if (pn < 24) { base = (bf16_t*)(ws + WS_SZ); ld = 1024; ct = pn - 20; act = 1; }
        else if (pn < 28) { base = (bf16_t*)(ws + WS_MQ); ld = 1024; ct = pn - 24; }
        else if (pn < 32) { base = (bf16_t*)(ws + WS_MZ); ld = 1024; ct = pn - 28; act = 1; }
        else if (pn < 56) { base = (bf16_t*)(ws + WS_GATES); ld = 6144; ct = pn - 32; act = 2; }
        else { base = (bf16_t*)(ws + WS_SKV); ld = 256; ct = 0; }
#pragma unroll
        for (int ai = 0; ai < 2; ++ai)
#pragma unroll
            for (int m = 0; m < 4; ++m) { bf16_t* rowp = base + (size_t)(row0 + ai * 128 + m * 16) * ld + ct * 256 + cin;
#pragma unroll
                for (int bj = 0; bj < 2; ++bj) { f32x4 v0 = acc[ai][bj][m][0], v1 = acc[ai][bj][m][1];
                    if (act == 1) {
#pragma unroll
                        for (int j = 0; j < 4; ++j) { v0[j] = siluf_(v0[j]); v1[j] = siluf_(v1[j]); } }
                    else if (act == 2) {
#pragma unroll
                        for (int j = 0; j < 4; ++j) { v0[j] = sigmoidf_(v0[j]); v1[j] = sigmoidf_(v1[j]); } }
                    u32x4 w; w.x = pg8::cvt_pk_bf16(v0[0], v0[1]); w.y = pg8::cvt_pk_bf16(v0[2], v0[3]); w.z = pg8::cvt_pk_bf16(v1[0], v1[1]); w.w = pg8::cvt_pk_bf16(v1[2], v1[3]);
                    *(u32x4*)(rowp + bj * 128) = w;
                    if (pn == 56 && bj == 1) { const int r = row0 + ai * 128 + m * 16;
                        if (r < MP) { bf16_t* vt = (bf16_t*)(ws + WS_VTS) + ((size_t)((r >> 13) * 2 + (cin >> 6)) * 64 + (cin & 63)) * SEQ + (r & (SEQ - 1));
                            vt[0] = (bf16_t)(w.x & 0xffffu); vt[SEQ] = (bf16_t)(w.x >> 16); vt[2 * SEQ] = (bf16_t)(w.y & 0xffffu); vt[3 * SEQ] = (bf16_t)(w.y >> 16);
                            vt[4 * SEQ] = (bf16_t)(w.z & 0xffffu); vt[5 * SEQ] = (bf16_t)(w.z >> 16); vt[6 * SEQ] = (bf16_t)(w.w & 0xffffu); vt[7 * SEQ] = (bf16_t)(w.w >> 16); } } } }
    }
};

__device__ __forceinline__ void gdn_gate_scalars(Frame& F, int r, int h) {
    const float* GAB = (const float*)(F.ws + WS_GAB); float* Gp = (float*)(F.ws + WS_G); float* Bp = (float*)(F.ws + WS_BETA);
    const float gb = GAB[(size_t)r * 16 + h], ga = GAB[(size_t)r * 16 + 8 + h];
    Bp[(size_t)r * 8 + h] = sigmoidf_(gb);
    const float xx = ga + F.in[I_DTB][h]; const float sp = xx > 20.f ? xx : log1pf(expf(xx));
    Gp[(size_t)r * 8 + h] = -expf(F.in[I_ALOG][h]) * sp;
}
__device__ __forceinline__ void conv_prompt_item(Frame& F, int item) {
    const int b = item >> 7, n = item & 127, row0 = b * SEQ + 64 * n, tid = F.tid;
    const bf16_t* QKV = (const bf16_t*)(F.ws + WS_QKV);
    bf16_t* QN = (bf16_t*)((unsigned char*)F.out + DO_QN); bf16_t* KN = (bf16_t*)((unsigned char*)F.out + DO_KN);
    bf16_t* KT = (bf16_t*)((unsigned char*)F.out + DO_KT); bf16_t* VT = (bf16_t*)((unsigned char*)F.out + DO_VT);
    const float* cw = F.in[I_CONVW];
    constexpr int SP = 136;
    LAS bf16_t* slab = (LAS bf16_t*)F.lds;
    { const int tok = tid >> 3, h = tid & 7; gdn_gate_scalars(F, row0 + tok, h); }
    const int t0 = tid >> 4, cg = (tid & 15) * 8;
    LAS float* cwl = (LAS float*)(F.lds + 32768);
    for (int i = tid; i < 4 * 3072 / 4; i += NTHREADS) ((LAS f32x4*)cwl)[i] = ((const f32x4*)cw)[i];
    __syncthreads();
    struct Slab { u32x4 x[2][4]; };
#define CONV_LOAD(S_, sl_) do { const int ch_ = ((sl_) >> 3) * 1024 + ((sl_) & 7) * 128 + cg; \
        _Pragma("unroll") for (int p = 0; p < 2; ++p) _Pragma("unroll") for (int j = 0; j < 4; ++j) { const int tk = t0 + 32 * p - 3 + j; \
            S_.x[p][j] = (64 * n + tk >= 0) ? *(const u32x4*)(QKV + (size_t)(row0 + tk) * 3072 + ch_) : (u32x4){0u, 0u, 0u, 0u}; } \
        } while (0)
#define CONV_SLAB(S_, sl_) do { const int part = (sl_) >> 3, h = (sl_) & 7; f32x4 wq[4][2]; \
        _Pragma("unroll") for (int j = 0; j < 4; ++j) { wq[j][0] = *(const LAS f32x4*)(cwl + j * 3072 + part * 1024 + h * 128 + cg); wq[j][1] = *(const LAS f32x4*)(cwl + j * 3072 + part * 1024 + h * 128 + cg + 4); } \
        _Pragma("unroll") for (int p = 0; p < 2; ++p) { \
            const int tok = t0 + 32 * p, r = row0 + tok; \
            float a[8]; \
            _Pragma("unroll") for (int e = 0; e < 8; ++e) a[e] = 0.f; \
            _Pragma("unroll") for (int j = 0; j < 4; ++j) { const u32x4 v = S_.x[p][j]; \
                a[0] += bf2f(v.x & 0xffffu) * wq[j][0][0]; a[1] += bf2f(v.x >> 16) * wq[j][0][1]; a[2] += bf2f(v.y & 0xffffu) * wq[j][0][2]; a[3] += bf2f(v.y >> 16) * wq[j][0][3]; \
                a[4] += bf2f(v.z & 0xffffu) * wq[j][1][0]; a[5] += bf2f(v.z >> 16) * wq[j][1][1]; a[6] += bf2f(v.w & 0xffffu) * wq[j][1][2]; a[7] += bf2f(v.w >> 16) * wq[j][1][3]; } \
            _Pragma("unroll") for (int e = 0; e < 8; ++e) a[e] = siluf_(a[e]); \
            if (part < 2) { float ss = ((a[0] * a[0] + a[1] * a[1]) + (a[2] * a[2] + a[3] * a[3])) + ((a[4] * a[4] + a[5] * a[5]) + (a[6] * a[6] + a[7] * a[7])); \
                ss += __shfl_xor(ss, 1); ss += __shfl_xor(ss, 2); ss += __shfl_xor(ss, 4); ss += __shfl_xor(ss, 8); \
                if (cg == 0) ((float*)(F.ws + (part == 0 ? WS_SSQ : WS_SSK)))[(size_t)(row0 + t0 + 32 * p) * 8 + h] = ss; } \
            u32x4 o4; o4.x = pk2(a[0], a[1]); o4.y = pk2(a[2], a[3]); o4.z = pk2(a[4], a[5]); o4.w = pk2(a[6], a[7]); \
            const size_t o = (size_t)r * 1024 + h * 128 + cg; \
            if (part == 0) *(u32x4*)(QN + o) = o4; \
            else { if (part == 1) *(u32x4*)(KN + o) = o4; *(LAS u32x4*)(slab + tok * SP + cg) = o4; } \
            if (n == 127 && tok >= 61) { const u32x4 raw = S_.x[p][3]; float* cdst = F.out + O_GCP + ((size_t)b * 3 + (tok - 61)) * 3072 + part * 1024 + h * 128 + cg; \
                *(f32x4*)cdst = (f32x4){bf2f(raw.x & 0xffffu), bf2f(raw.x >> 16), bf2f(raw.y & 0xffffu), bf2f(raw.y >> 16)}; \
                *(f32x4*)(cdst + 4) = (f32x4){bf2f(raw.z & 0xffffu), bf2f(raw.z >> 16), bf2f(raw.w & 0xffffu), bf2f(raw.w >> 16)}; } \
        } \
        if (part > 0) { \
            __syncthreads(); \
            bf16_t* dst = (part == 1 ? KT : VT) + (size_t)((b * 8 + h) * 128 + n) * 8192; \
            _Pragma("unroll") for (int u = 0; u < 2; ++u) { const int e = tid + 512 * u, chn = 16 * (e >> 7) + (e & 15), tg = 4 * ((e >> 6) & 1) + ((e >> 4) & 3); const LAS bf16_t* s = slab + (8 * tg) * SP + chn; \
                u32x4 o4; o4.x = (unsigned)s[0] | ((unsigned)s[SP] << 16); o4.y = (unsigned)s[2 * SP] | ((unsigned)s[3 * SP] << 16); \
                o4.z = (unsigned)s[4 * SP] | ((unsigned)s[5 * SP] << 16); o4.w = (unsigned)s[6 * SP] | ((unsigned)s[7 * SP] << 16); \
                *(u32x4*)(dst + e * 8) = o4; } \
            __syncthreads(); \
        } } while (0)
    Slab s0, s1, s2;
    CONV_LOAD(s0, 0); CONV_LOAD(s1, 1);
#pragma unroll 1
    for (int sl = 0; sl < 24; sl += 3) {
        CONV_LOAD(s2, sl + 2); CONV_SLAB(s0, sl);
        if (sl + 3 < 24) CONV_LOAD(s0, sl + 3); CONV_SLAB(s1, sl + 1);
        if (sl + 4 < 24) CONV_LOAD(s1, sl + 4); CONV_SLAB(s2, sl + 2);
    }
#undef CONV_LOAD
#undef CONV_SLAB
}
__device__ __forceinline__ void conv_sample_items(Frame& F) {
    const int gw = F.bid * NWAVES + F.wave, NGW = F.G * NWAVES, lane = F.lane;
    const bf16_t* QKV = (const bf16_t*)(F.ws + WS_QKV);
    bf16_t* QN = (bf16_t*)((unsigned char*)F.out + DO_QN); bf16_t* KN = (bf16_t*)((unsigned char*)F.out + DO_KN); bf16_t* VNS = (bf16_t*)((unsigned char*)F.out + DO_VNS);
    const float* cw = F.in[I_CONVW];
    for (int it = gw; it < 128 * 8; it += NGW) {
        const int bd = it >> 3, h = it & 7;
        float xr[3][7][2], wv[3][4][2];
#pragma unroll
        for (int part = 0; part < 3; ++part) { const int ch = part * 1024 + h * 128 + 2 * lane;
#pragma unroll
            for (int i = 0; i < 3; ++i) { const float2 p2 = *(const float2*)(F.in[I_SCONV] + ((size_t)bd * 3 + i) * 3072 + ch); xr[part][i][0] = p2.x; xr[part][i][1] = p2.y; }
#pragma unroll
            for (int i = 0; i < 4; ++i) { const unsigned v = *(const unsigned*)(QKV + (size_t)(MP + bd * 4 + i) * 3072 + ch); xr[part][3 + i][0] = bf2f(v & 0xffffu); xr[part][3 + i][1] = bf2f(v >> 16); }
#pragma unroll
            for (int j = 0; j < 4; ++j) { const float2 w2 = *(const float2*)(cw + j * 3072 + ch); wv[part][j][0] = w2.x; wv[part][j][1] = w2.y; } }
#pragma unroll
        for (int s = 0; s < 4; ++s) {
            const int r = MP + bd * 4 + s;
            float y[3][2];
#pragma unroll
            for (int part = 0; part < 3; ++part) { float a0 = 0.f, a1 = 0.f;
#pragma unroll
                for (int j = 0; j < 4; ++j) { a0 += xr[part][s + j][0] * wv[part][j][0]; a1 += xr[part][s + j][1] * wv[part][j][1]; }
                y[part][0] = siluf_(a0); y[part][1] = siluf_(a1); }
            const float sq = wave_sum(y[0][0] * y[0][0] + y[0][1] * y[0][1]), sk = wave_sum(y[1][0] * y[1][0] + y[1][1] * y[1][1]);
            const float rq = rsqrtf(sq + EPS) * 0.08838834764831845f, rk = rsqrtf(sk + EPS);
            const size_t o = (size_t)r * 1024 + h * 128 + 2 * lane;
            *(unsigned*)(QN + o) = pk2(y[0][0] * rq, y[0][1] * rq);
            *(unsigned*)(KN + o) = pk2(y[1][0] * rk, y[1][1] * rk);
            *(unsigned*)(VNS + (size_t)(r - MP) * 1024 + h * 128 + 2 * lane) = pk2(y[2][0], y[2][1]);
            if (lane == 0) gdn_gate_scalars(F, r, h);
            if (s >= 1) { float* cdst = F.out + O_GCS + ((size_t)bd * 3 + (s - 1)) * 3072;
#pragma unroll
                for (int part = 0; part < 3; ++part) { const int ch = part * 1024 + h * 128 + 2 * lane; *(float2*)(cdst + ch) = make_float2(xr[part][3 + s][0], xr[part][3 + s][1]); } }
        }
    }
}
__device__ __forceinline__ void p2_conv(Frame& F) {
    for (int it = F.bid; it < 256; it += F.G) conv_prompt_item(F, it);
    conv_sample_items(F);
}

__device__ __forceinline__ f32x4 mfma16(bf16x8 a, bf16x8 b, f32x4 c) { return __builtin_amdgcn_mfma_f32_16x16x32_bf16(a, b, c, 0, 0, 0); }
__device__ __forceinline__ u32x2 pack4(f32x4 v) { u32x2 r; r.x = pk2(v[0], v[1]); r.y = pk2(v[2], v[3]); return r; }
__device__ __forceinline__ void prep_item(Frame& F, int item) {
    const int b = item >> 7, n = item & 127, row0 = b * SEQ + 64 * n, lane = F.lane, h = F.wave, c = lane & 15, q = lane >> 4;
    const int ci = (b * 8 + h) * 128 + n;
    const bf16_t* QN = (const bf16_t*)((const unsigned char*)F.out + DO_QN); const bf16_t* KN = (const bf16_t*)((const unsigned char*)F.out + DO_KN);
    const bf16_t* KT = (const bf16_t*)((const unsigned char*)F.out + DO_KT) + (size_t)ci * 8192; const bf16_t* VT = (const bf16_t*)((const unsigned char*)F.out + DO_VT) + (size_t)ci * 8192;
    bf16_t* NEGW = (bf16_t*)(F.ws + WS_NEGW) + (size_t)ci * 8192; bf16_t* UT = (bf16_t*)(F.ws + WS_UT) + (size_t)ci * 8192; bf16_t* ATT = (bf16_t*)(F.ws + WS_ATT) + (size_t)ci * 4096;
    const float* Gp = (const float*)(F.ws + WS_G); const float* Bp = (const float*)(F.ws + WS_BETA);
    float* GC = (float*)(F.ws + WS_GC); float* DEC = (float*)(F.ws + WS_DEC); float* GT = (float*)(F.ws + WS_GT);
    LAS float* Als = (LAS float*)(F.lds + h * 18432);
    LAS float* gcs = Als + 4096; LAS float* bes = gcs + 64;
    float gc = Gp[(size_t)(row0 + lane) * 8 + h];
#pragma unroll
    for (int o = 1; o < 64; o <<= 1) { const float x = __shfl_up(gc, o); if (lane >= o) gc += x; }
    const float beta = Bp[(size_t)(row0 + lane) * 8 + h];
    const float gl = __shfl(gc, 63);
    const float sk = ((const float*)(F.ws + WS_SSK))[(size_t)(row0 + lane) * 8 + h], sq = ((const float*)(F.ws + WS_SSQ))[(size_t)(row0 + lane) * 8 + h];
    const float rk = rsqrtf(sk + EPS), rq = rsqrtf(sq + EPS) * 0.08838834764831845f;
    LAS float* rks = bes + 64; LAS float* rqs = rks + 64;
    gcs[lane] = gc; bes[lane] = beta; rks[lane] = rk; rqs[lane] = rq;
    GC[(size_t)(row0 + lane) * 8 + h] = __expf(gc) * rq; DEC[(size_t)ci * 64 + lane] = __expf(gl - gc) * rk; if (lane == 0) GT[ci] = __expf(gl);
    LDS_WAIT(); asm volatile("" ::: "memory");
    bf16x8 kf[4][4];
#pragma unroll
    for (int mt = 0; mt < 4; ++mt)
#pragma unroll
        for (int s = 0; s < 4; ++s) { const size_t o = (size_t)(row0 + 16 * mt + c) * 1024 + h * 128 + 32 * s + 8 * q; kf[mt][s] = *(const bf16x8*)(KN + o); }
#pragma unroll
    for (int mi = 0; mi < 4; ++mi) {
        const int ii = 16 * mi + c; const float gci = gcs[ii], bi = bes[ii] * rks[ii], rqi = rqs[ii];
        const bf16_t* qrow_p = QN + (size_t)(row0 + ii) * 1024 + h * 128 + 8 * q;
#pragma unroll
        for (int nj = 0; nj < 4; ++nj) {
            u32x2 av; av.x = 0u; av.y = 0u;
            if (nj <= mi) {
                f32x4 dk = {0.f, 0.f, 0.f, 0.f}, dq = {0.f, 0.f, 0.f, 0.f};
#pragma unroll
                for (int s = 0; s < 4; ++s) { dk = mfma16(kf[nj][s], kf[mi][s], dk); dq = mfma16(kf[nj][s], *(const bf16x8*)(qrow_p + 32 * s), dq); }
                const f32x4 gj = *(const LAS f32x4*)(gcs + 16 * nj + 4 * q), rkj = *(const LAS f32x4*)(rks + 16 * nj + 4 * q);
                f32x4 a, at;
#pragma unroll
                for (int r = 0; r < 4; ++r) { const int jj = 16 * nj + 4 * q + r; const float e = __expf(gci - gj[r]);
                    a[r] = (ii > jj) ? bi * rkj[r] * dk[r] * e : 0.f; at[r] = (ii >= jj) ? rqi * rkj[r] * dq[r] * e : 0.f; }
                *(LAS f32x4*)(Als + ii * 64 + 16 * nj + 4 * q) = a;
                av = pack4(at);
            }
            *(u32x2*)(ATT + ((mi * 2 + (nj >> 1)) * 64 + (2 * (nj & 1) + (q >> 1)) * 16 + c) * 8 + 4 * (q & 1)) = av;
        }
    }
    LDS_WAIT();
    float t[64];
#pragma unroll
    for (int i = 0; i < 64; ++i) {
        float acc = (lane == i) ? 1.f : 0.f;
#pragma unroll
        for (int m4 = 0; m4 < i; m4 += 4) { const f32x4 a = *(const LAS f32x4*)(Als + i * 64 + m4);
            acc -= a[0] * t[m4]; if (m4 + 1 < i) acc -= a[1] * t[m4 + 1]; if (m4 + 2 < i) acc -= a[2] * t[m4 + 2]; if (m4 + 3 < i) acc -= a[3] * t[m4 + 3]; }
        t[i] = acc;
    }
    LAS bf16_t* T1 = (LAS bf16_t*)Als; LAS bf16_t* T2 = T1 + 64 * 72;
    const float s1 = beta, s2 = -beta * __expf(gc) * rk;
    LDS_WAIT();
#pragma unroll
    for (int i = 0; i < 64; ++i) { T1[i * 72 + lane] = (bf16_t)f2bf(t[i] * s1); T2[i * 72 + lane] = (bf16_t)f2bf(t[i] * s2); }
    LDS_WAIT();
    bf16x8 t1f[4][2], t2f[4][2];
#pragma unroll
    for (int it = 0; it < 4; ++it)
#pragma unroll
        for (int s = 0; s < 2; ++s) { t1f[it][s] = *(const LAS bf16x8*)(T1 + (16 * it + c) * 72 + 32 * s + 8 * q); t2f[it][s] = *(const LAS bf16x8*)(T2 + (16 * it + c) * 72 + 32 * s + 8 * q); }
#pragma unroll 2
    for (int dt = 0; dt < 8; ++dt) {
        bf16x8 vb[2], ka[2];
#pragma unroll
        for (int s = 0; s < 2; ++s) { vb[s] = *(const bf16x8*)(VT + ((dt * 2 + s) * 64 + lane) * 8); ka[s] = *(const bf16x8*)(KT + ((dt * 2 + s) * 64 + lane) * 8); }
#pragma unroll
        for (int it = 0; it < 4; ++it) {
            f32x4 du = {0.f, 0.f, 0.f, 0.f}, dw = {0.f, 0.f, 0.f, 0.f};
            du = mfma16(t1f[it][0], vb[0], du); dw = mfma16(ka[0], t2f[it][0], dw);
            if (it >= 2) { du = mfma16(t1f[it][1], vb[1], du); dw = mfma16(ka[1], t2f[it][1], dw); }
            *(u32x2*)(UT + ((dt * 2 + (it >> 1)) * 64 + (2 * (it & 1) + (q >> 1)) * 16 + c) * 8 + 4 * (q & 1)) = pack4(du);
            *(u32x2*)(NEGW + ((it * 4 + (dt >> 1)) * 64 + (2 * (dt & 1) + (q >> 1)) * 16 + c) * 8 + 4 * (q & 1)) = pack4(dw);
        }
    }
    LDS_WAIT();
}
__device__ __forceinline__ void p2_prep(Frame& F) { for (int it = F.bid; it < 256; it += F.G) { prep_item(F, it); __syncthreads(); } }

__device__ __forceinline__ void scan_item(Frame& F, int bh, int sl) {
    const int lane = F.lane, w = F.wave, c = lane & 15, q = lane >> 4, dvs = 16 * sl;
    const bf16_t* KT = (const bf16_t*)((const unsigned char*)F.out + DO_KT); const bf16_t* NEGW = (const bf16_t*)(F.ws + WS_NEGW);
    bf16_t* UT = (bf16_t*)(F.ws + WS_UT); bf16_t* SN = (bf16_t*)(F.ws + WS_SN);
    const float* DEC = (const float*)(F.ws + WS_DEC); const float* GT = (const float*)(F.ws + WS_GT);
    LAS bf16_t* SS = (LAS bf16_t*)F.lds;
    LAS bf16_t* VS = SS + 16 * 136;
    LAS bf16_t* VU = VS + 16 * 72;
    f32x4 Sacc = {0.f, 0.f, 0.f, 0.f};
    for (int e = F.tid; e < 16 * 136 / 2; e += NTHREADS) ((LAS unsigned*)SS)[e] = 0u;
    struct Ops { bf16x8 wf[4], kf[2]; u32x2 u2; f32x4 dec4; float gt; };
#define SCAN_LOAD(o, n_) do { const size_t ci__ = (size_t)bh * 128 + ((n_) < 128 ? (n_) : 127); \
        _Pragma("unroll") for (int s = 0; s < 2; ++s) o.kf[s] = *(const bf16x8*)(KT + ci__ * 8192 + ((w * 2 + s) * 64 + lane) * 8); \
        o.gt = GT[ci__]; \
        if (w < 4) { _Pragma("unroll") for (int s = 0; s < 4; ++s) o.wf[s] = *(const bf16x8*)(NEGW + ci__ * 8192 + ((w * 4 + s) * 64 + lane) * 8); \
            o.u2 = *(const u32x2*)(UT + ci__ * 8192 + ((sl * 2 + (w >> 1)) * 64 + (2 * (w & 1) + (q >> 1)) * 16 + c) * 8 + 4 * (q & 1)); o.dec4 = *(const f32x4*)(DEC + ci__ * 64 + 16 * w + 4 * q); } } while (0)
#define SCAN_STEP(o, n_) do { const size_t ci = (size_t)bh * 128 + (n_); \
        if (w < 4) { \
            f32x4 v = {bf2f(o.u2.x & 0xffffu), bf2f(o.u2.x >> 16), bf2f(o.u2.y & 0xffffu), bf2f(o.u2.y >> 16)}; \
            _Pragma("unroll") for (int s = 0; s < 4; ++s) { const bf16x8 sf = *(const LAS bf16x8*)(SS + c * 136 + 32 * s + 8 * q); v = mfma16(o.wf[s], sf, v); } \
            *(LAS u32x2*)(VU + c * 72 + 16 * w + 4 * q) = pack4(v); \
            const f32x4 vd = v * o.dec4; \
            *(LAS u32x2*)(VS + c * 72 + 16 * w + 4 * q) = pack4(vd); \
        } else if (w == 4) {   \
            _Pragma("unroll") for (int u = 0; u < 4; ++u) {   \
                *(u32x4*)(SN + ci * 16384 + ((sl * 4 + u) * 64 + lane) * 8) = *(const LAS u32x4*)(SS + c * 136 + 32 * u + 8 * q); } \
        } \
        asm volatile("s_waitcnt lgkmcnt(0)" ::: "memory"); __builtin_amdgcn_s_barrier(); asm volatile("" ::: "memory"); \
        Sacc = Sacc * o.gt; \
        _Pragma("unroll") for (int s = 0; s < 2; ++s) { const bf16x8 vf = *(const LAS bf16x8*)(VS + c * 72 + 32 * s + 8 * q); Sacc = mfma16(o.kf[s], vf, Sacc); } \
        if (w == 5) {   \
            _Pragma("unroll") for (int u = 0; u < 2; ++u) { \
                *(u32x4*)(UT + ci * 8192 + ((sl * 2 + u) * 64 + lane) * 8) = *(const LAS u32x4*)(VU + c * 72 + 32 * u + 8 * q); } } \
        { const u32x2 sp = pack4(Sacc); *(LAS u32x2*)(SS + c * 136 + 16 * w + 4 * q) = sp; } \
        asm volatile("s_waitcnt lgkmcnt(0)" ::: "memory"); __builtin_amdgcn_s_barrier(); asm volatile("" ::: "memory"); } while (0)
    Ops o0, o1, o2, o3;
    SCAN_LOAD(o0, 0); SCAN_LOAD(o1, 1); SCAN_LOAD(o2, 2);
    asm volatile("s_waitcnt lgkmcnt(0)" ::: "memory"); __builtin_amdgcn_s_barrier(); asm volatile("" ::: "memory");
#pragma unroll 1
    for (int n0 = 0; n0 < 128; n0 += 4) {
        SCAN_LOAD(o3, n0 + 3); SCAN_STEP(o0, n0);
        SCAN_LOAD(o0, n0 + 4); SCAN_STEP(o1, n0 + 1);
        SCAN_LOAD(o1, n0 + 5); SCAN_STEP(o2, n0 + 2);
        SCAN_LOAD(o2, n0 + 6); SCAN_STEP(o3, n0 + 3);
    }
#undef SCAN_LOAD
#undef SCAN_STEP
    float* so = F.out + O_GSP + (size_t)bh * 16384;
#pragma unroll
    for (int r = 0; r < 4; ++r) so[(size_t)(16 * w + 4 * q + r) * 128 + dvs + c] = Sacc[r];
}

__device__ __forceinline__ void gdn_out_item(Frame& F, int item) {
    const int b = item >> 7, n = item & 127, row0 = b * SEQ + 64 * n, lane = F.lane, h = F.wave, c = lane & 15, q = lane >> 4;
    const size_t ci = (size_t)(b * 8 + h) * 128 + n;
    const bf16_t* QN = (const bf16_t*)((const unsigned char*)F.out + DO_QN);
    const bf16_t* SN = (const bf16_t*)(F.ws + WS_SN) + ci * 16384; const bf16_t* VNT = (const bf16_t*)(F.ws + WS_UT) + ci * 8192; const bf16_t* ATT = (const bf16_t*)(F.ws + WS_ATT) + ci * 4096;
    const float* GC = (const float*)(F.ws + WS_GC); const bf16_t* GZ = (const bf16_t*)(F.ws + WS_GZ); bf16_t* OG = (bf16_t*)(F.ws + WS_OG); const float* gn = F.in[I_GNORM];
    LAS bf16_t* ol = (LAS bf16_t*)(F.lds + h * 18432);
    bf16x8 qf[4][4], af[4][2]; float egc[4], ss[4];
#pragma unroll
    for (int it = 0; it < 4; ++it) { const int i = 16 * it + c; const size_t r = (size_t)row0 + i;
#pragma unroll
        for (int s = 0; s < 4; ++s) qf[it][s] = *(const bf16x8*)(QN + r * 1024 + h * 128 + 32 * s + 8 * q);
#pragma unroll
        for (int s = 0; s < 2; ++s) af[it][s] = *(const bf16x8*)(ATT + ((it * 2 + s) * 64 + lane) * 8);
        egc[it] = GC[r * 8 + h]; ss[it] = 0.f; }
#pragma unroll 1
    for (int dt = 0; dt < 8; ++dt) {
        bf16x8 sf[4], vf[2];
#pragma unroll
        for (int s = 0; s < 4; ++s) sf[s] = *(const bf16x8*)(SN + ((dt * 4 + s) * 64 + lane) * 8);
#pragma unroll
        for (int s = 0; s < 2; ++s) vf[s] = *(const bf16x8*)(VNT + ((dt * 2 + s) * 64 + lane) * 8);
#pragma unroll
        for (int it = 0; it < 4; ++it) {
            f32x4 a = {0.f, 0.f, 0.f, 0.f};
#pragma unroll
            for (int s = 0; s < 4; ++s) a = mfma16(sf[s], qf[it][s], a);
            a = a * egc[it];
#pragma unroll
            for (int s = 0; s < 2; ++s) a = mfma16(vf[s], af[it][s], a);
            ss[it] += (a[0] * a[0] + a[1] * a[1]) + (a[2] * a[2] + a[3] * a[3]);
            *(LAS u32x2*)(ol + (16 * it + c) * 136 + 16 * dt + 4 * q) = pack4(a);
        }
    }
    float rs[4];
#pragma unroll
    for (int it = 0; it < 4; ++it) { float s = ss[it]; s += __shfl_xor(s, 16); s += __shfl_xor(s, 32); rs[it] = rsqrtf(s * (1.f / 128.f) + EPS); }
    LDS_WAIT();
#pragma unroll
    for (int it = 0; it < 4; ++it)
#pragma unroll
        for (int dt = 0; dt < 8; ++dt) { const size_t o = ((size_t)row0 + 16 * it + c) * 1024 + h * 128 + 16 * dt + 4 * q; const u32x2 z = *(const u32x2*)(GZ + o); const f32x4 g4 = *(const f32x4*)(gn + 16 * dt + 4 * q);
            const u32x2 pv = *(const LAS u32x2*)(ol + (16 * it + c) * 136 + 16 * dt + 4 * q); f32x4 v;
            v[0] = bf2f(pv.x & 0xffffu) * rs[it] * g4[0] * bf2f(z.x & 0xffffu); v[1] = bf2f(pv.x >> 16) * rs[it] * g4[1] * bf2f(z.x >> 16);
            v[2] = bf2f(pv.y & 0xffffu) * rs[it] * g4[2] * bf2f(z.y & 0xffffu); v[3] = bf2f(pv.y >> 16) * rs[it] * g4[3] * bf2f(z.y >> 16);
            *(u32x2*)(OG + o) = pack4(v); }
    LDS_WAIT();
}

__device__ __forceinline__ void gdn_seq_item(Frame& F, int row0, int L, int h, const float* S0, float* Sout, bf16_t* OG) {
    const bf16_t* QN = (const bf16_t*)((unsigned char*)F.out + DO_QN); const bf16_t* KN = (const bf16_t*)((unsigned char*)F.out + DO_KN); const bf16_t* VNS = (const bf16_t*)((unsigned char*)F.out + DO_VNS);
    const float* Gp = (const float*)(F.ws + WS_G); const float* Bp = (const float*)(F.ws + WS_BETA);
    const int tid = F.tid, dvc = tid & 127, dkq = tid >> 7;
    constexpr int TB = 32;
    LAS float* sq = (LAS float*)F.lds;
    LAS float* sk = sq + TB * 128;
    LAS float* sv = sk + TB * 128;
    LAS float* sg = sv + TB * 128;
    LAS float* red = sg + 2 * TB;
    LAS float* redqk = red + 2 * 2 * 4 * 128;
    float S[32];
#pragma unroll
    for (int i = 0; i < 32; ++i) S[i] = S0 ? S0[(size_t)(32 * dkq + i) * 128 + dvc] : 0.f;
    int buf = 0;
    for (int t0 = 0; t0 < L; t0 += TB) {
        const int nb = (L - t0) < TB ? (L - t0) : TB;
        __syncthreads();
        for (int e = tid; e < nb * 128; e += NTHREADS) { const int tt = e >> 7, c = e & 127; const size_t o = (size_t)(row0 + t0 + tt) * 1024 + h * 128 + c;
            sq[e] = bf2f(QN[o]); sk[e] = bf2f(KN[o]); sv[e] = bf2f(VNS[o - (size_t)MP * 1024]); }
        if (tid < nb) { sg[tid] = expf(Gp[(size_t)(row0 + t0 + tid) * 8 + h]); sg[TB + tid] = Bp[(size_t)(row0 + t0 + tid) * 8 + h]; }
        __syncthreads();
        for (int tt = 0; tt < nb; ++tt) {
            const LAS float* kq = sk + tt * 128 + 32 * dkq; const LAS float* qq = sq + tt * 128 + 32 * dkq;
            float pk = 0.f, pq = 0.f, pqk = 0.f;
#pragma unroll
            for (int i = 0; i < 32; ++i) { const float kk = kq[i], qv = qq[i]; pk += kk * S[i]; pq += qv * S[i]; pqk += qv * kk; }
            LAS float* rb = red + buf * 1024;
            rb[dkq * 128 + dvc] = pk; rb[512 + dkq * 128 + dvc] = pq; if (dvc == 0) redqk[buf * 4 + dkq] = pqk;
            __syncthreads();
            const float kS = (rb[dvc] + rb[128 + dvc]) + (rb[256 + dvc] + rb[384 + dvc]);
            const float qS = (rb[512 + dvc] + rb[640 + dvc]) + (rb[768 + dvc] + rb[896 + dvc]);
            const float qk = (redqk[buf * 4] + redqk[buf * 4 + 1]) + (redqk[buf * 4 + 2] + redqk[buf * 4 + 3]);
            const float e = sg[tt], beta = sg[TB + tt];
            const float vnew = beta * (sv[tt * 128 + dvc] - e * kS);
            const float o = e * qS + qk * vnew;
#pragma unroll
            for (int i = 0; i < 32; ++i) S[i] = e * S[i] + kq[i] * vnew;
            if (dkq == 0) OG[(size_t)(row0 + t0 + tt) * 1024 + h * 128 + dvc] = (bf16_t)f2bf(o);
            buf ^= 1;
        }
    }
#pragma unroll
    for (int i = 0; i < 32; ++i) Sout[(size_t)(32 * dkq + i) * 128 + dvc] = S[i];
    __syncthreads();
}
__device__ __forceinline__ void p2_gdn_sample(Frame& F, int wk, int nwk, int lo, int hi) {
    bf16_t* OG = (bf16_t*)(F.ws + WS_OG);
    for (int q = lo + wk; q < hi; q += nwk) { const int bd = q >> 3, h = q & 7; gdn_seq_item(F, MP + bd * 4, 4, h, F.in[I_SGDN] + (size_t)q * 16384, F.out + O_GSS + (size_t)q * 16384, OG); }
}
__device__ __forceinline__ void p2_gdn_norm_sample(Frame& F) {
    const int gw = F.bid * NWAVES + F.wave, NGW = F.G * NWAVES, lane = F.lane;
    bf16_t* OG = (bf16_t*)(F.ws + WS_OG); const bf16_t* GZ = (const bf16_t*)(F.ws + WS_GZ); const float* gn = F.in[I_GNORM];
    for (int it = gw; it < MS * 8; it += NGW) {
        const size_t o = (size_t)(MP + (it >> 3)) * 1024 + (it & 7) * 128 + 2 * lane;
        const unsigned v = *(const unsigned*)(OG + o), z = *(const unsigned*)(GZ + o);
        const float a = bf2f(v & 0xffffu), b = bf2f(v >> 16);
        const float r = rsqrtf(wave_sum(a * a + b * b) * (1.f / 128.f) + EPS);
        *(unsigned*)(OG + o) = pk2(a * r * gn[2 * lane] * bf2f(z & 0xffffu), b * r * gn[2 * lane + 1] * bf2f(z >> 16));
    }
}

__device__ __forceinline__ void swa_wave_item(Frame& F, bool sample, int bidx, int t, int kv) {
    const int lane = F.lane;
    LAS float* qs = (LAS float*)(F.lds + F.wave * 8192);
    LAS float* ps = qs + 512;
    const bf16_t* SQ = (const bf16_t*)(F.ws + WS_SQ); const bf16_t* SKV = (const bf16_t*)(F.ws + WS_SKV); const bf16_t* SZ = (const bf16_t*)(F.ws + WS_SZ);
    const float* BT = (const float*)(F.ws + WS_BTAB);
    const int row = sample ? MP + bidx * 4 + t : bidx * SEQ + t;
    const int qpos = sample ? 128 + t : t;
    for (int e = lane; e < 512; e += 64) qs[e] = bf2f(SQ[(size_t)row * 1024 + kv * 512 + e]);
    LDS_WAIT();
#pragma unroll 1
    for (int u = 0; u < 2; ++u) {
        const int j = lane + 64 * u; const int kp = qpos - j;
        float kr[64];
        const bool valid = kp >= 0;
        if (valid) {
            if (sample && kp < 128) { const float* p = F.in[I_CSK] + (((size_t)bidx * 128 + kp) * 2 + kv) * 64;
#pragma unroll
                for (int d = 0; d < 64; d += 4) { const f32x4 v = *(const f32x4*)(p + d); kr[d] = v.x; kr[d + 1] = v.y; kr[d + 2] = v.z; kr[d + 3] = v.w; } }
            else { const int krow = sample ? MP + bidx * 4 + (kp - 128) : bidx * SEQ + kp; const bf16_t* p = SKV + (size_t)krow * 256 + kv * 64;
#pragma unroll
                for (int d = 0; d < 64; d += 8) { const u32x4 v = *(const u32x4*)(p + d);
                    kr[d] = bf2f(v.x & 0xffffu); kr[d + 1] = bf2f(v.x >> 16); kr[d + 2] = bf2f(v.y & 0xffffu); kr[d + 3] = bf2f(v.y >> 16);
                    kr[d + 4] = bf2f(v.z & 0xffffu); kr[d + 5] = bf2f(v.z >> 16); kr[d + 6] = bf2f(v.w & 0xffffu); kr[d + 7] = bf2f(v.w >> 16); } }
        } else {
#pragma unroll
            for (int d = 0; d < 64; ++d) kr[d] = 0.f;
        }
#pragma unroll 1
        for (int g = 0; g < 8; ++g) { float a = 0.f;
#pragma unroll
            for (int d = 0; d < 64; d += 4) { const f32x4 qv = *(const LAS f32x4*)(qs + g * 64 + d); a += kr[d] * qv.x + kr[d + 1] * qv.y + kr[d + 2] * qv.z + kr[d + 3] * qv.w; }
            ps[g * 128 + j] = valid ? a * 0.125f + BT[(kv * 8 + g) * 128 + j] : -INFINITY; }
    }
    LDS_WAIT();
    float inv[8];
#pragma unroll
    for (int g = 0; g < 8; ++g) {
        const float sink = F.in[I_SINKS][kv * 8 + g];
        const float l0 = ps[g * 128 + lane], l1 = ps[g * 128 + 64 + lane];
        const float mx = fmaxf(wave_max(fmaxf(l0, l1)), sink);
        const float p0 = __expf(l0 - mx), p1 = __expf(l1 - mx);
        const float den = wave_sum(p0 + p1) + __expf(sink - mx);
        inv[g] = 1.f / den;
        ps[g * 128 + lane] = p0; ps[g * 128 + 64 + lane] = p1;
    }
    LDS_WAIT();
    float o[8];
#pragma unroll
    for (int g = 0; g < 8; ++g) o[g] = 0.f;
#pragma unroll 1
    for (int j0 = 0; j0 < 128; j0 += 8) {
        float vv[8];
#pragma unroll
        for (int u = 0; u < 8; ++u) { int kp = qpos - (j0 + u); kp = kp < 0 ? 0 : kp;
            if (sample && kp < 128) vv[u] = F.in[I_CSV][(((size_t)bidx * 128 + kp) * 2 + kv) * 64 + lane];
            else { const int krow = sample ? MP + bidx * 4 + (kp - 128) : bidx * SEQ + kp; vv[u] = bf2f(SKV[(size_t)krow * 256 + 128 + kv * 64 + lane]); } }
#pragma unroll
        for (int u = 0; u < 8; ++u)
#pragma unroll
            for (int g = 0; g < 8; ++g) o[g] += ps[g * 128 + j0 + u] * vv[u];
    }
    bf16_t* OS = (bf16_t*)(F.ws + WS_OS);
#pragma unroll
    for (int g = 0; g < 8; ++g) { const size_t oo = (size_t)row * 1024 + (kv * 8 + g) * 64 + lane; OS[oo] = (bf16_t)f2bf(o[g] * inv[g] * bf2f(SZ[oo])); }
    LDS_WAIT();
}
__device__ __forceinline__ bf16x8 cat8(u32x2 a, u32x2 b) { u32x4 t; t.x = a.x; t.y = a.y; t.z = b.x; t.w = b.y; return __builtin_bit_cast(bf16x8, t); }
__device__ __forceinline__ void mem_mfma_item(Frame& F, int b, int h, int qt) {
    const int lane = F.lane, c = lane & 15, q = lane >> 4;
    const bf16_t* Kp = (const bf16_t*)(F.ws + WS_MEMKV) + (size_t)(b * 256) * 2048 + h * 256;
    const bf16_t* VTp = (const bf16_t*)(F.ws + WS_MVT) + (size_t)((b * 4 + h) * 256) * 256;
    const bf16_t* MQ = (const bf16_t*)(F.ws + WS_MQ); const bf16_t* MZ = (const bf16_t*)(F.ws + WS_MZ); bf16_t* OM = (bf16_t*)(F.ws + WS_OM);
    const size_t qrow = (size_t)b * SEQ + 16 * qt + c;
    bf16x8 qf[8];
#pragma unroll
    for (int s = 0; s < 8; ++s) qf[s] = *(const bf16x8*)(MQ + qrow * 1024 + h * 256 + 32 * s + 8 * q);
    f32x4 sacc[16];
#pragma unroll
    for (int mt = 0; mt < 16; ++mt) { f32x4 a = {0.f, 0.f, 0.f, 0.f};
#pragma unroll
        for (int s = 0; s < 8; ++s) a = mfma16(*(const bf16x8*)(Kp + (size_t)(16 * mt + c) * 2048 + 32 * s + 8 * q), qf[s], a);
        sacc[mt] = a; }
    float mx = -INFINITY;
#pragma unroll
    for (int mt = 0; mt < 16; ++mt) mx = fmaxf(mx, fmaxf(fmaxf(sacc[mt][0], sacc[mt][1]), fmaxf(sacc[mt][2], sacc[mt][3])));
    mx = fmaxf(mx, __shfl_xor(mx, 16)); mx = fmaxf(mx, __shfl_xor(mx, 32));
    float sum = 0.f; const float sc = 0.0625f * 1.4426950408889634f;
#pragma unroll
    for (int mt = 0; mt < 16; ++mt)
#pragma unroll
        for (int r = 0; r < 4; ++r) { const float p = exp2f((sacc[mt][r] - mx) * sc); sacc[mt][r] = p; sum += p; }
    sum += __shfl_xor(sum, 16); sum += __shfl_xor(sum, 32);
    const float inv = 1.f / sum;
    bf16x8 pf[8];
#pragma unroll
    for (int ks = 0; ks < 8; ++ks) pf[ks] = cat8(pack4(sacc[2 * ks]), pack4(sacc[2 * ks + 1]));
#pragma unroll 4
    for (int dt = 0; dt < 16; ++dt) { f32x4 o = {0.f, 0.f, 0.f, 0.f};
#pragma unroll
        for (int ks = 0; ks < 8; ++ks) { const bf16_t* vp = VTp + (size_t)(16 * dt + c) * 256 + 32 * ks + 4 * q;
            o = mfma16(cat8(*(const u32x2*)vp, *(const u32x2*)(vp + 16)), pf[ks], o); }
        const size_t oo = qrow * 1024 + h * 256 + 16 * dt + 4 * q; const u32x2 z = *(const u32x2*)(MZ + oo);
        o[0] *= inv * bf2f(z.x & 0xffffu); o[1] *= inv * bf2f(z.x >> 16); o[2] *= inv * bf2f(z.y & 0xffffu); o[3] *= inv * bf2f(z.y >> 16);
        *(u32x2*)(OM + oo) = pack4(o); }
}
__device__ __forceinline__ void swa_mfma_item(Frame& F, int b, int h, int a) {
    const int lane = F.lane, c = lane & 15, q = lane >> 4, kv = h >> 3;
    const bf16_t* SQ = (const bf16_t*)(F.ws + WS_SQ); const bf16_t* SKV = (const bf16_t*)(F.ws + WS_SKV); const bf16_t* SZ = (const bf16_t*)(F.ws + WS_SZ); bf16_t* OS = (bf16_t*)(F.ws + WS_OS);
    const bf16_t* VTp = (const bf16_t*)(F.ws + WS_VTS) + (size_t)((b * 2 + kv) * 64) * SEQ;
    const LAS float* BTl = (const LAS float*)(F.lds + LDS_BT) + h * 128;
    const size_t qrow = (size_t)b * SEQ + 16 * a + c;
    bf16x8 qf[2];
#pragma unroll
    for (int s = 0; s < 2; ++s) qf[s] = *(const bf16x8*)(SQ + qrow * 1024 + h * 64 + 32 * s + 8 * q);
    f32x4 p[10];
    const float sink = F.in[I_SINKS][h];
    float mx = sink;
#pragma unroll
    for (int u = 0; u < 9; ++u) {
        const int kbase = 16 * (a - 8 + u);
        f32x4 d = {0.f, 0.f, 0.f, 0.f};
        if (kbase >= 0) {
#pragma unroll
            for (int s = 0; s < 2; ++s) d = mfma16(*(const bf16x8*)(SKV + ((size_t)b * SEQ + kbase + c) * 256 + kv * 64 + 32 * s + 8 * q), qf[s], d);
        }
#pragma unroll
        for (int r = 0; r < 4; ++r) { const int dist = (16 * a + c) - (kbase + 4 * q + r); const bool valid = kbase >= 0 && dist >= 0 && dist < 128;
            const float l = valid ? d[r] * 0.125f + BTl[dist & 127] : -INFINITY; d[r] = l; mx = fmaxf(mx, l); }
        p[u] = d;
    }
    mx = fmaxf(mx, __shfl_xor(mx, 16)); mx = fmaxf(mx, __shfl_xor(mx, 32));
    float sum = 0.f;
#pragma unroll
    for (int u = 0; u < 9; ++u)
#pragma unroll
        for (int r = 0; r < 4; ++r) { const float e = __expf(p[u][r] - mx); p[u][r] = e; sum += e; }
    p[9] = (f32x4){0.f, 0.f, 0.f, 0.f};
    sum += __shfl_xor(sum, 16); sum += __shfl_xor(sum, 32);
    const float inv = 1.f / (sum + __expf(sink - mx));
    bf16x8 pf[5];
#pragma unroll
    for (int ks = 0; ks < 5; ++ks) pf[ks] = cat8(pack4(p[2 * ks]), pack4(p[2 * ks + 1]));
#pragma unroll
    for (int dt = 0; dt < 4; ++dt) { f32x4 o = {0.f, 0.f, 0.f, 0.f};
#pragma unroll
        for (int ks = 0; ks < 5; ++ks) { int m0 = 16 * (a - 8 + 2 * ks) + 4 * q, m1 = m0 + 16;
            m0 = m0 < 0 ? 0 : m0; m1 = m1 < 0 ? 0 : (m1 > SEQ - 4 ? SEQ - 4 : m1);
            const bf16_t* vp = VTp + (size_t)(16 * dt + c) * SEQ;
            o = mfma16(cat8(*(const u32x2*)(vp + m0), *(const u32x2*)(vp + m1)), pf[ks], o); }
        const size_t oo = qrow * 1024 + h * 64 + 16 * dt + 4 * q; const u32x2 z = *(const u32x2*)(SZ + oo);
        o[0] *= inv * bf2f(z.x & 0xffffu); o[1] *= inv * bf2f(z.x >> 16); o[2] *= inv * bf2f(z.y & 0xffffu); o[3] *= inv * bf2f(z.y >> 16);
        *(u32x2*)(OS + oo) = pack4(o); }
}
__device__ __forceinline__ void swa_wg_item(Frame& F, int b, int kv, int qb) {
    int lane_ = F.lane, tid_ = F.tid; asm volatile("" : "+v"(lane_), "+v"(tid_));
    const int lane = lane_, c = lane & 15, q = lane >> 4, tid = tid_, h = kv * 8 + F.wave;
    const bf16_t* SQ = (const bf16_t*)(F.ws + WS_SQ); const bf16_t* SKV = (const bf16_t*)(F.ws + WS_SKV); const bf16_t* SZ = (const bf16_t*)(F.ws + WS_SZ); bf16_t* OS = (bf16_t*)(F.ws + WS_OS);
    const bf16_t* VTg = (const bf16_t*)(F.ws + WS_VTS) + (size_t)((b * 2 + kv) * 64) * SEQ;
    LAS unsigned char* Kl = F.lds; LAS unsigned char* Vl = F.lds + 32768;
    const LAS float* BTl = (const LAS float*)(F.lds + LDS_BT) + h * 128;
    const int kstart = 128 * (qb - 1);
    __syncthreads();
    {   u32x4 kr[4], vr[4];
#pragma unroll
        for (int u = 0; u < 4; ++u) { const int p = tid + 512 * u, key = p >> 3, ch = p & 7;
            kr[u] = (kstart + key >= 0) ? *(const u32x4*)(SKV + ((size_t)b * SEQ + kstart + key) * 256 + kv * 64 + ch * 8) : (u32x4){0u, 0u, 0u, 0u};
            const int d = p >> 5, c16 = p & 31;
            vr[u] = (kstart + c16 * 8 >= 0) ? *(const u32x4*)(VTg + (size_t)d * SEQ + kstart + c16 * 8) : (u32x4){0u, 0u, 0u, 0u}; }
#pragma unroll
        for (int u = 0; u < 4; ++u) { const int p = tid + 512 * u, key = p >> 3, ch = p & 7;
            *(LAS u32x4*)(Kl + key * 128 + ((ch ^ ((key >> 1) & 7)) << 4)) = kr[u];
            const int d = p >> 5, c16 = p & 31;
            *(LAS u32x4*)(Vl + d * 512 + (((2 * c16) ^ (2 * (d & 15))) << 3)) = vr[u]; } }
    __syncthreads();
    const float L2E = 1.4426950408889634f;
    const float sink = F.in[I_SINKS][h] * L2E;
    float bias[9][4];
#pragma unroll
    for (int u = 0; u < 9; ++u)
#pragma unroll
        for (int r = 0; r < 4; ++r) { const int dist = 128 - 16 * u + c - 4 * q - r; bias[u][r] = (dist >= 0 && dist < 128) ? BTl[dist & 127] * L2E : -INFINITY; }
    bf16x8 qfa[8][2];
#pragma unroll
    for (int ap = 0; ap < 8; ++ap)
#pragma unroll
        for (int s = 0; s < 2; ++s) qfa[ap][s] = *(const bf16x8*)(SQ + ((size_t)b * SEQ + 128 * qb + 16 * ap + c) * 1024 + h * 64 + 32 * s + 8 * q);
#pragma unroll
    for (int ap = 0; ap < 8; ++ap) {
        const size_t qrow = (size_t)b * SEQ + 128 * qb + 16 * ap + c;
        bf16x8 qf[2]; qf[0] = qfa[ap][0]; qf[1] = qfa[ap][1];
        LAS bf16_t* ow = (LAS bf16_t*)(F.lds + 65536 + F.wave * 2304);
        u32x4 zz[2];
#pragma unroll
        for (int u = 0; u < 2; ++u) { const int p = lane + 64 * u; zz[u] = *(const u32x4*)(SZ + ((size_t)b * SEQ + 128 * qb + 16 * ap + (p >> 3)) * 1024 + h * 64 + (p & 7) * 8); }
        f32x4 p[10]; float mx = sink;
#pragma unroll
        for (int u = 0; u < 9; ++u) {
            const int wt = ap + u, row = 16 * wt + c;
            f32x4 d = {0.f, 0.f, 0.f, 0.f};
#pragma unroll
            for (int s = 0; s < 2; ++s) d = mfma16(*(const LAS bf16x8*)(Kl + row * 128 + (((4 * s + q) ^ ((row >> 1) & 7)) << 4)), qf[s], d);
            const float tmask = ((qb > 0) || (wt >= 8)) ? 0.f : -INFINITY;
#pragma unroll
            for (int r = 0; r < 4; ++r) { const float l = d[r] * (0.125f * L2E) + (bias[u][r] + tmask); d[r] = l; mx = fmaxf(mx, l); }
            p[u] = d;
        }
        mx = fmaxf(mx, __shfl_xor(mx, 16)); mx = fmaxf(mx, __shfl_xor(mx, 32));
        float sum = 0.f;
#pragma unroll
        for (int u = 0; u < 9; ++u)
#pragma unroll
            for (int r = 0; r < 4; ++r) { const float e = exp2f(p[u][r] - mx); p[u][r] = e; sum += e; }
        p[9] = (f32x4){0.f, 0.f, 0.f, 0.f};
        sum += __shfl_xor(sum, 16); sum += __shfl_xor(sum, 32);
        const float inv = 1.f / (sum + exp2f(sink - mx));
        bf16x8 pf[5];
#pragma unroll
        for (int ks = 0; ks < 5; ++ks) pf[ks] = cat8(pack4(p[2 * ks]), pack4(p[2 * ks + 1]));
#pragma unroll
        for (int dt = 0; dt < 4; ++dt) { f32x4 o = {0.f, 0.f, 0.f, 0.f}; const int dd = 16 * dt + c; const LAS unsigned char* vrow = Vl + dd * 512; const int sw = 2 * (dd & 15);
#pragma unroll
            for (int ks = 0; ks < 5; ++ks) { const int wt0 = ap + 2 * ks; int wt1 = wt0 + 1; wt1 = wt1 > 15 ? 15 : wt1;
                const u32x2 v0 = *(const LAS u32x2*)(vrow + (((4 * wt0 + q) ^ sw) << 3)), v1 = *(const LAS u32x2*)(vrow + (((4 * wt1 + q) ^ sw) << 3));
                o = mfma16(cat8(v0, v1), pf[ks], o); }
            o = o * inv; *(LAS u32x2*)(ow + c * 72 + 16 * dt + 4 * q) = pack4(o); }
        LDS_WAIT();
#pragma unroll
        for (int u = 0; u < 2; ++u) { const int p = lane + 64 * u, rr = p >> 3, ch = p & 7; const u32x4 pv = *(const LAS u32x4*)(ow + rr * 72 + ch * 8), z = zz[u]; u32x4 w;
            w.x = pk2(bf2f(pv.x & 0xffffu) * bf2f(z.x & 0xffffu), bf2f(pv.x >> 16) * bf2f(z.x >> 16)); w.y = pk2(bf2f(pv.y & 0xffffu) * bf2f(z.y & 0xffffu), bf2f(pv.y >> 16) * bf2f(z.y >> 16));
            w.z = pk2(bf2f(pv.z & 0xffffu) * bf2f(z.z & 0xffffu), bf2f(pv.z >> 16) * bf2f(z.z >> 16)); w.w = pk2(bf2f(pv.w & 0xffffu) * bf2f(z.w & 0xffffu), bf2f(pv.w >> 16) * bf2f(z.w >> 16));
            *(u32x4*)(OS + ((size_t)b * SEQ + 128 * qb + 16 * ap + rr) * 1024 + h * 64 + ch * 8) = w; }
        LDS_WAIT(); asm volatile("" ::: "memory");
    }
}
__device__ __forceinline__ void mem_wg_item(Frame& F, int b, int h, int qblk) {
    int lane_ = F.lane, tid_ = F.tid; asm volatile("" : "+v"(lane_), "+v"(tid_));
    const int lane = lane_, c = lane & 15, q = lane >> 4, tid = tid_, w = F.wave;
    const bf16_t* Kg = (const bf16_t*)(F.ws + WS_MEMKV) + (size_t)(b * 256) * 2048 + h * 256;
    const bf16_t* VTg = (const bf16_t*)(F.ws + WS_MVT) + (size_t)((b * 4 + h) * 256) * 256;
    const bf16_t* MQ = (const bf16_t*)(F.ws + WS_MQ); const bf16_t* MZ = (const bf16_t*)(F.ws + WS_MZ); bf16_t* OM = (bf16_t*)(F.ws + WS_OM);
    LAS unsigned char* L = F.lds;
    __syncthreads();
#pragma unroll
    for (int hf = 0; hf < 2; ++hf) { u32x4 kr[8];
#pragma unroll
        for (int u = 0; u < 8; ++u) { const int p = tid + 512 * (u + 8 * hf), key = p >> 5, ch = p & 31; kr[u] = *(const u32x4*)(Kg + (size_t)key * 2048 + ch * 8); }
#pragma unroll
        for (int u = 0; u < 8; ++u) { const int p = tid + 512 * (u + 8 * hf), key = p >> 5, ch = p & 31; *(LAS u32x4*)(L + key * 512 + ((ch ^ (key & 15)) << 4)) = kr[u]; } }
    __syncthreads();
    size_t qrow[2];
#pragma unroll
    for (int t = 0; t < 2; ++t) qrow[t] = (size_t)b * SEQ + 256 * qblk + 32 * w + 16 * t + c;
    f32x4 sacc[2][16];
#pragma unroll
    for (int mt = 0; mt < 16; ++mt) { sacc[0][mt] = (f32x4){0.f, 0.f, 0.f, 0.f}; sacc[1][mt] = (f32x4){0.f, 0.f, 0.f, 0.f}; }
    bf16x8 qn0 = *(const bf16x8*)(MQ + qrow[0] * 1024 + h * 256 + 8 * q), qn1 = *(const bf16x8*)(MQ + qrow[1] * 1024 + h * 256 + 8 * q);
#pragma unroll 1
    for (int s = 0; s < 8; ++s) {
        const bf16x8 q0 = qn0, q1 = qn1; const int sn = s < 7 ? s + 1 : 7;
        qn0 = *(const bf16x8*)(MQ + qrow[0] * 1024 + h * 256 + 32 * sn + 8 * q); qn1 = *(const bf16x8*)(MQ + qrow[1] * 1024 + h * 256 + 32 * sn + 8 * q);
#pragma unroll
        for (int mt = 0; mt < 16; ++mt) { const int row = 16 * mt + c;
            const bf16x8 kf = *(const LAS bf16x8*)(L + row * 512 + (((4 * s + q) ^ (row & 15)) << 4));
            sacc[0][mt] = mfma16(kf, q0, sacc[0][mt]); sacc[1][mt] = mfma16(kf, q1, sacc[1][mt]); }
        asm volatile("" ::: "memory");
    }
    float inv[2]; bf16x8 pf[2][8];
    const float sc = 0.0625f * 1.4426950408889634f;
#pragma unroll
    for (int t = 0; t < 2; ++t) { float mx = -INFINITY;
#pragma unroll
        for (int mt = 0; mt < 16; ++mt) mx = fmaxf(mx, fmaxf(fmaxf(sacc[t][mt][0], sacc[t][mt][1]), fmaxf(sacc[t][mt][2], sacc[t][mt][3])));
        mx = fmaxf(mx, __shfl_xor(mx, 16)); mx = fmaxf(mx, __shfl_xor(mx, 32));
        float sum = 0.f;
#pragma unroll
        for (int mt = 0; mt < 16; ++mt)
#pragma unroll
            for (int r = 0; r < 4; ++r) { const float e = exp2f((sacc[t][mt][r] - mx) * sc); sacc[t][mt][r] = e; sum += e; }
        sum += __shfl_xor(sum, 16); sum += __shfl_xor(sum, 32); inv[t] = 1.f / sum;
#pragma unroll
        for (int ks = 0; ks < 8; ++ks) pf[t][ks] = cat8(pack4(sacc[t][2 * ks]), pack4(sacc[t][2 * ks + 1])); }
    __syncthreads();
#pragma unroll
    for (int hf = 0; hf < 2; ++hf) { u32x4 vr[8];
#pragma unroll
        for (int u = 0; u < 8; ++u) { const int p = tid + 512 * (u + 8 * hf), d = p >> 5, c16 = p & 31; vr[u] = *(const u32x4*)(VTg + (size_t)d * 256 + c16 * 8); }
#pragma unroll
        for (int u = 0; u < 8; ++u) { const int p = tid + 512 * (u + 8 * hf), d = p >> 5, c16 = p & 31; *(LAS u32x4*)(L + d * 512 + (((2 * c16) ^ (2 * (d & 15))) << 3)) = vr[u]; } }
    __syncthreads();
    LAS bf16_t* ow = (LAS bf16_t*)(F.lds + 131072 + w * 2048);
#pragma unroll 1
    for (int dg = 0; dg < 4; ++dg) {
        f32x4 oacc1[4];
#pragma unroll
        for (int d4 = 0; d4 < 4; ++d4) { const int dt = 4 * dg + d4; f32x4 o0 = {0.f, 0.f, 0.f, 0.f}, o1 = {0.f, 0.f, 0.f, 0.f}; const int dd = 16 * dt + c; const LAS unsigned char* vrow = L + dd * 512; const int sw = 2 * (dd & 15);
#pragma unroll
            for (int ks = 0; ks < 8; ++ks) { const bf16x8 vf = cat8(*(const LAS u32x2*)(vrow + (((8 * ks + q) ^ sw) << 3)), *(const LAS u32x2*)(vrow + (((8 * ks + 4 + q) ^ sw) << 3)));
                o0 = mfma16(vf, pf[0][ks], o0); o1 = mfma16(vf, pf[1][ks], o1); }
            *(LAS u32x2*)(ow + c * 64 + 16 * d4 + 4 * q) = pack4(o0 * inv[0]); oacc1[d4] = o1 * inv[1]; }
#pragma unroll
        for (int t = 0; t < 2; ++t) {
            u32x4 zz[2];
#pragma unroll
            for (int u = 0; u < 2; ++u) { const int p = lane + 64 * u; zz[u] = *(const u32x4*)(MZ + ((size_t)b * SEQ + 256 * qblk + 32 * w + 16 * t + (p >> 3)) * 1024 + h * 256 + 64 * dg + (p & 7) * 8); }
            if (t == 1) {
#pragma unroll
                for (int d4 = 0; d4 < 4; ++d4) *(LAS u32x2*)(ow + c * 64 + 16 * d4 + 4 * q) = pack4(oacc1[d4]); }
            LDS_WAIT();
#pragma unroll
            for (int u = 0; u < 2; ++u) { const int p = lane + 64 * u, rr = p >> 3, ch = p & 7; const u32x4 pv = *(const LAS u32x4*)(ow + rr * 64 + ch * 8), z = zz[u]; u32x4 wv;
                wv.x = pk2(bf2f(pv.x & 0xffffu) * bf2f(z.x & 0xffffu), bf2f(pv.x >> 16) * bf2f(z.x >> 16)); wv.y = pk2(bf2f(pv.y & 0xffffu) * bf2f(z.y & 0xffffu), bf2f(pv.y >> 16) * bf2f(z.y >> 16));
                wv.z = pk2(bf2f(pv.z & 0xffffu) * bf2f(z.z & 0xffffu), bf2f(pv.z >> 16) * bf2f(z.z >> 16)); wv.w = pk2(bf2f(pv.w & 0xffffu) * bf2f(z.w & 0xffffu), bf2f(pv.w >> 16) * bf2f(z.w >> 16));
                *(u32x4*)(OM + ((size_t)b * SEQ + 256 * qblk + 32 * w + 16 * t + rr) * 1024 + h * 256 + 64 * dg + ch * 8) = wv; }
            LDS_WAIT(); asm volatile("" ::: "memory");
        }
    }
}
__device__ __forceinline__ void p2_attn_prompt(Frame& F, int wk, int nwk) {
    const int gw = wk * NWAVES + F.wave, NGW = nwk * NWAVES, lane = F.lane;
    for (int it = wk; it < 256; it += nwk) { const int qblk = it & 31, bh = it >> 5; mem_wg_item(F, bh >> 2, bh & 3, qblk); }
    __syncthreads();
    { LAS float* BTl = (LAS float*)(F.lds + LDS_BT); const float* BT = (const float*)(F.ws + WS_BTAB); for (int i = F.tid; i < 2048; i += NTHREADS) BTl[i] = BT[i]; }
    __syncthreads();
    for (int it = wk; it < 256; it += nwk) { const int qb = it & 63, bk = it >> 6; swa_wg_item(F, bk >> 1, bk & 1, qb); }
    __syncthreads();
    const bf16_t* SKV = (const bf16_t*)(F.ws + WS_SKV);
    for (int it = gw; it < 256; it += NGW) { const int b = it >> 7, j = it & 127; const bf16_t* pp = SKV + (size_t)(b * SEQ + SEQ - 128 + j) * 256;
        for (int cc = lane; cc < 128; cc += 64) { F.out[O_SKP + ((size_t)b * 128 + j) * 128 + cc] = bf2f(pp[cc]); F.out[O_SVP + ((size_t)b * 128 + j) * 128 + cc] = bf2f(pp[128 + cc]); } }
}
__device__ __forceinline__ void p2_swa_sample(Frame& F, int wk, int nwk) {
    const int gw = wk * NWAVES + F.wave, NGW = nwk * NWAVES, lane = F.lane;
    const bf16_t* SKV = (const bf16_t*)(F.ws + WS_SKV);
    for (int it = gw; it < MS * 2; it += NGW) { const int r = it >> 1, kv = it & 1; swa_wave_item(F, true, r >> 2, r & 3, kv); }
    { const u32x4* s4 = (const u32x4*)(F.ws + WS_OMS); u32x4* d4 = (u32x4*)(F.ws + WS_OM + (size_t)MP * 1024 * 2); for (int i = gw * 64 + lane; i < MS * 1024 / 8; i += NGW * 64) d4[i] = s4[i]; }
    { const int gt = gw * 64 + lane, NT = NGW * 64;
        for (int i = gt; i < 128 * 124 * 32; i += NT) { const int bd = i / (124 * 32), e = i - bd * (124 * 32);
            ((f32x4*)(F.out + O_SKS + (size_t)bd * 16384))[e] = ((const f32x4*)(F.in[I_CSK] + (size_t)bd * 16384 + 512))[e];
            ((f32x4*)(F.out + O_SVS + (size_t)bd * 16384))[e] = ((const f32x4*)(F.in[I_CSV] + (size_t)bd * 16384 + 512))[e]; }
        for (int i = gt; i < 128 * 4 * 128; i += NT) { const int bd = i >> 9, jj = (i >> 7) & 3, cc = i & 127; const bf16_t* pp = SKV + (size_t)(MP + bd * 4 + jj) * 256;
            F.out[O_SKS + ((size_t)bd * 128 + 124 + jj) * 128 + cc] = bf2f(pp[cc]); F.out[O_SVS + ((size_t)bd * 128 + 124 + jj) * 128 + cc] = bf2f(pp[128 + cc]); } }
}
__device__ __forceinline__ void mem_sample_item(Frame& F, int bd, int hp) {
    const int lane = F.lane, w = F.wave, tid = F.tid, hl = lane >> 5, h = 2 * hp + hl, d0 = (lane & 31) * 8;
    const bf16_t* MQ = (const bf16_t*)(F.ws + WS_MQ); const bf16_t* MZ = (const bf16_t*)(F.ws + WS_MZ); bf16_t* OM = (bf16_t*)(F.ws + WS_OM);
    LAS float* lg = (LAS float*)F.lds;
    LAS float* isum = lg + 2048;
    LAS float* po = isum + 8;
    float qr[4][8];
#pragma unroll
    for (int s = 0; s < 4; ++s) { const u32x4 v = *(const u32x4*)(MQ + (size_t)(MP + bd * 4 + s) * 1024 + h * 256 + d0);
        qr[s][0] = bf2f(v.x & 0xffffu); qr[s][1] = bf2f(v.x >> 16); qr[s][2] = bf2f(v.y & 0xffffu); qr[s][3] = bf2f(v.y >> 16);
        qr[s][4] = bf2f(v.z & 0xffffu); qr[s][5] = bf2f(v.z >> 16); qr[s][6] = bf2f(v.w & 0xffffu); qr[s][7] = bf2f(v.w >> 16); }
    const float* Kc = F.in[I_CMK] + ((size_t)bd * 256 * 4 + h) * 256 + d0; const float* Vc = F.in[I_CMV] + ((size_t)bd * 256 * 4 + h) * 256 + d0;
#pragma unroll 4
    for (int i = 0; i < 32; ++i) { const int m = w + 8 * i; const f32x4 k0 = *(const f32x4*)(Kc + (size_t)m * 1024), k1 = *(const f32x4*)(Kc + (size_t)m * 1024 + 4);
        float l[4];
#pragma unroll
        for (int s = 0; s < 4; ++s) { float a = k0.x * qr[s][0] + k0.y * qr[s][1] + k0.z * qr[s][2] + k0.w * qr[s][3] + k1.x * qr[s][4] + k1.y * qr[s][5] + k1.z * qr[s][6] + k1.w * qr[s][7];
#pragma unroll
            for (int o = 1; o < 32; o <<= 1) a += __shfl_xor(a, o);
            l[s] = a * 0.0625f; }
        if ((lane & 31) == 0) {
#pragma unroll
            for (int s = 0; s < 4; ++s) lg[(hl * 4 + s) * 256 + m] = l[s]; } }
    __syncthreads();
    { const int pr = w; float l4[4];
#pragma unroll
        for (int u = 0; u < 4; ++u) l4[u] = lg[pr * 256 + lane + 64 * u];
        const float mx = wave_max(fmaxf(fmaxf(l4[0], l4[1]), fmaxf(l4[2], l4[3]))); float s = 0.f;
#pragma unroll
        for (int u = 0; u < 4; ++u) { l4[u] = __expf(l4[u] - mx); s += l4[u]; lg[pr * 256 + lane + 64 * u] = l4[u]; }
        s = wave_sum(s); if (lane == 0) isum[pr] = 1.f / s; }
    __syncthreads();
    float o[4][8];
#pragma unroll
    for (int s = 0; s < 4; ++s)
#pragma unroll
        for (int j = 0; j < 8; ++j) o[s][j] = 0.f;
#pragma unroll 4
    for (int i = 0; i < 32; ++i) { const int m = w + 8 * i; const f32x4 v0 = *(const f32x4*)(Vc + (size_t)m * 1024), v1 = *(const f32x4*)(Vc + (size_t)m * 1024 + 4);
#pragma unroll
        for (int s = 0; s < 4; ++s) { const float p = lg[(hl * 4 + s) * 256 + m];
            o[s][0] += p * v0.x; o[s][1] += p * v0.y; o[s][2] += p * v0.z; o[s][3] += p * v0.w; o[s][4] += p * v1.x; o[s][5] += p * v1.y; o[s][6] += p * v1.z; o[s][7] += p * v1.w; } }
#pragma unroll
    for (int s = 0; s < 4; ++s) { LAS float* pp = po + ((w * 4 + s) * 512 + hl * 256 + d0);
        *(LAS f32x4*)pp = (f32x4){o[s][0], o[s][1], o[s][2], o[s][3]}; *(LAS f32x4*)(pp + 4) = (f32x4){o[s][4], o[s][5], o[s][6], o[s][7]}; }
    __syncthreads();
#pragma unroll
    for (int u = 0; u < 4; ++u) { const int e = tid + 512 * u, s = e >> 9, cc = e & 511; float a = 0.f;
#pragma unroll
        for (int ww = 0; ww < 8; ++ww) a += po[(ww * 4 + s) * 512 + cc];
        const int hh = 2 * hp + (cc >> 8); const size_t oo = (size_t)(MP + bd * 4 + s) * 1024 + hh * 256 + (cc & 255);
        ((bf16_t*)(F.ws + WS_OMS))[oo - (size_t)MP * 1024] = (bf16_t)f2bf(a * isum[(cc >> 8) * 4 + s] * bf2f(MZ[oo])); }
    __syncthreads();
}

struct SchedP3 {
    int G, c; const unsigned char* ws;
    __device__ __forceinline__ int ntiles(const pg8::Unit&) const { return 1024 / 64; }
    __device__ __forceinline__ bool next(int i, pg8::Unit& u) const {
        if (i < 6) { const int round = i / 3, b = i - round * 3; pg8::tile_of(round * G + c, 64, 8, u.pm, u.pn); u.job = b; return true; }
        if (i == 6 && c < 48) { u.pm = 64 + c / 24; const int rem = c % 24; u.pn = rem / 3; u.job = rem % 3; return true; }
        return false;
    }
    __device__ __forceinline__ void ptrs(const pg8::Unit& u, const char*& A, const char*& B) const {
        A = (const char*)ws + WS_OG + (size_t)u.job * M * 1024 * 2 + (size_t)u.pm * 256 * 1024 * 2;
        B = (const char*)ws + WS_WB + (size_t)u.job * 2048 * 1024 * 2 + (size_t)u.pn * 256 * 1024 * 2;
    }
};
struct EpiP3 {
    unsigned char* ws;
    __device__ __forceinline__ void operator()(const f32x4 (&acc)[2][2][4][2], const pg8::Unit& u, int wr, int wc, int fr, int fq) const {
        const int row0 = u.pm * 256 + wr * 64 + fr, col0 = u.pn * 256 + wc * 32 + 8 * fq, b = u.job;
        const bf16_t* GT = (const bf16_t*)(ws + WS_GATES); bf16_t* MG = (bf16_t*)(ws + WS_MERGED);
        const bool rmw = (b > 0) && (u.pm < 64);
#pragma unroll
        for (int ai = 0; ai < 2; ++ai) {
            u32x4 g[4][2], p[4][2];
#pragma unroll
            for (int m = 0; m < 4; ++m)
#pragma unroll
                for (int bj = 0; bj < 2; ++bj) { const int r = row0 + ai * 128 + m * 16, c = col0 + bj * 128;
                    g[m][bj] = *(const u32x4*)(GT + (size_t)r * 6144 + b * 2048 + c);
                    p[m][bj] = rmw ? *(const u32x4*)(MG + (size_t)r * 2048 + c) : (u32x4){0u, 0u, 0u, 0u}; }
#pragma unroll
            for (int m = 0; m < 4; ++m)
#pragma unroll
                for (int bj = 0; bj < 2; ++bj) { const int r = row0 + ai * 128 + m * 16, c = col0 + bj * 128;
                    const u32x4 gg = g[m][bj], pp = p[m][bj];
                    f32x4 v0 = acc[ai][bj][m][0], v1 = acc[ai][bj][m][1];
                    v0[0] = v0[0] * bf2f(gg.x & 0xffffu) + bf2f(pp.x & 0xffffu); v0[1] = v0[1] * bf2f(gg.x >> 16) + bf2f(pp.x >> 16); v0[2] = v0[2] * bf2f(gg.y & 0xffffu) + bf2f(pp.y & 0xffffu); v0[3] = v0[3] * bf2f(gg.y >> 16) + bf2f(pp.y >> 16);
                    v1[0] = v1[0] * bf2f(gg.z & 0xffffu) + bf2f(pp.z & 0xffffu); v1[1] = v1[1] * bf2f(gg.z >> 16) + bf2f(pp.z >> 16); v1[2] = v1[2] * bf2f(gg.w & 0xffffu) + bf2f(pp.w & 0xffffu); v1[3] = v1[3] * bf2f(gg.w >> 16) + bf2f(pp.w >> 16);
                    u32x4 w; w.x = pg8::cvt_pk_bf16(v0[0], v0[1]); w.y = pg8::cvt_pk_bf16(v0[2], v0[3]); w.z = pg8::cvt_pk_bf16(v1[0], v1[1]); w.w = pg8::cvt_pk_bf16(v1[2], v1[3]);
                    u32x4* mp = u.pm < 64 ? (u32x4*)(MG + (size_t)r * 2048 + c) : (u32x4*)((bf16_t*)(ws + WS_PS) + ((size_t)b * MS + (r - MP)) * 2048 + c);
                    *mp = w; }
        }
    }
};

struct SchedP4 {
    int G, c; const unsigned char* ws;
    __device__ __forceinline__ int ntiles(const pg8::Unit& u) const { return u.job == 0 ? D / 64 : 512 / 64; }
    __device__ __forceinline__ bool next(int i, pg8::Unit& u) const {
        if (i < 2) { pg8::tile_of(i * G + c, 64, 8, u.pm, u.pn); u.job = 0; return true; }
        if (i == 2 && c < 64) { u.pm = 64 + c / 32; const int rem = c % 32; u.pn = rem / 4; u.job = 1 + (rem & 3); return true; }
        return false;
    }
    __device__ __forceinline__ void ptrs(const pg8::Unit& u, const char*& A, const char*& B) const {
        const size_t ko = u.job == 0 ? 0 : (size_t)(u.job - 1) * 512 * 2;
        A = (const char*)ws + WS_MERGED + (size_t)u.pm * 256 * 2048 * 2 + ko; B = (const char*)ws + WS_WO + (size_t)u.pn * 256 * 2048 * 2 + ko;
    }
};
struct EpiP4 {
    unsigned char* ws; float* out; const float* xp; const float* xs;
    __device__ __forceinline__ void operator()(const f32x4 (&acc)[2][2][4][2], const pg8::Unit& u, int wr, int wc, int fr, int fq) const {
        const int row0 = u.pm * 256 + wr * 64 + fr, col0 = u.pn * 256 + wc * 32 + 8 * fq;
        if (u.job != 0) {
#pragma unroll
            for (int ai = 0; ai < 2; ++ai)
#pragma unroll
                for (int m = 0; m < 4; ++m) { const int r = row0 + ai * 128 + m * 16; float* yp = (float*)(ws + WS_YP) + ((size_t)(u.job - 1) * MS + (r - MP)) * D;
#pragma unroll
                    for (int bj = 0; bj < 2; ++bj) { const int c = col0 + bj * 128; *(f32x4*)(yp + c) = acc[ai][bj][m][0]; *(f32x4*)(yp + c + 4) = acc[ai][bj][m][1]; } }
            return;
        }
#pragma unroll
        for (int ai = 0; ai < 2; ++ai)
#pragma unroll
            for (int mh = 0; mh < 2; ++mh) {
                f32x4 xv[2][2][2];
#pragma unroll
                for (int mm = 0; mm < 2; ++mm)
#pragma unroll
                    for (int bj = 0; bj < 2; ++bj) { const float* xr = xp + (size_t)(row0 + ai * 128 + (2 * mh + mm) * 16) * D + col0 + bj * 128; xv[mm][bj][0] = *(const f32x4*)xr; xv[mm][bj][1] = *(const f32x4*)(xr + 4); }
#pragma unroll
                for (int mm = 0; mm < 2; ++mm)
#pragma unroll
                    for (int bj = 0; bj < 2; ++bj) { float* yr = out + (size_t)(row0 + ai * 128 + (2 * mh + mm) * 16) * D + col0 + bj * 128;
                        *(f32x4*)yr = acc[ai][bj][2 * mh + mm][0] + xv[mm][bj][0]; *(f32x4*)(yr + 4) = acc[ai][bj][2 * mh + mm][1] + xv[mm][bj][1]; }
            }
    }
};
__device__ __forceinline__ void p3_combine_sample(Frame& F) {
    const u32x4* ps = (const u32x4*)(F.ws + WS_PS); u32x4* mg = (u32x4*)(F.ws + WS_MERGED + (size_t)MP * 2048 * 2);
    constexpr int NV = MS * 2048 / 8;
    for (int i = F.bid * NTHREADS + F.tid; i < NV; i += F.G * NTHREADS) { const u32x4 a = ps[i], b = ps[NV + i], c = ps[2 * NV + i]; u32x4 o;
        o.x = pk2(bf2f(a.x & 0xffffu) + bf2f(b.x & 0xffffu) + bf2f(c.x & 0xffffu), bf2f(a.x >> 16) + bf2f(b.x >> 16) + bf2f(c.x >> 16));
        o.y = pk2(bf2f(a.y & 0xffffu) + bf2f(b.y & 0xffffu) + bf2f(c.y & 0xffffu), bf2f(a.y >> 16) + bf2f(b.y >> 16) + bf2f(c.y >> 16));
        o.z = pk2(bf2f(a.z & 0xffffu) + bf2f(b.z & 0xffffu) + bf2f(c.z & 0xffffu), bf2f(a.z >> 16) + bf2f(b.z >> 16) + bf2f(c.z >> 16));
        o.w = pk2(bf2f(a.w & 0xffffu) + bf2f(b.w & 0xffffu) + bf2f(c.w & 0xffffu), bf2f(a.w >> 16) + bf2f(b.w >> 16) + bf2f(c.w >> 16));
        mg[i] = o; }
}
__device__ __forceinline__ void p5_final_norm(Frame& F) {
    const int gw = F.bid * NWAVES + F.wave, NGW = F.G * NWAVES, lane = F.lane;
    const f32x4* wn = (const f32x4*)F.in[I_NORMF] + lane;
    for (int r = gw; r < M; r += NGW) {
        f32x4* y = (f32x4*)(F.out + (size_t)r * D) + lane;
        f32x4 v[8]; float s = 0.f;
        if (r >= MP) { const f32x4* xs4 = (const f32x4*)(F.in[I_XS] + (size_t)(r - MP) * D) + lane; const f32x4* yp4 = (const f32x4*)((const float*)(F.ws + WS_YP) + (size_t)(r - MP) * D) + lane;
#pragma unroll
            for (int j = 0; j < 8; ++j) { f32x4 a = xs4[64 * j];
#pragma unroll
                for (int kq = 0; kq < 4; ++kq) a = a + yp4[(size_t)kq * MS * D / 4 + 64 * j];
                v[j] = a; s += (a.x * a.x + a.y * a.y) + (a.z * a.z + a.w * a.w); } }
        else
#pragma unroll
        for (int j = 0; j < 8; ++j) { v[j] = y[64 * j]; s += (v[j].x * v[j].x + v[j].y * v[j].y) + (v[j].z * v[j].z + v[j].w * v[j].w); }
        const float sc = rsqrtf(wave_sum(s) * (1.f / D) + EPS);
#pragma unroll
        for (int j = 0; j < 8; ++j) { const f32x4 w = wn[64 * j]; f32x4 o = v[j]; o.x *= sc * w.x; o.y *= sc * w.y; o.z *= sc * w.z; o.w *= sc * w.w; y[64 * j] = o; }
    }
}

constexpr int N_PHASES = 10;
__global__ void __launch_bounds__(NTHREADS, 2) hybrid_fwd(Args args) {
    extern __shared__ __attribute__((aligned(16))) unsigned char lds_raw[];
    cg::grid_group grid = cg::this_grid();
    Frame F;
    F.lds = (LAS unsigned char*)lds_raw; F.tid = threadIdx.x; F.lane = F.tid & 63; F.wave = __builtin_amdgcn_readfirstlane(F.tid >> 6);
    F.G = gridDim.x; F.bid = blockIdx.x; F.in = args.in; F.out = args.out; F.ws = args.ws;
    const int lo = args.ph_lo, hi = args.ph_hi;
    if (lo < 0) grid.sync();
    if (F.tid < 64) ((LAS unsigned*)(F.lds + LDS_CTL))[F.tid] = 0u;
    __syncthreads();
    const XcdBarrier bar = xcd_barrier_post((unsigned*)(F.ws + WS_CTL), (volatile LAS unsigned*)(F.lds + LDS_CTL));
#define IN(k) (lo <= (k) && (k) < hi)
#define SEAM(k) do { if (IN(k) && IN((k) + 1)) xcd_barrier(bar); } while (0)
    if (IN(0)) p0_prologue(F);
    SEAM(0);
    if (IN(1)) { SchedP1 S{F.G, F.bid, F.ws, (const unsigned char*)F.out + DO_XN}; EpiP1 E{F.ws, F.out}; pg8::gemm_phase<EpiP1, SchedP1>(F.lds, D, S, E); }
    SEAM(1);
    if (IN(2)) { p2_conv(F); __syncthreads(); for (int it = F.bid; it < 256; it += F.G) mem_sample_item(F, it >> 1, it & 1); }
    SEAM(2);
    if (IN(3)) p2_prep(F);
    SEAM(3);
    if (IN(4)) {
        constexpr int GSPLIT = 1024;
        if (F.bid < 128) { scan_item(F, F.bid & 15, F.bid >> 4); __syncthreads(); p2_gdn_sample(F, F.bid, 128, 0, GSPLIT); }
        else { const int wk = F.bid - 128, nwk = F.G - 128; p2_attn_prompt(F, wk, nwk); __syncthreads(); p2_swa_sample(F, wk, nwk); __syncthreads(); p2_gdn_sample(F, wk, nwk, GSPLIT, 1024); }
    }
    SEAM(4);
    if (IN(5)) { for (int it = F.bid; it < 256; it += F.G) gdn_out_item(F, it); p2_gdn_norm_sample(F); }
    SEAM(5);
    if (IN(6)) { SchedP3 S{F.G, F.bid, F.ws}; EpiP3 E{F.ws}; pg8::gemm_phase<EpiP3, SchedP3>(F.lds, 1024, S, E); }
    SEAM(6);
    if (IN(7)) p3_combine_sample(F);
    SEAM(7);
    if (IN(8)) { SchedP4 S{F.G, F.bid, F.ws}; EpiP4 E{F.ws, F.out, F.in[I_XP], F.in[I_XS]}; pg8::gemm_phase<EpiP4, SchedP4>(F.lds, D, S, E); }
    SEAM(8);
    if (IN(9)) p5_final_norm(F);
#undef IN
#undef SEAM
}

extern "C" void kernel_launch(void* const* d_in, const int* in_sizes, int n_in, void* d_out, int out_size, void* d_ws, size_t ws_size, hipStream_t stream) {
    static int grid = 0;
    if (grid == 0) {
        if (n_in != 22 || out_size != (int)O_END || ws_size < WS_END) { fprintf(stderr, "kernel_launch: unexpected shapes (n_in %d out %d ws %zu need %zu)\n", n_in, out_size, ws_size, (size_t)WS_END); grid = -1; return; }
        int dev = 0, cus = 0, per_cu = 0;
        hipGetDevice(&dev); hipDeviceGetAttribute(&cus, hipDeviceAttributeMultiprocessorCount, dev);
        hipFuncSetAttribute((const void*)hybrid_fwd, hipFuncAttributeMaxDynamicSharedMemorySize, LDS_BYTES);
        hipOccupancyMaxActiveBlocksPerMultiprocessor(&per_cu, (const void*)hybrid_fwd, NTHREADS, LDS_BYTES);
        if (per_cu < 1) { fprintf(stderr, "kernel_launch: occupancy query says %d blocks per CU\n", per_cu); grid = -1; return; }
        grid = cus;
    }
    if (grid < 0) return;
    Args a{};
    for (int i = 0; i < 22; ++i) a.in[i] = (const float*)d_in[i];
    a.out = (float*)d_out; a.ws = (unsigned char*)d_ws;
    if (hipMemsetAsync((char*)d_ws + WS_CTL, 0, XCD_BAR_WORDS * 4, stream) != hipSuccess) { fprintf(stderr, "kernel_launch: hipMemsetAsync failed\n"); return; }
#if MK_N_LAUNCHES == 1
    a.ph_lo = 0; a.ph_hi = N_PHASES;
    void* kargs[] = {&a};
    hipError_t e = hipLaunchCooperativeKernel((const void*)hybrid_fwd, dim3(grid), dim3(NTHREADS), kargs, LDS_BYTES, stream);
    if (e != hipSuccess) fprintf(stderr, "cooperative launch failed: %s (grid %d)\n", hipGetErrorString(e), grid);
#endif
}
```

```cpp
#include <hip/hip_runtime.h>
#include <hip/hip_cooperative_groups.h>
#include <cstdio>
#include <cstdint>
namespace cg = cooperative_groups;

#ifndef MK_N_LAUNCHES
#define MK_N_LAUNCHES 1
#endif

#define LAS __attribute__((address_space(3)))
typedef unsigned short bf16_t;
typedef short bf16x8 __attribute__((ext_vector_type(8)));
typedef float f32x4 __attribute__((ext_vector_type(4)));
typedef unsigned u32x4 __attribute__((ext_vector_type(4)));
typedef unsigned u32x2 __attribute__((ext_vector_type(2)));

constexpr int D = 2048, SEQ = 8192, MP = 2 * SEQ, MS = 512, M = MP + MS;
constexpr int IN_COLS = 14608;
constexpr int NIN = 58 * 256;
constexpr float EPS = 1e-6f;
__host__ __device__ __forceinline__ int win_src_col(int j) {
    if (j < 4096) return j;
    if (j < 5120) return 4112 + (j - 4096);
    if (j < 6144) return 5392 + (j - 5120);
    if (j < 7168) return 6416 + (j - 6144);
    if (j < 8192) return 7440 + (j - 7168);
    if (j < 14336) return 8464 + (j - 8192);
    if (j < 14592) return 5136 + (j - 14336);
    if (j < 14608) return 4096 + (j - 14592);
    return -1;
}
constexpr size_t O_YP = 0, O_YS = O_YP + (size_t)MP * D, O_GSP = O_YS + (size_t)MS * D, O_GCP = O_GSP + 2 * 8 * 128 * 128, O_SKP = O_GCP + 2 * 3 * 3072,
                 O_SVP = O_SKP + 2 * 128 * 128, O_MKP = O_SVP + 2 * 128 * 128, O_MVP = O_MKP + 512 * 1024, O_GSS = O_MVP + 512 * 1024,
                 O_GCS = O_GSS + (size_t)128 * 8 * 128 * 128, O_SKS = O_GCS + 128 * 3 * 3072, O_SVS = O_SKS + 128 * 128 * 128, O_END = O_SVS + 128 * 128 * 128;
static_assert(O_END == 58148864, "d_out map");
constexpr size_t al(size_t x) { return (x + 255) & ~(size_t)255; }
constexpr size_t WS_CTL = 0, WS_WB = 1u << 20, WS_WO = WS_WB + al((size_t)3 * 2048 * 1024 * 2), WS_WIN = WS_WO + al((size_t)2048 * 2048 * 2),
                 WS_WMKV = WS_WIN + al((size_t)NIN * 2048 * 2), WS_QKV = WS_WMKV + al((size_t)2048 * 2048 * 2), WS_GZ = WS_QKV + al((size_t)M * 3072 * 2),
                 WS_SQ = WS_GZ + al((size_t)M * 1024 * 2), WS_SZ = WS_SQ + al((size_t)M * 1024 * 2), WS_MQ = WS_SZ + al((size_t)M * 1024 * 2), WS_MZ = WS_MQ + al((size_t)M * 1024 * 2),
                 WS_SKV = WS_MZ + al((size_t)M * 1024 * 2), WS_GATES = WS_SKV + al((size_t)M * 256 * 2), WS_MEMN = WS_GATES + al((size_t)M * 6144 * 2),
                 WS_MEMKV = WS_MEMN + al((size_t)512 * 2048 * 2), WS_GAB = WS_MEMKV + al((size_t)512 * 2048 * 2), WS_ROWSS = WS_GAB + al((size_t)M * 16 * 4),
                 WS_G = WS_ROWSS + al((size_t)M * 4), WS_BETA = WS_G + al((size_t)M * 8 * 4), WS_BTAB = WS_BETA + al((size_t)M * 8 * 4), WS_END0 = WS_BTAB + al(16 * 128 * 4);
constexpr size_t WS_OG = WS_QKV, WS_OS = WS_OG + (size_t)M * 1024 * 2, WS_OM = WS_OS + (size_t)M * 1024 * 2, WS_MERGED = WS_SQ;
constexpr size_t WS_NEGW = WS_OG, WS_SN = WS_WIN, WS_OMS = WS_MEMN, WS_DELTA = WS_QKV;
constexpr size_t WS_UT = WS_END0, WS_ATT = WS_UT + al((size_t)2048 * 128 * 64 * 2), WS_GC = WS_ATT + al((size_t)2048 * 64 * 64 * 2), WS_DEC = WS_GC + al((size_t)MP * 8 * 4),
                 WS_GT = WS_DEC + al((size_t)2048 * 64 * 4), WS_MVT = WS_GT + al(2048 * 4), WS_VTS = WS_MVT + al((size_t)2 * 4 * 256 * 256 * 2), WS_SSQ = WS_VTS + al((size_t)2 * 2 * 64 * SEQ * 2 + 4096), WS_SSK = WS_SSQ + al((size_t)MP * 8 * 4), WS_END = WS_SSK + al((size_t)MP * 8 * 4);
constexpr size_t WS_PS = WS_UT, WS_YP = WS_UT + (size_t)3 * MS * 2048 * 2;
static_assert((size_t)3 * MS * 2048 * 2 + (size_t)4 * MS * 2048 * 4 <= (size_t)2048 * 128 * 64 * 2, "PS/YP fit in UT");
static_assert(WS_OM + (size_t)M * 1024 * 2 <= WS_GZ && WS_MERGED + (size_t)M * 2048 * 2 <= WS_MQ, "overlays");
static_assert((size_t)2048 * 64 * 128 * 2 <= (size_t)MP * 1024 * 2 && WS_SN + (size_t)2048 * 128 * 128 * 2 <= WS_QKV, "overlays 2");
static_assert(WS_END <= 670000000, "workspace budget");
constexpr size_t DO_XN = 0, DO_QN = 0, DO_KN = (size_t)M * 1024 * 2, DO_KT = 2 * (size_t)M * 1024 * 2, DO_VT = DO_KT + (size_t)2048 * 8192 * 2, DO_VNS = DO_VT + (size_t)2048 * 8192 * 2;
static_assert(DO_VNS + (size_t)512 * 1024 * 2 <= (size_t)M * D * 4, "y scratch");

constexpr int NWAVES = 8, NTHREADS = 512;
constexpr int LDS_CTL = 147456;
constexpr int LDS_BYTES = 147456 + 256;
constexpr int LDS_BT = 139264;

__device__ __forceinline__ float bf2f(unsigned v) { return __uint_as_float(v << 16); }
__device__ __forceinline__ unsigned f2bf(float f) { unsigned u = __float_as_uint(f); return (u + 0x7fffu + ((u >> 16) & 1u)) >> 16; }
__device__ __forceinline__ unsigned pk2(float lo, float hi) { return f2bf(lo) | (f2bf(hi) << 16); }
__device__ __forceinline__ float wave_sum(float v) {
#pragma unroll
    for (int o = 1; o < 64; o <<= 1) v += __shfl_xor(v, o);
    return v;
}
__device__ __forceinline__ float wave_max(float v) {
#pragma unroll
    for (int o = 1; o < 64; o <<= 1) v = fmaxf(v, __shfl_xor(v, o));
    return v;
}
__device__ __forceinline__ float sigmoidf_(float x) { return __builtin_amdgcn_rcpf(1.f + __expf(-x)); }
__device__ __forceinline__ float siluf_(float x) { return x * __builtin_amdgcn_rcpf(1.f + __expf(-x)); }
#define LDS_WAIT() asm volatile("s_waitcnt lgkmcnt(0)" ::: "memory")

namespace pg8 {
constexpr int BM = 256, BK = 64, HALF = 128, HTB = HALF * BK * 2, STAGE_BYTES = 8 * HTB, NXCD = 8, WGM = 8;
__host__ __device__ __forceinline__ int lds_byte(int r, int c) { const int st = (r >> 4) * 2 + (c >> 5), rr = r & 15, cc = c & 31, ob = rr * 64 + cc * 2; return st * 1024 + (ob ^ (((ob >> 9) & 1) << 5)); }
__host__ __device__ __forceinline__ void stage_rc(int b, int& R, int& C) { const int st = b / 1024, sb = b % 1024, swz = sb ^ (((sb >> 9) & 1) << 5); R = (st >> 1) * 16 + swz / 64; C = (st & 1) * 32 + (swz % 64) / 2; }
__host__ __device__ __forceinline__ int perm32(int rho) { const int n = rho >> 4, i = rho & 15; return 8 * (i >> 2) + 4 * n + (i & 3); }
struct Unit { int pm, pn, job; };
__device__ __forceinline__ void tile_of(int L, int nM, int nN, int& pm, int& pn) {
    const int nwg = nM * nN; int wgid = L;
    { const int q = nwg / NXCD, r = nwg % NXCD, xcd = wgid % NXCD, off = wgid / NXCD; wgid = (xcd < r ? xcd * (q + 1) : r * (q + 1) + (xcd - r) * q) + off; }
    const int nig = WGM * nN, gid = wgid / nig, fm = gid * WGM, gsz = (nM - fm) < WGM ? (nM - fm) : WGM;
    pm = fm + ((wgid % nig) % gsz); pn = (wgid % nig) / gsz;
}
__device__ __forceinline__ unsigned cvt_pk_bf16(float lo, float hi) { unsigned r; asm volatile("v_cvt_pk_bf16_f32 %0, %1, %2" : "=v"(r) : "v"(lo), "v"(hi)); return r; }

template <class Epi, class Sched, bool ALIGN_EPI = true>
__device__ __forceinline__ void gemm_phase(LAS unsigned char* lds, const int K, const Sched& S, const Epi& E) {
    const int tid = threadIdx.x, wid = __builtin_amdgcn_readfirstlane(tid >> 6), lane = tid & 63, wr = wid >> 2, wc = wid & 3, fr = lane & 15, fq = lane >> 4;
    unsigned voffA[2], voffB[2];
#pragma unroll
    for (int i = 0; i < 2; ++i) { int R, C; stage_rc(tid * 16 + i * 8192, R, C); const int Rb = ((R & ~31) + perm32(R & 31));
        voffA[i] = (unsigned)(R * K + C) * 2u; voffB[i] = (unsigned)(Rb * K + C) * 2u; }
    const size_t kstep = (size_t)(BK * 2);
    const size_t hstep = (size_t)HALF * K * 2;
    const unsigned ldsw = (unsigned)wid * 1024u;
    const int aoff = lds_byte(wr * 64 + fr, fq * 8), boff = lds_byte(wc * 32 + fr, fq * 8);
#define PG8_SA(b, h) (((b) * 2 + (h)) * HTB)
#define PG8_SB(b, h) ((4 + (b) * 2 + (h)) * HTB)
#define PG8_STAGE(bufoff, gbase, voff) do { _Pragma("unroll") for (int _i = 0; _i < 2; ++_i) \
        __builtin_amdgcn_global_load_lds((const unsigned*)((const char*)(gbase) + (voff)[_i]), (LAS unsigned*)(lds + (bufoff) + ldsw + _i * 8192), 16, 0, 0); } while (0)
#define PG8_LDA(dst, b, h) do { _Pragma("unroll") for (int m = 0; m < 4; ++m) _Pragma("unroll") for (int k = 0; k < 2; ++k) dst[m][k] = *(const LAS bf16x8*)(lds + PG8_SA(b, h) + aoff + m * 2048 + k * 1024); } while (0)
#define PG8_LDB(dst, b, h) do { _Pragma("unroll") for (int n = 0; n < 2; ++n) _Pragma("unroll") for (int k = 0; k < 2; ++k) dst[n][k] = *(const LAS bf16x8*)(lds + PG8_SB(b, h) + boff + n * 2048 + k * 1024); } while (0)
#define PG8_MMA(ai, bj, At, Bt) do { __builtin_amdgcn_s_setprio(1); _Pragma("unroll") for (int m = 0; m < 4; ++m) _Pragma("unroll") for (int n = 0; n < 2; ++n) _Pragma("unroll") for (int k = 0; k < 2; ++k) \
        acc[ai][bj][m][n] = __builtin_amdgcn_mfma_f32_16x16x32_bf16(Bt[n][k], At[m][k], acc[ai][bj][m][n], 0, 0, 0); __builtin_amdgcn_s_setprio(0); } while (0)
#define PG8_WAIT_V(n) asm volatile("s_waitcnt vmcnt(" #n ")" ::: "memory")
#define PG8_WAIT_L(n) asm volatile("s_waitcnt lgkmcnt(" #n ")" ::: "memory")
#define PG8_BAR __builtin_amdgcn_s_barrier()
#define PG8_SCHED __builtin_amdgcn_sched_barrier(0)
    Unit cur, nxt; int ui = 0;
    if (!S.next(0, cur)) return;
    f32x4 acc[2][2][4][2];
#pragma unroll
    for (int a = 0; a < 2; ++a)
#pragma unroll
        for (int b = 0; b < 2; ++b)
#pragma unroll
            for (int m = 0; m < 4; ++m)
#pragma unroll
                for (int n = 0; n < 2; ++n) acc[a][b][m][n] = (f32x4){0.f, 0.f, 0.f, 0.f};
    bf16x8 At[4][2], B0[2][2], B1[2][2];
    const char* cA; const char* cB; S.ptrs(cur, cA, cB);
    PG8_STAGE(PG8_SB(0, 0), cB, voffB); PG8_STAGE(PG8_SB(0, 1), cB + hstep, voffB); PG8_STAGE(PG8_SA(0, 0), cA, voffA); PG8_STAGE(PG8_SA(0, 1), cA + hstep, voffA);
    if (wr == 1) PG8_BAR;
    PG8_WAIT_V(2); PG8_BAR;
    PG8_STAGE(PG8_SB(1, 0), cB + kstep, voffB); PG8_STAGE(PG8_SA(1, 0), cA + kstep, voffA); PG8_STAGE(PG8_SB(1, 1), cB + hstep + kstep, voffB);
    PG8_WAIT_V(6); PG8_BAR;
    for (;;) {
        const bool has_next = S.next(ui + 1, nxt);
        const char* nA = cA; const char* nB = cB; if (has_next) S.ptrs(nxt, nA, nB);
        const int nt = S.ntiles(cur);
        for (int t = 0; t < nt; t += 2) {
            const bool last = (t == nt - 2);
            const char* a1 = cA + (size_t)(t + 1) * kstep;
            const char* a2 = last ? nA : cA + (size_t)(t + 2) * kstep; const char* b2 = last ? nB : cB + (size_t)(t + 2) * kstep;
            const char* a3 = a2 + kstep; const char* b3 = b2 + kstep;
            PG8_LDB(B0, 0, 0); PG8_LDB(B1, 0, 1); PG8_SCHED; PG8_LDA(At, 0, 0); PG8_STAGE(PG8_SA(1, 1), a1 + hstep, voffA);
            PG8_WAIT_V(8); PG8_WAIT_L(0); PG8_BAR; PG8_MMA(0, 0, At, B0); PG8_MMA(0, 1, At, B1); PG8_BAR; PG8_SCHED;
            PG8_LDA(At, 0, 1); PG8_STAGE(PG8_SB(0, 0), b2, voffB); PG8_STAGE(PG8_SB(0, 1), b2 + hstep, voffB); PG8_STAGE(PG8_SA(0, 0), a2, voffA);
            PG8_WAIT_V(8); PG8_WAIT_L(0); PG8_BAR; PG8_MMA(1, 0, At, B0); PG8_MMA(1, 1, At, B1); PG8_BAR; PG8_SCHED;
            PG8_LDB(B0, 1, 0); PG8_LDB(B1, 1, 1); PG8_SCHED; PG8_LDA(At, 1, 0); PG8_STAGE(PG8_SA(0, 1), a2 + hstep, voffA);
            PG8_WAIT_V(8); PG8_WAIT_L(0); PG8_BAR; PG8_MMA(0, 0, At, B0); PG8_MMA(0, 1, At, B1); PG8_BAR; PG8_SCHED;
            PG8_LDA(At, 1, 1); PG8_STAGE(PG8_SB(1, 0), b3, voffB); PG8_STAGE(PG8_SB(1, 1), b3 + hstep, voffB); PG8_STAGE(PG8_SA(1, 0), a3, voffA);
            PG8_WAIT_V(8); PG8_WAIT_L(0); PG8_BAR; PG8_MMA(1, 0, At, B0); PG8_MMA(1, 1, At, B1); PG8_BAR; PG8_SCHED;
        }
        if constexpr (ALIGN_EPI) { if (wr == 0) PG8_BAR; }
        E(acc, cur, wr, wc, fr, fq);
        if (!has_next) break;
#pragma unroll
        for (int a = 0; a < 2; ++a)
#pragma unroll
            for (int b = 0; b < 2; ++b)
#pragma unroll
                for (int m = 0; m < 4; ++m)
#pragma unroll
                    for (int n = 0; n < 2; ++n) acc[a][b][m][n] = (f32x4){0.f, 0.f, 0.f, 0.f};
        cur = nxt; cA = nA; cB = nB; ++ui;
        if constexpr (ALIGN_EPI) { if (wr == 1) PG8_BAR; }
    }
    PG8_WAIT_V(0);
    if constexpr (!ALIGN_EPI) { if (wr == 0) PG8_BAR; }
    PG8_BAR;
#undef PG8_SA
#undef PG8_SB
#undef PG8_STAGE
#undef PG8_LDA
#undef PG8_LDB
#undef PG8_MMA
#undef PG8_WAIT_V
#undef PG8_WAIT_L
#undef PG8_BAR
#undef PG8_SCHED
}
}

#define XB_TMO      128
#define XB_XCNT(j)  (256  + 64 * (j))
#define XB_XSUB(j)  (1280 + 64 * (j))
#define XB_XGEN(j)  (2304 + 64 * (j))
#define XB_TOP      3328
#define XB_TOPGEN   3392
#define XCD_BAR_WORDS 3456
#define XB_SPIN_CAP (1u << 20)
__device__ __forceinline__ unsigned xb_ld(unsigned* p)              { return __hip_atomic_load(p, __ATOMIC_RELAXED, __HIP_MEMORY_SCOPE_AGENT); }
__device__ __forceinline__ unsigned xb_add(unsigned* p, unsigned v) { return __hip_atomic_fetch_add(p, v, __ATOMIC_RELAXED, __HIP_MEMORY_SCOPE_AGENT); }
__device__ __forceinline__ unsigned xb_xcc_id() { return (unsigned)__builtin_amdgcn_s_getreg((3 << 11) | 20) & 0xFu; }
#define XB_SPIN(cond, bar) do { unsigned _sp = 0; while (cond) { __builtin_amdgcn_s_sleep(1); \
    if ((++_sp & 255u) == 0u) { if (xb_ld(&(bar)[XB_TMO])) break; if (_sp > XB_SPIN_CAP) { atomicAdd(&(bar)[XB_TMO], 1u); break; } } } } while (0)
struct XcdBarrier { unsigned* bar; unsigned x; volatile LAS unsigned* st; };
__device__ __forceinline__ XcdBarrier xcd_barrier_post(unsigned* bar, volatile LAS unsigned* st) {
    XcdBarrier b; b.bar = bar; b.x = xb_xcc_id(); b.st = st;
    if (threadIdx.x == 0) (void)xb_add(&bar[XB_XCNT(b.x)], 1u);
    return b;
}
__device__ __forceinline__ void xcd_barrier_complete(unsigned* bar, unsigned x, unsigned& nloc, unsigned& nx) {
    const unsigned G = gridDim.x * gridDim.y * gridDim.z;
    unsigned sum, cnt, mine, sp = 0u;
    for (;;) {
        sum = 0u; cnt = 0u; mine = 0u;
#pragma unroll
        for (unsigned j = 0; j < 16; ++j) { const unsigned c = xb_ld(&bar[XB_XCNT(j)]); sum += c; cnt += (c > 0u) ? 1u : 0u; mine = (j == x) ? c : mine; }
        if (sum == G) break;
        __builtin_amdgcn_s_sleep(1);
        if ((++sp & 255u) == 0u) { if (xb_ld(&bar[XB_TMO])) break; if (sp > XB_SPIN_CAP) { atomicAdd(&bar[XB_TMO], 1u); break; } }
    }
    nloc = mine > 0u ? mine : 1u; nx = cnt > 0u ? cnt : 1u;
}
__device__ __forceinline__ void xcd_barrier(const XcdBarrier& b) {
    asm volatile("s_waitcnt vmcnt(0)" ::: "memory");
    __syncthreads();
    if (threadIdx.x == 0) {
        unsigned* bar = b.bar;
        __builtin_amdgcn_s_waitcnt(0);
        unsigned nloc = b.st[0], nx = b.st[1];
        if (nloc == 0u) { xcd_barrier_complete(bar, b.x, nloc, nx); b.st[0] = nloc; b.st[1] = nx; }
        const unsigned old = xb_add(&bar[XB_XSUB(b.x)], 1u);
        const unsigned gen = old / nloc;
        if (old + 1u == (gen + 1u) * nloc) {
            __builtin_amdgcn_fence(__ATOMIC_RELEASE, "agent");
            asm volatile("s_waitcnt vmcnt(0)" ::: "memory");
            const unsigned og = xb_add(&bar[XB_TOP], 1u);
            const unsigned tg = og / nx;
            if (og + 1u == (tg + 1u) * nx) xb_add(&bar[XB_TOPGEN], 1u);
            else XB_SPIN(xb_ld(&bar[XB_TOPGEN]) == tg, bar);
            __builtin_amdgcn_fence(__ATOMIC_ACQUIRE, "agent");
            xb_add(&bar[XB_XGEN(b.x)], 1u);
            asm volatile("s_waitcnt vmcnt(0)" ::: "memory");
        } else {
            XB_SPIN(xb_ld(&bar[XB_XGEN(b.x)]) == gen, bar);
            __builtin_amdgcn_fence(__ATOMIC_ACQUIRE, "agent");
            asm volatile("s_waitcnt vmcnt(0)" ::: "memory");
        }
    }
    __syncthreads();
}

struct Args { const float* in[22]; float* out; unsigned char* ws; int ph_lo, ph_hi; };
enum { I_XP = 0, I_XS, I_SGDN, I_SCONV, I_CSK, I_CSV, I_CMK, I_CMV, I_MEMP, I_NORM_IN, I_WIN, I_CONVW, I_ALOG, I_DTB, I_GNORM, I_SINKS, I_RELB, I_NORM_MEM, I_WMKV, I_WBR, I_WOUT, I_NORMF };

struct Frame {
    LAS unsigned char* lds;
    int tid, lane, wave, G, bid;
    const float* const* in; float* out; unsigned char* ws;
};

template <bool WINMAP>
__device__ __forceinline__ void p0_transpose_item(const float* W, int K, int Nsrc, bf16_t* WT, LAS bf16_t* scr, int kb, int nb, int lane) {
    constexpr int TP = 130;
    const int k0 = 64 * kb, n0 = 128 * nb;
    const int dj = n0 + 4 * (lane & 31);
    const int sc = WINMAP ? win_src_col(dj) : dj;
    f32x4 v[32];
#pragma unroll
    for (int i = 0; i < 32; ++i) { const int kk = 2 * i + (lane >> 5); v[i] = sc >= 0 ? *(const f32x4*)(W + (size_t)(k0 + kk) * Nsrc + sc) : (f32x4){0.f, 0.f, 0.f, 0.f}; }
#pragma unroll
    for (int i = 0; i < 32; ++i) { const int kk = 2 * i + (lane >> 5); LAS unsigned* d = (LAS unsigned*)(scr + kk * TP + 4 * (lane & 31)); d[0] = pk2(v[i].x, v[i].y); d[1] = pk2(v[i].z, v[i].w); }
    LDS_WAIT(); asm volatile("" ::: "memory");
#pragma unroll 4
    for (int u = 0; u < 16; ++u) { const int e = lane + 64 * u, ch = e & 7, n = e >> 3; const LAS bf16_t* s = scr + (8 * ch) * TP + n;
        u32x4 o; o.x = (unsigned)s[0] | ((unsigned)s[TP] << 16); o.y = (unsigned)s[2 * TP] | ((unsigned)s[3 * TP] << 16);
        o.z = (unsigned)s[4 * TP] | ((unsigned)s[5 * TP] << 16); o.w = (unsigned)s[6 * TP] | ((unsigned)s[7 * TP] << 16);
        *(u32x4*)(WT + (size_t)(n0 + n) * K + k0 + 8 * ch) = o; }
    LDS_WAIT(); asm volatile("" ::: "memory");
}
__device__ __forceinline__ void rms_row_to_bf16(const float* xrow, const float* w, bf16_t* orow, int lane) {
    const f32x4* xr = (const f32x4*)xrow + lane; const f32x4* wr = (const f32x4*)w + lane;
    f32x4 v[8]; float s = 0.f;
#pragma unroll
    for (int j = 0; j < 8; ++j) { v[j] = xr[64 * j]; s += (v[j].x * v[j].x + v[j].y * v[j].y) + (v[j].z * v[j].z + v[j].w * v[j].w); }
    const float r = rsqrtf(wave_sum(s) * (1.f / D) + EPS);
    unsigned long long* o8 = (unsigned long long*)orow + lane;
#pragma unroll
    for (int j = 0; j < 8; ++j) { const f32x4 ww = wr[64 * j];
        o8[64 * j] = (unsigned long long)pk2(v[j].x * r * ww.x, v[j].y * r * ww.y) | ((unsigned long long)pk2(v[j].z * r * ww.z, v[j].w * r * ww.w) << 32); }
}
__device__ __forceinline__ int t5_bucket(int n) {
    if (n < 16) return n;
    int large = 16 + (int)(logf((float)n / 16.f) / 2.0794415416798357f * 16.f);
    return large < 31 ? large : 31;
}
__device__ __forceinline__ void p0_prologue(Frame& F) {
    LAS bf16_t* scr = (LAS bf16_t*)(F.lds + F.wave * 16896);
    const int gw = F.bid * NWAVES + F.wave, NGW = F.G * NWAVES;
    constexpr int I_IN = 32 * (NIN / 128), I_MKV = 32 * 16, I_BR = 16 * 16, I_OUT = 32 * 16;
    constexpr int NITEMS = I_IN + I_MKV + 3 * I_BR + I_OUT;
    bf16_t* WINT = (bf16_t*)(F.ws + WS_WIN); bf16_t* WMKVT = (bf16_t*)(F.ws + WS_WMKV); bf16_t* WBT = (bf16_t*)(F.ws + WS_WB); bf16_t* WOT = (bf16_t*)(F.ws + WS_WO);
    for (int it = gw; it < NITEMS; it += NGW) {
        int r = it;
        if (r < I_IN) { p0_transpose_item<true>(F.in[I_WIN], D, IN_COLS, WINT, scr, r / (NIN / 128), r % (NIN / 128), F.lane); continue; } r -= I_IN;
        if (r < I_MKV) { p0_transpose_item<false>(F.in[I_WMKV], D, 2048, WMKVT, scr, r / 16, r % 16, F.lane); continue; } r -= I_MKV;
        if (r < 3 * I_BR) { const int b = r / I_BR, q = r % I_BR; p0_transpose_item<false>(F.in[I_WBR] + (size_t)b * 1024 * 2048, 1024, 2048, WBT + (size_t)b * 2048 * 1024, scr, q / 16, q % 16, F.lane); continue; } r -= 3 * I_BR;
        p0_transpose_item<false>(F.in[I_WOUT], D, 2048, WOT, scr, r / 16, r % 16, F.lane);
    }
    bf16_t* XN = (bf16_t*)((unsigned char*)F.out + DO_XN); bf16_t* MEMN = (bf16_t*)(F.ws + WS_MEMN);
    for (int m = gw; m < M + 512; m += NGW) {
        if (m < MP) rms_row_to_bf16(F.in[I_XP] + (size_t)m * D, F.in[I_NORM_IN], XN + (size_t)m * D, F.lane);
        else if (m < M) rms_row_to_bf16(F.in[I_XS] + (size_t)(m - MP) * D, F.in[I_NORM_IN], XN + (size_t)m * D, F.lane);
        else rms_row_to_bf16(F.in[I_MEMP] + (size_t)(m - M) * D, F.in[I_NORM_MEM], MEMN + (size_t)(m - M) * D, F.lane);
    }
    float* BT = (float*)(F.ws + WS_BTAB);
    for (int i = F.bid * NTHREADS + F.tid; i < 16 * 128; i += F.G * NTHREADS) { const int h = i >> 7, dist = i & 127; BT[i] = F.in[I_RELB][t5_bucket(dist) * 16 + h]; }
}

struct SchedP1 {
    int G, c; const unsigned char* ws; const unsigned char* xn;
    __device__ __forceinline__ int ntiles(const pg8::Unit&) const { return D / 64; }
    static constexpr int NM = M / 256, NN = NIN / 256, NU0 = NM * NN, NU = NU0 + 16;
    __device__ __forceinline__ bool next(int i, pg8::Unit& u) const {
        const long L = (long)i * G + c; if (L >= NU) return false;
        if (L < NU0) { pg8::tile_of((int)L, NM, NN, u.pm, u.pn); u.job = 0; } else { const int q = (int)L - NU0; u.pm = q >> 3; u.pn = q & 7; u.job = 1; }
        return true;
    }
    __device__ __forceinline__ void ptrs(const pg8::Unit& u, const char*& A, const char*& B) const {
        const size_t tstep = (size_t)256 * D * 2;
        if (u.job == 0) { A = (const char*)xn + (size_t)u.pm * tstep; B = (const char*)ws + WS_WIN + (size_t)u.pn * tstep; }
        else { A = (const char*)ws + WS_MEMN + (size_t)u.pm * tstep; B = (const char*)ws + WS_WMKV + (size_t)u.pn * tstep; }
    }
};
struct EpiP1 {
    unsigned char* ws; float* out;
    __device__ __forceinline__ void operator()(const f32x4 (&acc)[2][2][4][2], const pg8::Unit& u, int wr, int wc, int fr, int fq) const {
        const int row0 = u.pm * 256 + wr * 64 + fr;
        const int cin = wc * 32 + 8 * fq;
        if (u.job == 1) {
            bf16_t* MK = (bf16_t*)(ws + WS_MEMKV);
#pragma unroll
            for (int ai = 0; ai < 2; ++ai)
#pragma unroll
                for (int m = 0; m < 4; ++m) { const int r = row0 + ai * 128 + m * 16;
#pragma unroll
                    for (int bj = 0; bj < 2; ++bj) { const int c = u.pn * 256 + bj * 128 + cin; const f32x4 v0 = acc[ai][bj][m][0], v1 = acc[ai][bj][m][1];
                        float* o = out + (c < 1024 ? O_MKP + (size_t)r * 1024 + c : O_MVP + (size_t)r * 1024 + (c - 1024));
                        *(f32x4*)o = v0; *(f32x4*)(o + 4) = v1;
                        u32x4 w; w.x = pg8::cvt_pk_bf16(v0[0], v0[1]); w.y = pg8::cvt_pk_bf16(v0[2], v0[3]); w.z = pg8::cvt_pk_bf16(v1[0], v1[1]); w.w = pg8::cvt_pk_bf16(v1[2], v1[3]);
                        *(u32x4*)(MK + (size_t)r * 2048 + c) = w;
                        if (c >= 1024) { bf16_t* MVT = (bf16_t*)(ws + WS_MVT) + ((size_t)((r >> 8) * 4 + ((c - 1024) >> 8)) * 256 + ((c - 1024) & 255)) * 256 + (r & 255);
                            MVT[0] = (bf16_t)(w.x & 0xffffu); MVT[256] = (bf16_t)(w.x >> 16); MVT[512] = (bf16_t)(w.y & 0xffffu); MVT[768] = (bf16_t)(w.y >> 16);
                            MVT[1024] = (bf16_t)(w.z & 0xffffu); MVT[1280] = (bf16_t)(w.z >> 16); MVT[1536] = (bf16_t)(w.w & 0xffffu); MVT[1792] = (bf16_t)(w.w >> 16); } } }
            return;
        }
        const int pn = u.pn;
        if (pn == 57) {
            if (wc == 0 && fq < 2) { float* GAB = (float*)(ws + WS_GAB);
#pragma unroll
                for (int ai = 0; ai < 2; ++ai)
#pragma unroll
                    for (int m = 0; m < 4; ++m) { const int r = row0 + ai * 128 + m * 16; float* o = GAB + (size_t)r * 16 + 8 * fq; *(f32x4*)o = acc[ai][0][m][0]; *(f32x4*)(o + 4) = acc[ai][0][m][1]; } }
            return;
        }
        bf16_t* base; int ld, ct, act = 0;
        if (pn < 12) { base = (bf16_t*)(ws + WS_QKV); ld = 3072; ct = pn; }
        else if (pn < 16) { base = (bf16_t*)(ws + WS_GZ); ld = 1024; ct = pn - 12; act = 1; }
        else if (pn < 20) { base = (bf16_t*)(ws + WS_SQ); ld = 1024; ct = pn - 16; }
        else if (pn < 24) { base = (bf16_t*)(ws + WS_SZ); ld = 1024; ct = pn - 20; act = 1; }
        else if (pn < 28) { base = (bf16_t*)(ws + WS_MQ); ld = 1024; ct = pn - 24; }
        else if (pn < 32) { base = (bf16_t*)(ws + WS_MZ); ld = 1024; ct = pn - 28; act = 1; }
        else if (pn < 56) { base = (bf16_t*)(ws + WS_GATES); ld = 6144; ct = pn - 32; act = 2; }
        else { base = (bf16_t*)(ws + WS_SKV); ld = 256; ct = 0; }
#pragma unroll
        for (int ai = 0; ai < 2; ++ai)
#pragma unroll
            for (int m = 0; m < 4; ++m) { bf16_t* rowp = base + (size_t)(row0 + ai * 128 + m * 16) * ld + ct * 256 + cin;
#pragma unroll
                for (int bj = 0; bj < 2; ++bj) { f32x4 v0 = acc[ai][bj][m][0], v1 = acc[ai][bj][m][1];
                    if (act == 1) {
#pragma unroll
                        for (int j = 0; j < 4; ++j) { v0[j] = siluf_(v0[j]); v1[j] = siluf_(v1[j]); } }
                    else if (act == 2) {
#pragma unroll
                        for (int j = 0; j < 4; ++j) { v0[j] = sigmoidf_(v0[j]); v1[j] = sigmoidf_(v1[j]); } }
                    u32x4 w; w.x = pg8::cvt_pk_bf16(v0[0], v0[1]); w.y = pg8::cvt_pk_bf16(v0[2], v0[3]); w.z = pg8::cvt_pk_bf16(v1[0], v1[1]); w.w = pg8::cvt_pk_bf16(v1[2], v1[3]);
                    *(u32x4*)(rowp + bj * 128) = w;
                    if (pn == 56 && bj == 1) { const int r = row0 + ai * 128 + m * 16;
                        if (r < MP) { bf16_t* vt = (bf16_t*)(ws + WS_VTS) + ((size_t)((r >> 13) * 2 + (cin >> 6)) * 64 + (cin & 63)) * SEQ + (r & (SEQ - 1));
                            vt[0] = (bf16_t)(w.x & 0xffffu); vt[SEQ] = (bf16_t)(w.x >> 16); vt[2 * SEQ] = (bf16_t)(w.y & 0xffffu); vt[3 * SEQ] = (bf16_t)(w.y >> 16);
                            vt[4 * SEQ] = (bf16_t)(w.z & 0xffffu); vt[5 * SEQ] = (bf16_t)(w.z >> 16); vt[6 * SEQ] = (bf16_t)(w.w & 0xffffu); vt[7 * SEQ] = (bf16_t)(w.w >> 16); } } } }
    }
};

__device__ __forceinline__ void gdn_gate_scalars(Frame& F, int r, int h) {
    const float* GAB = (const float*)(F.ws + WS_GAB); float* Gp = (float*)(F.ws + WS_G); float* Bp = (float*)(F.ws + WS_BETA);
    const float gb = GAB[(size_t)r * 16 + h], ga = GAB[(size_t)r * 16 + 8 + h];
    Bp[(size_t)r * 8 + h] = sigmoidf_(gb);
    const float xx = ga + F.in[I_DTB][h]; const float sp = xx > 20.f ? xx : log1pf(expf(xx));
    Gp[(size_t)r * 8 + h] = -expf(F.in[I_ALOG][h]) * sp;
}
__device__ __forceinline__ void conv_prompt_item(Frame& F, int item) {
    const int b = item >> 7, n = item & 127, row0 = b * SEQ + 64 * n, tid = F.tid;
    const bf16_t* QKV = (const bf16_t*)(F.ws + WS_QKV);
    bf16_t* QN = (bf16_t*)((unsigned char*)F.out + DO_QN); bf16_t* KN = (bf16_t*)((unsigned char*)F.out + DO_KN);
    bf16_t* KT = (bf16_t*)((unsigned char*)F.out + DO_KT); bf16_t* VT = (bf16_t*)((unsigned char*)F.out + DO_VT);
    const float* cw = F.in[I_CONVW];
    constexpr int SP = 136;
    LAS bf16_t* slab = (LAS bf16_t*)F.lds;
    { const int tok = tid >> 3, h = tid & 7; gdn_gate_scalars(F, row0 + tok, h); }
    const int t0 = tid >> 4, cg = (tid & 15) * 8;
    LAS float* cwl = (LAS float*)(F.lds + 32768);
    for (int i = tid; i < 4 * 3072 / 4; i += NTHREADS) ((LAS f32x4*)cwl)[i] = ((const f32x4*)cw)[i];
    __syncthreads();
    struct Slab { u32x4 x[2][4]; };
#define CONV_LOAD(S_, sl_) do { const int ch_ = ((sl_) >> 3) * 1024 + ((sl_) & 7) * 128 + cg; \
        _Pragma("unroll") for (int p = 0; p < 2; ++p) _Pragma("unroll") for (int j = 0; j < 4; ++j) { const int tk = t0 + 32 * p - 3 + j; \
            S_.x[p][j] = (64 * n + tk >= 0) ? *(const u32x4*)(QKV + (size_t)(row0 + tk) * 3072 + ch_) : (u32x4){0u, 0u, 0u, 0u}; } \
        } while (0)
#define CONV_SLAB(S_, sl_) do { const int part = (sl_) >> 3, h = (sl_) & 7; f32x4 wq[4][2]; \
        _Pragma("unroll") for (int j = 0; j < 4; ++j) { wq[j][0] = *(const LAS f32x4*)(cwl + j * 3072 + part * 1024 + h * 128 + cg); wq[j][1] = *(const LAS f32x4*)(cwl + j * 3072 + part * 1024 + h * 128 + cg + 4); } \
        _Pragma("unroll") for (int p = 0; p < 2; ++p) { \
            const int tok = t0 + 32 * p, r = row0 + tok; \
            float a[8]; \
            _Pragma("unroll") for (int e = 0; e < 8; ++e) a[e] = 0.f; \
            _Pragma("unroll") for (int j = 0; j < 4; ++j) { const u32x4 v = S_.x[p][j]; \
                a[0] += bf2f(v.x & 0xffffu) * wq[j][0][0]; a[1] += bf2f(v.x >> 16) * wq[j][0][1]; a[2] += bf2f(v.y & 0xffffu) * wq[j][0][2]; a[3] += bf2f(v.y >> 16) * wq[j][0][3]; \
                a[4] += bf2f(v.z & 0xffffu) * wq[j][1][0]; a[5] += bf2f(v.z >> 16) * wq[j][1][1]; a[6] += bf2f(v.w & 0xffffu) * wq[j][1][2]; a[7] += bf2f(v.w >> 16) * wq[j][1][3]; } \
            _Pragma("unroll") for (int e = 0; e < 8; ++e) a[e] = siluf_(a[e]); \
            if (part < 2) { float ss = ((a[0] * a[0] + a[1] * a[1]) + (a[2] * a[2] + a[3] * a[3])) + ((a[4] * a[4] + a[5] * a[5]) + (a[6] * a[6] + a[7] * a[7])); \
                ss += __shfl_xor(ss, 1); ss += __shfl_xor(ss, 2); ss += __shfl_xor(ss, 4); ss += __shfl_xor(ss, 8); \
                if (cg == 0) ((float*)(F.ws + (part == 0 ? WS_SSQ : WS_SSK)))[(size_t)(row0 + t0 + 32 * p) * 8 + h] = ss; } \
            u32x4 o4; o4.x = pk2(a[0], a[1]); o4.y = pk2(a[2], a[3]); o4.z = pk2(a[4], a[5]); o4.w = pk2(a[6], a[7]); \
            const size_t o = (size_t)r * 1024 + h * 128 + cg; \
            if (part == 0) *(u32x4*)(QN + o) = o4; \
            else { if (part == 1) *(u32x4*)(KN + o) = o4; *(LAS u32x4*)(slab + tok * SP + cg) = o4; } \
            if (n == 127 && tok >= 61) { const u32x4 raw = S_.x[p][3]; float* cdst = F.out + O_GCP + ((size_t)b * 3 + (tok - 61)) * 3072 + part * 1024 + h * 128 + cg; \
                *(f32x4*)cdst = (f32x4){bf2f(raw.x & 0xffffu), bf2f(raw.x >> 16), bf2f(raw.y & 0xffffu), bf2f(raw.y >> 16)}; \
                *(f32x4*)(cdst + 4) = (f32x4){bf2f(raw.z & 0xffffu), bf2f(raw.z >> 16), bf2f(raw.w & 0xffffu), bf2f(raw.w >> 16)}; } \
        } \
        if (part > 0) { \
            __syncthreads(); \
            bf16_t* dst = (part == 1 ? KT : VT) + (size_t)((b * 8 + h) * 128 + n) * 8192; \
            _Pragma("unroll") for (int u = 0; u < 2; ++u) { const int e = tid + 512 * u, chn = 16 * (e >> 7) + (e & 15), tg = 4 * ((e >> 6) & 1) + ((e >> 4) & 3); const LAS bf16_t* s = slab + (8 * tg) * SP + chn; \
                u32x4 o4; o4.x = (unsigned)s[0] | ((unsigned)s[SP] << 16); o4.y = (unsigned)s[2 * SP] | ((unsigned)s[3 * SP] << 16); \
                o4.z = (unsigned)s[4 * SP] | ((unsigned)s[5 * SP] << 16); o4.w = (unsigned)s[6 * SP] | ((unsigned)s[7 * SP] << 16); \
                *(u32x4*)(dst + e * 8) = o4; } \
            __syncthreads(); \
        } } while (0)
    Slab s0, s1, s2;
    CONV_LOAD(s0, 0); CONV_LOAD(s1, 1);
#pragma unroll 1
    for (int sl = 0; sl < 24; sl += 3) {
        CONV_LOAD(s2, sl + 2); CONV_SLAB(s0, sl);
        if (sl + 3 < 24) CONV_LOAD(s0, sl + 3); CONV_SLAB(s1, sl + 1);
        if (sl + 4 < 24) CONV_LOAD(s1, sl + 4); CONV_SLAB(s2, sl + 2);
    }
#undef CONV_LOAD
#undef CONV_SLAB
}
__device__ __forceinline__ void conv_sample_items(Frame& F) {
    const int gw = F.bid * NWAVES + F.wave, NGW = F.G * NWAVES, lane = F.lane;
    const bf16_t* QKV = (const bf16_t*)(F.ws + WS_QKV);
    bf16_t* QN = (bf16_t*)((unsigned char*)F.out + DO_QN); bf16_t* KN = (bf16_t*)((unsigned char*)F.out + DO_KN); bf16_t* VNS = (bf16_t*)((unsigned char*)F.out + DO_VNS);
    const float* cw = F.in[I_CONVW];
    for (int it = gw; it < 128 * 8; it += NGW) {
        const int bd = it >> 3, h = it & 7;
        float xr[3][7][2], wv[3][4][2];
#pragma unroll
        for (int part = 0; part < 3; ++part) { const int ch = part * 1024 + h * 128 + 2 * lane;
#pragma unroll
            for (int i = 0; i < 3; ++i) { const float2 p2 = *(const float2*)(F.in[I_SCONV] + ((size_t)bd * 3 + i) * 3072 + ch); xr[part][i][0] = p2.x; xr[part][i][1] = p2.y; }
#pragma unroll
            for (int i = 0; i < 4; ++i) { const unsigned v = *(const unsigned*)(QKV + (size_t)(MP + bd * 4 + i) * 3072 + ch); xr[part][3 + i][0] = bf2f(v & 0xffffu); xr[part][3 + i][1] = bf2f(v >> 16); }
#pragma unroll
            for (int j = 0; j < 4; ++j) { const float2 w2 = *(const float2*)(cw + j * 3072 + ch); wv[part][j][0] = w2.x; wv[part][j][1] = w2.y; } }
#pragma unroll
        for (int s = 0; s < 4; ++s) {
            const int r = MP + bd * 4 + s;
            float y[3][2];
#pragma unroll
            for (int part = 0; part < 3; ++part) { float a0 = 0.f, a1 = 0.f;
#pragma unroll
                for (int j = 0; j < 4; ++j) { a0 += xr[part][s + j][0] * wv[part][j][0]; a1 += xr[part][s + j][1] * wv[part][j][1]; }
                y[part][0] = siluf_(a0); y[part][1] = siluf_(a1); }
            const float sq = wave_sum(y[0][0] * y[0][0] + y[0][1] * y[0][1]), sk = wave_sum(y[1][0] * y[1][0] + y[1][1] * y[1][1]);
            const float rq = rsqrtf(sq + EPS) * 0.08838834764831845f, rk = rsqrtf(sk + EPS);
            const size_t o = (size_t)r * 1024 + h * 128 + 2 * lane;
            *(unsigned*)(QN + o) = pk2(y[0][0] * rq, y[0][1] * rq);
            *(unsigned*)(KN + o) = pk2(y[1][0] * rk, y[1][1] * rk);
            *(unsigned*)(VNS + (size_t)(r - MP) * 1024 + h * 128 + 2 * lane) = pk2(y[2][0], y[2][1]);
            if (lane == 0) gdn_gate_scalars(F, r, h);
            if (s >= 1) { float* cdst = F.out + O_GCS + ((size_t)bd * 3 + (s - 1)) * 3072;
#pragma unroll
                for (int part = 0; part < 3; ++part) { const int ch = part * 1024 + h * 128 + 2 * lane; *(float2*)(cdst + ch) = make_float2(xr[part][3 + s][0], xr[part][3 + s][1]); } }
        }
    }
}
__device__ __forceinline__ void p2_conv(Frame& F) {
    for (int it = F.bid; it < 256; it += F.G) conv_prompt_item(F, it);
    conv_sample_items(F);
}

__device__ __forceinline__ f32x4 mfma16(bf16x8 a, bf16x8 b, f32x4 c) { return __builtin_amdgcn_mfma_f32_16x16x32_bf16(a, b, c, 0, 0, 0); }
__device__ __forceinline__ u32x2 pack4(f32x4 v) { u32x2 r; r.x = pk2(v[0], v[1]); r.y = pk2(v[2], v[3]); return r; }
__device__ __forceinline__ void prep_item(Frame& F, int item) {
    const int b = item >> 7, n = item & 127, row0 = b * SEQ + 64 * n, lane = F.lane, h = F.wave, c = lane & 15, q = lane >> 4;
    const int ci = (b * 8 + h) * 128 + n;
    const bf16_t* QN = (const bf16_t*)((const unsigned char*)F.out + DO_QN); const bf16_t* KN = (const bf16_t*)((const unsigned char*)F.out + DO_KN);
    const bf16_t* KT = (const bf16_t*)((const unsigned char*)F.out + DO_KT) + (size_t)ci * 8192; const bf16_t* VT = (const bf16_t*)((const unsigned char*)F.out + DO_VT) + (size_t)ci * 8192;
    bf16_t* NEGW = (bf16_t*)(F.ws + WS_NEGW) + (size_t)ci * 8192; bf16_t* UT = (bf16_t*)(F.ws + WS_UT) + (size_t)ci * 8192; bf16_t* ATT = (bf16_t*)(F.ws + WS_ATT) + (size_t)ci * 4096;
    const float* Gp = (const float*)(F.ws + WS_G); const float* Bp = (const float*)(F.ws + WS_BETA);
    float* GC = (float*)(F.ws + WS_GC); float* DEC = (float*)(F.ws + WS_DEC); float* GT = (float*)(F.ws + WS_GT);
    LAS float* Als = (LAS float*)(F.lds + h * 18432);
    LAS float* gcs = Als + 4096; LAS float* bes = gcs + 64;
    float gc = Gp[(size_t)(row0 + lane) * 8 + h];
#pragma unroll
    for (int o = 1; o < 64; o <<= 1) { const float x = __shfl_up(gc, o); if (lane >= o) gc += x; }
    const float beta = Bp[(size_t)(row0 + lane) * 8 + h];
    const float gl = __shfl(gc, 63);
    const float sk = ((const float*)(F.ws + WS_SSK))[(size_t)(row0 + lane) * 8 + h], sq = ((const float*)(F.ws + WS_SSQ))[(size_t)(row0 + lane) * 8 + h];
    const float rk = rsqrtf(sk + EPS), rq = rsqrtf(sq + EPS) * 0.08838834764831845f;
    LAS float* rks = bes + 64; LAS float* rqs = rks + 64;
    gcs[lane] = gc; bes[lane] = beta; rks[lane] = rk; rqs[lane] = rq;
    GC[(size_t)(row0 + lane) * 8 + h] = __expf(gc) * rq; DEC[(size_t)ci * 64 + lane] = __expf(gl - gc) * rk; if (lane == 0) GT[ci] = __expf(gl);
    LDS_WAIT(); asm volatile("" ::: "memory");
    bf16x8 kf[4][4];
#pragma unroll
    for (int mt = 0; mt < 4; ++mt)
#pragma unroll
        for (int s = 0; s < 4; ++s) { const size_t o = (size_t)(row0 + 16 * mt + c) * 1024 + h * 128 + 32 * s + 8 * q; kf[mt][s] = *(const bf16x8*)(KN + o); }
#pragma unroll
    for (int mi = 0; mi < 4; ++mi) {
        const int ii = 16 * mi + c; const float gci = gcs[ii], bi = bes[ii] * rks[ii], rqi = rqs[ii];
        const bf16_t* qrow_p = QN + (size_t)(row0 + ii) * 1024 + h * 128 + 8 * q;
#pragma unroll
        for (int nj = 0; nj < 4; ++nj) {
            u32x2 av; av.x = 0u; av.y = 0u;
            if (nj <= mi) {
                f32x4 dk = {0.f, 0.f, 0.f, 0.f}, dq = {0.f, 0.f, 0.f, 0.f};
#pragma unroll
                for (int s = 0; s < 4; ++s) { dk = mfma16(kf[nj][s], kf[mi][s], dk); dq = mfma16(kf[nj][s], *(const bf16x8*)(qrow_p + 32 * s), dq); }
                const f32x4 gj = *(const LAS f32x4*)(gcs + 16 * nj + 4 * q), rkj = *(const LAS f32x4*)(rks + 16 * nj + 4 * q);
                f32x4 a, at;
#pragma unroll
                for (int r = 0; r < 4; ++r) { const int jj = 16 * nj + 4 * q + r; const float e = __expf(gci - gj[r]);
                    a[r] = (ii > jj) ? bi * rkj[r] * dk[r] * e : 0.f; at[r] = (ii >= jj) ? rqi * rkj[r] * dq[r] * e : 0.f; }
                *(LAS f32x4*)(Als + ii * 64 + 16 * nj + 4 * q) = a;
                av = pack4(at);
            }
            *(u32x2*)(ATT + ((mi * 2 + (nj >> 1)) * 64 + (2 * (nj & 1) + (q >> 1)) * 16 + c) * 8 + 4 * (q & 1)) = av;
        }
    }
    LDS_WAIT();
    float t[64];
#pragma unroll
    for (int i = 0; i < 64; ++i) {
        float acc = (lane == i) ? 1.f : 0.f;
#pragma unroll
        for (int m4 = 0; m4 < i; m4 += 4) { const f32x4 a = *(const LAS f32x4*)(Als + i * 64 + m4);
            acc -= a[0] * t[m4]; if (m4 + 1 < i) acc -= a[1] * t[m4 + 1]; if (m4 + 2 < i) acc -= a[2] * t[m4 + 2]; if (m4 + 3 < i) acc -= a[3] * t[m4 + 3]; }
        t[i] = acc;
    }
    LAS bf16_t* T1 = (LAS bf16_t*)Als; LAS bf16_t* T2 = T1 + 64 * 72;
    const float s1 = beta, s2 = -beta * __expf(gc) * rk;
    LDS_WAIT();
#pragma unroll
    for (int i = 0; i < 64; ++i) { T1[i * 72 + lane] = (bf16_t)f2bf(t[i] * s1); T2[i * 72 + lane] = (bf16_t)f2bf(t[i] * s2); }
    LDS_WAIT();
    bf16x8 t1f[4][2], t2f[4][2];
#pragma unroll
    for (int it = 0; it < 4; ++it)
#pragma unroll
        for (int s = 0; s < 2; ++s) { t1f[it][s] = *(const LAS bf16x8*)(T1 + (16 * it + c) * 72 + 32 * s + 8 * q); t2f[it][s] = *(const LAS bf16x8*)(T2 + (16 * it + c) * 72 + 32 * s + 8 * q); }
#pragma unroll 2
    for (int dt = 0; dt < 8; ++dt) {
        bf16x8 vb[2], ka[2];
#pragma unroll
        for (int s = 0; s < 2; ++s) { vb[s] = *(const bf16x8*)(VT + ((dt * 2 + s) * 64 + lane) * 8); ka[s] = *(const bf16x8*)(KT + ((dt * 2 + s) * 64 + lane) * 8); }
#pragma unroll
        for (int it = 0; it < 4; ++it) {
            f32x4 du = {0.f, 0.f, 0.f, 0.f}, dw = {0.f, 0.f, 0.f, 0.f};
            du = mfma16(t1f[it][0], vb[0], du); dw = mfma16(ka[0], t2f[it][0], dw);
            if (it >= 2) { du = mfma16(t1f[it][1], vb[1], du); dw = mfma16(ka[1], t2f[it][1], dw); }
            *(u32x2*)(UT + ((dt * 2 + (it >> 1)) * 64 + (2 * (it & 1) + (q >> 1)) * 16 + c) * 8 + 4 * (q & 1)) = pack4(du);
            *(u32x2*)(NEGW + ((it * 4 + (dt >> 1)) * 64 + (2 * (dt & 1) + (q >> 1)) * 16 + c) * 8 + 4 * (q & 1)) = pack4(dw);
        }
    }
    LDS_WAIT();
}
__device__ __forceinline__ void p2_prep(Frame& F) { for (int it = F.bid; it < 256; it += F.G) { prep_item(F, it); __syncthreads(); } }

__device__ __forceinline__ void scan_item(Frame& F, int bh, int sl) {
    const int lane = F.lane, w = F.wave, c = lane & 15, q = lane >> 4, dvs = 16 * sl;
    const bf16_t* KT = (const bf16_t*)((const unsigned char*)F.out + DO_KT); const bf16_t* NEGW = (const bf16_t*)(F.ws + WS_NEGW);
    bf16_t* UT = (bf16_t*)(F.ws + WS_UT); bf16_t* SN = (bf16_t*)(F.ws + WS_SN);
    const float* DEC = (const float*)(F.ws + WS_DEC); const float* GT = (const float*)(F.ws + WS_GT);
    LAS bf16_t* SS = (LAS bf16_t*)F.lds;
    LAS bf16_t* VS = SS + 16 * 136;
    LAS bf16_t* VU = VS + 16 * 72;
    f32x4 Sacc = {0.f, 0.f, 0.f, 0.f};
    for (int e = F.tid; e < 16 * 136 / 2; e += NTHREADS) ((LAS unsigned*)SS)[e] = 0u;
    struct Ops { bf16x8 wf[4], kf[2]; u32x2 u2; f32x4 dec4; float gt; };
#define SCAN_LOAD(o, n_) do { const size_t ci__ = (size_t)bh * 128 + ((n_) < 128 ? (n_) : 127); \
        _Pragma("unroll") for (int s = 0; s < 2; ++s) o.kf[s] = *(const bf16x8*)(KT + ci__ * 8192 + ((w * 2 + s) * 64 + lane) * 8); \
        o.gt = GT[ci__]; \
        if (w < 4) { _Pragma("unroll") for (int s = 0; s < 4; ++s) o.wf[s] = *(const bf16x8*)(NEGW + ci__ * 8192 + ((w * 4 + s) * 64 + lane) * 8); \
            o.u2 = *(const u32x2*)(UT + ci__ * 8192 + ((sl * 2 + (w >> 1)) * 64 + (2 * (w & 1) + (q >> 1)) * 16 + c) * 8 + 4 * (q & 1)); o.dec4 = *(const f32x4*)(DEC + ci__ * 64 + 16 * w + 4 * q); } } while (0)
#define SCAN_STEP(o, n_) do { const size_t ci = (size_t)bh * 128 + (n_); \
        if (w < 4) { \
            f32x4 v = {bf2f(o.u2.x & 0xffffu), bf2f(o.u2.x >> 16), bf2f(o.u2.y & 0xffffu), bf2f(o.u2.y >> 16)}; \
            _Pragma("unroll") for (int s = 0; s < 4; ++s) { const bf16x8 sf = *(const LAS bf16x8*)(SS + c * 136 + 32 * s + 8 * q); v = mfma16(o.wf[s], sf, v); } \
            *(LAS u32x2*)(VU + c * 72 + 16 * w + 4 * q) = pack4(v); \
            const f32x4 vd = v * o.dec4; \
            *(LAS u32x2*)(VS + c * 72 + 16 * w + 4 * q) = pack4(vd); \
        } else if (w == 4) {   \
            _Pragma("unroll") for (int u = 0; u < 4; ++u) {   \
                *(u32x4*)(SN + ci * 16384 + ((sl * 4 + u) * 64 + lane) * 8) = *(const LAS u32x4*)(SS + c * 136 + 32 * u + 8 * q); } \
        } \
        asm volatile("s_waitcnt lgkmcnt(0)" ::: "memory"); __builtin_amdgcn_s_barrier(); asm volatile("" ::: "memory"); \
        Sacc = Sacc * o.gt; \
        _Pragma("unroll") for (int s = 0; s < 2; ++s) { const bf16x8 vf = *(const LAS bf16x8*)(VS + c * 72 + 32 * s + 8 * q); Sacc = mfma16(o.kf[s], vf, Sacc); } \
        if (w == 5) {   \
            _Pragma("unroll") for (int u = 0; u < 2; ++u) { \
                *(u32x4*)(UT + ci * 8192 + ((sl * 2 + u) * 64 + lane) * 8) = *(const LAS u32x4*)(VU + c * 72 + 32 * u + 8 * q); } } \
        { const u32x2 sp = pack4(Sacc); *(LAS u32x2*)(SS + c * 136 + 16 * w + 4 * q) = sp; } \
        asm volatile("s_waitcnt lgkmcnt(0)" ::: "memory"); __builtin_amdgcn_s_barrier(); asm volatile("" ::: "memory"); } while (0)
    Ops o0, o1, o2, o3;
    SCAN_LOAD(o0, 0); SCAN_LOAD(o1, 1); SCAN_LOAD(o2, 2);
    asm volatile("s_waitcnt lgkmcnt(0)" ::: "memory"); __builtin_amdgcn_s_barrier(); asm volatile("" ::: "memory");
#pragma unroll 1
    for (int n0 = 0; n0 < 128; n0 += 4) {
        SCAN_LOAD(o3, n0 + 3); SCAN_STEP(o0, n0);
        SCAN_LOAD(o0, n0 + 4); SCAN_STEP(o1, n0 + 1);
        SCAN_LOAD(o1, n0 + 5); SCAN_STEP(o2, n0 + 2);
        SCAN_LOAD(o2, n0 + 6); SCAN_STEP(o3, n0 + 3);
    }
#undef SCAN_LOAD
#undef SCAN_STEP
    float* so = F.out + O_GSP + (size_t)bh * 16384;
#pragma unroll
    for (int r = 0; r < 4; ++r) so[(size_t)(16 * w + 4 * q + r) * 128 + dvs + c] = Sacc[r];
}

__device__ __forceinline__ void gdn_out_item(Frame& F, int item) {
    const int b = item >> 7, n = item & 127, row0 = b * SEQ + 64 * n, lane = F.lane, h = F.wave, c = lane & 15, q = lane >> 4;
    const size_t ci = (size_t)(b * 8 + h) * 128 + n;
    const bf16_t* QN = (const bf16_t*)((const unsigned char*)F.out + DO_QN);
    const bf16_t* SN = (const bf16_t*)(F.ws + WS_SN) + ci * 16384; const bf16_t* VNT = (const bf16_t*)(F.ws + WS_UT) + ci * 8192; const bf16_t* ATT = (const bf16_t*)(F.ws + WS_ATT) + ci * 4096;
    const float* GC = (const float*)(F.ws + WS_GC); const bf16_t* GZ = (const bf16_t*)(F.ws + WS_GZ); bf16_t* OG = (bf16_t*)(F.ws + WS_OG); const float* gn = F.in[I_GNORM];
    LAS bf16_t* ol = (LAS bf16_t*)(F.lds + h * 18432);
    bf16x8 qf[4][4], af[4][2]; float egc[4], ss[4];
#pragma unroll
    for (int it = 0; it < 4; ++it) { const int i = 16 * it + c; const size_t r = (size_t)row0 + i;
#pragma unroll
        for (int s = 0; s < 4; ++s) qf[it][s] = *(const bf16x8*)(QN + r * 1024 + h * 128 + 32 * s + 8 * q);
#pragma unroll
        for (int s = 0; s < 2; ++s) af[it][s] = *(const bf16x8*)(ATT + ((it * 2 + s) * 64 + lane) * 8);
        egc[it] = GC[r * 8 + h]; ss[it] = 0.f; }
#pragma unroll 1
    for (int dt = 0; dt < 8; ++dt) {
        bf16x8 sf[4], vf[2];
#pragma unroll
        for (int s = 0; s < 4; ++s) sf[s] = *(const bf16x8*)(SN + ((dt * 4 + s) * 64 + lane) * 8);
#pragma unroll
        for (int s = 0; s < 2; ++s) vf[s] = *(const bf16x8*)(VNT + ((dt * 2 + s) * 64 + lane) * 8);
#pragma unroll
        for (int it = 0; it < 4; ++it) {
            f32x4 a = {0.f, 0.f, 0.f, 0.f};
#pragma unroll
            for (int s = 0; s < 4; ++s) a = mfma16(sf[s], qf[it][s], a);
            a = a * egc[it];
#pragma unroll
            for (int s = 0; s < 2; ++s) a = mfma16(vf[s], af[it][s], a);
            ss[it] += (a[0] * a[0] + a[1] * a[1]) + (a[2] * a[2] + a[3] * a[3]);
            *(LAS u32x2*)(ol + (16 * it + c) * 136 + 16 * dt + 4 * q) = pack4(a);
        }
    }
    float rs[4];
#pragma unroll
    for (int it = 0; it < 4; ++it) { float s = ss[it]; s += __shfl_xor(s, 16); s += __shfl_xor(s, 32); rs[it] = rsqrtf(s * (1.f / 128.f) + EPS); }
    LDS_WAIT();
#pragma unroll
    for (int it = 0; it < 4; ++it)
#pragma unroll
        for (int dt = 0; dt < 8; ++dt) { const size_t o = ((size_t)row0 + 16 * it + c) * 1024 + h * 128 + 16 * dt + 4 * q; const u32x2 z = *(const u32x2*)(GZ + o); const f32x4 g4 = *(const f32x4*)(gn + 16 * dt + 4 * q);
            const u32x2 pv = *(const LAS u32x2*)(ol + (16 * it + c) * 136 + 16 * dt + 4 * q); f32x4 v;
            v[0] = bf2f(pv.x & 0xffffu) * rs[it] * g4[0] * bf2f(z.x & 0xffffu); v[1] = bf2f(pv.x >> 16) * rs[it] * g4[1] * bf2f(z.x >> 16);
            v[2] = bf2f(pv.y & 0xffffu) * rs[it] * g4[2] * bf2f(z.y & 0xffffu); v[3] = bf2f(pv.y >> 16) * rs[it] * g4[3] * bf2f(z.y >> 16);
            *(u32x2*)(OG + o) = pack4(v); }
    LDS_WAIT();
}

__device__ __forceinline__ void gdn_seq_item(Frame& F, int row0, int L, int h, const float* S0, float* Sout, bf16_t* OG) {
    const bf16_t* QN = (const bf16_t*)((unsigned char*)F.out + DO_QN); const bf16_t* KN = (const bf16_t*)((unsigned char*)F.out + DO_KN); const bf16_t* VNS = (const bf16_t*)((unsigned char*)F.out + DO_VNS);
    const float* Gp = (const float*)(F.ws + WS_G); const float* Bp = (const float*)(F.ws + WS_BETA);
    const int tid = F.tid, dvc = tid & 127, dkq = tid >> 7;
    constexpr int TB = 32;
    LAS float* sq = (LAS float*)F.lds;
    LAS float* sk = sq + TB * 128;
    LAS float* sv = sk + TB * 128;
    LAS float* sg = sv + TB * 128;
    LAS float* red = sg + 2 * TB;
    LAS float* redqk = red + 2 * 2 * 4 * 128;
    float S[32];
#pragma unroll
    for (int i = 0; i < 32; ++i) S[i] = S0 ? S0[(size_t)(32 * dkq + i) * 128 + dvc] : 0.f;
    int buf = 0;
    for (int t0 = 0; t0 < L; t0 += TB) {
        const int nb = (L - t0) < TB ? (L - t0) : TB;
        __syncthreads();
        for (int e = tid; e < nb * 128; e += NTHREADS) { const int tt = e >> 7, c = e & 127; const size_t o = (size_t)(row0 + t0 + tt) * 1024 + h * 128 + c;
            sq[e] = bf2f(QN[o]); sk[e] = bf2f(KN[o]); sv[e] = bf2f(VNS[o - (size_t)MP * 1024]); }
        if (tid < nb) { sg[tid] = expf(Gp[(size_t)(row0 + t0 + tid) * 8 + h]); sg[TB + tid] = Bp[(size_t)(row0 + t0 + tid) * 8 + h]; }
        __syncthreads();
        for (int tt = 0; tt < nb; ++tt) {
            const LAS float* kq = sk + tt * 128 + 32 * dkq; const LAS float* qq = sq + tt * 128 + 32 * dkq;
            float pk = 0.f, pq = 0.f, pqk = 0.f;
#pragma unroll
            for (int i = 0; i < 32; ++i) { const float kk = kq[i], qv = qq[i]; pk += kk * S[i]; pq += qv * S[i]; pqk += qv * kk; }
            LAS float* rb = red + buf * 1024;
            rb[dkq * 128 + dvc] = pk; rb[512 + dkq * 128 + dvc] = pq; if (dvc == 0) redqk[buf * 4 + dkq] = pqk;
            __syncthreads();
            const float kS = (rb[dvc] + rb[128 + dvc]) + (rb[256 + dvc] + rb[384 + dvc]);
            const float qS = (rb[512 + dvc] + rb[640 + dvc]) + (rb[768 + dvc] + rb[896 + dvc]);
            const float qk = (redqk[buf * 4] + redqk[buf * 4 + 1]) + (redqk[buf * 4 + 2] + redqk[buf * 4 + 3]);
            const float e = sg[tt], beta = sg[TB + tt];
            const float vnew = beta * (sv[tt * 128 + dvc] - e * kS);
            const float o = e * qS + qk * vnew;
#pragma unroll
            for (int i = 0; i < 32; ++i) S[i] = e * S[i] + kq[i] * vnew;
            if (dkq == 0) OG[(size_t)(row0 + t0 + tt) * 1024 + h * 128 + dvc] = (bf16_t)f2bf(o);
            buf ^= 1;
        }
    }
#pragma unroll
    for (int i = 0; i < 32; ++i) Sout[(size_t)(32 * dkq + i) * 128 + dvc] = S[i];
    __syncthreads();
}
__device__ __forceinline__ void p2_gdn_sample(Frame& F, int wk, int nwk, int lo, int hi) {
    bf16_t* OG = (bf16_t*)(F.ws + WS_OG);
    for (int q = lo + wk; q < hi; q += nwk) { const int bd = q >> 3, h = q & 7; gdn_seq_item(F, MP + bd * 4, 4, h, F.in[I_SGDN] + (size_t)q * 16384, F.out + O_GSS + (size_t)q * 16384, OG); }
}
__device__ __forceinline__ void p2_gdn_norm_sample(Frame& F) {
    const int gw = F.bid * NWAVES + F.wave, NGW = F.G * NWAVES, lane = F.lane;
    bf16_t* OG = (bf16_t*)(F.ws + WS_OG); const bf16_t* GZ = (const bf16_t*)(F.ws + WS_GZ); const float* gn = F.in[I_GNORM];
    for (int it = gw; it < MS * 8; it += NGW) {
        const size_t o = (size_t)(MP + (it >> 3)) * 1024 + (it & 7) * 128 + 2 * lane;
        const unsigned v = *(const unsigned*)(OG + o), z = *(const unsigned*)(GZ + o);
        const float a = bf2f(v & 0xffffu), b = bf2f(v >> 16);
        const float r = rsqrtf(wave_sum(a * a + b * b) * (1.f / 128.f) + EPS);
        *(unsigned*)(OG + o) = pk2(a * r * gn[2 * lane] * bf2f(z & 0xffffu), b * r * gn[2 * lane + 1] * bf2f(z >> 16));
    }
}

__device__ __forceinline__ void swa_wave_item(Frame& F, bool sample, int bidx, int t, int kv) {
    const int lane = F.lane;
    LAS float* qs = (LAS float*)(F.lds + F.wave * 8192);
    LAS float* ps = qs + 512;
    const bf16_t* SQ = (const bf16_t*)(F.ws + WS_SQ); const bf16_t* SKV = (const bf16_t*)(F.ws + WS_SKV); const bf16_t* SZ = (const bf16_t*)(F.ws + WS_SZ);
    const float* BT = (const float*)(F.ws + WS_BTAB);
    const int row = sample ? MP + bidx * 4 + t : bidx * SEQ + t;
    const int qpos = sample ? 128 + t : t;
    for (int e = lane; e < 512; e += 64) qs[e] = bf2f(SQ[(size_t)row * 1024 + kv * 512 + e]);
    LDS_WAIT();
#pragma unroll 1
    for (int u = 0; u < 2; ++u) {
        const int j = lane + 64 * u; const int kp = qpos - j;
        float kr[64];
        const bool valid = kp >= 0;
        if (valid) {
            if (sample && kp < 128) { const float* p = F.in[I_CSK] + (((size_t)bidx * 128 + kp) * 2 + kv) * 64;
#pragma unroll
                for (int d = 0; d < 64; d += 4) { const f32x4 v = *(const f32x4*)(p + d); kr[d] = v.x; kr[d + 1] = v.y; kr[d + 2] = v.z; kr[d + 3] = v.w; } }
            else { const int krow = sample ? MP + bidx * 4 + (kp - 128) : bidx * SEQ + kp; const bf16_t* p = SKV + (size_t)krow * 256 + kv * 64;
#pragma unroll
                for (int d = 0; d < 64; d += 8) { const u32x4 v = *(const u32x4*)(p + d);
                    kr[d] = bf2f(v.x & 0xffffu); kr[d + 1] = bf2f(v.x >> 16); kr[d + 2] = bf2f(v.y & 0xffffu); kr[d + 3] = bf2f(v.y >> 16);
                    kr[d + 4] = bf2f(v.z & 0xffffu); kr[d + 5] = bf2f(v.z >> 16); kr[d + 6] = bf2f(v.w & 0xffffu); kr[d + 7] = bf2f(v.w >> 16); } }
        } else {
#pragma unroll
            for (int d = 0; d < 64; ++d) kr[d] = 0.f;
        }
#pragma unroll 1
        for (int g = 0; g < 8; ++g) { float a = 0.f;
#pragma unroll
            for (int d = 0; d < 64; d += 4) { const f32x4 qv = *(const LAS f32x4*)(qs + g * 64 + d); a += kr[d] * qv.x + kr[d + 1] * qv.y + kr[d + 2] * qv.z + kr[d + 3] * qv.w; }
            ps[g * 128 + j] = valid ? a * 0.125f + BT[(kv * 8 + g) * 128 + j] : -INFINITY; }
    }
    LDS_WAIT();
    float inv[8];
#pragma unroll
    for (int g = 0; g < 8; ++g) {
        const float sink = F.in[I_SINKS][kv * 8 + g];
        const float l0 = ps[g * 128 + lane], l1 = ps[g * 128 + 64 + lane];
        const float mx = fmaxf(wave_max(fmaxf(l0, l1)), sink);
        const float p0 = __expf(l0 - mx), p1 = __expf(l1 - mx);
        const float den = wave_sum(p0 + p1) + __expf(sink - mx);
        inv[g] = 1.f / den;
        ps[g * 128 + lane] = p0; ps[g * 128 + 64 + lane] = p1;
    }
    LDS_WAIT();
    float o[8];
#pragma unroll
    for (int g = 0; g < 8; ++g) o[g] = 0.f;
#pragma unroll 1
    for (int j0 = 0; j0 < 128; j0 += 8) {
        float vv[8];
#pragma unroll
        for (int u = 0; u < 8; ++u) { int kp = qpos - (j0 + u); kp = kp < 0 ? 0 : kp;
            if (sample && kp < 128) vv[u] = F.in[I_CSV][(((size_t)bidx * 128 + kp) * 2 + kv) * 64 + lane];
            else { const int krow = sample ? MP + bidx * 4 + (kp - 128) : bidx * SEQ + kp; vv[u] = bf2f(SKV[(size_t)krow * 256 + 128 + kv * 64 + lane]); } }
#pragma unroll
        for (int u = 0; u < 8; ++u)
#pragma unroll
            for (int g = 0; g < 8; ++g) o[g] += ps[g * 128 + j0 + u] * vv[u];
    }
    bf16_t* OS = (bf16_t*)(F.ws + WS_OS);
#pragma unroll
    for (int g = 0; g < 8; ++g) { const size_t oo = (size_t)row * 1024 + (kv * 8 + g) * 64 + lane; OS[oo] = (bf16_t)f2bf(o[g] * inv[g] * bf2f(SZ[oo])); }
    LDS_WAIT();
}
__device__ __forceinline__ bf16x8 cat8(u32x2 a, u32x2 b) { u32x4 t; t.x = a.x; t.y = a.y; t.z = b.x; t.w = b.y; return __builtin_bit_cast(bf16x8, t); }
__device__ __forceinline__ void mem_mfma_item(Frame& F, int b, int h, int qt) {
    const int lane = F.lane, c = lane & 15, q = lane >> 4;
    const bf16_t* Kp = (const bf16_t*)(F.ws + WS_MEMKV) + (size_t)(b * 256) * 2048 + h * 256;
    const bf16_t* VTp = (const bf16_t*)(F.ws + WS_MVT) + (size_t)((b * 4 + h) * 256) * 256;
    const bf16_t* MQ = (const bf16_t*)(F.ws + WS_MQ); const bf16_t* MZ = (const bf16_t*)(F.ws + WS_MZ); bf16_t* OM = (bf16_t*)(F.ws + WS_OM);
    const size_t qrow = (size_t)b * SEQ + 16 * qt + c;
    bf16x8 qf[8];
#pragma unroll
    for (int s = 0; s < 8; ++s) qf[s] = *(const bf16x8*)(MQ + qrow * 1024 + h * 256 + 32 * s + 8 * q);
    f32x4 sacc[16];
#pragma unroll
    for (int mt = 0; mt < 16; ++mt) { f32x4 a = {0.f, 0.f, 0.f, 0.f};
#pragma unroll
        for (int s = 0; s < 8; ++s) a = mfma16(*(const bf16x8*)(Kp + (size_t)(16 * mt + c) * 2048 + 32 * s + 8 * q), qf[s], a);
        sacc[mt] = a; }
    float mx = -INFINITY;
#pragma unroll
    for (int mt = 0; mt < 16; ++mt) mx = fmaxf(mx, fmaxf(fmaxf(sacc[mt][0], sacc[mt][1]), fmaxf(sacc[mt][2], sacc[mt][3])));
    mx = fmaxf(mx, __shfl_xor(mx, 16)); mx = fmaxf(mx, __shfl_xor(mx, 32));
    float sum = 0.f; const float sc = 0.0625f * 1.4426950408889634f;
#pragma unroll
    for (int mt = 0; mt < 16; ++mt)
#pragma unroll
        for (int r = 0; r < 4; ++r) { const float p = exp2f((sacc[mt][r] - mx) * sc); sacc[mt][r] = p; sum += p; }
    sum += __shfl_xor(sum, 16); sum += __shfl_xor(sum, 32);
    const float inv = 1.f / sum;
    bf16x8 pf[8];
#pragma unroll
    for (int ks = 0; ks < 8; ++ks) pf[ks] = cat8(pack4(sacc[2 * ks]), pack4(sacc[2 * ks + 1]));
#pragma unroll 4
    for (int dt = 0; dt < 16; ++dt) { f32x4 o = {0.f, 0.f, 0.f, 0.f};
#pragma unroll
        for (int ks = 0; ks < 8; ++ks) { const bf16_t* vp = VTp + (size_t)(16 * dt + c) * 256 + 32 * ks + 4 * q;
            o = mfma16(cat8(*(const u32x2*)vp, *(const u32x2*)(vp + 16)), pf[ks], o); }
        const size_t oo = qrow * 1024 + h * 256 + 16 * dt + 4 * q; const u32x2 z = *(const u32x2*)(MZ + oo);
        o[0] *= inv * bf2f(z.x & 0xffffu); o[1] *= inv * bf2f(z.x >> 16); o[2] *= inv * bf2f(z.y & 0xffffu); o[3] *= inv * bf2f(z.y >> 16);
        *(u32x2*)(OM + oo) = pack4(o); }
}
__device__ __forceinline__ void swa_mfma_item(Frame& F, int b, int h, int a) {
    const int lane = F.lane, c = lane & 15, q = lane >> 4, kv = h >> 3;
    const bf16_t* SQ = (const bf16_t*)(F.ws + WS_SQ); const bf16_t* SKV = (const bf16_t*)(F.ws + WS_SKV); const bf16_t* SZ = (const bf16_t*)(F.ws + WS_SZ); bf16_t* OS = (bf16_t*)(F.ws + WS_OS);
    const bf16_t* VTp = (const bf16_t*)(F.ws + WS_VTS) + (size_t)((b * 2 + kv) * 64) * SEQ;
    const LAS float* BTl = (const LAS float*)(F.lds + LDS_BT) + h * 128;
    const size_t qrow = (size_t)b * SEQ + 16 * a + c;
    bf16x8 qf[2];
#pragma unroll
    for (int s = 0; s < 2; ++s) qf[s] = *(const bf16x8*)(SQ + qrow * 1024 + h * 64 + 32 * s + 8 * q);
    f32x4 p[10];
    const float sink = F.in[I_SINKS][h];
    float mx = sink;
#pragma unroll
    for (int u = 0; u < 9; ++u) {
        const int kbase = 16 * (a - 8 + u);
        f32x4 d = {0.f, 0.f, 0.f, 0.f};
        if (kbase >= 0) {
#pragma unroll
            for (int s = 0; s < 2; ++s) d = mfma16(*(const bf16x8*)(SKV + ((size_t)b * SEQ + kbase + c) * 256 + kv * 64 + 32 * s + 8 * q), qf[s], d);
        }
#pragma unroll
        for (int r = 0; r < 4; ++r) { const int dist = (16 * a + c) - (kbase + 4 * q + r); const bool valid = kbase >= 0 && dist >= 0 && dist < 128;
            const float l = valid ? d[r] * 0.125f + BTl[dist & 127] : -INFINITY; d[r] = l; mx = fmaxf(mx, l); }
        p[u] = d;
    }
    mx = fmaxf(mx, __shfl_xor(mx, 16)); mx = fmaxf(mx, __shfl_xor(mx, 32));
    float sum = 0.f;
#pragma unroll
    for (int u = 0; u < 9; ++u)
#pragma unroll
        for (int r = 0; r < 4; ++r) { const float e = __expf(p[u][r] - mx); p[u][r] = e; sum += e; }
    p[9] = (f32x4){0.f, 0.f, 0.f, 0.f};
    sum += __shfl_xor(sum, 16); sum += __shfl_xor(sum, 32);
    const float inv = 1.f / (sum + __expf(sink - mx));
    bf16x8 pf[5];
#pragma unroll
    for (int ks = 0; ks < 5; ++ks) pf[ks] = cat8(pack4(p[2 * ks]), pack4(p[2 * ks + 1]));
#pragma unroll
    for (int dt = 0; dt < 4; ++dt) { f32x4 o = {0.f, 0.f, 0.f, 0.f};
#pragma unroll
        for (int ks = 0; ks < 5; ++ks) { int m0 = 16 * (a - 8 + 2 * ks) + 4 * q, m1 = m0 + 16;
            m0 = m0 < 0 ? 0 : m0; m1 = m1 < 0 ? 0 : (m1 > SEQ - 4 ? SEQ - 4 : m1);
            const bf16_t* vp = VTp + (size_t)(16 * dt + c) * SEQ;
            o = mfma16(cat8(*(const u32x2*)(vp + m0), *(const u32x2*)(vp + m1)), pf[ks], o); }
        const size_t oo = qrow * 1024 + h * 64 + 16 * dt + 4 * q; const u32x2 z = *(const u32x2*)(SZ + oo);
        o[0] *= inv * bf2f(z.x & 0xffffu); o[1] *= inv * bf2f(z.x >> 16); o[2] *= inv * bf2f(z.y & 0xffffu); o[3] *= inv * bf2f(z.y >> 16);
        *(u32x2*)(OS + oo) = pack4(o); }
}
__device__ __forceinline__ void swa_wg_item(Frame& F, int b, int kv, int qb) {
    int lane_ = F.lane, tid_ = F.tid; asm volatile("" : "+v"(lane_), "+v"(tid_));
    const int lane = lane_, c = lane & 15, q = lane >> 4, tid = tid_, h = kv * 8 + F.wave;
    const bf16_t* SQ = (const bf16_t*)(F.ws + WS_SQ); const bf16_t* SKV = (const bf16_t*)(F.ws + WS_SKV); const bf16_t* SZ = (const bf16_t*)(F.ws + WS_SZ); bf16_t* OS = (bf16_t*)(F.ws + WS_OS);
    const bf16_t* VTg = (const bf16_t*)(F.ws + WS_VTS) + (size_t)((b * 2 + kv) * 64) * SEQ;
    LAS unsigned char* Kl = F.lds; LAS unsigned char* Vl = F.lds + 32768;
    const LAS float* BTl = (const LAS float*)(F.lds + LDS_BT) + h * 128;
    const int kstart = 128 * (qb - 1);
    __syncthreads();
    {   u32x4 kr[4], vr[4];
#pragma unroll
        for (int u = 0; u < 4; ++u) { const int p = tid + 512 * u, key = p >> 3, ch = p & 7;
            kr[u] = (kstart + key >= 0) ? *(const u32x4*)(SKV + ((size_t)b * SEQ + kstart + key) * 256 + kv * 64 + ch * 8) : (u32x4){0u, 0u, 0u, 0u};
            const int d = p >> 5, c16 = p & 31;
            vr[u] = (kstart + c16 * 8 >= 0) ? *(const u32x4*)(VTg + (size_t)d * SEQ + kstart + c16 * 8) : (u32x4){0u, 0u, 0u, 0u}; }
#pragma unroll
        for (int u = 0; u < 4; ++u) { const int p = tid + 512 * u, key = p >> 3, ch = p & 7;
            *(LAS u32x4*)(Kl + key * 128 + ((ch ^ ((key >> 1) & 7)) << 4)) = kr[u];
            const int d = p >> 5, c16 = p & 31;
            *(LAS u32x4*)(Vl + d * 512 + (((2 * c16) ^ (2 * (d & 15))) << 3)) = vr[u]; } }
    __syncthreads();
    const float L2E = 1.4426950408889634f;
    const float sink = F.in[I_SINKS][h] * L2E;
    float bias[9][4];
#pragma unroll
    for (int u = 0; u < 9; ++u)
#pragma unroll
        for (int r = 0; r < 4; ++r) { const int dist = 128 - 16 * u + c - 4 * q - r; bias[u][r] = (dist >= 0 && dist < 128) ? BTl[dist & 127] * L2E : -INFINITY; }
    bf16x8 qfa[8][2];
#pragma unroll
    for (int ap = 0; ap < 8; ++ap)
#pragma unroll
        for (int s = 0; s < 2; ++s) qfa[ap][s] = *(const bf16x8*)(SQ + ((size_t)b * SEQ + 128 * qb + 16 * ap + c) * 1024 + h * 64 + 32 * s + 8 * q);
#pragma unroll
    for (int ap = 0; ap < 8; ++ap) {
        const size_t qrow = (size_t)b * SEQ + 128 * qb + 16 * ap + c;
        bf16x8 qf[2]; qf[0] = qfa[ap][0]; qf[1] = qfa[ap][1];
        LAS bf16_t* ow = (LAS bf16_t*)(F.lds + 65536 + F.wave * 2304);
        u32x4 zz[2];
#pragma unroll
        for (int u = 0; u < 2; ++u) { const int p = lane + 64 * u; zz[u] = *(const u32x4*)(SZ + ((size_t)b * SEQ + 128 * qb + 16 * ap + (p >> 3)) * 1024 + h * 64 + (p & 7) * 8); }
        f32x4 p[10]; float mx = sink;
#pragma unroll
        for (int u = 0; u < 9; ++u) {
            const int wt = ap + u, row = 16 * wt + c;
            f32x4 d = {0.f, 0.f, 0.f, 0.f};
#pragma unroll
            for (int s = 0; s < 2; ++s) d = mfma16(*(const LAS bf16x8*)(Kl + row * 128 + (((4 * s + q) ^ ((row >> 1) & 7)) << 4)), qf[s], d);
            const float tmask = ((qb > 0) || (wt >= 8)) ? 0.f : -INFINITY;
#pragma unroll
            for (int r = 0; r < 4; ++r) { const float l = d[r] * (0.125f * L2E) + (bias[u][r] + tmask); d[r] = l; mx = fmaxf(mx, l); }
            p[u] = d;
        }
        mx = fmaxf(mx, __shfl_xor(mx, 16)); mx = fmaxf(mx, __shfl_xor(mx, 32));
        float sum = 0.f;
#pragma unroll
        for (int u = 0; u < 9; ++u)
#pragma unroll
            for (int r = 0; r < 4; ++r) { const float e = exp2f(p[u][r] - mx); p[u][r] = e; sum += e; }
        p[9] = (f32x4){0.f, 0.f, 0.f, 0.f};
        sum += __shfl_xor(sum, 16); sum += __shfl_xor(sum, 32);
        const float inv = 1.f / (sum + exp2f(sink - mx));
        bf16x8 pf[5];
#pragma unroll
        for (int ks = 0; ks < 5; ++ks) pf[ks] = cat8(pack4(p[2 * ks]), pack4(p[2 * ks + 1]));
#pragma unroll
        for (int dt = 0; dt < 4; ++dt) { f32x4 o = {0.f, 0.f, 0.f, 0.f}; const int dd = 16 * dt + c; const LAS unsigned char* vrow = Vl + dd * 512; const int sw = 2 * (dd & 15);
#pragma unroll
            for (int ks = 0; ks < 5; ++ks) { const int wt0 = ap + 2 * ks; int wt1 = wt0 + 1; wt1 = wt1 > 15 ? 15 : wt1;
                const u32x2 v0 = *(const LAS u32x2*)(vrow + (((4 * wt0 + q) ^ sw) << 3)), v1 = *(const LAS u32x2*)(vrow + (((4 * wt1 + q) ^ sw) << 3));
                o = mfma16(cat8(v0, v1), pf[ks], o); }
            o = o * inv; *(LAS u32x2*)(ow + c * 72 + 16 * dt + 4 * q) = pack4(o); }
        LDS_WAIT();
#pragma unroll
        for (int u = 0; u < 2; ++u) { const int p = lane + 64 * u, rr = p >> 3, ch = p & 7; const u32x4 pv = *(const LAS u32x4*)(ow + rr * 72 + ch * 8), z = zz[u]; u32x4 w;
            w.x = pk2(bf2f(pv.x & 0xffffu) * bf2f(z.x & 0xffffu), bf2f(pv.x >> 16) * bf2f(z.x >> 16)); w.y = pk2(bf2f(pv.y & 0xffffu) * bf2f(z.y & 0xffffu), bf2f(pv.y >> 16) * bf2f(z.y >> 16));
            w.z = pk2(bf2f(pv.z & 0xffffu) * bf2f(z.z & 0xffffu), bf2f(pv.z >> 16) * bf2f(z.z >> 16)); w.w = pk2(bf2f(pv.w & 0xffffu) * bf2f(z.w & 0xffffu), bf2f(pv.w >> 16) * bf2f(z.w >> 16));
            *(u32x4*)(OS + ((size_t)b * SEQ + 128 * qb + 16 * ap + rr) * 1024 + h * 64 + ch * 8) = w; }
        LDS_WAIT(); asm volatile("" ::: "memory");
    }
}
__device__ __forceinline__ void mem_wg_item(Frame& F, int b, int h, int qblk) {
    int lane_ = F.lane, tid_ = F.tid; asm volatile("" : "+v"(lane_), "+v"(tid_));
    const int lane = lane_, c = lane & 15, q = lane >> 4, tid = tid_, w = F.wave;
    const bf16_t* Kg = (const bf16_t*)(F.ws + WS_MEMKV) + (size_t)(b * 256) * 2048 + h * 256;
    const bf16_t* VTg = (const bf16_t*)(F.ws + WS_MVT) + (size_t)((b * 4 + h) * 256) * 256;
    const bf16_t* MQ = (const bf16_t*)(F.ws + WS_MQ); const bf16_t* MZ = (const bf16_t*)(F.ws + WS_MZ); bf16_t* OM = (bf16_t*)(F.ws + WS_OM);
    LAS unsigned char* L = F.lds;
    __syncthreads();
#pragma unroll
    for (int hf = 0; hf < 2; ++hf) { u32x4 kr[8];
#pragma unroll
        for (int u = 0; u < 8; ++u) { const int p = tid + 512 * (u + 8 * hf), key = p >> 5, ch = p & 31; kr[u] = *(const u32x4*)(Kg + (size_t)key * 2048 + ch * 8); }
#pragma unroll
        for (int u = 0; u < 8; ++u) { const int p = tid + 512 * (u + 8 * hf), key = p >> 5, ch = p & 31; *(LAS u32x4*)(L + key * 512 + ((ch ^ (key & 15)) << 4)) = kr[u]; } }
    __syncthreads();
    size_t qrow[2];
#pragma unroll
    for (int t = 0; t < 2; ++t) qrow[t] = (size_t)b * SEQ + 256 * qblk + 32 * w + 16 * t + c;
    f32x4 sacc[2][16];
#pragma unroll
    for (int mt = 0; mt < 16; ++mt) { sacc[0][mt] = (f32x4){0.f, 0.f, 0.f, 0.f}; sacc[1][mt] = (f32x4){0.f, 0.f, 0.f, 0.f}; }
    bf16x8 qn0 = *(const bf16x8*)(MQ + qrow[0] * 1024 + h * 256 + 8 * q), qn1 = *(const bf16x8*)(MQ + qrow[1] * 1024 + h * 256 + 8 * q);
#pragma unroll 1
    for (int s = 0; s < 8; ++s) {
        const bf16x8 q0 = qn0, q1 = qn1; const int sn = s < 7 ? s + 1 : 7;
        qn0 = *(const bf16x8*)(MQ + qrow[0] * 1024 + h * 256 + 32 * sn + 8 * q); qn1 = *(const bf16x8*)(MQ + qrow[1] * 1024 + h * 256 + 32 * sn + 8 * q);
#pragma unroll
        for (int mt = 0; mt < 16; ++mt) { const int row = 16 * mt + c;
            const bf16x8 kf = *(const LAS bf16x8*)(L + row * 512 + (((4 * s + q) ^ (row & 15)) << 4));
            sacc[0][mt] = mfma16(kf, q0, sacc[0][mt]); sacc[1][mt] = mfma16(kf, q1, sacc[1][mt]); }
        asm volatile("" ::: "memory");
    }
    float inv[2]; bf16x8 pf[2][8];
    const float sc = 0.0625f * 1.4426950408889634f;
#pragma unroll
    for (int t = 0; t < 2; ++t) { float mx = -INFINITY;
#pragma unroll
        for (int mt = 0; mt < 16; ++mt) mx = fmaxf(mx, fmaxf(fmaxf(sacc[t][mt][0], sacc[t][mt][1]), fmaxf(sacc[t][mt][2], sacc[t][mt][3])));
        mx = fmaxf(mx, __shfl_xor(mx, 16)); mx = fmaxf(mx, __shfl_xor(mx, 32));
        float sum = 0.f;
#pragma unroll
        for (int mt = 0; mt < 16; ++mt)
#pragma unroll
            for (int r = 0; r < 4; ++r) { const float e = exp2f((sacc[t][mt][r] - mx) * sc); sacc[t][mt][r] = e; sum += e; }
        sum += __shfl_xor(sum, 16); sum += __shfl_xor(sum, 32); inv[t] = 1.f / sum;
#pragma unroll
        for (int ks = 0; ks < 8; ++ks) pf[t][ks] = cat8(pack4(sacc[t][2 * ks]), pack4(sacc[t][2 * ks + 1])); }
    __syncthreads();
#pragma unroll
    for (int hf = 0; hf < 2; ++hf) { u32x4 vr[8];
#pragma unroll
        for (int u = 0; u < 8; ++u) { const int p = tid + 512 * (u + 8 * hf), d = p >> 5, c16 = p & 31; vr[u] = *(const u32x4*)(VTg + (size_t)d * 256 + c16 * 8); }
#pragma unroll
        for (int u = 0; u < 8; ++u) { const int p = tid + 512 * (u + 8 * hf), d = p >> 5, c16 = p & 31; *(LAS u32x4*)(L + d * 512 + (((2 * c16) ^ (2 * (d & 15))) << 3)) = vr[u]; } }
    __syncthreads();
    LAS bf16_t* ow = (LAS bf16_t*)(F.lds + 131072 + w * 2048);
#pragma unroll 1
    for (int dg = 0; dg < 4; ++dg) {
        f32x4 oacc1[4];
#pragma unroll
        for (int d4 = 0; d4 < 4; ++d4) { const int dt = 4 * dg + d4; f32x4 o0 = {0.f, 0.f, 0.f, 0.f}, o1 = {0.f, 0.f, 0.f, 0.f}; const int dd = 16 * dt + c; const LAS unsigned char* vrow = L + dd * 512; const int sw = 2 * (dd & 15);
#pragma unroll
            for (int ks = 0; ks < 8; ++ks) { const bf16x8 vf = cat8(*(const LAS u32x2*)(vrow + (((8 * ks + q) ^ sw) << 3)), *(const LAS u32x2*)(vrow + (((8 * ks + 4 + q) ^ sw) << 3)));
                o0 = mfma16(vf, pf[0][ks], o0); o1 = mfma16(vf, pf[1][ks], o1); }
            *(LAS u32x2*)(ow + c * 64 + 16 * d4 + 4 * q) = pack4(o0 * inv[0]); oacc1[d4] = o1 * inv[1]; }
#pragma unroll
        for (int t = 0; t < 2; ++t) {
            u32x4 zz[2];
#pragma unroll
            for (int u = 0; u < 2; ++u) { const int p = lane + 64 * u; zz[u] = *(const u32x4*)(MZ + ((size_t)b * SEQ + 256 * qblk + 32 * w + 16 * t + (p >> 3)) * 1024 + h * 256 + 64 * dg + (p & 7) * 8); }
            if (t == 1) {
#pragma unroll
                for (int d4 = 0; d4 < 4; ++d4) *(LAS u32x2*)(ow + c * 64 + 16 * d4 + 4 * q) = pack4(oacc1[d4]); }
            LDS_WAIT();
#pragma unroll
            for (int u = 0; u < 2; ++u) { const int p = lane + 64 * u, rr = p >> 3, ch = p & 7; const u32x4 pv = *(const LAS u32x4*)(ow + rr * 64 + ch * 8), z = zz[u]; u32x4 wv;
                wv.x = pk2(bf2f(pv.x & 0xffffu) * bf2f(z.x & 0xffffu), bf2f(pv.x >> 16) * bf2f(z.x >> 16)); wv.y = pk2(bf2f(pv.y & 0xffffu) * bf2f(z.y & 0xffffu), bf2f(pv.y >> 16) * bf2f(z.y >> 16));
                wv.z = pk2(bf2f(pv.z & 0xffffu) * bf2f(z.z & 0xffffu), bf2f(pv.z >> 16) * bf2f(z.z >> 16)); wv.w = pk2(bf2f(pv.w & 0xffffu) * bf2f(z.w & 0xffffu), bf2f(pv.w >> 16) * bf2f(z.w >> 16));
                *(u32x4*)(OM + ((size_t)b * SEQ + 256 * qblk + 32 * w + 16 * t + rr) * 1024 + h * 256 + 64 * dg + ch * 8) = wv; }
            LDS_WAIT(); asm volatile("" ::: "memory");
        }
    }
}
__device__ __forceinline__ void p2_attn_prompt(Frame& F, int wk, int nwk) {
    const int gw = wk * NWAVES + F.wave, NGW = nwk * NWAVES, lane = F.lane;
    for (int it = wk; it < 256; it += nwk) { const int qblk = it & 31, bh = it >> 5; mem_wg_item(F, bh >> 2, bh & 3, qblk); }
    __syncthreads();
    { LAS float* BTl = (LAS float*)(F.lds + LDS_BT); const float* BT = (const float*)(F.ws + WS_BTAB); for (int i = F.tid; i < 2048; i += NTHREADS) BTl[i] = BT[i]; }
    __syncthreads();
    for (int it = wk; it < 256; it += nwk) { const int qb = it & 63, bk = it >> 6; swa_wg_item(F, bk >> 1, bk & 1, qb); }
    __syncthreads();
    const bf16_t* SKV = (const bf16_t*)(F.ws + WS_SKV);
    for (int it = gw; it < 256; it += NGW) { const int b = it >> 7, j = it & 127; const bf16_t* pp = SKV + (size_t)(b * SEQ + SEQ - 128 + j) * 256;
        for (int cc = lane; cc < 128; cc += 64) { F.out[O_SKP + ((size_t)b * 128 + j) * 128 + cc] = bf2f(pp[cc]); F.out[O_SVP + ((size_t)b * 128 + j) * 128 + cc] = bf2f(pp[128 + cc]); } }
}
__device__ __forceinline__ void p2_swa_sample(Frame& F, int wk, int nwk) {
    const int gw = wk * NWAVES + F.wave, NGW = nwk * NWAVES, lane = F.lane;
    const bf16_t* SKV = (const bf16_t*)(F.ws + WS_SKV);
    for (int it = gw; it < MS * 2; it += NGW) { const int r = it >> 1, kv = it & 1; swa_wave_item(F, true, r >> 2, r & 3, kv); }
    { const u32x4* s4 = (const u32x4*)(F.ws + WS_OMS); u32x4* d4 = (u32x4*)(F.ws + WS_OM + (size_t)MP * 1024 * 2); for (int i = gw * 64 + lane; i < MS * 1024 / 8; i += NGW * 64) d4[i] = s4[i]; }
    { const int gt = gw * 64 + lane, NT = NGW * 64;
        for (int i = gt; i < 128 * 124 * 32; i += NT) { const int bd = i / (124 * 32), e = i - bd * (124 * 32);
            ((f32x4*)(F.out + O_SKS + (size_t)bd * 16384))[e] = ((const f32x4*)(F.in[I_CSK] + (size_t)bd * 16384 + 512))[e];
            ((f32x4*)(F.out + O_SVS + (size_t)bd * 16384))[e] = ((const f32x4*)(F.in[I_CSV] + (size_t)bd * 16384 + 512))[e]; }
        for (int i = gt; i < 128 * 4 * 128; i += NT) { const int bd = i >> 9, jj = (i >> 7) & 3, cc = i & 127; const bf16_t* pp = SKV + (size_t)(MP + bd * 4 + jj) * 256;
            F.out[O_SKS + ((size_t)bd * 128 + 124 + jj) * 128 + cc] = bf2f(pp[cc]); F.out[O_SVS + ((size_t)bd * 128 + 124 + jj) * 128 + cc] = bf2f(pp[128 + cc]); } }
}
__device__ __forceinline__ void mem_sample_item(Frame& F, int bd, int hp) {
    const int lane = F.lane, w = F.wave, tid = F.tid, hl = lane >> 5, h = 2 * hp + hl, d0 = (lane & 31) * 8;
    const bf16_t* MQ = (const bf16_t*)(F.ws + WS_MQ); const bf16_t* MZ = (const bf16_t*)(F.ws + WS_MZ); bf16_t* OM = (bf16_t*)(F.ws + WS_OM);
    LAS float* lg = (LAS float*)F.lds;
    LAS float* isum = lg + 2048;
    LAS float* po = isum + 8;
    float qr[4][8];
#pragma unroll
    for (int s = 0; s < 4; ++s) { const u32x4 v = *(const u32x4*)(MQ + (size_t)(MP + bd * 4 + s) * 1024 + h * 256 + d0);
        qr[s][0] = bf2f(v.x & 0xffffu); qr[s][1] = bf2f(v.x >> 16); qr[s][2] = bf2f(v.y & 0xffffu); qr[s][3] = bf2f(v.y >> 16);
        qr[s][4] = bf2f(v.z & 0xffffu); qr[s][5] = bf2f(v.z >> 16); qr[s][6] = bf2f(v.w & 0xffffu); qr[s][7] = bf2f(v.w >> 16); }
    const float* Kc = F.in[I_CMK] + ((size_t)bd * 256 * 4 + h) * 256 + d0; const float* Vc = F.in[I_CMV] + ((size_t)bd * 256 * 4 + h) * 256 + d0;
#pragma unroll 4
    for (int i = 0; i < 32; ++i) { const int m = w + 8 * i; const f32x4 k0 = *(const f32x4*)(Kc + (size_t)m * 1024), k1 = *(const f32x4*)(Kc + (size_t)m * 1024 + 4);
        float l[4];
#pragma unroll
        for (int s = 0; s < 4; ++s) { float a = k0.x * qr[s][0] + k0.y * qr[s][1] + k0.z * qr[s][2] + k0.w * qr[s][3] + k1.x * qr[s][4] + k1.y * qr[s][5] + k1.z * qr[s][6] + k1.w * qr[s][7];
#pragma unroll
            for (int o = 1; o < 32; o <<= 1) a += __shfl_xor(a, o);
            l[s] = a * 0.0625f; }
        if ((lane & 31) == 0) {
#pragma unroll
            for (int s = 0; s < 4; ++s) lg[(hl * 4 + s) * 256 + m] = l[s]; } }
    __syncthreads();
    { const int pr = w; float l4[4];
#pragma unroll
        for (int u = 0; u < 4; ++u) l4[u] = lg[pr * 256 + lane + 64 * u];
        const float mx = wave_max(fmaxf(fmaxf(l4[0], l4[1]), fmaxf(l4[2], l4[3]))); float s = 0.f;
#pragma unroll
        for (int u = 0; u < 4; ++u) { l4[u] = __expf(l4[u] - mx); s += l4[u]; lg[pr * 256 + lane + 64 * u] = l4[u]; }
        s = wave_sum(s); if (lane == 0) isum[pr] = 1.f / s; }
    __syncthreads();
    float o[4][8];
#pragma unroll
    for (int s = 0; s < 4; ++s)
#pragma unroll
        for (int j = 0; j < 8; ++j) o[s][j] = 0.f;
#pragma unroll 4
    for (int i = 0; i < 32; ++i) { const int m = w + 8 * i; const f32x4 v0 = *(const f32x4*)(Vc + (size_t)m * 1024), v1 = *(const f32x4*)(Vc + (size_t)m * 1024 + 4);
#pragma unroll
        for (int s = 0; s < 4; ++s) { const float p = lg[(hl * 4 + s) * 256 + m];
            o[s][0] += p * v0.x; o[s][1] += p * v0.y; o[s][2] += p * v0.z; o[s][3] += p * v0.w; o[s][4] += p * v1.x; o[s][5] += p * v1.y; o[s][6] += p * v1.z; o[s][7] += p * v1.w; } }
#pragma unroll
    for (int s = 0; s < 4; ++s) { LAS float* pp = po + ((w * 4 + s) * 512 + hl * 256 + d0);
        *(LAS f32x4*)pp = (f32x4){o[s][0], o[s][1], o[s][2], o[s][3]}; *(LAS f32x4*)(pp + 4) = (f32x4){o[s][4], o[s][5], o[s][6], o[s][7]}; }
    __syncthreads();
#pragma unroll
    for (int u = 0; u < 4; ++u) { const int e = tid + 512 * u, s = e >> 9, cc = e & 511; float a = 0.f;
#pragma unroll
        for (int ww = 0; ww < 8; ++ww) a += po[(ww * 4 + s) * 512 + cc];
        const int hh = 2 * hp + (cc >> 8); const size_t oo = (size_t)(MP + bd * 4 + s) * 1024 + hh * 256 + (cc & 255);
        ((bf16_t*)(F.ws + WS_OMS))[oo - (size_t)MP * 1024] = (bf16_t)f2bf(a * isum[(cc >> 8) * 4 + s] * bf2f(MZ[oo])); }
    __syncthreads();
}

struct SchedP3 {
    int G, c; const unsigned char* ws;
    __device__ __forceinline__ int ntiles(const pg8::Unit&) const { return 1024 / 64; }
    __device__ __forceinline__ bool next(int i, pg8::Unit& u) const {
        if (i < 6) { const int round = i / 3, b = i - round * 3; pg8::tile_of(round * G + c, 64, 8, u.pm, u.pn); u.job = b; return true; }
        if (i == 6 && c < 48) { u.pm = 64 + c / 24; const int rem = c % 24; u.pn = rem / 3; u.job = rem % 3; return true; }
        return false;
    }
    __device__ __forceinline__ void ptrs(const pg8::Unit& u, const char*& A, const char*& B) const {
        A = (const char*)ws + WS_OG + (size_t)u.job * M * 1024 * 2 + (size_t)u.pm * 256 * 1024 * 2;
        B = (const char*)ws + WS_WB + (size_t)u.job * 2048 * 1024 * 2 + (size_t)u.pn * 256 * 1024 * 2;
    }
};
struct EpiP3 {
    unsigned char* ws;
    __device__ __forceinline__ void operator()(const f32x4 (&acc)[2][2][4][2], const pg8::Unit& u, int wr, int wc, int fr, int fq) const {
        const int row0 = u.pm * 256 + wr * 64 + fr, col0 = u.pn * 256 + wc * 32 + 8 * fq, b = u.job;
        const bf16_t* GT = (const bf16_t*)(ws + WS_GATES); bf16_t* MG = (bf16_t*)(ws + WS_MERGED);
        const bool rmw = (b > 0) && (u.pm < 64);
#pragma unroll
        for (int ai = 0; ai < 2; ++ai) {
            u32x4 g[4][2], p[4][2];
#pragma unroll
            for (int m = 0; m < 4; ++m)
#pragma unroll
                for (int bj = 0; bj < 2; ++bj) { const int r = row0 + ai * 128 + m * 16, c = col0 + bj * 128;
                    g[m][bj] = *(const u32x4*)(GT + (size_t)r * 6144 + b * 2048 + c);
                    p[m][bj] = rmw ? *(const u32x4*)(MG + (size_t)r * 2048 + c) : (u32x4){0u, 0u, 0u, 0u}; }
#pragma unroll
            for (int m = 0; m < 4; ++m)
#pragma unroll
                for (int bj = 0; bj < 2; ++bj) { const int r = row0 + ai * 128 + m * 16, c = col0 + bj * 128;
                    const u32x4 gg = g[m][bj], pp = p[m][bj];
                    f32x4 v0 = acc[ai][bj][m][0], v1 = acc[ai][bj][m][1];
                    v0[0] = v0[0] * bf2f(gg.x & 0xffffu) + bf2f(pp.x & 0xffffu); v0[1] = v0[1] * bf2f(gg.x >> 16) + bf2f(pp.x >> 16); v0[2] = v0[2] * bf2f(gg.y & 0xffffu) + bf2f(pp.y & 0xffffu); v0[3] = v0[3] * bf2f(gg.y >> 16) + bf2f(pp.y >> 16);
                    v1[0] = v1[0] * bf2f(gg.z & 0xffffu) + bf2f(pp.z & 0xffffu); v1[1] = v1[1] * bf2f(gg.z >> 16) + bf2f(pp.z >> 16); v1[2] = v1[2] * bf2f(gg.w & 0xffffu) + bf2f(pp.w & 0xffffu); v1[3] = v1[3] * bf2f(gg.w >> 16) + bf2f(pp.w >> 16);
                    u32x4 w; w.x = pg8::cvt_pk_bf16(v0[0], v0[1]); w.y = pg8::cvt_pk_bf16(v0[2], v0[3]); w.z = pg8::cvt_pk_bf16(v1[0], v1[1]); w.w = pg8::cvt_pk_bf16(v1[2], v1[3]);
                    u32x4* mp = u.pm < 64 ? (u32x4*)(MG + (size_t)r * 2048 + c) : (u32x4*)((bf16_t*)(ws + WS_PS) + ((size_t)b * MS + (r - MP)) * 2048 + c);
                    *mp = w; }
        }
    }
};

struct SchedP4 {
    int G, c; const unsigned char* ws;
    __device__ __forceinline__ int ntiles(const pg8::Unit& u) const { return u.job == 0 ? D / 64 : 512 / 64; }
    __device__ __forceinline__ bool next(int i, pg8::Unit& u) const {
        if (i < 2) { pg8::tile_of(i * G + c, 64, 8, u.pm, u.pn); u.job = 0; return true; }
        if (i == 2 && c < 64) { u.pm = 64 + c / 32; const int rem = c % 32; u.pn = rem / 4; u.job = 1 + (rem & 3); return true; }
        return false;
    }
    __device__ __forceinline__ void ptrs(const pg8::Unit& u, const char*& A, const char*& B) const {
        const size_t ko = u.job == 0 ? 0 : (size_t)(u.job - 1) * 512 * 2;
        A = (const char*)ws + WS_MERGED + (size_t)u.pm * 256 * 2048 * 2 + ko; B = (const char*)ws + WS_WO + (size_t)u.pn * 256 * 2048 * 2 + ko;
    }
};
struct EpiP4 {
    unsigned char* ws; float* out; const float* xp; const float* xs;
    __device__ __forceinline__ void operator()(const f32x4 (&acc)[2][2][4][2], const pg8::Unit& u, int wr, int wc, int fr, int fq) const {
        const int row0 = u.pm * 256 + wr * 64 + fr, col0 = u.pn * 256 + wc * 32 + 8 * fq;
        if (u.job != 0) {
#pragma unroll
            for (int ai = 0; ai < 2; ++ai)
#pragma unroll
                for (int m = 0; m < 4; ++m) { const int r = row0 + ai * 128 + m * 16; float* yp = (float*)(ws + WS_YP) + ((size_t)(u.job - 1) * MS + (r - MP)) * D;
#pragma unroll
                    for (int bj = 0; bj < 2; ++bj) { const int c = col0 + bj * 128; *(f32x4*)(yp + c) = acc[ai][bj][m][0]; *(f32x4*)(yp + c + 4) = acc[ai][bj][m][1]; } }
            return;
        }
        bf16_t* DL = (bf16_t*)(ws + WS_DELTA);
#pragma unroll
        for (int ai = 0; ai < 2; ++ai)
#pragma unroll
            for (int m = 0; m < 4; ++m) { bf16_t* dr = DL + (size_t)(row0 + ai * 128 + m * 16) * D + col0;
#pragma unroll
                for (int bj = 0; bj < 2; ++bj) { const f32x4 v0 = acc[ai][bj][m][0], v1 = acc[ai][bj][m][1];
                    u32x4 w; w.x = pg8::cvt_pk_bf16(v0[0], v0[1]); w.y = pg8::cvt_pk_bf16(v0[2], v0[3]); w.z = pg8::cvt_pk_bf16(v1[0], v1[1]); w.w = pg8::cvt_pk_bf16(v1[2], v1[3]);
                    *(u32x4*)(dr + bj * 128) = w; } }
    }
};
__device__ __forceinline__ void p3_combine_sample(Frame& F) {
    const u32x4* ps = (const u32x4*)(F.ws + WS_PS); u32x4* mg = (u32x4*)(F.ws + WS_MERGED + (size_t)MP * 2048 * 2);
    constexpr int NV = MS * 2048 / 8;
    for (int i = F.bid * NTHREADS + F.tid; i < NV; i += F.G * NTHREADS) { const u32x4 a = ps[i], b = ps[NV + i], c = ps[2 * NV + i]; u32x4 o;
        o.x = pk2(bf2f(a.x & 0xffffu) + bf2f(b.x & 0xffffu) + bf2f(c.x & 0xffffu), bf2f(a.x >> 16) + bf2f(b.x >> 16) + bf2f(c.x >> 16));
        o.y = pk2(bf2f(a.y & 0xffffu) + bf2f(b.y & 0xffffu) + bf2f(c.y & 0xffffu), bf2f(a.y >> 16) + bf2f(b.y >> 16) + bf2f(c.y >> 16));
        o.z = pk2(bf2f(a.z & 0xffffu) + bf2f(b.z & 0xffffu) + bf2f(c.z & 0xffffu), bf2f(a.z >> 16) + bf2f(b.z >> 16) + bf2f(c.z >> 16));
        o.w = pk2(bf2f(a.w & 0xffffu) + bf2f(b.w & 0xffffu) + bf2f(c.w & 0xffffu), bf2f(a.w >> 16) + bf2f(b.w >> 16) + bf2f(c.w >> 16));
        mg[i] = o; }
}
__device__ __forceinline__ void p5_final_norm(Frame& F) {
    const int gw = F.bid * NWAVES + F.wave, NGW = F.G * NWAVES, lane = F.lane;
    const f32x4* wn = (const f32x4*)F.in[I_NORMF] + lane;
    for (int r = gw; r < M; r += NGW) {
        f32x4* y = (f32x4*)(F.out + (size_t)r * D) + lane;
        f32x4 v[8]; float s = 0.f;
        if (r >= MP) { const f32x4* xs4 = (const f32x4*)(F.in[I_XS] + (size_t)(r - MP) * D) + lane; const f32x4* yp4 = (const f32x4*)((const float*)(F.ws + WS_YP) + (size_t)(r - MP) * D) + lane;
#pragma unroll
            for (int j = 0; j < 8; ++j) { f32x4 a = xs4[64 * j];
#pragma unroll
                for (int kq = 0; kq < 4; ++kq) a = a + yp4[(size_t)kq * MS * D / 4 + 64 * j];
                v[j] = a; s += (a.x * a.x + a.y * a.y) + (a.z * a.z + a.w * a.w); } }
        else { const f32x4* xp4 = (const f32x4*)(F.in[I_XP] + (size_t)r * D) + lane; const u32x2* dl = (const u32x2*)((const bf16_t*)(F.ws + WS_DELTA) + (size_t)r * D) + lane;
#pragma unroll
            for (int j = 0; j < 8; ++j) { const u32x2 dd = dl[64 * j]; f32x4 a = xp4[64 * j];
                a.x += bf2f(dd.x & 0xffffu); a.y += bf2f(dd.x >> 16); a.z += bf2f(dd.y & 0xffffu); a.w += bf2f(dd.y >> 16);
                v[j] = a; s += (a.x * a.x + a.y * a.y) + (a.z * a.z + a.w * a.w); } }
        const float sc = rsqrtf(wave_sum(s) * (1.f / D) + EPS);
#pragma unroll
        for (int j = 0; j < 8; ++j) { const f32x4 w = wn[64 * j]; f32x4 o = v[j]; o.x *= sc * w.x; o.y *= sc * w.y; o.z *= sc * w.z; o.w *= sc * w.w; y[64 * j] = o; }
    }
}

constexpr int N_PHASES = 10;
__global__ void __launch_bounds__(NTHREADS, 2) hybrid_fwd(Args args) {
    extern __shared__ __attribute__((aligned(16))) unsigned char lds_raw[];
    cg::grid_group grid = cg::this_grid();
    Frame F;
    F.lds = (LAS unsigned char*)lds_raw; F.tid = threadIdx.x; F.lane = F.tid & 63; F.wave = __builtin_amdgcn_readfirstlane(F.tid >> 6);
    F.G = gridDim.x; F.bid = blockIdx.x; F.in = args.in; F.out = args.out; F.ws = args.ws;
    const int lo = args.ph_lo, hi = args.ph_hi;
    if (lo < 0) grid.sync();
    if (F.tid < 64) ((LAS unsigned*)(F.lds + LDS_CTL))[F.tid] = 0u;
    __syncthreads();
    const XcdBarrier bar = xcd_barrier_post((unsigned*)(F.ws + WS_CTL), (volatile LAS unsigned*)(F.lds + LDS_CTL));
#define IN(k) (lo <= (k) && (k) < hi)
#define SEAM(k) do { if (IN(k) && IN((k) + 1)) xcd_barrier(bar); } while (0)
    if (IN(0)) p0_prologue(F);
    SEAM(0);
    if (IN(1)) { SchedP1 S{F.G, F.bid, F.ws, (const unsigned char*)F.out + DO_XN}; EpiP1 E{F.ws, F.out}; pg8::gemm_phase<EpiP1, SchedP1>(F.lds, D, S, E); }
    SEAM(1);
    if (IN(2)) { p2_conv(F); __syncthreads(); for (int it = F.bid; it < 256; it += F.G) mem_sample_item(F, it >> 1, it & 1); }
    SEAM(2);
    if (IN(3)) p2_prep(F);
    SEAM(3);
    if (IN(4)) {
        constexpr int GSPLIT = 1024;
        if (F.bid < 128) { scan_item(F, F.bid & 15, F.bid >> 4); __syncthreads(); p2_gdn_sample(F, F.bid, 128, 0, GSPLIT); }
        else { const int wk = F.bid - 128, nwk = F.G - 128; p2_attn_prompt(F, wk, nwk); __syncthreads(); p2_swa_sample(F, wk, nwk); __syncthreads(); p2_gdn_sample(F, wk, nwk, GSPLIT, 1024); }
    }
    SEAM(4);
    if (IN(5)) { for (int it = F.bid; it < 256; it += F.G) gdn_out_item(F, it); p2_gdn_norm_sample(F); }
    SEAM(5);
    if (IN(6)) { SchedP3 S{F.G, F.bid, F.ws}; EpiP3 E{F.ws}; pg8::gemm_phase<EpiP3, SchedP3>(F.lds, 1024, S, E); }
    SEAM(6);
    if (IN(7)) p3_combine_sample(F);
    SEAM(7);
    if (IN(8)) { SchedP4 S{F.G, F.bid, F.ws}; EpiP4 E{F.ws, F.out, F.in[I_XP], F.in[I_XS]}; pg8::gemm_phase<EpiP4, SchedP4>(F.lds, D, S, E); }
    SEAM(8);
    if (IN(9)) p5_final_norm(F);
#undef IN
#undef SEAM
}

extern "C" void kernel_launch(void* const* d_in, const int* in_sizes, int n_in, void* d_out, int out_size, void* d_ws, size_t ws_size, hipStream_t stream) {
    static int grid = 0;
    if (grid == 0) {
        if (n_in != 22 || out_size != (int)O_END || ws_size < WS_END) { fprintf(stderr, "kernel_launch: unexpected shapes (n_in %d out %d ws %zu need %zu)\n", n_in, out_size, ws_size, (size_t)WS_END); grid = -1; return; }
        int dev = 0, cus = 0, per_cu = 0;
        hipGetDevice(&dev); hipDeviceGetAttribute(&cus, hipDeviceAttributeMultiprocessorCount, dev);
        hipFuncSetAttribute((const void*)hybrid_fwd, hipFuncAttributeMaxDynamicSharedMemorySize, LDS_BYTES);
        hipOccupancyMaxActiveBlocksPerMultiprocessor(&per_cu, (const void*)hybrid_fwd, NTHREADS, LDS_BYTES);
        if (per_cu < 1) { fprintf(stderr, "kernel_launch: occupancy query says %d blocks per CU\n", per_cu); grid = -1; return; }
        grid = cus;
    }
    if (grid < 0) return;
    Args a{};
    for (int i = 0; i < 22; ++i) a.in[i] = (const float*)d_in[i];
    a.out = (float*)d_out; a.ws = (unsigned char*)d_ws;
    if (hipMemsetAsync((char*)d_ws + WS_CTL, 0, XCD_BAR_WORDS * 4, stream) != hipSuccess) { fprintf(stderr, "kernel_launch: hipMemsetAsync failed\n"); return; }
#if MK_N_LAUNCHES == 1
    a.ph_lo = 0; a.ph_hi = N_PHASES;
    void* kargs[] = {&a};
    hipError_t e = hipLaunchCooperativeKernel((const void*)hybrid_fwd, dim3(grid), dim3(NTHREADS), kargs, LDS_BYTES, stream);
    if (e != hipSuccess) fprintf(stderr, "cooperative launch failed: %s (grid %d)\n", hipGetErrorString(e), grid);
#endif
}
```

```cpp
#include <hip/hip_runtime.h>
#include <hip/hip_cooperative_groups.h>
#include <cstdio>
#include <cstdint>
namespace cg = cooperative_groups;

#ifndef MK_N_LAUNCHES
#define MK_N_LAUNCHES 1
#endif

#define LAS __attribute__((address_space(3)))
typedef unsigned short bf16_t;
typedef short bf16x8 __attribute__((ext_vector_type(8)));
typedef float f32x4 __attribute__((ext_vector_type(4)));
typedef unsigned u32x4 __attribute__((ext_vector_type(4)));
typedef unsigned u32x2 __attribute__((ext_vector_type(2)));

constexpr int D = 2048, SEQ = 8192, MP = 2 * SEQ, MS = 512, M = MP + MS;
constexpr int IN_COLS = 14608;
constexpr int NIN = 58 * 256;
constexpr float EPS = 1e-6f;
__host__ __device__ __forceinline__ int win_src_col(int j) {
    if (j < 4096) return j;
    if (j < 5120) return 4112 + (j - 4096);
    if (j < 6144) return 5392 + (j - 5120);
    if (j < 7168) return 6416 + (j - 6144);
    if (j < 8192) return 7440 + (j - 7168);
    if (j < 14336) return 8464 + (j - 8192);
    if (j < 14592) return 5136 + (j - 14336);
    if (j < 14608) return 4096 + (j - 14592);
    return -1;
}
constexpr size_t O_YP = 0, O_YS = O_YP + (size_t)MP * D, O_GSP = O_YS + (size_t)MS * D, O_GCP = O_GSP + 2 * 8 * 128 * 128, O_SKP = O_GCP + 2 * 3 * 3072,
                 O_SVP = O_SKP + 2 * 128 * 128, O_MKP = O_SVP + 2 * 128 * 128, O_MVP = O_MKP + 512 * 1024, O_GSS = O_MVP + 512 * 1024,
                 O_GCS = O_GSS + (size_t)128 * 8 * 128 * 128, O_SKS = O_GCS + 128 * 3 * 3072, O_SVS = O_SKS + 128 * 128 * 128, O_END = O_SVS + 128 * 128 * 128;
static_assert(O_END == 58148864, "d_out map");
constexpr size_t al(size_t x) { return (x + 255) & ~(size_t)255; }
constexpr size_t WS_CTL = 0, WS_WB = 1u << 20, WS_WO = WS_WB + al((size_t)3 * 2048 * 1024 * 2), WS_WIN = WS_WO + al((size_t)2048 * 2048 * 2),
                 WS_WMKV = WS_WIN + al((size_t)NIN * 2048 * 2), WS_QKV = WS_WMKV + al((size_t)2048 * 2048 * 2), WS_GZ = WS_QKV + al((size_t)M * 3072 * 2),
                 WS_SQ = WS_GZ + al((size_t)M * 1024 * 2), WS_SZ = WS_SQ + al((size_t)M * 1024 * 2), WS_MQ = WS_SZ + al((size_t)M * 1024 * 2), WS_MZ = WS_MQ + al((size_t)M * 1024 * 2),
                 WS_SKV = WS_MZ + al((size_t)M * 1024 * 2), WS_GATES = WS_SKV + al((size_t)M * 256 * 2), WS_MEMN = WS_GATES + al((size_t)M * 6144 * 2),
                 WS_MEMKV = WS_MEMN + al((size_t)512 * 2048 * 2), WS_GAB = WS_MEMKV + al((size_t)512 * 2048 * 2), WS_ROWSS = WS_GAB + al((size_t)M * 16 * 4),
                 WS_G = WS_ROWSS + al((size_t)M * 4), WS_BETA = WS_G + al((size_t)M * 8 * 4), WS_BTAB = WS_BETA + al((size_t)M * 8 * 4), WS_END0 = WS_BTAB + al(16 * 128 * 4);
constexpr size_t WS_OG = WS_QKV, WS_OS = WS_OG + (size_t)M * 1024 * 2, WS_OM = WS_OS + (size_t)M * 1024 * 2, WS_MERGED = WS_SQ;
constexpr size_t WS_NEGW = WS_OG, WS_SN = WS_WIN, WS_OMS = WS_MEMN, WS_DELTA = WS_QKV;
constexpr size_t WS_UT = WS_END0, WS_ATT = WS_UT + al((size_t)2048 * 128 * 64 * 2), WS_GC = WS_ATT + al((size_t)2048 * 64 * 64 * 2), WS_DEC = WS_GC + al((size_t)MP * 8 * 4),
                 WS_GT = WS_DEC + al((size_t)2048 * 64 * 4), WS_MVT = WS_GT + al(2048 * 4), WS_VTS = WS_MVT + al((size_t)2 * 4 * 256 * 256 * 2), WS_SSQ = WS_VTS + al((size_t)2 * 2 * 64 * SEQ * 2 + 4096), WS_SSK = WS_SSQ + al((size_t)MP * 8 * 4), WS_END = WS_SSK + al((size_t)MP * 8 * 4);
constexpr size_t WS_PS = WS_UT, WS_YP = WS_UT;
static_assert((size_t)6 * MS * 2048 * 2 <= (size_t)2048 * 128 * 64 * 2 && (size_t)8 * MS * 2048 * 4 <= (size_t)2048 * 128 * 64 * 2, "PS/YP fit in UT");
static_assert(WS_OM + (size_t)M * 1024 * 2 <= WS_GZ && WS_MERGED + (size_t)M * 2048 * 2 <= WS_MQ, "overlays");
static_assert((size_t)2048 * 64 * 128 * 2 <= (size_t)MP * 1024 * 2 && WS_SN + (size_t)2048 * 128 * 128 * 2 <= WS_QKV, "overlays 2");
static_assert(WS_END <= 670000000, "workspace budget");
constexpr size_t DO_XN = 0, DO_QN = 0, DO_KN = (size_t)M * 1024 * 2, DO_KT = 2 * (size_t)M * 1024 * 2, DO_VT = DO_KT + (size_t)2048 * 8192 * 2, DO_VNS = DO_VT + (size_t)2048 * 8192 * 2;
static_assert(DO_VNS + (size_t)512 * 1024 * 2 <= (size_t)M * D * 4, "y scratch");

constexpr int NWAVES = 8, NTHREADS = 512;
constexpr int LDS_CTL = 147456;
constexpr int LDS_BYTES = 147456 + 256;
constexpr int LDS_BT = 139264;

__device__ __forceinline__ float bf2f(unsigned v) { return __uint_as_float(v << 16); }
__device__ __forceinline__ unsigned f2bf(float f) { unsigned u = __float_as_uint(f); return (u + 0x7fffu + ((u >> 16) & 1u)) >> 16; }
__device__ __forceinline__ unsigned pk2(float lo, float hi) { return f2bf(lo) | (f2bf(hi) << 16); }
__device__ __forceinline__ float wave_sum(float v) {
#pragma unroll
    for (int o = 1; o < 64; o <<= 1) v += __shfl_xor(v, o);
    return v;
}
__device__ __forceinline__ float wave_max(float v) {
#pragma unroll
    for (int o = 1; o < 64; o <<= 1) v = fmaxf(v, __shfl_xor(v, o));
    return v;
}
__device__ __forceinline__ float sigmoidf_(float x) { return __builtin_amdgcn_rcpf(1.f + __expf(-x)); }
__device__ __forceinline__ float siluf_(float x) { return x * __builtin_amdgcn_rcpf(1.f + __expf(-x)); }
#define LDS_WAIT() asm volatile("s_waitcnt lgkmcnt(0)" ::: "memory")

#ifndef WGM_P1
#define WGM_P1 4
#endif
#ifndef WGM_P3
#define WGM_P3 4
#endif
#ifndef WGM_P4
#define WGM_P4 4
#endif
#ifndef P0_NSKIP
#define P0_NSKIP 3
#endif
#ifndef GSPLIT_V
#define GSPLIT_V 1024
#endif
#ifndef ALIGN_P3
#define ALIGN_P3 false
#endif
#ifndef ALIGN_P4
#define ALIGN_P4 false
#endif
namespace pg8 {
constexpr int BM = 256, BK = 64, HALF = 128, HTB = HALF * BK * 2, STAGE_BYTES = 8 * HTB, NXCD = 8;
__host__ __device__ __forceinline__ int lds_byte(int r, int c) { const int st = (r >> 4) * 2 + (c >> 5), rr = r & 15, cc = c & 31, ob = rr * 64 + cc * 2; return st * 1024 + (ob ^ (((ob >> 9) & 1) << 5)); }
__host__ __device__ __forceinline__ void stage_rc(int b, int& R, int& C) { const int st = b / 1024, sb = b % 1024, swz = sb ^ (((sb >> 9) & 1) << 5); R = (st >> 1) * 16 + swz / 64; C = (st & 1) * 32 + (swz % 64) / 2; }
__host__ __device__ __forceinline__ int perm32(int rho) { const int n = rho >> 4, i = rho & 15; return 8 * (i >> 2) + 4 * n + (i & 3); }
struct Unit { int pm, pn, job; };
__device__ __forceinline__ void tile_of(int L, int nM, int nN, int& pm, int& pn, const int WGM) {
    const int nwg = nM * nN; int wgid = L;
    { const int q = nwg / NXCD, r = nwg % NXCD, xcd = wgid % NXCD, off = wgid / NXCD; wgid = (xcd < r ? xcd * (q + 1) : r * (q + 1) + (xcd - r) * q) + off; }
    const int nig = WGM * nN, gid = wgid / nig, fm = gid * WGM, gsz = (nM - fm) < WGM ? (nM - fm) : WGM;
    pm = fm + ((wgid % nig) % gsz); pn = (wgid % nig) / gsz;
}
__device__ __forceinline__ unsigned cvt_pk_bf16(float lo, float hi) { unsigned r; asm volatile("v_cvt_pk_bf16_f32 %0, %1, %2" : "=v"(r) : "v"(lo), "v"(hi)); return r; }

template <class Epi, class Sched, bool ALIGN_EPI = true>
__device__ __forceinline__ void gemm_phase(LAS unsigned char* lds, const int K, const Sched& S, const Epi& E) {
    const int tid = threadIdx.x, wid = __builtin_amdgcn_readfirstlane(tid >> 6), lane = tid & 63, wr = wid >> 2, wc = wid & 3, fr = lane & 15, fq = lane >> 4;
    unsigned voffA[2], voffB[2];
#pragma unroll
    for (int i = 0; i < 2; ++i) { int R, C; stage_rc(tid * 16 + i * 8192, R, C); const int Rb = ((R & ~31) + perm32(R & 31));
        voffA[i] = (unsigned)(R * K + C) * 2u; voffB[i] = (unsigned)(Rb * K + C) * 2u; }
    const size_t kstep = (size_t)(BK * 2);
    const size_t hstep = (size_t)HALF * K * 2;
    const unsigned ldsw = (unsigned)wid * 1024u;
    const int aoff = lds_byte(wr * 64 + fr, fq * 8), boff = lds_byte(wc * 32 + fr, fq * 8);
#define PG8_SA(b, h) (((b) * 2 + (h)) * HTB)
#define PG8_SB(b, h) ((4 + (b) * 2 + (h)) * HTB)
#define PG8_STAGE(bufoff, gbase, voff) do { _Pragma("unroll") for (int _i = 0; _i < 2; ++_i) \
        __builtin_amdgcn_global_load_lds((const unsigned*)((const char*)(gbase) + (voff)[_i]), (LAS unsigned*)(lds + (bufoff) + ldsw + _i * 8192), 16, 0, 0); } while (0)
#define PG8_LDA(dst, b, h) do { _Pragma("unroll") for (int m = 0; m < 4; ++m) _Pragma("unroll") for (int k = 0; k < 2; ++k) dst[m][k] = *(const LAS bf16x8*)(lds + PG8_SA(b, h) + aoff + m * 2048 + k * 1024); } while (0)
#define PG8_LDB(dst, b, h) do { _Pragma("unroll") for (int n = 0; n < 2; ++n) _Pragma("unroll") for (int k = 0; k < 2; ++k) dst[n][k] = *(const LAS bf16x8*)(lds + PG8_SB(b, h) + boff + n * 2048 + k * 1024); } while (0)
#define PG8_MMA(ai, bj, At, Bt) do { __builtin_amdgcn_s_setprio(1); _Pragma("unroll") for (int m = 0; m < 4; ++m) _Pragma("unroll") for (int n = 0; n < 2; ++n) _Pragma("unroll") for (int k = 0; k < 2; ++k) \
        acc[ai][bj][m][n] = __builtin_amdgcn_mfma_f32_16x16x32_bf16(Bt[n][k], At[m][k], acc[ai][bj][m][n], 0, 0, 0); __builtin_amdgcn_s_setprio(0); } while (0)
#define PG8_WAIT_V(n) asm volatile("s_waitcnt vmcnt(" #n ")" ::: "memory")
#define PG8_WAIT_L(n) asm volatile("s_waitcnt lgkmcnt(" #n ")" ::: "memory")
#define PG8_BAR __builtin_amdgcn_s_barrier()
#define PG8_SCHED __builtin_amdgcn_sched_barrier(0)
    Unit cur, nxt; int ui = 0;
    volatile LAS unsigned* tslot = (volatile LAS unsigned*)(lds + 2 * STAGE_BYTES / 2 + 0);
    unsigned tk_next = 0u, tk_async = 0u;
    if constexpr (Sched::DYN) {
        if (!S.unit_of(S.first(), cur)) return;
        if (tid == 0) { tslot[1] = atomicAdd(S.ctr, 1u); }
        __syncthreads();
        tk_next = tslot[1];
    } else {
        if (!S.next(0, cur)) return;
    }
    f32x4 acc[2][2][4][2];
#pragma unroll
    for (int a = 0; a < 2; ++a)
#pragma unroll
        for (int b = 0; b < 2; ++b)
#pragma unroll
            for (int m = 0; m < 4; ++m)
#pragma unroll
                for (int n = 0; n < 2; ++n) acc[a][b][m][n] = (f32x4){0.f, 0.f, 0.f, 0.f};
    bf16x8 At[4][2], B0[2][2], B1[2][2];
    const char* cA; const char* cB; S.ptrs(cur, cA, cB);
    PG8_STAGE(PG8_SB(0, 0), cB, voffB); PG8_STAGE(PG8_SB(0, 1), cB + hstep, voffB); PG8_STAGE(PG8_SA(0, 0), cA, voffA); PG8_STAGE(PG8_SA(0, 1), cA + hstep, voffA);
    if (wr == 1) PG8_BAR;
    PG8_WAIT_V(2); PG8_BAR;
    PG8_STAGE(PG8_SB(1, 0), cB + kstep, voffB); PG8_STAGE(PG8_SA(1, 0), cA + kstep, voffA); PG8_STAGE(PG8_SB(1, 1), cB + hstep + kstep, voffB);
    PG8_WAIT_V(6); PG8_BAR;
    for (;;) {
        bool has_next;
        if constexpr (Sched::DYN) {
            has_next = S.unit_of(S.from_ticket(tk_next), nxt);
            if (tid == 0) asm volatile("global_atomic_add %0, %1, %2, off sc0" : "=v"(tk_async) : "v"(S.ctr), "v"(1u) : "memory");
        } else has_next = S.next(ui + 1, nxt);
        const char* nA = cA; const char* nB = cB; if (has_next) S.ptrs(nxt, nA, nB);
        const int nt = S.ntiles(cur);
        for (int t = 0; t < nt; t += 2) {
            const bool last = (t == nt - 2);
            const char* a1 = cA + (size_t)(t + 1) * kstep;
            const char* a2 = last ? nA : cA + (size_t)(t + 2) * kstep; const char* b2 = last ? nB : cB + (size_t)(t + 2) * kstep;
            const char* a3 = a2 + kstep; const char* b3 = b2 + kstep;
            PG8_LDB(B0, 0, 0); PG8_LDB(B1, 0, 1); PG8_SCHED; PG8_LDA(At, 0, 0); PG8_STAGE(PG8_SA(1, 1), a1 + hstep, voffA);
            PG8_WAIT_V(8); PG8_WAIT_L(0); PG8_BAR; PG8_MMA(0, 0, At, B0); PG8_MMA(0, 1, At, B1); PG8_BAR; PG8_SCHED;
            PG8_LDA(At, 0, 1); PG8_STAGE(PG8_SB(0, 0), b2, voffB); PG8_STAGE(PG8_SB(0, 1), b2 + hstep, voffB); PG8_STAGE(PG8_SA(0, 0), a2, voffA);
            PG8_WAIT_V(8); PG8_WAIT_L(0); PG8_BAR; PG8_MMA(1, 0, At, B0); PG8_MMA(1, 1, At, B1); PG8_BAR; PG8_SCHED;
            PG8_LDB(B0, 1, 0); PG8_LDB(B1, 1, 1); PG8_SCHED; PG8_LDA(At, 1, 0); PG8_STAGE(PG8_SA(0, 1), a2 + hstep, voffA);
            PG8_WAIT_V(8); PG8_WAIT_L(0); PG8_BAR; PG8_MMA(0, 0, At, B0); PG8_MMA(0, 1, At, B1); PG8_BAR; PG8_SCHED;
            PG8_LDA(At, 1, 1); PG8_STAGE(PG8_SB(1, 0), b3, voffB); PG8_STAGE(PG8_SB(1, 1), b3 + hstep, voffB); PG8_STAGE(PG8_SA(1, 0), a3, voffA);
            PG8_WAIT_V(8); PG8_WAIT_L(0); PG8_BAR; PG8_MMA(1, 0, At, B0); PG8_MMA(1, 1, At, B1); PG8_BAR; PG8_SCHED;
        }
        if constexpr (Sched::DYN) { if (tid == 0) { tslot[ui & 1] = tk_async; PG8_WAIT_L(0); } }
        if constexpr (ALIGN_EPI) { if (wr == 0) PG8_BAR; }
        E(acc, cur, wr, wc, fr, fq);
        if (!has_next) break;
        if constexpr (Sched::DYN) tk_next = tslot[ui & 1];
#pragma unroll
        for (int a = 0; a < 2; ++a)
#pragma unroll
            for (int b = 0; b < 2; ++b)
#pragma unroll
                for (int m = 0; m < 4; ++m)
#pragma unroll
                    for (int n = 0; n < 2; ++n) acc[a][b][m][n] = (f32x4){0.f, 0.f, 0.f, 0.f};
        cur = nxt; cA = nA; cB = nB; ++ui;
        if constexpr (ALIGN_EPI) { if (wr == 1) PG8_BAR; }
    }
    PG8_WAIT_V(0);
    if constexpr (!ALIGN_EPI) { if (wr == 0) PG8_BAR; }
    PG8_BAR;
#undef PG8_SA
#undef PG8_SB
#undef PG8_STAGE
#undef PG8_LDA
#undef PG8_LDB
#undef PG8_MMA
#undef PG8_WAIT_V
#undef PG8_WAIT_L
#undef PG8_BAR
#undef PG8_SCHED
}
}

#define XB_TMO      128
#define XB_XCNT(j)  (256  + 64 * (j))
#define XB_XSUB(j)  (1280 + 64 * (j))
#define XB_XGEN(j)  (2304 + 64 * (j))
#define XB_TOP      3328
#define XB_TOPGEN   3392
#define XCD_BAR_WORDS 3456
#define XB_SPIN_CAP (1u << 20)
__device__ __forceinline__ unsigned xb_ld(unsigned* p)              { return __hip_atomic_load(p, __ATOMIC_RELAXED, __HIP_MEMORY_SCOPE_AGENT); }
__device__ __forceinline__ unsigned xb_add(unsigned* p, unsigned v) { return __hip_atomic_fetch_add(p, v, __ATOMIC_RELAXED, __HIP_MEMORY_SCOPE_AGENT); }
__device__ __forceinline__ unsigned xb_xcc_id() { return (unsigned)__builtin_amdgcn_s_getreg((3 << 11) | 20) & 0xFu; }
#define XB_SPIN(cond, bar) do { unsigned _sp = 0; while (cond) { __builtin_amdgcn_s_sleep(1); \
    if ((++_sp & 255u) == 0u) { if (xb_ld(&(bar)[XB_TMO])) break; if (_sp > XB_SPIN_CAP) { atomicAdd(&(bar)[XB_TMO], 1u); break; } } } } while (0)
struct XcdBarrier { unsigned* bar; unsigned x; volatile LAS unsigned* st; };
__device__ __forceinline__ XcdBarrier xcd_barrier_post(unsigned* bar, volatile LAS unsigned* st) {
    XcdBarrier b; b.bar = bar; b.x = xb_xcc_id(); b.st = st;
    if (threadIdx.x == 0) (void)xb_add(&bar[XB_XCNT(b.x)], 1u);
    return b;
}
__device__ __forceinline__ void xcd_barrier_complete(unsigned* bar, unsigned x, unsigned& nloc, unsigned& nx) {
    const unsigned G = gridDim.x * gridDim.y * gridDim.z;
    unsigned sum, cnt, mine, sp = 0u;
    for (;;) {
        sum = 0u; cnt = 0u; mine = 0u;
#pragma unroll
        for (unsigned j = 0; j < 16; ++j) { const unsigned c = xb_ld(&bar[XB_XCNT(j)]); sum += c; cnt += (c > 0u) ? 1u : 0u; mine = (j == x) ? c : mine; }
        if (sum == G) break;
        __builtin_amdgcn_s_sleep(1);
        if ((++sp & 255u) == 0u) { if (xb_ld(&bar[XB_TMO])) break; if (sp > XB_SPIN_CAP) { atomicAdd(&bar[XB_TMO], 1u); break; } }
    }
    nloc = mine > 0u ? mine : 1u; nx = cnt > 0u ? cnt : 1u;
}
__device__ __forceinline__ void xcd_barrier(const XcdBarrier& b) {
    asm volatile("s_waitcnt vmcnt(0)" ::: "memory");
    __syncthreads();
    if (threadIdx.x == 0) {
        unsigned* bar = b.bar;
        __builtin_amdgcn_s_waitcnt(0);
        unsigned nloc = b.st[0], nx = b.st[1];
        if (nloc == 0u) { xcd_barrier_complete(bar, b.x, nloc, nx); b.st[0] = nloc; b.st[1] = nx; }
        const unsigned old = xb_add(&bar[XB_XSUB(b.x)], 1u);
        const unsigned gen = old / nloc;
        if (old + 1u == (gen + 1u) * nloc) {
            __builtin_amdgcn_fence(__ATOMIC_RELEASE, "agent");
            asm volatile("s_waitcnt vmcnt(0)" ::: "memory");
            const unsigned og = xb_add(&bar[XB_TOP], 1u);
            const unsigned tg = og / nx;
            if (og + 1u == (tg + 1u) * nx) xb_add(&bar[XB_TOPGEN], 1u);
            else XB_SPIN(xb_ld(&bar[XB_TOPGEN]) == tg, bar);
            __builtin_amdgcn_fence(__ATOMIC_ACQUIRE, "agent");
            xb_add(&bar[XB_XGEN(b.x)], 1u);
            asm volatile("s_waitcnt vmcnt(0)" ::: "memory");
        } else {
            XB_SPIN(xb_ld(&bar[XB_XGEN(b.x)]) == gen, bar);
            __builtin_amdgcn_fence(__ATOMIC_ACQUIRE, "agent");
            asm volatile("s_waitcnt vmcnt(0)" ::: "memory");
        }
    }
    __syncthreads();
}

struct Args { const float* in[22]; float* out; unsigned char* ws; int ph_lo, ph_hi; };
enum { I_XP = 0, I_XS, I_SGDN, I_SCONV, I_CSK, I_CSV, I_CMK, I_CMV, I_MEMP, I_NORM_IN, I_WIN, I_CONVW, I_ALOG, I_DTB, I_GNORM, I_SINKS, I_RELB, I_NORM_MEM, I_WMKV, I_WBR, I_WOUT, I_NORMF };

struct Frame {
    LAS unsigned char* lds;
    int tid, lane, wave, G, bid;
    const float* const* in; float* out; unsigned char* ws;
};

template <bool WINMAP>
__device__ __forceinline__ void p0_transpose_item(const float* W, int K, int Nsrc, bf16_t* WT, LAS bf16_t* scr, int kb, int nb, int lane) {
    constexpr int TP = 130;
    const int k0 = 64 * kb, n0 = 128 * nb;
    const int dj = n0 + 4 * (lane & 31);
    const int sc = WINMAP ? win_src_col(dj) : dj;
    f32x4 v[32];
#pragma unroll
    for (int i = 0; i < 32; ++i) { const int kk = 2 * i + (lane >> 5); v[i] = sc >= 0 ? __builtin_nontemporal_load((const f32x4*)(W + (size_t)(k0 + kk) * Nsrc + sc)) : (f32x4){0.f, 0.f, 0.f, 0.f}; }
#pragma unroll
    for (int i = 0; i < 32; ++i) { const int kk = 2 * i + (lane >> 5); LAS unsigned* d = (LAS unsigned*)(scr + kk * TP + 4 * (lane & 31)); d[0] = pk2(v[i].x, v[i].y); d[1] = pk2(v[i].z, v[i].w); }
    LDS_WAIT(); asm volatile("" ::: "memory");
#pragma unroll 4
    for (int u = 0; u < 16; ++u) { const int e = lane + 64 * u, ch = e & 7, n = e >> 3; const LAS bf16_t* s = scr + (8 * ch) * TP + n;
        u32x4 o; o.x = (unsigned)s[0] | ((unsigned)s[TP] << 16); o.y = (unsigned)s[2 * TP] | ((unsigned)s[3 * TP] << 16);
        o.z = (unsigned)s[4 * TP] | ((unsigned)s[5 * TP] << 16); o.w = (unsigned)s[6 * TP] | ((unsigned)s[7 * TP] << 16);
        *(u32x4*)(WT + (size_t)(n0 + n) * K + k0 + 8 * ch) = o; }
    LDS_WAIT(); asm volatile("" ::: "memory");
}
__device__ __forceinline__ void rms_row_to_bf16(const float* xrow, const float* w, bf16_t* orow, int lane) {
    const f32x4* xr = (const f32x4*)xrow + lane; const f32x4* wr = (const f32x4*)w + lane;
    f32x4 v[8]; float s = 0.f;
#pragma unroll
    for (int j = 0; j < 8; ++j) { v[j] = xr[64 * j]; s += (v[j].x * v[j].x + v[j].y * v[j].y) + (v[j].z * v[j].z + v[j].w * v[j].w); }
    const float r = rsqrtf(wave_sum(s) * (1.f / D) + EPS);
    unsigned long long* o8 = (unsigned long long*)orow + lane;
#pragma unroll
    for (int j = 0; j < 8; ++j) { const f32x4 ww = wr[64 * j];
        o8[64 * j] = (unsigned long long)pk2(v[j].x * r * ww.x, v[j].y * r * ww.y) | ((unsigned long long)pk2(v[j].z * r * ww.z, v[j].w * r * ww.w) << 32); }
}
__device__ __forceinline__ int t5_bucket(int n) {
    if (n < 16) return n;
    int large = 16 + (int)(logf((float)n / 16.f) / 2.0794415416798357f * 16.f);
    return large < 31 ? large : 31;
}
__device__ __forceinline__ void late_weight_items(Frame& F, int wk, int nwk) {
    LAS bf16_t* scr = (LAS bf16_t*)(F.lds + F.wave * 16896);
    constexpr int I_BR = 16 * 16, I_OUT = 32 * 16;
    bf16_t* WBT = (bf16_t*)(F.ws + WS_WB); bf16_t* WOT = (bf16_t*)(F.ws + WS_WO);
    for (int it = wk * NWAVES + F.wave; it < 3 * I_BR + I_OUT; it += nwk * NWAVES) {
        int r = it;
        if (r < 3 * I_BR) { const int b = r / I_BR, q = r % I_BR; p0_transpose_item<false>(F.in[I_WBR] + (size_t)b * 1024 * 2048, 1024, 2048, WBT + (size_t)b * 2048 * 1024, scr, q / 16, q % 16, F.lane); continue; } r -= 3 * I_BR;
        p0_transpose_item<false>(F.in[I_WOUT], D, 2048, WOT, scr, r / 16, r % 16, F.lane);
    }
}
__device__ __forceinline__ void p0_prologue(Frame& F) {
    LAS bf16_t* scr = (LAS bf16_t*)(F.lds + F.wave * 16896);
    const int gw = F.bid * NWAVES + F.wave, NGW = F.G * NWAVES;
    constexpr int I_IN = 32 * (NIN / 128), I_MKV = 32 * 16, I_BR = 16 * 16, I_OUT = 32 * 16;
    constexpr int NITEMS = I_IN + I_MKV;
    (void)I_BR; (void)I_OUT;
    bf16_t* WINT = (bf16_t*)(F.ws + WS_WIN); bf16_t* WMKVT = (bf16_t*)(F.ws + WS_WMKV);
    for (int it = gw; it < NITEMS; it += NGW) {
        int r = it;
        if (r < I_IN) { p0_transpose_item<true>(F.in[I_WIN], D, IN_COLS, WINT, scr, r / (NIN / 128), r % (NIN / 128), F.lane); continue; } r -= I_IN;
        p0_transpose_item<false>(F.in[I_WMKV], D, 2048, WMKVT, scr, r / 16, r % 16, F.lane);
    }
    bf16_t* XN = (bf16_t*)((unsigned char*)F.out + DO_XN); bf16_t* MEMN = (bf16_t*)(F.ws + WS_MEMN);
    {
        const int extra = NITEMS % NGW, nlate = NGW - extra, RA = P0_NSKIP * nlate, nA = gw >= extra ? P0_NSKIP : 0, lane = F.lane;
        const float* xpp = F.in[I_XP]; const float* xsp = F.in[I_XS]; const float* mpp = F.in[I_MEMP];
        asm volatile("" : "+s"(xpp), "+s"(xsp), "+s"(mpp));
#define P0_ROW_OF(j) ((j) < nA ? (gw - extra) + (j) * nlate : RA + gw + ((j) - nA) * NGW)
#define P0_SRC(m) ((m) < MP ? xpp + (size_t)(m) * D : (m) < M ? xsp + (size_t)((m) - MP) * D : mpp + (size_t)((m) - M) * D)
        f32x4 v[8];
        int m = P0_ROW_OF(0);
        if (m < M + 512) { const f32x4* xr = (const f32x4*)P0_SRC(m) + lane;
#pragma unroll
            for (int j = 0; j < 8; ++j) v[j] = __builtin_nontemporal_load(xr + 64 * j); }
#pragma unroll 1
        for (int jr = 0; m < M + 512; ++jr) {
            float s = 0.f;
#pragma unroll
            for (int j = 0; j < 8; ++j) s += (v[j].x * v[j].x + v[j].y * v[j].y) + (v[j].z * v[j].z + v[j].w * v[j].w);
            const int mn = P0_ROW_OF(jr + 1);
            f32x4 nv[8];
            if (mn < M + 512) { const f32x4* xr = (const f32x4*)P0_SRC(mn) + lane;
#pragma unroll
                for (int j = 0; j < 8; ++j) nv[j] = __builtin_nontemporal_load(xr + 64 * j); }
            const float r = rsqrtf(wave_sum(s) * (1.f / D) + EPS);
            const f32x4* wr = (const f32x4*)(m < M ? F.in[I_NORM_IN] : F.in[I_NORM_MEM]) + lane;
            unsigned long long* o8 = (unsigned long long*)(m < M ? XN + (size_t)m * D : MEMN + (size_t)(m - M) * D) + lane;
#pragma unroll
            for (int j = 0; j < 8; ++j) { const f32x4 ww = wr[64 * j];
                o8[64 * j] = (unsigned long long)pk2(v[j].x * r * ww.x, v[j].y * r * ww.y) | ((unsigned long long)pk2(v[j].z * r * ww.z, v[j].w * r * ww.w) << 32); }
#pragma unroll
            for (int j = 0; j < 8; ++j) v[j] = nv[j];
            m = mn;
        }
#undef P0_ROW_OF
#undef P0_SRC
    }
    float* BT = (float*)(F.ws + WS_BTAB);
    for (int i = F.bid * NTHREADS + F.tid; i < 16 * 128; i += F.G * NTHREADS) { const int h = i >> 7, dist = i & 127; BT[i] = F.in[I_RELB][t5_bucket(dist) * 16 + h]; }
}

struct SchedP1 {
    int G, c; const unsigned char* ws; const unsigned char* xn; unsigned* ctr;
    static constexpr bool DYN = true;
    __device__ __forceinline__ int ntiles(const pg8::Unit&) const { return D / 64; }
    static constexpr int NM = M / 256, NN = NIN / 256, NU0 = NM * NN, NU = NU0 + 16;
    __device__ __forceinline__ bool unit_of(long L, pg8::Unit& u) const {
        if (L >= NU) return false;
        if (L < 16) { u.pm = (int)L >> 3; u.pn = (int)L & 7; u.job = 1; } else { pg8::tile_of((int)L - 16, NM, NN, u.pm, u.pn, WGM_P1); u.job = 0; }
        return true;
    }
    __device__ __forceinline__ long first() const { return c; }
    __device__ __forceinline__ long from_ticket(unsigned t) const { const int x = c & 7; return ((long)t + (G - x + 7) / 8) * 8 + x; }
    __device__ __forceinline__ bool next(int i, pg8::Unit& u) const { return unit_of((long)i * G + c, u); }
    __device__ __forceinline__ void ptrs(const pg8::Unit& u, const char*& A, const char*& B) const {
        const size_t tstep = (size_t)256 * D * 2;
        if (u.job == 0) { A = (const char*)xn + (size_t)u.pm * tstep; B = (const char*)ws + WS_WIN + (size_t)u.pn * tstep; }
        else { A = (const char*)ws + WS_MEMN + (size_t)u.pm * tstep; B = (const char*)ws + WS_WMKV + (size_t)u.pn * tstep; }
    }
};
struct EpiP1 {
    unsigned char* ws; float* out;
    __device__ __forceinline__ void operator()(const f32x4 (&acc)[2][2][4][2], const pg8::Unit& u, int wr, int wc, int fr, int fq) const {
        const int row0 = u.pm * 256 + wr * 64 + fr;
        const int cin = wc * 32 + 8 * fq;
        if (u.job == 1) {
            bf16_t* MK = (bf16_t*)(ws + WS_MEMKV);
#pragma unroll
            for (int ai = 0; ai < 2; ++ai)
#pragma unroll
                for (int m = 0; m < 4; ++m) { const int r = row0 + ai * 128 + m * 16;
#pragma unroll
                    for (int bj = 0; bj < 2; ++bj) { const int c = u.pn * 256 + bj * 128 + cin; const f32x4 v0 = acc[ai][bj][m][0], v1 = acc[ai][bj][m][1];
                        float* o = out + (c < 1024 ? O_MKP + (size_t)r * 1024 + c : O_MVP + (size_t)r * 1024 + (c - 1024));
                        *(f32x4*)o = v0; *(f32x4*)(o + 4) = v1;
                        u32x4 w; w.x = pg8::cvt_pk_bf16(v0[0], v0[1]); w.y = pg8::cvt_pk_bf16(v0[2], v0[3]); w.z = pg8::cvt_pk_bf16(v1[0], v1[1]); w.w = pg8::cvt_pk_bf16(v1[2], v1[3]);
                        *(u32x4*)(MK + (size_t)r * 2048 + c) = w;
                        if (c >= 1024) { bf16_t* MVT = (bf16_t*)(ws + WS_MVT) + ((size_t)((r >> 8) * 4 + ((c - 1024) >> 8)) * 256 + ((c - 1024) & 255)) * 256 + (r & 255);
                            MVT[0] = (bf16_t)(w.x & 0xffffu); MVT[256] = (bf16_t)(w.x >> 16); MVT[512] = (bf16_t)(w.y & 0xffffu); MVT[768] = (bf16_t)(w.y >> 16);
                            MVT[1024] = (bf16_t)(w.z & 0xffffu); MVT[1280] = (bf16_t)(w.z >> 16); MVT[1536] = (bf16_t)(w.w & 0xffffu); MVT[1792] = (bf16_t)(w.w >> 16); } } }
            return;
        }
        const int pn = u.pn;
        if (pn == 57) {
            if (wc == 0 && fq < 2) { float* GAB = (float*)(ws + WS_GAB);
#pragma unroll
                for (int ai = 0; ai < 2; ++ai)
#pragma unroll
                    for (int m = 0; m < 4; ++m) { const int r = row0 + ai * 128 + m * 16; float* o = GAB + (size_t)r * 16 + 8 * fq; *(f32x4*)o = acc[ai][0][m][0]; *(f32x4*)(o + 4) = acc[ai][0][m][1]; } }
            return;
        }
        bf16_t* base; int ld, ct, act = 0;
        if (pn < 12) { base = (bf16_t*)(ws + WS_QKV); ld = 3072; ct = pn; }
        else if (pn < 16) { base = (bf16_t*)(ws + WS_GZ); ld = 1024; ct = pn - 12; act = 1; }
        else if (pn < 20) { base = (bf16_t*)(ws + WS_SQ); ld = 1024; ct = pn - 16; }
        else if (pn < 24) { base = (bf16_t*)(ws + WS_SZ); ld = 1024; ct = pn - 20; act = 1; }
        else if (pn < 28) { base = (bf16_t*)(ws + WS_MQ); ld = 1024; ct = pn - 24; }
        else if (pn < 32) { base = (bf16_t*)(ws + WS_MZ); ld = 1024; ct = pn - 28; act = 1; }
        else if (pn < 56) { base = (bf16_t*)(ws + WS_GATES); ld = 6144; ct = pn - 32; act = 2; }
        else { base = (bf16_t*)(ws + WS_SKV); ld = 256; ct = 0; }
#pragma unroll
        for (int ai = 0; ai < 2; ++ai)
#pragma unroll
            for (int m = 0; m < 4; ++m) { bf16_t* rowp = base + (size_t)(row0 + ai * 128 + m * 16) * ld + ct * 256 + cin;
#pragma unroll
                for (int bj = 0; bj < 2; ++bj) { f32x4 v0 = acc[ai][bj][m][0], v1 = acc[ai][bj][m][1];
                    if (act == 1) {
#pragma unroll
                        for (int j = 0; j < 4; ++j) { v0[j] = siluf_(v0[j]); v1[j] = siluf_(v1[j]); } }
                    else if (act == 2) {
#pragma unroll
                        for (int j = 0; j < 4; ++j) { v0[j] = sigmoidf_(v0[j]); v1[j] = sigmoidf_(v1[j]); } }
                    u32x4 w; w.x = pg8::cvt_pk_bf16(v0[0], v0[1]); w.y = pg8::cvt_pk_bf16(v0[2], v0[3]); w.z = pg8::cvt_pk_bf16(v1[0], v1[1]); w.w = pg8::cvt_pk_bf16(v1[2], v1[3]);
                    __builtin_nontemporal_store(w, (u32x4*)(rowp + bj * 128));
                    if (pn == 56 && bj == 1) { const int r = row0 + ai * 128 + m * 16;
                        if (r < MP) { bf16_t* vt = (bf16_t*)(ws + WS_VTS) + ((size_t)((r >> 13) * 2 + (cin >> 6)) * 64 + (cin & 63)) * SEQ + (r & (SEQ - 1));
                            vt[0] = (bf16_t)(w.x & 0xffffu); vt[SEQ] = (bf16_t)(w.x >> 16); vt[2 * SEQ] = (bf16_t)(w.y & 0xffffu); vt[3 * SEQ] = (bf16_t)(w.y >> 16);
                            vt[4 * SEQ] = (bf16_t)(w.z & 0xffffu); vt[5 * SEQ] = (bf16_t)(w.z >> 16); vt[6 * SEQ] = (bf16_t)(w.w & 0xffffu); vt[7 * SEQ] = (bf16_t)(w.w >> 16); } } } }
    }
};

__device__ __forceinline__ void gdn_gate_scalars(Frame& F, int r, int h) {
    const float* GAB = (const float*)(F.ws + WS_GAB); float* Gp = (float*)(F.ws + WS_G); float* Bp = (float*)(F.ws + WS_BETA);
    const float gb = GAB[(size_t)r * 16 + h], ga = GAB[(size_t)r * 16 + 8 + h];
    Bp[(size_t)r * 8 + h] = sigmoidf_(gb);
    const float xx = ga + F.in[I_DTB][h]; const float sp = xx > 20.f ? xx : log1pf(expf(xx));
    Gp[(size_t)r * 8 + h] = -expf(F.in[I_ALOG][h]) * sp;
}
__device__ __forceinline__ void conv_prompt_item(Frame& F, int item) {
    const int b = item >> 7, n = item & 127, row0 = b * SEQ + 64 * n, tid = F.tid;
    const bf16_t* QKV = (const bf16_t*)(F.ws + WS_QKV);
    bf16_t* QN = (bf16_t*)((unsigned char*)F.out + DO_QN); bf16_t* KN = (bf16_t*)((unsigned char*)F.out + DO_KN);
    bf16_t* KT = (bf16_t*)((unsigned char*)F.out + DO_KT); bf16_t* VT = (bf16_t*)((unsigned char*)F.out + DO_VT);
    const float* cw = F.in[I_CONVW];
    constexpr int SP = 136;
    LAS bf16_t* slab = (LAS bf16_t*)F.lds;
    { const int tok = tid >> 3, h = tid & 7; gdn_gate_scalars(F, row0 + tok, h); }
    const int t0 = tid >> 4, cg = (tid & 15) * 8;
    LAS float* cwl = (LAS float*)(F.lds + 32768);
    for (int i = tid; i < 4 * 3072 / 4; i += NTHREADS) ((LAS f32x4*)cwl)[i] = ((const f32x4*)cw)[i];
    __syncthreads();
    struct Slab { u32x4 x[2][4]; };
#define CONV_LOAD(S_, sl_) do { const int ch_ = ((sl_) >> 3) * 1024 + ((sl_) & 7) * 128 + cg; \
        _Pragma("unroll") for (int p = 0; p < 2; ++p) _Pragma("unroll") for (int j = 0; j < 4; ++j) { const int tk = t0 + 32 * p - 3 + j; \
            S_.x[p][j] = (64 * n + tk >= 0) ? *(const u32x4*)(QKV + (size_t)(row0 + tk) * 3072 + ch_) : (u32x4){0u, 0u, 0u, 0u}; } \
        } while (0)
#define CONV_SLAB(S_, sl_) do { const int part = (sl_) >> 3, h = (sl_) & 7; f32x4 wq[4][2]; \
        _Pragma("unroll") for (int j = 0; j < 4; ++j) { wq[j][0] = *(const LAS f32x4*)(cwl + j * 3072 + part * 1024 + h * 128 + cg); wq[j][1] = *(const LAS f32x4*)(cwl + j * 3072 + part * 1024 + h * 128 + cg + 4); } \
        _Pragma("unroll") for (int p = 0; p < 2; ++p) { \
            const int tok = t0 + 32 * p, r = row0 + tok; \
            float a[8]; \
            _Pragma("unroll") for (int e = 0; e < 8; ++e) a[e] = 0.f; \
            _Pragma("unroll") for (int j = 0; j < 4; ++j) { const u32x4 v = S_.x[p][j]; \
                a[0] += bf2f(v.x & 0xffffu) * wq[j][0][0]; a[1] += bf2f(v.x >> 16) * wq[j][0][1]; a[2] += bf2f(v.y & 0xffffu) * wq[j][0][2]; a[3] += bf2f(v.y >> 16) * wq[j][0][3]; \
                a[4] += bf2f(v.z & 0xffffu) * wq[j][1][0]; a[5] += bf2f(v.z >> 16) * wq[j][1][1]; a[6] += bf2f(v.w & 0xffffu) * wq[j][1][2]; a[7] += bf2f(v.w >> 16) * wq[j][1][3]; } \
            _Pragma("unroll") for (int e = 0; e < 8; ++e) a[e] = siluf_(a[e]); \
            if (part < 2) { float ss = ((a[0] * a[0] + a[1] * a[1]) + (a[2] * a[2] + a[3] * a[3])) + ((a[4] * a[4] + a[5] * a[5]) + (a[6] * a[6] + a[7] * a[7])); \
                ss += __shfl_xor(ss, 1); ss += __shfl_xor(ss, 2); ss += __shfl_xor(ss, 4); ss += __shfl_xor(ss, 8); \
                if (cg == 0) ((float*)(F.ws + (part == 0 ? WS_SSQ : WS_SSK)))[(size_t)(row0 + t0 + 32 * p) * 8 + h] = ss; } \
            u32x4 o4; o4.x = pk2(a[0], a[1]); o4.y = pk2(a[2], a[3]); o4.z = pk2(a[4], a[5]); o4.w = pk2(a[6], a[7]); \
            const size_t o = (size_t)r * 1024 + h * 128 + cg; \
            if (part == 0) *(u32x4*)(QN + o) = o4; \
            else { if (part == 1) *(u32x4*)(KN + o) = o4; *(LAS u32x4*)(slab + tok * SP + cg) = o4; } \
            if (n == 127 && tok >= 61) { const u32x4 raw = S_.x[p][3]; float* cdst = F.out + O_GCP + ((size_t)b * 3 + (tok - 61)) * 3072 + part * 1024 + h * 128 + cg; \
                *(f32x4*)cdst = (f32x4){bf2f(raw.x & 0xffffu), bf2f(raw.x >> 16), bf2f(raw.y & 0xffffu), bf2f(raw.y >> 16)}; \
                *(f32x4*)(cdst + 4) = (f32x4){bf2f(raw.z & 0xffffu), bf2f(raw.z >> 16), bf2f(raw.w & 0xffffu), bf2f(raw.w >> 16)}; } \
        } \
        if (part > 0) { \
            __syncthreads(); \
            bf16_t* dst = (part == 1 ? KT : VT) + (size_t)((b * 8 + h) * 128 + n) * 8192; \
            _Pragma("unroll") for (int u = 0; u < 2; ++u) { const int e = tid + 512 * u, chn = 16 * (e >> 7) + (e & 15), tg = 4 * ((e >> 6) & 1) + ((e >> 4) & 3); const LAS bf16_t* s = slab + (8 * tg) * SP + chn; \
                u32x4 o4; o4.x = (unsigned)s[0] | ((unsigned)s[SP] << 16); o4.y = (unsigned)s[2 * SP] | ((unsigned)s[3 * SP] << 16); \
                o4.z = (unsigned)s[4 * SP] | ((unsigned)s[5 * SP] << 16); o4.w = (unsigned)s[6 * SP] | ((unsigned)s[7 * SP] << 16); \
                *(u32x4*)(dst + e * 8) = o4; } \
            __syncthreads(); \
        } } while (0)
    Slab s0, s1, s2;
    CONV_LOAD(s0, 0); CONV_LOAD(s1, 1);
#pragma unroll 1
    for (int sl = 0; sl < 24; sl += 3) {
        CONV_LOAD(s2, sl + 2); CONV_SLAB(s0, sl);
        if (sl + 3 < 24) CONV_LOAD(s0, sl + 3); CONV_SLAB(s1, sl + 1);
        if (sl + 4 < 24) CONV_LOAD(s1, sl + 4); CONV_SLAB(s2, sl + 2);
    }
#undef CONV_LOAD
#undef CONV_SLAB
}
__device__ __forceinline__ void conv_sample_items(Frame& F) {
    const int gw = F.bid * NWAVES + F.wave, NGW = F.G * NWAVES, lane = F.lane;
    const bf16_t* QKV = (const bf16_t*)(F.ws + WS_QKV);
    bf16_t* QN = (bf16_t*)((unsigned char*)F.out + DO_QN); bf16_t* KN = (bf16_t*)((unsigned char*)F.out + DO_KN); bf16_t* VNS = (bf16_t*)((unsigned char*)F.out + DO_VNS);
    const float* cw = F.in[I_CONVW];
    for (int it = gw; it < 128 * 8; it += NGW) {
        const int bd = it >> 3, h = it & 7;
        float xr[3][7][2], wv[3][4][2];
#pragma unroll
        for (int part = 0; part < 3; ++part) { const int ch = part * 1024 + h * 128 + 2 * lane;
#pragma unroll
            for (int i = 0; i < 3; ++i) { const float2 p2 = *(const float2*)(F.in[I_SCONV] + ((size_t)bd * 3 + i) * 3072 + ch); xr[part][i][0] = p2.x; xr[part][i][1] = p2.y; }
#pragma unroll
            for (int i = 0; i < 4; ++i) { const unsigned v = *(const unsigned*)(QKV + (size_t)(MP + bd * 4 + i) * 3072 + ch); xr[part][3 + i][0] = bf2f(v & 0xffffu); xr[part][3 + i][1] = bf2f(v >> 16); }
#pragma unroll
            for (int j = 0; j < 4; ++j) { const float2 w2 = *(const float2*)(cw + j * 3072 + ch); wv[part][j][0] = w2.x; wv[part][j][1] = w2.y; } }
#pragma unroll
        for (int s = 0; s < 4; ++s) {
            const int r = MP + bd * 4 + s;
            float y[3][2];
#pragma unroll
            for (int part = 0; part < 3; ++part) { float a0 = 0.f, a1 = 0.f;
#pragma unroll
                for (int j = 0; j < 4; ++j) { a0 += xr[part][s + j][0] * wv[part][j][0]; a1 += xr[part][s + j][1] * wv[part][j][1]; }
                y[part][0] = siluf_(a0); y[part][1] = siluf_(a1); }
            const float sq = wave_sum(y[0][0] * y[0][0] + y[0][1] * y[0][1]), sk = wave_sum(y[1][0] * y[1][0] + y[1][1] * y[1][1]);
            const float rq = rsqrtf(sq + EPS) * 0.08838834764831845f, rk = rsqrtf(sk + EPS);
            const size_t o = (size_t)r * 1024 + h * 128 + 2 * lane;
            *(unsigned*)(QN + o) = pk2(y[0][0] * rq, y[0][1] * rq);
            *(unsigned*)(KN + o) = pk2(y[1][0] * rk, y[1][1] * rk);
            *(unsigned*)(VNS + (size_t)(r - MP) * 1024 + h * 128 + 2 * lane) = pk2(y[2][0], y[2][1]);
            if (lane == 0) gdn_gate_scalars(F, r, h);
            if (s >= 1) { float* cdst = F.out + O_GCS + ((size_t)bd * 3 + (s - 1)) * 3072;
#pragma unroll
                for (int part = 0; part < 3; ++part) { const int ch = part * 1024 + h * 128 + 2 * lane; *(float2*)(cdst + ch) = make_float2(xr[part][3 + s][0], xr[part][3 + s][1]); } }
        }
    }
}
__device__ __forceinline__ void p2_conv(Frame& F) {
    for (int it = F.bid; it < 256; it += F.G) conv_prompt_item(F, it);
    conv_sample_items(F);
}

__device__ __forceinline__ f32x4 mfma16(bf16x8 a, bf16x8 b, f32x4 c) { return __builtin_amdgcn_mfma_f32_16x16x32_bf16(a, b, c, 0, 0, 0); }
__device__ __forceinline__ u32x2 pack4(f32x4 v) { u32x2 r; r.x = pk2(v[0], v[1]); r.y = pk2(v[2], v[3]); return r; }
__device__ __forceinline__ void prep_item(Frame& F, int item) {
    const int b = item >> 7, n = item & 127, row0 = b * SEQ + 64 * n, lane = F.lane, h = F.wave, c = lane & 15, q = lane >> 4;
    const int ci = (b * 8 + h) * 128 + n;
    const bf16_t* QN = (const bf16_t*)((const unsigned char*)F.out + DO_QN); const bf16_t* KN = (const bf16_t*)((const unsigned char*)F.out + DO_KN);
    const bf16_t* KT = (const bf16_t*)((const unsigned char*)F.out + DO_KT) + (size_t)ci * 8192; const bf16_t* VT = (const bf16_t*)((const unsigned char*)F.out + DO_VT) + (size_t)ci * 8192;
    bf16_t* NEGW = (bf16_t*)(F.ws + WS_NEGW) + (size_t)ci * 8192; bf16_t* UT = (bf16_t*)(F.ws + WS_UT) + (size_t)ci * 8192; bf16_t* ATT = (bf16_t*)(F.ws + WS_ATT) + (size_t)ci * 4096;
    const float* Gp = (const float*)(F.ws + WS_G); const float* Bp = (const float*)(F.ws + WS_BETA);
    float* GC = (float*)(F.ws + WS_GC); float* DEC = (float*)(F.ws + WS_DEC); float* GT = (float*)(F.ws + WS_GT);
    LAS float* Als = (LAS float*)(F.lds + h * 18432);
    LAS float* gcs = Als + 4096; LAS float* bes = gcs + 64;
    float gc = Gp[(size_t)(row0 + lane) * 8 + h];
#pragma unroll
    for (int o = 1; o < 64; o <<= 1) { const float x = __shfl_up(gc, o); if (lane >= o) gc += x; }
    const float beta = Bp[(size_t)(row0 + lane) * 8 + h];
    const float gl = __shfl(gc, 63);
    const float sk = ((const float*)(F.ws + WS_SSK))[(size_t)(row0 + lane) * 8 + h], sq = ((const float*)(F.ws + WS_SSQ))[(size_t)(row0 + lane) * 8 + h];
    const float rk = rsqrtf(sk + EPS), rq = rsqrtf(sq + EPS) * 0.08838834764831845f;
    LAS float* rks = bes + 64; LAS float* rqs = rks + 64;
    gcs[lane] = gc; bes[lane] = beta; rks[lane] = rk; rqs[lane] = rq;
    GC[(size_t)(row0 + lane) * 8 + h] = __expf(gc) * rq; DEC[(size_t)ci * 64 + lane] = __expf(gl - gc) * rk; if (lane == 0) GT[ci] = __expf(gl);
    LDS_WAIT(); asm volatile("" ::: "memory");
    bf16x8 kf[4][4];
#pragma unroll
    for (int mt = 0; mt < 4; ++mt)
#pragma unroll
        for (int s = 0; s < 4; ++s) { const size_t o = (size_t)(row0 + 16 * mt + c) * 1024 + h * 128 + 32 * s + 8 * q; kf[mt][s] = *(const bf16x8*)(KN + o); }
#pragma unroll
    for (int mi = 0; mi < 4; ++mi) {
        const int ii = 16 * mi + c; const float gci = gcs[ii], bi = bes[ii] * rks[ii], rqi = rqs[ii];
        const bf16_t* qrow_p = QN + (size_t)(row0 + ii) * 1024 + h * 128 + 8 * q;
#pragma unroll
        for (int nj = 0; nj < 4; ++nj) {
            u32x2 av; av.x = 0u; av.y = 0u;
            if (nj <= mi) {
                f32x4 dk = {0.f, 0.f, 0.f, 0.f}, dq = {0.f, 0.f, 0.f, 0.f};
#pragma unroll
                for (int s = 0; s < 4; ++s) { dk = mfma16(kf[nj][s], kf[mi][s], dk); dq = mfma16(kf[nj][s], *(const bf16x8*)(qrow_p + 32 * s), dq); }
                const f32x4 gj = *(const LAS f32x4*)(gcs + 16 * nj + 4 * q), rkj = *(const LAS f32x4*)(rks + 16 * nj + 4 * q);
                f32x4 a, at;
#pragma unroll
                for (int r = 0; r < 4; ++r) { const int jj = 16 * nj + 4 * q + r; const float e = __expf(gci - gj[r]);
                    a[r] = (ii > jj) ? bi * rkj[r] * dk[r] * e : 0.f; at[r] = (ii >= jj) ? rqi * rkj[r] * dq[r] * e : 0.f; }
                *(LAS f32x4*)(Als + ii * 64 + 16 * nj + 4 * q) = a;
                av = pack4(at);
            }
            *(u32x2*)(ATT + ((mi * 2 + (nj >> 1)) * 64 + (2 * (nj & 1) + (q >> 1)) * 16 + c) * 8 + 4 * (q & 1)) = av;
        }
    }
    LDS_WAIT();
    float t[64];
#pragma unroll
    for (int i = 0; i < 64; ++i) {
        float acc = (lane == i) ? 1.f : 0.f;
#pragma unroll
        for (int m4 = 0; m4 < i; m4 += 4) { const f32x4 a = *(const LAS f32x4*)(Als + i * 64 + m4);
            acc -= a[0] * t[m4]; if (m4 + 1 < i) acc -= a[1] * t[m4 + 1]; if (m4 + 2 < i) acc -= a[2] * t[m4 + 2]; if (m4 + 3 < i) acc -= a[3] * t[m4 + 3]; }
        t[i] = acc;
    }
    LAS bf16_t* T1 = (LAS bf16_t*)Als; LAS bf16_t* T2 = T1 + 64 * 72;
    const float s1 = beta, s2 = -beta * __expf(gc) * rk;
    LDS_WAIT();
#pragma unroll
    for (int i = 0; i < 64; ++i) { T1[i * 72 + lane] = (bf16_t)f2bf(t[i] * s1); T2[i * 72 + lane] = (bf16_t)f2bf(t[i] * s2); }
    LDS_WAIT();
    bf16x8 t1f[4][2], t2f[4][2];
#pragma unroll
    for (int it = 0; it < 4; ++it)
#pragma unroll
        for (int s = 0; s < 2; ++s) { t1f[it][s] = *(const LAS bf16x8*)(T1 + (16 * it + c) * 72 + 32 * s + 8 * q); t2f[it][s] = *(const LAS bf16x8*)(T2 + (16 * it + c) * 72 + 32 * s + 8 * q); }
#pragma unroll 2
    for (int dt = 0; dt < 8; ++dt) {
        bf16x8 vb[2], ka[2];
#pragma unroll
        for (int s = 0; s < 2; ++s) { vb[s] = *(const bf16x8*)(VT + ((dt * 2 + s) * 64 + lane) * 8); ka[s] = *(const bf16x8*)(KT + ((dt * 2 + s) * 64 + lane) * 8); }
#pragma unroll
        for (int it = 0; it < 4; ++it) {
            f32x4 du = {0.f, 0.f, 0.f, 0.f}, dw = {0.f, 0.f, 0.f, 0.f};
            du = mfma16(t1f[it][0], vb[0], du); dw = mfma16(ka[0], t2f[it][0], dw);
            if (it >= 2) { du = mfma16(t1f[it][1], vb[1], du); dw = mfma16(ka[1], t2f[it][1], dw); }
            *(u32x2*)(UT + ((dt * 2 + (it >> 1)) * 64 + (2 * (it & 1) + (q >> 1)) * 16 + c) * 8 + 4 * (q & 1)) = pack4(du);
            *(u32x2*)(NEGW + ((it * 4 + (dt >> 1)) * 64 + (2 * (dt & 1) + (q >> 1)) * 16 + c) * 8 + 4 * (q & 1)) = pack4(dw);
        }
    }
    LDS_WAIT();
}
__device__ __forceinline__ void p2_prep(Frame& F) { for (int it = F.bid; it < 256; it += F.G) { prep_item(F, it); __syncthreads(); } }

__device__ __forceinline__ void scan_item(Frame& F, int bh, int sl) {
    const int lane = F.lane, w = F.wave, c = lane & 15, q = lane >> 4, dvs = 16 * sl;
    const bf16_t* KT = (const bf16_t*)((const unsigned char*)F.out + DO_KT); const bf16_t* NEGW = (const bf16_t*)(F.ws + WS_NEGW);
    bf16_t* UT = (bf16_t*)(F.ws + WS_UT); bf16_t* SN = (bf16_t*)(F.ws + WS_SN);
    const float* DEC = (const float*)(F.ws + WS_DEC); const float* GT = (const float*)(F.ws + WS_GT);
    LAS bf16_t* SS = (LAS bf16_t*)F.lds;
    LAS bf16_t* VS = SS + 16 * 136;
    LAS bf16_t* VU = VS + 16 * 72;
    f32x4 Sacc = {0.f, 0.f, 0.f, 0.f};
    for (int e = F.tid; e < 16 * 136 / 2; e += NTHREADS) ((LAS unsigned*)SS)[e] = 0u;
    struct Ops { bf16x8 wf[4], kf[2]; u32x2 u2; f32x4 dec4; float gt; };
#define SCAN_LOAD(o, n_) do { const size_t ci__ = (size_t)bh * 128 + ((n_) < 128 ? (n_) : 127); \
        _Pragma("unroll") for (int s = 0; s < 2; ++s) o.kf[s] = *(const bf16x8*)(KT + ci__ * 8192 + ((w * 2 + s) * 64 + lane) * 8); \
        o.gt = GT[ci__]; \
        if (w < 4) { _Pragma("unroll") for (int s = 0; s < 4; ++s) o.wf[s] = *(const bf16x8*)(NEGW + ci__ * 8192 + ((w * 4 + s) * 64 + lane) * 8); \
            o.u2 = *(const u32x2*)(UT + ci__ * 8192 + ((sl * 2 + (w >> 1)) * 64 + (2 * (w & 1) + (q >> 1)) * 16 + c) * 8 + 4 * (q & 1)); o.dec4 = *(const f32x4*)(DEC + ci__ * 64 + 16 * w + 4 * q); } } while (0)
#define SCAN_STEP(o, n_) do { const size_t ci = (size_t)bh * 128 + (n_); \
        if (w < 4) { \
            f32x4 v = {bf2f(o.u2.x & 0xffffu), bf2f(o.u2.x >> 16), bf2f(o.u2.y & 0xffffu), bf2f(o.u2.y >> 16)}; \
            _Pragma("unroll") for (int s = 0; s < 4; ++s) { const bf16x8 sf = *(const LAS bf16x8*)(SS + c * 136 + 32 * s + 8 * q); v = mfma16(o.wf[s], sf, v); } \
            *(LAS u32x2*)(VU + c * 72 + 16 * w + 4 * q) = pack4(v); \
            const f32x4 vd = v * o.dec4; \
            *(LAS u32x2*)(VS + c * 72 + 16 * w + 4 * q) = pack4(vd); \
        } else if (w == 4) {   \
            _Pragma("unroll") for (int u = 0; u < 4; ++u) {   \
                *(u32x4*)(SN + ci * 16384 + ((sl * 4 + u) * 64 + lane) * 8) = *(const LAS u32x4*)(SS + c * 136 + 32 * u + 8 * q); } \
        } \
        asm volatile("s_waitcnt lgkmcnt(0)" ::: "memory"); __builtin_amdgcn_s_barrier(); asm volatile("" ::: "memory"); \
        Sacc = Sacc * o.gt; \
        _Pragma("unroll") for (int s = 0; s < 2; ++s) { const bf16x8 vf = *(const LAS bf16x8*)(VS + c * 72 + 32 * s + 8 * q); Sacc = mfma16(o.kf[s], vf, Sacc); } \
        if (w == 5) {   \
            _Pragma("unroll") for (int u = 0; u < 2; ++u) { \
                *(u32x4*)(UT + ci * 8192 + ((sl * 2 + u) * 64 + lane) * 8) = *(const LAS u32x4*)(VU + c * 72 + 32 * u + 8 * q); } } \
        { const u32x2 sp = pack4(Sacc); *(LAS u32x2*)(SS + c * 136 + 16 * w + 4 * q) = sp; } \
        asm volatile("s_waitcnt lgkmcnt(0)" ::: "memory"); __builtin_amdgcn_s_barrier(); asm volatile("" ::: "memory"); } while (0)
    Ops o0, o1, o2, o3;
    SCAN_LOAD(o0, 0); SCAN_LOAD(o1, 1); SCAN_LOAD(o2, 2);
    asm volatile("s_waitcnt lgkmcnt(0)" ::: "memory"); __builtin_amdgcn_s_barrier(); asm volatile("" ::: "memory");
#pragma unroll 1
    for (int n0 = 0; n0 < 128; n0 += 4) {
        SCAN_LOAD(o3, n0 + 3); SCAN_STEP(o0, n0);
        SCAN_LOAD(o0, n0 + 4); SCAN_STEP(o1, n0 + 1);
        SCAN_LOAD(o1, n0 + 5); SCAN_STEP(o2, n0 + 2);
        SCAN_LOAD(o2, n0 + 6); SCAN_STEP(o3, n0 + 3);
    }
#undef SCAN_LOAD
#undef SCAN_STEP
    float* so = F.out + O_GSP + (size_t)bh * 16384;
#pragma unroll
    for (int r = 0; r < 4; ++r) so[(size_t)(16 * w + 4 * q + r) * 128 + dvs + c] = Sacc[r];
}

__device__ __forceinline__ void gdn_out_item(Frame& F, int item) {
    const int b = item >> 7, n = item & 127, row0 = b * SEQ + 64 * n, lane = F.lane, h = F.wave, c = lane & 15, q = lane >> 4;
    const size_t ci = (size_t)(b * 8 + h) * 128 + n;
    const bf16_t* QN = (const bf16_t*)((const unsigned char*)F.out + DO_QN);
    const bf16_t* SN = (const bf16_t*)(F.ws + WS_SN) + ci * 16384; const bf16_t* VNT = (const bf16_t*)(F.ws + WS_UT) + ci * 8192; const bf16_t* ATT = (const bf16_t*)(F.ws + WS_ATT) + ci * 4096;
    const float* GC = (const float*)(F.ws + WS_GC); const bf16_t* GZ = (const bf16_t*)(F.ws + WS_GZ); bf16_t* OG = (bf16_t*)(F.ws + WS_OG); const float* gn = F.in[I_GNORM];
    LAS bf16_t* ol = (LAS bf16_t*)(F.lds + h * 18432);
    bf16x8 qf[4][4], af[4][2]; float egc[4], ss[4];
#pragma unroll
    for (int it = 0; it < 4; ++it) { const int i = 16 * it + c; const size_t r = (size_t)row0 + i;
#pragma unroll
        for (int s = 0; s < 4; ++s) qf[it][s] = *(const bf16x8*)(QN + r * 1024 + h * 128 + 32 * s + 8 * q);
#pragma unroll
        for (int s = 0; s < 2; ++s) af[it][s] = *(const bf16x8*)(ATT + ((it * 2 + s) * 64 + lane) * 8);
        egc[it] = GC[r * 8 + h]; ss[it] = 0.f; }
#pragma unroll 1
    for (int dt = 0; dt < 8; ++dt) {
        bf16x8 sf[4], vf[2];
#pragma unroll
        for (int s = 0; s < 4; ++s) sf[s] = *(const bf16x8*)(SN + ((dt * 4 + s) * 64 + lane) * 8);
#pragma unroll
        for (int s = 0; s < 2; ++s) vf[s] = *(const bf16x8*)(VNT + ((dt * 2 + s) * 64 + lane) * 8);
#pragma unroll
        for (int it = 0; it < 4; ++it) {
            f32x4 a = {0.f, 0.f, 0.f, 0.f};
#pragma unroll
            for (int s = 0; s < 4; ++s) a = mfma16(sf[s], qf[it][s], a);
            a = a * egc[it];
#pragma unroll
            for (int s = 0; s < 2; ++s) a = mfma16(vf[s], af[it][s], a);
            ss[it] += (a[0] * a[0] + a[1] * a[1]) + (a[2] * a[2] + a[3] * a[3]);
            *(LAS u32x2*)(ol + (16 * it + c) * 136 + 16 * dt + 4 * q) = pack4(a);
        }
    }
    float rs[4];
#pragma unroll
    for (int it = 0; it < 4; ++it) { float s = ss[it]; s += __shfl_xor(s, 16); s += __shfl_xor(s, 32); rs[it] = rsqrtf(s * (1.f / 128.f) + EPS); }
    LDS_WAIT();
#pragma unroll
    for (int it = 0; it < 4; ++it)
#pragma unroll
        for (int dt = 0; dt < 8; ++dt) { const size_t o = ((size_t)row0 + 16 * it + c) * 1024 + h * 128 + 16 * dt + 4 * q; const u32x2 z = *(const u32x2*)(GZ + o); const f32x4 g4 = *(const f32x4*)(gn + 16 * dt + 4 * q);
            const u32x2 pv = *(const LAS u32x2*)(ol + (16 * it + c) * 136 + 16 * dt + 4 * q); f32x4 v;
            v[0] = bf2f(pv.x & 0xffffu) * rs[it] * g4[0] * bf2f(z.x & 0xffffu); v[1] = bf2f(pv.x >> 16) * rs[it] * g4[1] * bf2f(z.x >> 16);
            v[2] = bf2f(pv.y & 0xffffu) * rs[it] * g4[2] * bf2f(z.y & 0xffffu); v[3] = bf2f(pv.y >> 16) * rs[it] * g4[3] * bf2f(z.y >> 16);
            *(u32x2*)(OG + o) = pack4(v); }
    LDS_WAIT();
}

__device__ __forceinline__ void gdn_seq_item(Frame& F, int row0, int L, int h, const float* S0, float* Sout, bf16_t* OG) {
    const bf16_t* QN = (const bf16_t*)((unsigned char*)F.out + DO_QN); const bf16_t* KN = (const bf16_t*)((unsigned char*)F.out + DO_KN); const bf16_t* VNS = (const bf16_t*)((unsigned char*)F.out + DO_VNS);
    const float* Gp = (const float*)(F.ws + WS_G); const float* Bp = (const float*)(F.ws + WS_BETA);
    const int tid = F.tid, dvc = tid & 127, dkq = tid >> 7;
    constexpr int TB = 32;
    LAS float* sq = (LAS float*)F.lds;
    LAS float* sk = sq + TB * 128;
    LAS float* sv = sk + TB * 128;
    LAS float* sg = sv + TB * 128;
    LAS float* red = sg + 2 * TB;
    LAS float* redqk = red + 2 * 2 * 4 * 128;
    float S[32];
#pragma unroll
    for (int i = 0; i < 32; ++i) S[i] = S0 ? __builtin_nontemporal_load(S0 + (size_t)(32 * dkq + i) * 128 + dvc) : 0.f;
    int buf = 0;
    for (int t0 = 0; t0 < L; t0 += TB) {
        const int nb = (L - t0) < TB ? (L - t0) : TB;
        __syncthreads();
        for (int e = tid; e < nb * 128; e += NTHREADS) { const int tt = e >> 7, c = e & 127; const size_t o = (size_t)(row0 + t0 + tt) * 1024 + h * 128 + c;
            sq[e] = bf2f(QN[o]); sk[e] = bf2f(KN[o]); sv[e] = bf2f(VNS[o - (size_t)MP * 1024]); }
        if (tid < nb) { sg[tid] = expf(Gp[(size_t)(row0 + t0 + tid) * 8 + h]); sg[TB + tid] = Bp[(size_t)(row0 + t0 + tid) * 8 + h]; }
        __syncthreads();
        for (int tt = 0; tt < nb; ++tt) {
            const LAS float* kq = sk + tt * 128 + 32 * dkq; const LAS float* qq = sq + tt * 128 + 32 * dkq;
            float pk = 0.f, pq = 0.f, pqk = 0.f;
#pragma unroll
            for (int i = 0; i < 32; ++i) { const float kk = kq[i], qv = qq[i]; pk += kk * S[i]; pq += qv * S[i]; pqk += qv * kk; }
            LAS float* rb = red + buf * 1024;
            rb[dkq * 128 + dvc] = pk; rb[512 + dkq * 128 + dvc] = pq; if (dvc == 0) redqk[buf * 4 + dkq] = pqk;
            __syncthreads();
            const float kS = (rb[dvc] + rb[128 + dvc]) + (rb[256 + dvc] + rb[384 + dvc]);
            const float qS = (rb[512 + dvc] + rb[640 + dvc]) + (rb[768 + dvc] + rb[896 + dvc]);
            const float qk = (redqk[buf * 4] + redqk[buf * 4 + 1]) + (redqk[buf * 4 + 2] + redqk[buf * 4 + 3]);
            const float e = sg[tt], beta = sg[TB + tt];
            const float vnew = beta * (sv[tt * 128 + dvc] - e * kS);
            const float o = e * qS + qk * vnew;
#pragma unroll
            for (int i = 0; i < 32; ++i) S[i] = e * S[i] + kq[i] * vnew;
            if (dkq == 0) OG[(size_t)(row0 + t0 + tt) * 1024 + h * 128 + dvc] = (bf16_t)f2bf(o);
            buf ^= 1;
        }
    }
#pragma unroll
    for (int i = 0; i < 32; ++i) __builtin_nontemporal_store(S[i], Sout + (size_t)(32 * dkq + i) * 128 + dvc);
    __syncthreads();
}
__device__ __forceinline__ void p2_gdn_sample(Frame& F, int wk, int nwk, int lo, int hi) {
    bf16_t* OG = (bf16_t*)(F.ws + WS_OG);
    for (int q = lo + wk; q < hi; q += nwk) { const int bd = q >> 3, h = q & 7; gdn_seq_item(F, MP + bd * 4, 4, h, F.in[I_SGDN] + (size_t)q * 16384, F.out + O_GSS + (size_t)q * 16384, OG); }
}
__device__ __forceinline__ void p2_gdn_norm_sample(Frame& F) {
    const int gw = F.bid * NWAVES + F.wave, NGW = F.G * NWAVES, lane = F.lane;
    bf16_t* OG = (bf16_t*)(F.ws + WS_OG); const bf16_t* GZ = (const bf16_t*)(F.ws + WS_GZ); const float* gn = F.in[I_GNORM];
    for (int it = gw; it < MS * 8; it += NGW) {
        const size_t o = (size_t)(MP + (it >> 3)) * 1024 + (it & 7) * 128 + 2 * lane;
        const unsigned v = *(const unsigned*)(OG + o), z = *(const unsigned*)(GZ + o);
        const float a = bf2f(v & 0xffffu), b = bf2f(v >> 16);
        const float r = rsqrtf(wave_sum(a * a + b * b) * (1.f / 128.f) + EPS);
        *(unsigned*)(OG + o) = pk2(a * r * gn[2 * lane] * bf2f(z & 0xffffu), b * r * gn[2 * lane + 1] * bf2f(z >> 16));
    }
}

__device__ __forceinline__ void swa_wave_item(Frame& F, bool sample, int bidx, int t, int kv) {
    const int lane = F.lane;
    LAS float* qs = (LAS float*)(F.lds + F.wave * 8192);
    LAS float* ps = qs + 512;
    const bf16_t* SQ = (const bf16_t*)(F.ws + WS_SQ); const bf16_t* SKV = (const bf16_t*)(F.ws + WS_SKV); const bf16_t* SZ = (const bf16_t*)(F.ws + WS_SZ);
    const float* BT = (const float*)(F.ws + WS_BTAB);
    const int row = sample ? MP + bidx * 4 + t : bidx * SEQ + t;
    const int qpos = sample ? 128 + t : t;
    for (int e = lane; e < 512; e += 64) qs[e] = bf2f(SQ[(size_t)row * 1024 + kv * 512 + e]);
    LDS_WAIT();
#pragma unroll 1
    for (int u = 0; u < 2; ++u) {
        const int j = lane + 64 * u; const int kp = qpos - j;
        float kr[64];
        const bool valid = kp >= 0;
        if (valid) {
            if (sample && kp < 128) { const float* p = F.in[I_CSK] + (((size_t)bidx * 128 + kp) * 2 + kv) * 64;
#pragma unroll
                for (int d = 0; d < 64; d += 4) { const f32x4 v = *(const f32x4*)(p + d); kr[d] = v.x; kr[d + 1] = v.y; kr[d + 2] = v.z; kr[d + 3] = v.w; } }
            else { const int krow = sample ? MP + bidx * 4 + (kp - 128) : bidx * SEQ + kp; const bf16_t* p = SKV + (size_t)krow * 256 + kv * 64;
#pragma unroll
                for (int d = 0; d < 64; d += 8) { const u32x4 v = *(const u32x4*)(p + d);
                    kr[d] = bf2f(v.x & 0xffffu); kr[d + 1] = bf2f(v.x >> 16); kr[d + 2] = bf2f(v.y & 0xffffu); kr[d + 3] = bf2f(v.y >> 16);
                    kr[d + 4] = bf2f(v.z & 0xffffu); kr[d + 5] = bf2f(v.z >> 16); kr[d + 6] = bf2f(v.w & 0xffffu); kr[d + 7] = bf2f(v.w >> 16); } }
        } else {
#pragma unroll
            for (int d = 0; d < 64; ++d) kr[d] = 0.f;
        }
#pragma unroll 1
        for (int g = 0; g < 8; ++g) { float a = 0.f;
#pragma unroll
            for (int d = 0; d < 64; d += 4) { const f32x4 qv = *(const LAS f32x4*)(qs + g * 64 + d); a += kr[d] * qv.x + kr[d + 1] * qv.y + kr[d + 2] * qv.z + kr[d + 3] * qv.w; }
            ps[g * 128 + j] = valid ? a * 0.125f + BT[(kv * 8 + g) * 128 + j] : -INFINITY; }
    }
    LDS_WAIT();
    float inv[8];
#pragma unroll
    for (int g = 0; g < 8; ++g) {
        const float sink = F.in[I_SINKS][kv * 8 + g];
        const float l0 = ps[g * 128 + lane], l1 = ps[g * 128 + 64 + lane];
        const float mx = fmaxf(wave_max(fmaxf(l0, l1)), sink);
        const float p0 = __expf(l0 - mx), p1 = __expf(l1 - mx);
        const float den = wave_sum(p0 + p1) + __expf(sink - mx);
        inv[g] = 1.f / den;
        ps[g * 128 + lane] = p0; ps[g * 128 + 64 + lane] = p1;
    }
    LDS_WAIT();
    float o[8];
#pragma unroll
    for (int g = 0; g < 8; ++g) o[g] = 0.f;
#pragma unroll 1
    for (int j0 = 0; j0 < 128; j0 += 8) {
        float vv[8];
#pragma unroll
        for (int u = 0; u < 8; ++u) { int kp = qpos - (j0 + u); kp = kp < 0 ? 0 : kp;
            if (sample && kp < 128) vv[u] = F.in[I_CSV][(((size_t)bidx * 128 + kp) * 2 + kv) * 64 + lane];
            else { const int krow = sample ? MP + bidx * 4 + (kp - 128) : bidx * SEQ + kp; vv[u] = bf2f(SKV[(size_t)krow * 256 + 128 + kv * 64 + lane]); } }
#pragma unroll
        for (int u = 0; u < 8; ++u)
#pragma unroll
            for (int g = 0; g < 8; ++g) o[g] += ps[g * 128 + j0 + u] * vv[u];
    }
    bf16_t* OS = (bf16_t*)(F.ws + WS_OS);
#pragma unroll
    for (int g = 0; g < 8; ++g) { const size_t oo = (size_t)row * 1024 + (kv * 8 + g) * 64 + lane; OS[oo] = (bf16_t)f2bf(o[g] * inv[g] * bf2f(SZ[oo])); }
    LDS_WAIT();
}
__device__ __forceinline__ bf16x8 cat8(u32x2 a, u32x2 b) { u32x4 t; t.x = a.x; t.y = a.y; t.z = b.x; t.w = b.y; return __builtin_bit_cast(bf16x8, t); }
__device__ __forceinline__ void mem_mfma_item(Frame& F, int b, int h, int qt) {
    const int lane = F.lane, c = lane & 15, q = lane >> 4;
    const bf16_t* Kp = (const bf16_t*)(F.ws + WS_MEMKV) + (size_t)(b * 256) * 2048 + h * 256;
    const bf16_t* VTp = (const bf16_t*)(F.ws + WS_MVT) + (size_t)((b * 4 + h) * 256) * 256;
    const bf16_t* MQ = (const bf16_t*)(F.ws + WS_MQ); const bf16_t* MZ = (const bf16_t*)(F.ws + WS_MZ); bf16_t* OM = (bf16_t*)(F.ws + WS_OM);
    const size_t qrow = (size_t)b * SEQ + 16 * qt + c;
    bf16x8 qf[8];
#pragma unroll
    for (int s = 0; s < 8; ++s) qf[s] = *(const bf16x8*)(MQ + qrow * 1024 + h * 256 + 32 * s + 8 * q);
    f32x4 sacc[16];
#pragma unroll
    for (int mt = 0; mt < 16; ++mt) { f32x4 a = {0.f, 0.f, 0.f, 0.f};
#pragma unroll
        for (int s = 0; s < 8; ++s) a = mfma16(*(const bf16x8*)(Kp + (size_t)(16 * mt + c) * 2048 + 32 * s + 8 * q), qf[s], a);
        sacc[mt] = a; }
    float mx = -INFINITY;
#pragma unroll
    for (int mt = 0; mt < 16; ++mt) mx = fmaxf(mx, fmaxf(fmaxf(sacc[mt][0], sacc[mt][1]), fmaxf(sacc[mt][2], sacc[mt][3])));
    mx = fmaxf(mx, __shfl_xor(mx, 16)); mx = fmaxf(mx, __shfl_xor(mx, 32));
    float sum = 0.f; const float sc = 0.0625f * 1.4426950408889634f;
#pragma unroll
    for (int mt = 0; mt < 16; ++mt)
#pragma unroll
        for (int r = 0; r < 4; ++r) { const float p = exp2f((sacc[mt][r] - mx) * sc); sacc[mt][r] = p; sum += p; }
    sum += __shfl_xor(sum, 16); sum += __shfl_xor(sum, 32);
    const float inv = 1.f / sum;
    bf16x8 pf[8];
#pragma unroll
    for (int ks = 0; ks < 8; ++ks) pf[ks] = cat8(pack4(sacc[2 * ks]), pack4(sacc[2 * ks + 1]));
#pragma unroll 4
    for (int dt = 0; dt < 16; ++dt) { f32x4 o = {0.f, 0.f, 0.f, 0.f};
#pragma unroll
        for (int ks = 0; ks < 8; ++ks) { const bf16_t* vp = VTp + (size_t)(16 * dt + c) * 256 + 32 * ks + 4 * q;
            o = mfma16(cat8(*(const u32x2*)vp, *(const u32x2*)(vp + 16)), pf[ks], o); }
        const size_t oo = qrow * 1024 + h * 256 + 16 * dt + 4 * q; const u32x2 z = *(const u32x2*)(MZ + oo);
        o[0] *= inv * bf2f(z.x & 0xffffu); o[1] *= inv * bf2f(z.x >> 16); o[2] *= inv * bf2f(z.y & 0xffffu); o[3] *= inv * bf2f(z.y >> 16);
        *(u32x2*)(OM + oo) = pack4(o); }
}
__device__ __forceinline__ void swa_mfma_item(Frame& F, int b, int h, int a) {
    const int lane = F.lane, c = lane & 15, q = lane >> 4, kv = h >> 3;
    const bf16_t* SQ = (const bf16_t*)(F.ws + WS_SQ); const bf16_t* SKV = (const bf16_t*)(F.ws + WS_SKV); const bf16_t* SZ = (const bf16_t*)(F.ws + WS_SZ); bf16_t* OS = (bf16_t*)(F.ws + WS_OS);
    const bf16_t* VTp = (const bf16_t*)(F.ws + WS_VTS) + (size_t)((b * 2 + kv) * 64) * SEQ;
    const LAS float* BTl = (const LAS float*)(F.lds + LDS_BT) + h * 128;
    const size_t qrow = (size_t)b * SEQ + 16 * a + c;
    bf16x8 qf[2];
#pragma unroll
    for (int s = 0; s < 2; ++s) qf[s] = *(const bf16x8*)(SQ + qrow * 1024 + h * 64 + 32 * s + 8 * q);
    f32x4 p[10];
    const float sink = F.in[I_SINKS][h];
    float mx = sink;
#pragma unroll
    for (int u = 0; u < 9; ++u) {
        const int kbase = 16 * (a - 8 + u);
        f32x4 d = {0.f, 0.f, 0.f, 0.f};
        if (kbase >= 0) {
#pragma unroll
            for (int s = 0; s < 2; ++s) d = mfma16(*(const bf16x8*)(SKV + ((size_t)b * SEQ + kbase + c) * 256 + kv * 64 + 32 * s + 8 * q), qf[s], d);
        }
#pragma unroll
        for (int r = 0; r < 4; ++r) { const int dist = (16 * a + c) - (kbase + 4 * q + r); const bool valid = kbase >= 0 && dist >= 0 && dist < 128;
            const float l = valid ? d[r] * 0.125f + BTl[dist & 127] : -INFINITY; d[r] = l; mx = fmaxf(mx, l); }
        p[u] = d;
    }
    mx = fmaxf(mx, __shfl_xor(mx, 16)); mx = fmaxf(mx, __shfl_xor(mx, 32));
    float sum = 0.f;
#pragma unroll
    for (int u = 0; u < 9; ++u)
#pragma unroll
        for (int r = 0; r < 4; ++r) { const float e = __expf(p[u][r] - mx); p[u][r] = e; sum += e; }
    p[9] = (f32x4){0.f, 0.f, 0.f, 0.f};
    sum += __shfl_xor(sum, 16); sum += __shfl_xor(sum, 32);
    const float inv = 1.f / (sum + __expf(sink - mx));
    bf16x8 pf[5];
#pragma unroll
    for (int ks = 0; ks < 5; ++ks) pf[ks] = cat8(pack4(p[2 * ks]), pack4(p[2 * ks + 1]));
#pragma unroll
    for (int dt = 0; dt < 4; ++dt) { f32x4 o = {0.f, 0.f, 0.f, 0.f};
#pragma unroll
        for (int ks = 0; ks < 5; ++ks) { int m0 = 16 * (a - 8 + 2 * ks) + 4 * q, m1 = m0 + 16;
            m0 = m0 < 0 ? 0 : m0; m1 = m1 < 0 ? 0 : (m1 > SEQ - 4 ? SEQ - 4 : m1);
            const bf16_t* vp = VTp + (size_t)(16 * dt + c) * SEQ;
            o = mfma16(cat8(*(const u32x2*)(vp + m0), *(const u32x2*)(vp + m1)), pf[ks], o); }
        const size_t oo = qrow * 1024 + h * 64 + 16 * dt + 4 * q; const u32x2 z = *(const u32x2*)(SZ + oo);
        o[0] *= inv * bf2f(z.x & 0xffffu); o[1] *= inv * bf2f(z.x >> 16); o[2] *= inv * bf2f(z.y & 0xffffu); o[3] *= inv * bf2f(z.y >> 16);
        *(u32x2*)(OS + oo) = pack4(o); }
}
__device__ __forceinline__ void swa_wg_item(Frame& F, int b, int kv, int qb) {
    int lane_ = F.lane, tid_ = F.tid; asm volatile("" : "+v"(lane_), "+v"(tid_));
    const int lane = lane_, c = lane & 15, q = lane >> 4, tid = tid_, h = kv * 8 + F.wave;
    const bf16_t* SQ = (const bf16_t*)(F.ws + WS_SQ); const bf16_t* SKV = (const bf16_t*)(F.ws + WS_SKV); const bf16_t* SZ = (const bf16_t*)(F.ws + WS_SZ); bf16_t* OS = (bf16_t*)(F.ws + WS_OS);
    const bf16_t* VTg = (const bf16_t*)(F.ws + WS_VTS) + (size_t)((b * 2 + kv) * 64) * SEQ;
    LAS unsigned char* Kl = F.lds; LAS unsigned char* Vl = F.lds + 32768;
    const LAS float* BTl = (const LAS float*)(F.lds + LDS_BT) + h * 128;
    const int kstart = 128 * (qb - 1);
    __syncthreads();
    {   u32x4 kr[4], vr[4];
#pragma unroll
        for (int u = 0; u < 4; ++u) { const int p = tid + 512 * u, key = p >> 3, ch = p & 7;
            kr[u] = (kstart + key >= 0) ? *(const u32x4*)(SKV + ((size_t)b * SEQ + kstart + key) * 256 + kv * 64 + ch * 8) : (u32x4){0u, 0u, 0u, 0u};
            const int d = p >> 5, c16 = p & 31;
            vr[u] = (kstart + c16 * 8 >= 0) ? *(const u32x4*)(VTg + (size_t)d * SEQ + kstart + c16 * 8) : (u32x4){0u, 0u, 0u, 0u}; }
#pragma unroll
        for (int u = 0; u < 4; ++u) { const int p = tid + 512 * u, key = p >> 3, ch = p & 7;
            *(LAS u32x4*)(Kl + key * 128 + ((ch ^ ((key >> 1) & 7)) << 4)) = kr[u];
            const int d = p >> 5, c16 = p & 31;
            *(LAS u32x4*)(Vl + d * 512 + (((2 * c16) ^ (2 * (d & 15))) << 3)) = vr[u]; } }
    __syncthreads();
    const float L2E = 1.4426950408889634f;
    const float sink = F.in[I_SINKS][h] * L2E;
    float bias[9][4];
#pragma unroll
    for (int u = 0; u < 9; ++u)
#pragma unroll
        for (int r = 0; r < 4; ++r) { const int dist = 128 - 16 * u + c - 4 * q - r; bias[u][r] = (dist >= 0 && dist < 128) ? BTl[dist & 127] * L2E : -INFINITY; }
    bf16x8 qfa[8][2];
#pragma unroll
    for (int ap = 0; ap < 8; ++ap)
#pragma unroll
        for (int s = 0; s < 2; ++s) qfa[ap][s] = *(const bf16x8*)(SQ + ((size_t)b * SEQ + 128 * qb + 16 * ap + c) * 1024 + h * 64 + 32 * s + 8 * q);
#pragma unroll
    for (int ap = 0; ap < 8; ++ap) {
        const size_t qrow = (size_t)b * SEQ + 128 * qb + 16 * ap + c;
        bf16x8 qf[2]; qf[0] = qfa[ap][0]; qf[1] = qfa[ap][1];
        LAS bf16_t* ow = (LAS bf16_t*)(F.lds + 65536 + F.wave * 2304);
        u32x4 zz[2];
#pragma unroll
        for (int u = 0; u < 2; ++u) { const int p = lane + 64 * u; zz[u] = *(const u32x4*)(SZ + ((size_t)b * SEQ + 128 * qb + 16 * ap + (p >> 3)) * 1024 + h * 64 + (p & 7) * 8); }
        f32x4 p[10]; float mx = sink;
#pragma unroll
        for (int u = 0; u < 9; ++u) {
            const int wt = ap + u, row = 16 * wt + c;
            f32x4 d = {0.f, 0.f, 0.f, 0.f};
#pragma unroll
            for (int s = 0; s < 2; ++s) d = mfma16(*(const LAS bf16x8*)(Kl + row * 128 + (((4 * s + q) ^ ((row >> 1) & 7)) << 4)), qf[s], d);
            const float tmask = ((qb > 0) || (wt >= 8)) ? 0.f : -INFINITY;
#pragma unroll
            for (int r = 0; r < 4; ++r) { const float l = d[r] * (0.125f * L2E) + (bias[u][r] + tmask); d[r] = l; mx = fmaxf(mx, l); }
            p[u] = d;
        }
        mx = fmaxf(mx, __shfl_xor(mx, 16)); mx = fmaxf(mx, __shfl_xor(mx, 32));
        float sum = 0.f;
#pragma unroll
        for (int u = 0; u < 9; ++u)
#pragma unroll
            for (int r = 0; r < 4; ++r) { const float e = exp2f(p[u][r] - mx); p[u][r] = e; sum += e; }
        p[9] = (f32x4){0.f, 0.f, 0.f, 0.f};
        sum += __shfl_xor(sum, 16); sum += __shfl_xor(sum, 32);
        const float inv = 1.f / (sum + exp2f(sink - mx));
        bf16x8 pf[5];
#pragma unroll
        for (int ks = 0; ks < 5; ++ks) pf[ks] = cat8(pack4(p[2 * ks]), pack4(p[2 * ks + 1]));
#pragma unroll
        for (int dt = 0; dt < 4; ++dt) { f32x4 o = {0.f, 0.f, 0.f, 0.f}; const int dd = 16 * dt + c; const LAS unsigned char* vrow = Vl + dd * 512; const int sw = 2 * (dd & 15);
#pragma unroll
            for (int ks = 0; ks < 5; ++ks) { const int wt0 = ap + 2 * ks; int wt1 = wt0 + 1; wt1 = wt1 > 15 ? 15 : wt1;
                const u32x2 v0 = *(const LAS u32x2*)(vrow + (((4 * wt0 + q) ^ sw) << 3)), v1 = *(const LAS u32x2*)(vrow + (((4 * wt1 + q) ^ sw) << 3));
                o = mfma16(cat8(v0, v1), pf[ks], o); }
            o = o * inv; *(LAS u32x2*)(ow + c * 72 + 16 * dt + 4 * q) = pack4(o); }
        LDS_WAIT();
#pragma unroll
        for (int u = 0; u < 2; ++u) { const int p = lane + 64 * u, rr = p >> 3, ch = p & 7; const u32x4 pv = *(const LAS u32x4*)(ow + rr * 72 + ch * 8), z = zz[u]; u32x4 w;
            w.x = pk2(bf2f(pv.x & 0xffffu) * bf2f(z.x & 0xffffu), bf2f(pv.x >> 16) * bf2f(z.x >> 16)); w.y = pk2(bf2f(pv.y & 0xffffu) * bf2f(z.y & 0xffffu), bf2f(pv.y >> 16) * bf2f(z.y >> 16));
            w.z = pk2(bf2f(pv.z & 0xffffu) * bf2f(z.z & 0xffffu), bf2f(pv.z >> 16) * bf2f(z.z >> 16)); w.w = pk2(bf2f(pv.w & 0xffffu) * bf2f(z.w & 0xffffu), bf2f(pv.w >> 16) * bf2f(z.w >> 16));
            *(u32x4*)(OS + ((size_t)b * SEQ + 128 * qb + 16 * ap + rr) * 1024 + h * 64 + ch * 8) = w; }
        LDS_WAIT(); asm volatile("" ::: "memory");
    }
}
__device__ __forceinline__ void mem_wg_item(Frame& F, int b, int h, int qblk) {
    int lane_ = F.lane, tid_ = F.tid; asm volatile("" : "+v"(lane_), "+v"(tid_));
    const int lane = lane_, c = lane & 15, q = lane >> 4, tid = tid_, w = F.wave;
    const bf16_t* Kg = (const bf16_t*)(F.ws + WS_MEMKV) + (size_t)(b * 256) * 2048 + h * 256;
    const bf16_t* VTg = (const bf16_t*)(F.ws + WS_MVT) + (size_t)((b * 4 + h) * 256) * 256;
    const bf16_t* MQ = (const bf16_t*)(F.ws + WS_MQ); const bf16_t* MZ = (const bf16_t*)(F.ws + WS_MZ); bf16_t* OM = (bf16_t*)(F.ws + WS_OM);
    LAS unsigned char* L = F.lds;
    __syncthreads();
#pragma unroll
    for (int hf = 0; hf < 2; ++hf) { u32x4 kr[8];
#pragma unroll
        for (int u = 0; u < 8; ++u) { const int p = tid + 512 * (u + 8 * hf), key = p >> 5, ch = p & 31; kr[u] = *(const u32x4*)(Kg + (size_t)key * 2048 + ch * 8); }
#pragma unroll
        for (int u = 0; u < 8; ++u) { const int p = tid + 512 * (u + 8 * hf), key = p >> 5, ch = p & 31; *(LAS u32x4*)(L + key * 512 + ((ch ^ (key & 15)) << 4)) = kr[u]; } }
    __syncthreads();
    size_t qrow[2];
#pragma unroll
    for (int t = 0; t < 2; ++t) qrow[t] = (size_t)b * SEQ + 256 * qblk + 32 * w + 16 * t + c;
    f32x4 sacc[2][16];
#pragma unroll
    for (int mt = 0; mt < 16; ++mt) { sacc[0][mt] = (f32x4){0.f, 0.f, 0.f, 0.f}; sacc[1][mt] = (f32x4){0.f, 0.f, 0.f, 0.f}; }
    bf16x8 qn0 = *(const bf16x8*)(MQ + qrow[0] * 1024 + h * 256 + 8 * q), qn1 = *(const bf16x8*)(MQ + qrow[1] * 1024 + h * 256 + 8 * q);
#pragma unroll 1
    for (int s = 0; s < 8; ++s) {
        const bf16x8 q0 = qn0, q1 = qn1; const int sn = s < 7 ? s + 1 : 7;
        qn0 = *(const bf16x8*)(MQ + qrow[0] * 1024 + h * 256 + 32 * sn + 8 * q); qn1 = *(const bf16x8*)(MQ + qrow[1] * 1024 + h * 256 + 32 * sn + 8 * q);
#pragma unroll
        for (int mt = 0; mt < 16; ++mt) { const int row = 16 * mt + c;
            const bf16x8 kf = *(const LAS bf16x8*)(L + row * 512 + (((4 * s + q) ^ (row & 15)) << 4));
            sacc[0][mt] = mfma16(kf, q0, sacc[0][mt]); sacc[1][mt] = mfma16(kf, q1, sacc[1][mt]); }
        asm volatile("" ::: "memory");
    }
    float inv[2]; bf16x8 pf[2][8];
    const float sc = 0.0625f * 1.4426950408889634f;
#pragma unroll
    for (int t = 0; t < 2; ++t) { float mx = -INFINITY;
#pragma unroll
        for (int mt = 0; mt < 16; ++mt) mx = fmaxf(mx, fmaxf(fmaxf(sacc[t][mt][0], sacc[t][mt][1]), fmaxf(sacc[t][mt][2], sacc[t][mt][3])));
        mx = fmaxf(mx, __shfl_xor(mx, 16)); mx = fmaxf(mx, __shfl_xor(mx, 32));
        float sum = 0.f;
#pragma unroll
        for (int mt = 0; mt < 16; ++mt)
#pragma unroll
            for (int r = 0; r < 4; ++r) { const float e = exp2f((sacc[t][mt][r] - mx) * sc); sacc[t][mt][r] = e; sum += e; }
        sum += __shfl_xor(sum, 16); sum += __shfl_xor(sum, 32); inv[t] = 1.f / sum;
#pragma unroll
        for (int ks = 0; ks < 8; ++ks) pf[t][ks] = cat8(pack4(sacc[t][2 * ks]), pack4(sacc[t][2 * ks + 1])); }
    __syncthreads();
#pragma unroll
    for (int hf = 0; hf < 2; ++hf) { u32x4 vr[8];
#pragma unroll
        for (int u = 0; u < 8; ++u) { const int p = tid + 512 * (u + 8 * hf), d = p >> 5, c16 = p & 31; vr[u] = *(const u32x4*)(VTg + (size_t)d * 256 + c16 * 8); }
#pragma unroll
        for (int u = 0; u < 8; ++u) { const int p = tid + 512 * (u + 8 * hf), d = p >> 5, c16 = p & 31; *(LAS u32x4*)(L + d * 512 + (((2 * c16) ^ (2 * (d & 15))) << 3)) = vr[u]; } }
    __syncthreads();
    LAS bf16_t* ow = (LAS bf16_t*)(F.lds + 131072 + w * 2048);
#pragma unroll 1
    for (int dg = 0; dg < 4; ++dg) {
        f32x4 oacc1[4];
#pragma unroll
        for (int d4 = 0; d4 < 4; ++d4) { const int dt = 4 * dg + d4; f32x4 o0 = {0.f, 0.f, 0.f, 0.f}, o1 = {0.f, 0.f, 0.f, 0.f}; const int dd = 16 * dt + c; const LAS unsigned char* vrow = L + dd * 512; const int sw = 2 * (dd & 15);
#pragma unroll
            for (int ks = 0; ks < 8; ++ks) { const bf16x8 vf = cat8(*(const LAS u32x2*)(vrow + (((8 * ks + q) ^ sw) << 3)), *(const LAS u32x2*)(vrow + (((8 * ks + 4 + q) ^ sw) << 3)));
                o0 = mfma16(vf, pf[0][ks], o0); o1 = mfma16(vf, pf[1][ks], o1); }
            *(LAS u32x2*)(ow + c * 64 + 16 * d4 + 4 * q) = pack4(o0 * inv[0]); oacc1[d4] = o1 * inv[1]; }
#pragma unroll
        for (int t = 0; t < 2; ++t) {
            u32x4 zz[2];
#pragma unroll
            for (int u = 0; u < 2; ++u) { const int p = lane + 64 * u; zz[u] = *(const u32x4*)(MZ + ((size_t)b * SEQ + 256 * qblk + 32 * w + 16 * t + (p >> 3)) * 1024 + h * 256 + 64 * dg + (p & 7) * 8); }
            if (t == 1) {
#pragma unroll
                for (int d4 = 0; d4 < 4; ++d4) *(LAS u32x2*)(ow + c * 64 + 16 * d4 + 4 * q) = pack4(oacc1[d4]); }
            LDS_WAIT();
#pragma unroll
            for (int u = 0; u < 2; ++u) { const int p = lane + 64 * u, rr = p >> 3, ch = p & 7; const u32x4 pv = *(const LAS u32x4*)(ow + rr * 64 + ch * 8), z = zz[u]; u32x4 wv;
                wv.x = pk2(bf2f(pv.x & 0xffffu) * bf2f(z.x & 0xffffu), bf2f(pv.x >> 16) * bf2f(z.x >> 16)); wv.y = pk2(bf2f(pv.y & 0xffffu) * bf2f(z.y & 0xffffu), bf2f(pv.y >> 16) * bf2f(z.y >> 16));
                wv.z = pk2(bf2f(pv.z & 0xffffu) * bf2f(z.z & 0xffffu), bf2f(pv.z >> 16) * bf2f(z.z >> 16)); wv.w = pk2(bf2f(pv.w & 0xffffu) * bf2f(z.w & 0xffffu), bf2f(pv.w >> 16) * bf2f(z.w >> 16));
                *(u32x4*)(OM + ((size_t)b * SEQ + 256 * qblk + 32 * w + 16 * t + rr) * 1024 + h * 256 + 64 * dg + ch * 8) = wv; }
            LDS_WAIT(); asm volatile("" ::: "memory");
        }
    }
}
__device__ __forceinline__ void p2_attn_prompt(Frame& F, int wk, int nwk) {
    const int gw = wk * NWAVES + F.wave, NGW = nwk * NWAVES, lane = F.lane;
    for (int it = wk; it < 256; it += nwk) { const int qblk = it & 31, bh = it >> 5; mem_wg_item(F, bh >> 2, bh & 3, qblk); }
    __syncthreads();
    { LAS float* BTl = (LAS float*)(F.lds + LDS_BT); const float* BT = (const float*)(F.ws + WS_BTAB); for (int i = F.tid; i < 2048; i += NTHREADS) BTl[i] = BT[i]; }
    __syncthreads();
    for (int it = wk; it < 256; it += nwk) { const int qb = it & 63, bk = it >> 6; swa_wg_item(F, bk >> 1, bk & 1, qb); }
    __syncthreads();
    const bf16_t* SKV = (const bf16_t*)(F.ws + WS_SKV);
    for (int it = gw; it < 256; it += NGW) { const int b = it >> 7, j = it & 127; const bf16_t* pp = SKV + (size_t)(b * SEQ + SEQ - 128 + j) * 256;
        for (int cc = lane; cc < 128; cc += 64) { F.out[O_SKP + ((size_t)b * 128 + j) * 128 + cc] = bf2f(pp[cc]); F.out[O_SVP + ((size_t)b * 128 + j) * 128 + cc] = bf2f(pp[128 + cc]); } }
}
__device__ __forceinline__ void p2_swa_sample(Frame& F, int wk, int nwk) {
    const int gw = wk * NWAVES + F.wave, NGW = nwk * NWAVES, lane = F.lane;
    const bf16_t* SKV = (const bf16_t*)(F.ws + WS_SKV);
    for (int it = gw; it < MS * 2; it += NGW) { const int r = it >> 1, kv = it & 1; swa_wave_item(F, true, r >> 2, r & 3, kv); }
    { const u32x4* s4 = (const u32x4*)(F.ws + WS_OMS); u32x4* d4 = (u32x4*)(F.ws + WS_OM + (size_t)MP * 1024 * 2); for (int i = gw * 64 + lane; i < MS * 1024 / 8; i += NGW * 64) d4[i] = s4[i]; }
    { const int gt = gw * 64 + lane, NT = NGW * 64;
        for (int i = gt; i < 128 * 124 * 32; i += NT) { const int bd = i / (124 * 32), e = i - bd * (124 * 32);
            __builtin_nontemporal_store(__builtin_nontemporal_load((const f32x4*)(F.in[I_CSK] + (size_t)bd * 16384 + 512) + e), (f32x4*)(F.out + O_SKS + (size_t)bd * 16384) + e);
            __builtin_nontemporal_store(__builtin_nontemporal_load((const f32x4*)(F.in[I_CSV] + (size_t)bd * 16384 + 512) + e), (f32x4*)(F.out + O_SVS + (size_t)bd * 16384) + e); }
        for (int i = gt; i < 128 * 4 * 128; i += NT) { const int bd = i >> 9, jj = (i >> 7) & 3, cc = i & 127; const bf16_t* pp = SKV + (size_t)(MP + bd * 4 + jj) * 256;
            F.out[O_SKS + ((size_t)bd * 128 + 124 + jj) * 128 + cc] = bf2f(pp[cc]); F.out[O_SVS + ((size_t)bd * 128 + 124 + jj) * 128 + cc] = bf2f(pp[128 + cc]); } }
}
__device__ __forceinline__ void mem_sample_item(Frame& F, int bd, int hp) {
    const int lane = F.lane, w = F.wave, tid = F.tid, hl = lane >> 5, h = 2 * hp + hl, d0 = (lane & 31) * 8;
    const bf16_t* MQ = (const bf16_t*)(F.ws + WS_MQ); const bf16_t* MZ = (const bf16_t*)(F.ws + WS_MZ); bf16_t* OM = (bf16_t*)(F.ws + WS_OM);
    LAS float* lg = (LAS float*)F.lds;
    LAS float* isum = lg + 2048;
    LAS float* po = isum + 8;
    float qr[4][8];
#pragma unroll
    for (int s = 0; s < 4; ++s) { const u32x4 v = *(const u32x4*)(MQ + (size_t)(MP + bd * 4 + s) * 1024 + h * 256 + d0);
        qr[s][0] = bf2f(v.x & 0xffffu); qr[s][1] = bf2f(v.x >> 16); qr[s][2] = bf2f(v.y & 0xffffu); qr[s][3] = bf2f(v.y >> 16);
        qr[s][4] = bf2f(v.z & 0xffffu); qr[s][5] = bf2f(v.z >> 16); qr[s][6] = bf2f(v.w & 0xffffu); qr[s][7] = bf2f(v.w >> 16); }
    const float* Kc = F.in[I_CMK] + ((size_t)bd * 256 * 4 + h) * 256 + d0; const float* Vc = F.in[I_CMV] + ((size_t)bd * 256 * 4 + h) * 256 + d0;
#pragma unroll 4
    for (int i = 0; i < 32; ++i) { const int m = w + 8 * i; const f32x4 k0 = __builtin_nontemporal_load((const f32x4*)(Kc + (size_t)m * 1024)), k1 = __builtin_nontemporal_load((const f32x4*)(Kc + (size_t)m * 1024 + 4));
        float l[4];
#pragma unroll
        for (int s = 0; s < 4; ++s) { float a = k0.x * qr[s][0] + k0.y * qr[s][1] + k0.z * qr[s][2] + k0.w * qr[s][3] + k1.x * qr[s][4] + k1.y * qr[s][5] + k1.z * qr[s][6] + k1.w * qr[s][7];
#pragma unroll
            for (int o = 1; o < 32; o <<= 1) a += __shfl_xor(a, o);
            l[s] = a * 0.0625f; }
        if ((lane & 31) == 0) {
#pragma unroll
            for (int s = 0; s < 4; ++s) lg[(hl * 4 + s) * 256 + m] = l[s]; } }
    __syncthreads();
    { const int pr = w; float l4[4];
#pragma unroll
        for (int u = 0; u < 4; ++u) l4[u] = lg[pr * 256 + lane + 64 * u];
        const float mx = wave_max(fmaxf(fmaxf(l4[0], l4[1]), fmaxf(l4[2], l4[3]))); float s = 0.f;
#pragma unroll
        for (int u = 0; u < 4; ++u) { l4[u] = __expf(l4[u] - mx); s += l4[u]; lg[pr * 256 + lane + 64 * u] = l4[u]; }
        s = wave_sum(s); if (lane == 0) isum[pr] = 1.f / s; }
    __syncthreads();
    float o[4][8];
#pragma unroll
    for (int s = 0; s < 4; ++s)
#pragma unroll
        for (int j = 0; j < 8; ++j) o[s][j] = 0.f;
#pragma unroll 4
    for (int i = 0; i < 32; ++i) { const int m = w + 8 * i; const f32x4 v0 = __builtin_nontemporal_load((const f32x4*)(Vc + (size_t)m * 1024)), v1 = __builtin_nontemporal_load((const f32x4*)(Vc + (size_t)m * 1024 + 4));
#pragma unroll
        for (int s = 0; s < 4; ++s) { const float p = lg[(hl * 4 + s) * 256 + m];
            o[s][0] += p * v0.x; o[s][1] += p * v0.y; o[s][2] += p * v0.z; o[s][3] += p * v0.w; o[s][4] += p * v1.x; o[s][5] += p * v1.y; o[s][6] += p * v1.z; o[s][7] += p * v1.w; } }
#pragma unroll
    for (int s = 0; s < 4; ++s) { LAS float* pp = po + ((w * 4 + s) * 512 + hl * 256 + d0);
        *(LAS f32x4*)pp = (f32x4){o[s][0], o[s][1], o[s][2], o[s][3]}; *(LAS f32x4*)(pp + 4) = (f32x4){o[s][4], o[s][5], o[s][6], o[s][7]}; }
    __syncthreads();
#pragma unroll
    for (int u = 0; u < 4; ++u) { const int e = tid + 512 * u, s = e >> 9, cc = e & 511; float a = 0.f;
#pragma unroll
        for (int ww = 0; ww < 8; ++ww) a += po[(ww * 4 + s) * 512 + cc];
        const int hh = 2 * hp + (cc >> 8); const size_t oo = (size_t)(MP + bd * 4 + s) * 1024 + hh * 256 + (cc & 255);
        ((bf16_t*)(F.ws + WS_OMS))[oo - (size_t)MP * 1024] = (bf16_t)f2bf(a * isum[(cc >> 8) * 4 + s] * bf2f(MZ[oo])); }
    __syncthreads();
}

struct SchedP3 {
    int G, c; const unsigned char* ws;
    static constexpr bool DYN = false;
    __device__ __forceinline__ int ntiles(const pg8::Unit& u) const { return u.pm < 64 ? 1024 / 64 : 512 / 64; }
    __device__ __forceinline__ bool next(int i, pg8::Unit& u) const {
        if (i < 6) { const int round = i / 3, b = i - round * 3; pg8::tile_of(round * G + c, 64, 8, u.pm, u.pn, WGM_P3); u.job = b; return true; }
        if (i == 6 && c < 96) { u.pm = 64 + c / 48; const int rem = c % 48; u.pn = rem / 6; u.job = rem % 6; return true; }
        return false;
    }
    __device__ __forceinline__ void ptrs(const pg8::Unit& u, const char*& A, const char*& B) const {
        const int b = u.job % 3; const size_t ko = (size_t)(u.job / 3) * 512 * 2;
        A = (const char*)ws + WS_OG + (size_t)b * M * 1024 * 2 + (size_t)u.pm * 256 * 1024 * 2 + ko;
        B = (const char*)ws + WS_WB + (size_t)b * 2048 * 1024 * 2 + (size_t)u.pn * 256 * 1024 * 2 + ko;
    }
};
struct EpiP3 {
    unsigned char* ws;
    __device__ __forceinline__ void operator()(const f32x4 (&acc)[2][2][4][2], const pg8::Unit& u, int wr, int wc, int fr, int fq) const {
        const int row0 = u.pm * 256 + wr * 64 + fr, col0 = u.pn * 256 + wc * 32 + 8 * fq, b = u.job % 3;
        const bf16_t* GT = (const bf16_t*)(ws + WS_GATES); bf16_t* MG = (bf16_t*)(ws + WS_MERGED);
        const bool rmw = (b > 0) && (u.pm < 64);
#pragma unroll
        for (int ai = 0; ai < 2; ++ai) {
            u32x4 g[4][2], p[4][2];
#pragma unroll
            for (int m = 0; m < 4; ++m)
#pragma unroll
                for (int bj = 0; bj < 2; ++bj) { const int r = row0 + ai * 128 + m * 16, c = col0 + bj * 128;
                    g[m][bj] = *(const u32x4*)(GT + (size_t)r * 6144 + b * 2048 + c);
                    p[m][bj] = rmw ? *(const u32x4*)(MG + (size_t)r * 2048 + c) : (u32x4){0u, 0u, 0u, 0u}; }
#pragma unroll
            for (int m = 0; m < 4; ++m)
#pragma unroll
                for (int bj = 0; bj < 2; ++bj) { const int r = row0 + ai * 128 + m * 16, c = col0 + bj * 128;
                    const u32x4 gg = g[m][bj], pp = p[m][bj];
                    f32x4 v0 = acc[ai][bj][m][0], v1 = acc[ai][bj][m][1];
                    v0[0] = v0[0] * bf2f(gg.x & 0xffffu) + bf2f(pp.x & 0xffffu); v0[1] = v0[1] * bf2f(gg.x >> 16) + bf2f(pp.x >> 16); v0[2] = v0[2] * bf2f(gg.y & 0xffffu) + bf2f(pp.y & 0xffffu); v0[3] = v0[3] * bf2f(gg.y >> 16) + bf2f(pp.y >> 16);
                    v1[0] = v1[0] * bf2f(gg.z & 0xffffu) + bf2f(pp.z & 0xffffu); v1[1] = v1[1] * bf2f(gg.z >> 16) + bf2f(pp.z >> 16); v1[2] = v1[2] * bf2f(gg.w & 0xffffu) + bf2f(pp.w & 0xffffu); v1[3] = v1[3] * bf2f(gg.w >> 16) + bf2f(pp.w >> 16);
                    u32x4 w; w.x = pg8::cvt_pk_bf16(v0[0], v0[1]); w.y = pg8::cvt_pk_bf16(v0[2], v0[3]); w.z = pg8::cvt_pk_bf16(v1[0], v1[1]); w.w = pg8::cvt_pk_bf16(v1[2], v1[3]);
                    u32x4* mp = u.pm < 64 ? (u32x4*)(MG + (size_t)r * 2048 + c) : (u32x4*)((bf16_t*)(ws + WS_PS) + ((size_t)u.job * MS + (r - MP)) * 2048 + c);
                    *mp = w; }
        }
    }
};

struct SchedP4 {
    int G, c; const unsigned char* ws;
    static constexpr bool DYN = false;
    __device__ __forceinline__ int ntiles(const pg8::Unit& u) const { return u.job == 0 ? D / 64 : 256 / 64; }
    __device__ __forceinline__ bool next(int i, pg8::Unit& u) const {
        if (i < 2) { pg8::tile_of(i * G + c, 64, 8, u.pm, u.pn, WGM_P4); u.job = 0; return true; }
        if (i == 2 && c < 128) { u.pm = 64 + c / 64; const int rem = c % 64; u.pn = rem / 8; u.job = 1 + (rem & 7); return true; }
        return false;
    }
    __device__ __forceinline__ void ptrs(const pg8::Unit& u, const char*& A, const char*& B) const {
        const size_t ko = u.job == 0 ? 0 : (size_t)(u.job - 1) * 256 * 2;
        A = (const char*)ws + WS_MERGED + (size_t)u.pm * 256 * 2048 * 2 + ko; B = (const char*)ws + WS_WO + (size_t)u.pn * 256 * 2048 * 2 + ko;
    }
};
struct EpiP4 {
    unsigned char* ws; float* out; const float* xp; const float* xs;
    __device__ __forceinline__ void operator()(const f32x4 (&acc)[2][2][4][2], const pg8::Unit& u, int wr, int wc, int fr, int fq) const {
        const int row0 = u.pm * 256 + wr * 64 + fr, col0 = u.pn * 256 + wc * 32 + 8 * fq;
        if (u.job != 0) {
#pragma unroll
            for (int ai = 0; ai < 2; ++ai)
#pragma unroll
                for (int m = 0; m < 4; ++m) { const int r = row0 + ai * 128 + m * 16; float* yp = (float*)(ws + WS_YP) + ((size_t)(u.job - 1) * MS + (r - MP)) * D;
#pragma unroll
                    for (int bj = 0; bj < 2; ++bj) { const int c = col0 + bj * 128; *(f32x4*)(yp + c) = acc[ai][bj][m][0]; *(f32x4*)(yp + c + 4) = acc[ai][bj][m][1]; } }
            return;
        }
        bf16_t* DL = (bf16_t*)(ws + WS_DELTA);
#pragma unroll
        for (int ai = 0; ai < 2; ++ai)
#pragma unroll
            for (int m = 0; m < 4; ++m) { bf16_t* dr = DL + (size_t)(row0 + ai * 128 + m * 16) * D + col0;
#pragma unroll
                for (int bj = 0; bj < 2; ++bj) { const f32x4 v0 = acc[ai][bj][m][0], v1 = acc[ai][bj][m][1];
                    u32x4 w; w.x = pg8::cvt_pk_bf16(v0[0], v0[1]); w.y = pg8::cvt_pk_bf16(v0[2], v0[3]); w.z = pg8::cvt_pk_bf16(v1[0], v1[1]); w.w = pg8::cvt_pk_bf16(v1[2], v1[3]);
                    *(u32x4*)(dr + bj * 128) = w; } }
    }
};
__device__ __forceinline__ void p3_combine_sample(Frame& F) {
    const u32x4* ps = (const u32x4*)(F.ws + WS_PS); u32x4* mg = (u32x4*)(F.ws + WS_MERGED + (size_t)MP * 2048 * 2);
    constexpr int NV = MS * 2048 / 8;
    for (int i = F.bid * NTHREADS + F.tid; i < NV; i += F.G * NTHREADS) {
        u32x4 a[6];
#pragma unroll
        for (int k = 0; k < 6; ++k) a[k] = ps[(size_t)k * NV + i];
        float s[8];
#pragma unroll
        for (int e = 0; e < 8; ++e) s[e] = 0.f;
#pragma unroll
        for (int k = 0; k < 6; ++k) { s[0] += bf2f(a[k].x & 0xffffu); s[1] += bf2f(a[k].x >> 16); s[2] += bf2f(a[k].y & 0xffffu); s[3] += bf2f(a[k].y >> 16);
            s[4] += bf2f(a[k].z & 0xffffu); s[5] += bf2f(a[k].z >> 16); s[6] += bf2f(a[k].w & 0xffffu); s[7] += bf2f(a[k].w >> 16); }
        u32x4 o; o.x = pk2(s[0], s[1]); o.y = pk2(s[2], s[3]); o.z = pk2(s[4], s[5]); o.w = pk2(s[6], s[7]);
        mg[i] = o; }
}
__device__ __forceinline__ void p5_final_norm(Frame& F) {
    const int gw = F.bid * NWAVES + F.wave, NGW = F.G * NWAVES, lane = F.lane;
    const f32x4* wn = (const f32x4*)F.in[I_NORMF] + lane;
    for (int r = gw; r < M; r += NGW) {
        f32x4* y = (f32x4*)(F.out + (size_t)r * D) + lane;
        f32x4 v[8]; float s = 0.f;
        if (r >= MP) { const f32x4* xs4 = (const f32x4*)(F.in[I_XS] + (size_t)(r - MP) * D) + lane; const f32x4* yp4 = (const f32x4*)((const float*)(F.ws + WS_YP) + (size_t)(r - MP) * D) + lane;
#pragma unroll
            for (int j = 0; j < 8; ++j) { f32x4 a = xs4[64 * j];
#pragma unroll
                for (int kq = 0; kq < 8; ++kq) a = a + yp4[(size_t)kq * MS * D / 4 + 64 * j];
                v[j] = a; s += (a.x * a.x + a.y * a.y) + (a.z * a.z + a.w * a.w); } }
        else { const f32x4* xp4 = (const f32x4*)(F.in[I_XP] + (size_t)r * D) + lane; const u32x2* dl = (const u32x2*)((const bf16_t*)(F.ws + WS_DELTA) + (size_t)r * D) + lane;
#pragma unroll
            for (int j = 0; j < 8; ++j) { const u32x2 dd = __builtin_nontemporal_load(dl + 64 * j); f32x4 a = __builtin_nontemporal_load(xp4 + 64 * j);
                a.x += bf2f(dd.x & 0xffffu); a.y += bf2f(dd.x >> 16); a.z += bf2f(dd.y & 0xffffu); a.w += bf2f(dd.y >> 16);
                v[j] = a; s += (a.x * a.x + a.y * a.y) + (a.z * a.z + a.w * a.w); } }
        const float sc = rsqrtf(wave_sum(s) * (1.f / D) + EPS);
#pragma unroll
        for (int j = 0; j < 8; ++j) { const f32x4 w = wn[64 * j]; f32x4 o = v[j]; o.x *= sc * w.x; o.y *= sc * w.y; o.z *= sc * w.z; o.w *= sc * w.w; y[64 * j] = o; }
    }
}

constexpr int N_PHASES = 10;
__global__ void __launch_bounds__(NTHREADS, 2) hybrid_fwd(Args args) {
    extern __shared__ __attribute__((aligned(16))) unsigned char lds_raw[];
    cg::grid_group grid = cg::this_grid();
    Frame F;
    F.lds = (LAS unsigned char*)lds_raw; F.tid = threadIdx.x; F.lane = F.tid & 63; F.wave = __builtin_amdgcn_readfirstlane(F.tid >> 6);
    F.G = gridDim.x; F.bid = blockIdx.x; F.in = args.in; F.out = args.out; F.ws = args.ws;
    const int lo = args.ph_lo, hi = args.ph_hi;
    if (lo < 0) grid.sync();
    if (F.tid < 64) ((LAS unsigned*)(F.lds + LDS_CTL))[F.tid] = 0u;
    __syncthreads();
    const XcdBarrier bar = xcd_barrier_post((unsigned*)(F.ws + WS_CTL), (volatile LAS unsigned*)(F.lds + LDS_CTL));
#define IN(k) (lo <= (k) && (k) < hi)
#define SEAM(k) do { if (IN(k) && IN((k) + 1)) xcd_barrier(bar); } while (0)
    if (IN(0)) p0_prologue(F);
    SEAM(0);
    if (IN(1)) { SchedP1 S{F.G, F.bid, F.ws, (const unsigned char*)F.out + DO_XN, (unsigned*)(F.ws + WS_CTL + 16384) + (F.bid & 7) * 16}; EpiP1 E{F.ws, F.out}; pg8::gemm_phase<EpiP1, SchedP1>(F.lds, D, S, E); }
    SEAM(1);
    if (IN(2)) { p2_conv(F); __syncthreads(); for (int it = F.bid; it < 256; it += F.G) mem_sample_item(F, it >> 1, it & 1); }
    SEAM(2);
    if (IN(3)) p2_prep(F);
    SEAM(3);
    if (IN(4)) {
        constexpr int GSPLIT = GSPLIT_V;
        if (F.bid < 128) { scan_item(F, F.bid & 15, F.bid >> 4); __syncthreads(); p2_gdn_sample(F, F.bid, 128, 0, GSPLIT); __syncthreads(); late_weight_items(F, F.bid, 128); }
        else { const int wk = F.bid - 128, nwk = F.G - 128; p2_attn_prompt(F, wk, nwk); __syncthreads(); p2_swa_sample(F, wk, nwk); __syncthreads(); p2_gdn_sample(F, wk, nwk, GSPLIT, 1024); }
    }
    SEAM(4);
    if (IN(5)) { for (int it = F.bid; it < 256; it += F.G) gdn_out_item(F, it); p2_gdn_norm_sample(F); }
    SEAM(5);
    if (IN(6)) { SchedP3 S{F.G, F.bid, F.ws}; EpiP3 E{F.ws}; pg8::gemm_phase<EpiP3, SchedP3, ALIGN_P3>(F.lds, 1024, S, E); }
    SEAM(6);
    if (IN(7)) p3_combine_sample(F);
    SEAM(7);
    if (IN(8)) { SchedP4 S{F.G, F.bid, F.ws}; EpiP4 E{F.ws, F.out, F.in[I_XP], F.in[I_XS]}; pg8::gemm_phase<EpiP4, SchedP4, ALIGN_P4>(F.lds, D, S, E); }
    SEAM(8);
    if (IN(9)) p5_final_norm(F);
#undef IN
#undef SEAM
}

extern "C" void kernel_launch(void* const* d_in, const int* in_sizes, int n_in, void* d_out, int out_size, void* d_ws, size_t ws_size, hipStream_t stream) {
    static int grid = 0;
    if (grid == 0) {
        if (n_in != 22 || out_size != (int)O_END || ws_size < WS_END) { fprintf(stderr, "kernel_launch: unexpected shapes (n_in %d out %d ws %zu need %zu)\n", n_in, out_size, ws_size, (size_t)WS_END); grid = -1; return; }
        int dev = 0, cus = 0, per_cu = 0;
        hipGetDevice(&dev); hipDeviceGetAttribute(&cus, hipDeviceAttributeMultiprocessorCount, dev);
        hipFuncSetAttribute((const void*)hybrid_fwd, hipFuncAttributeMaxDynamicSharedMemorySize, LDS_BYTES);
        hipOccupancyMaxActiveBlocksPerMultiprocessor(&per_cu, (const void*)hybrid_fwd, NTHREADS, LDS_BYTES);
        if (per_cu < 1) { fprintf(stderr, "kernel_launch: occupancy query says %d blocks per CU\n", per_cu); grid = -1; return; }
        grid = cus;
    }
    if (grid < 0) return;
    Args a{};
    for (int i = 0; i < 22; ++i) a.in[i] = (const float*)d_in[i];
    a.out = (float*)d_out; a.ws = (unsigned char*)d_ws;
    if (hipMemsetAsync((char*)d_ws + WS_CTL, 0, 16384 + 4096, stream) != hipSuccess) { fprintf(stderr, "kernel_launch: hipMemsetAsync failed\n"); return; }
#if MK_N_LAUNCHES == 1
    a.ph_lo = 0; a.ph_hi = N_PHASES;
    void* kargs[] = {&a};
    hipError_t e = hipLaunchCooperativeKernel((const void*)hybrid_fwd, dim3(grid), dim3(NTHREADS), kargs, LDS_BYTES, stream);
    if (e != hipSuccess) fprintf(stderr, "cooperative launch failed: %s (grid %d)\n", hipGetErrorString(e), grid);
#endif
}
```
